# Optimizing an MI355X kernel written in HIP

```python
import math
import jax
import jax.numpy as jnp
from jax import lax
import numpy as np

D_MODEL = 1024
BATCH = 16
SEQ = 2048
DEPTH = 2

GRID_W = 64
CTX_LEN = 256
NA_HEADS = 8
NA_HEAD_DIM = 64
NA_WIN_H = 8
NA_WIN_W = 16
DIFF_HEADS = 4
DIFF_DIM = 64
A_WIDTH = NA_HEADS * NA_HEAD_DIM
B_WIDTH = DIFF_HEADS * 2 * DIFF_DIM
ATTN_IN = 3 * (A_WIDTH + B_WIDTH)
Q_BLOCK = 128
ROPE_THETA = 10000.0
SC_WIDTH = 512
SC_K = 3
CF_WIDTH = 512
CF_K = 31
CONV_IN = 3 * SC_WIDTH + 2 * CF_WIDTH
N_EXPERTS = 16
D_EXPERT = 2816
CAPACITY_FACTOR = 2
EPS = 1e-6

kernel_name = 'hybrid_flow_backbone'


def rmsnorm(x, g):
    xf = x.astype(jnp.float32)
    xf = xf * lax.rsqrt(jnp.mean(xf * xf, axis=-1, keepdims=True) + EPS)
    return xf.astype(x.dtype) * g


def layernorm(x, g, b):
    xf = x.astype(jnp.float32)
    mu = jnp.mean(xf, axis=-1, keepdims=True)
    var = jnp.mean(jnp.square(xf - mu), axis=-1, keepdims=True)
    return ((xf - mu) * lax.rsqrt(var + EPS)).astype(x.dtype) * g + b


def modulate(h, shift, scale):
    return h * (1 + scale[..., None, :]) + shift[..., None, :]


def axial_rope(x, row, col):
    half = x.shape[-1] // 2
    n_freq = half // 2
    freqs = ROPE_THETA ** (-jnp.arange(n_freq, dtype=jnp.float32) / n_freq)
    bshape = (x.shape[1],) + (1,) * (x.ndim - 3) + (n_freq,)

    def rotate(xa, pos):
        ang = (pos.astype(jnp.float32)[:, None] * freqs).reshape(bshape)
        cos = jnp.cos(ang).astype(x.dtype)
        sin = jnp.sin(ang).astype(x.dtype)
        x1, x2 = xa[..., :n_freq], xa[..., n_freq:]
        return jnp.concatenate([x1 * cos - x2 * sin, x1 * sin + x2 * cos], axis=-1)

    return jnp.concatenate([rotate(x[..., :half], row), rotate(x[..., half:], col)], axis=-1)


def neighbourhood_attention(q, k, v, k_ctx, v_ctx, rpb):
    bn, n, h, d = q.shape
    rows = n // GRID_W
    kh = min(NA_WIN_H, rows)
    kw = NA_WIN_W
    scale = d ** -0.5
    qg = q.reshape(bn, rows, GRID_W, h, d)
    kg = k.reshape(bn, rows, GRID_W, h, d)
    vg = v.reshape(bn, rows, GRID_W, h, d)
    col = np.arange(GRID_W)
    col_idx = np.clip(col - kw // 2, 0, GRID_W - kw)[:, None] + np.arange(kw)[None, :]
    dc = col_idx - col[:, None] + (NA_WIN_W - 1)
    rpb_c = rpb[:, :, dc]

    def row_fn(r):
        rs = jnp.clip(r - kh // 2, 0, rows - kh)
        q_r = lax.dynamic_index_in_dim(qg, r, axis=1, keepdims=False)
        k_band = lax.dynamic_slice_in_dim(kg, rs, kh, axis=1)
        v_band = lax.dynamic_slice_in_dim(vg, rs, kh, axis=1)
        k_win = k_band[:, :, col_idx]
        v_win = v_band[:, :, col_idx]
        dr = rs + jnp.arange(kh) - r + (NA_WIN_H - 1)
        bias = jnp.take(rpb_c, dr, axis=1).transpose(0, 2, 1, 3)
        s_win = (jnp.einsum('bqhd,brqchd->bhqrc', q_r, k_win).astype(jnp.float32) * scale
                 + bias[None].astype(jnp.float32))
        s_ctx = jnp.einsum('bqhd,bkhd->bhqk', q_r, k_ctx).astype(jnp.float32) * scale
        s = jnp.concatenate([s_win.reshape(bn, h, GRID_W, kh * kw), s_ctx], axis=-1)
        p = jax.nn.softmax(s, axis=-1).astype(v.dtype)
        p_win = p[..., :kh * kw].reshape(bn, h, GRID_W, kh, kw)
        p_ctx = p[..., kh * kw:]
        return (jnp.einsum('bhqrc,brqchd->bqhd', p_win, v_win)
                + jnp.einsum('bhqk,bkhd->bqhd', p_ctx, v_ctx))

    out = lax.map(row_fn, jnp.arange(rows))
    return out.transpose(1, 0, 2, 3, 4).reshape(bn, n, h, d)


def differential_attention(q, k, v, k_ctx, v_ctx, lam, lam_init, subln):
    bn, n, h, _, d = q.shape
    scale = d ** -0.5
    k_all = jnp.concatenate([k, k_ctx], axis=1)
    v_all = jnp.concatenate([v, v_ctx], axis=1)
    qb = q.reshape(bn, n // Q_BLOCK, Q_BLOCK, h, 2, d).transpose(1, 0, 2, 3, 4, 5)

    def block_fn(q_blk):
        s = jnp.einsum('bqhmd,bkhmd->bhmqk', q_blk, k_all).astype(jnp.float32) * scale
        p = jax.nn.softmax(s, axis=-1)
        a = (p[:, :, 0] - lam * p[:, :, 1]).astype(v_all.dtype)
        return jnp.einsum('bhqk,bkhe->bqhe', a, v_all)

    out = lax.map(block_fn, qb).transpose(1, 0, 2, 3, 4).reshape(bn, n, h, 2 * d)
    return rmsnorm(out, subln) * (1.0 - lam_init)


def attention_mixers(h, hc, w_in, w_out, rpb, lam_q1, lam_k1, lam_q2, lam_k2, subln, lam_init):
    bn, n, _ = h.shape
    nc = hc.shape[1]
    z = h @ w_in
    cuts = np.cumsum([A_WIDTH, B_WIDTH, A_WIDTH, B_WIDTH, A_WIDTH])
    aq, bq, ak, bk, av, bv = jnp.split(z, cuts, axis=-1)
    zc = hc @ w_in[:, A_WIDTH + B_WIDTH:]
    ak_c, bk_c, av_c, bv_c = jnp.split(zc, np.cumsum([A_WIDTH, B_WIDTH, A_WIDTH]), axis=-1)
    t = jnp.arange(n)
    row, col = t // GRID_W, t % GRID_W
    y_a = neighbourhood_attention(
        aq.reshape(bn, n, NA_HEADS, NA_HEAD_DIM), ak.reshape(bn, n, NA_HEADS, NA_HEAD_DIM),
        av.reshape(bn, n, NA_HEADS, NA_HEAD_DIM), ak_c.reshape(bn, nc, NA_HEADS, NA_HEAD_DIM),
        av_c.reshape(bn, nc, NA_HEADS, NA_HEAD_DIM), rpb)
    lam = (jnp.exp(jnp.sum((lam_q1 * lam_k1).astype(jnp.float32)))
           - jnp.exp(jnp.sum((lam_q2 * lam_k2).astype(jnp.float32))) + lam_init)
    qd = axial_rope(bq.reshape(bn, n, DIFF_HEADS, 2, DIFF_DIM), row, col)
    kd = axial_rope(bk.reshape(bn, n, DIFF_HEADS, 2, DIFF_DIM), row, col)
    y_b = differential_attention(
        qd, kd, bv.reshape(bn, n, DIFF_HEADS, 2 * DIFF_DIM),
        bk_c.reshape(bn, nc, DIFF_HEADS, 2, DIFF_DIM), bv_c.reshape(bn, nc, DIFF_HEADS, 2 * DIFF_DIM),
        lam, lam_init, subln)
    y = jnp.concatenate([y_a.reshape(bn, n, A_WIDTH), y_b.reshape(bn, n, B_WIDTH)], axis=-1)
    return y @ w_out


def depthwise_conv(x, w):
    kk = w.shape[0]
    return lax.conv_general_dilated(
        x, w[:, None, :], window_strides=(1,), padding=[(kk // 2, kk // 2)],
        dimension_numbers=('NWC', 'WIO', 'NWC'), feature_group_count=x.shape[-1])


def conv_mixers(h, w_in, w_out, sc_w, cf_w, cf_b, ln_g, ln_b):
    z = h @ w_in
    cuts = np.cumsum([SC_WIDTH, SC_WIDTH, SC_WIDTH, CF_WIDTH])
    xc, gate_b, gate_c, glu_a, glu_g = jnp.split(z, cuts, axis=-1)
    y_c = gate_b * depthwise_conv(gate_c * xc, sc_w)
    u = glu_a * jax.nn.sigmoid(glu_g)
    u = depthwise_conv(u, cf_w) + cf_b
    y_d = jax.nn.silu(layernorm(u, ln_g, ln_b))
    return jnp.concatenate([y_c, y_d], axis=-1) @ w_out


def expert_choice_ffn(h, w_router, w1, w3, w2):
    bn, n, d = h.shape
    cap = CAPACITY_FACTOR * n // N_EXPERTS
    aff = jax.nn.softmax((h @ w_router).astype(jnp.float32), axis=-1)
    g, idx = lax.top_k(aff.transpose(0, 2, 1), cap)
    xin = jax.vmap(lambda hb, ib: hb[ib])(h, idx)
    hid = (jax.nn.silu(jnp.einsum('becd,edf->becf', xin, w1))
           * jnp.einsum('becd,edf->becf', xin, w3))
    y = jnp.einsum('becf,efd->becd', hid, w2) * g[..., None].astype(h.dtype)
    return jax.vmap(
        lambda ib, yb: jnp.zeros((n, d), yb.dtype).at[ib.reshape(-1)].add(yb.reshape(-1, d))
    )(idx, y)


def setup_inputs(seed: int = 0) -> dict:
    key = jax.random.key(seed)
    keys = iter(jax.random.split(key, 48))
    D = D_MODEL

    def nrm(shape, scale):
        return jax.random.normal(next(keys), shape, jnp.float32) * scale

    def gain(n):
        return 1.0 + nrm((n,), 0.02)

    inp = {}
    inp['x'] = nrm((BATCH, SEQ, D), 1.0)
    inp['c'] = nrm((BATCH, D), 1.0)
    inp['ctx'] = nrm((BATCH, CTX_LEN, D), 1.0)
    inp['c_ctx'] = nrm((D,), 1.0)
    inp['l0_norm1'] = gain(D)
    inp['l0_w_mod'] = nrm((D, 6 * D), 0.5 * D ** -0.5)
    inp['l0_b_mod'] = nrm((6 * D,), 0.01)
    inp['l0_w_in'] = nrm((D, ATTN_IN), D ** -0.5)
    inp['l0_w_out'] = nrm((A_WIDTH + B_WIDTH, D), (A_WIDTH + B_WIDTH) ** -0.5)
    inp['l0_rpb'] = nrm((NA_HEADS, 2 * NA_WIN_H - 1, 2 * NA_WIN_W - 1), 0.1)
    inp['l0_lam_q1'] = nrm((DIFF_DIM,), 0.1)
    inp['l0_lam_k1'] = nrm((DIFF_DIM,), 0.1)
    inp['l0_lam_q2'] = nrm((DIFF_DIM,), 0.1)
    inp['l0_lam_k2'] = nrm((DIFF_DIM,), 0.1)
    inp['l0_subln'] = gain(2 * DIFF_DIM)
    inp['l0_norm2'] = gain(D)
    inp['l0_w_router'] = nrm((D, N_EXPERTS), D ** -0.5)
    inp['l0_w1'] = nrm((N_EXPERTS, D, D_EXPERT), D ** -0.5)
    inp['l0_w3'] = nrm((N_EXPERTS, D, D_EXPERT), D ** -0.5)
    inp['l0_w2'] = nrm((N_EXPERTS, D_EXPERT, D), D_EXPERT ** -0.5)
    inp['l1_norm1'] = gain(D)
    inp['l1_w_mod'] = nrm((D, 6 * D), 0.5 * D ** -0.5)
    inp['l1_b_mod'] = nrm((6 * D,), 0.01)
    inp['l1_w_in'] = nrm((D, CONV_IN), D ** -0.5)
    inp['l1_w_out'] = nrm((SC_WIDTH + CF_WIDTH, D), (SC_WIDTH + CF_WIDTH) ** -0.5)
    inp['l1_sc_w'] = nrm((SC_K, SC_WIDTH), SC_K ** -0.5)
    inp['l1_cf_w'] = nrm((CF_K, CF_WIDTH), CF_K ** -0.5)
    inp['l1_cf_b'] = nrm((CF_WIDTH,), 0.01)
    inp['l1_ln_g'] = gain(CF_WIDTH)
    inp['l1_ln_b'] = nrm((CF_WIDTH,), 0.01)
    inp['l1_norm2'] = gain(D)
    inp['l1_w_router'] = nrm((D, N_EXPERTS), D ** -0.5)
    inp['l1_w1'] = nrm((N_EXPERTS, D, D_EXPERT), D ** -0.5)
    inp['l1_w3'] = nrm((N_EXPERTS, D, D_EXPERT), D ** -0.5)
    inp['l1_w2'] = nrm((N_EXPERTS, D_EXPERT, D), D_EXPERT ** -0.5)
    inp['final_norm'] = gain(D)
    return inp


def reference(x, c, ctx, c_ctx,
              l0_norm1, l0_w_mod, l0_b_mod, l0_w_in, l0_w_out, l0_rpb,
              l0_lam_q1, l0_lam_k1, l0_lam_q2, l0_lam_k2, l0_subln,
              l0_norm2, l0_w_router, l0_w1, l0_w3, l0_w2,
              l1_norm1, l1_w_mod, l1_b_mod, l1_w_in, l1_w_out,
              l1_sc_w, l1_cf_w, l1_cf_b, l1_ln_g, l1_ln_b,
              l1_norm2, l1_w_router, l1_w1, l1_w3, l1_w2,
              final_norm):
    layers = [
        dict(norm1=l0_norm1, w_mod=l0_w_mod, b_mod=l0_b_mod, w_in=l0_w_in, w_out=l0_w_out,
             rpb=l0_rpb, lam_q1=l0_lam_q1, lam_k1=l0_lam_k1, lam_q2=l0_lam_q2, lam_k2=l0_lam_k2,
             subln=l0_subln, norm2=l0_norm2, w_router=l0_w_router, w1=l0_w1, w3=l0_w3, w2=l0_w2),
        dict(norm1=l1_norm1, w_mod=l1_w_mod, b_mod=l1_b_mod, w_in=l1_w_in, w_out=l1_w_out,
             sc_w=l1_sc_w, cf_w=l1_cf_w, cf_b=l1_cf_b, ln_g=l1_ln_g, ln_b=l1_ln_b,
             norm2=l1_norm2, w_router=l1_w_router, w1=l1_w1, w3=l1_w3, w2=l1_w2),
    ]
    silu_c = jax.nn.silu(c)
    silu_c_ctx = jax.nn.silu(c_ctx)
    for l in range(DEPTH):
        p = layers[l]
        mod = silu_c @ p['w_mod'] + p['b_mod']
        shift1, scale1, gate1, shift2, scale2, gate2 = jnp.split(mod, 6, axis=-1)
        h = modulate(rmsnorm(x, p['norm1']), shift1, scale1)
        if l % 2 == 0:
            ctx_mod = silu_c_ctx @ p['w_mod'][:, :2 * D_MODEL] + p['b_mod'][:2 * D_MODEL]
            ctx_shift, ctx_scale = jnp.split(ctx_mod, 2)
            hc = modulate(rmsnorm(ctx, p['norm1']), ctx_shift, ctx_scale)
            lam_init = 0.8 - 0.6 * math.exp(-0.3 * l)
            y = attention_mixers(h, hc, p['w_in'], p['w_out'], p['rpb'], p['lam_q1'], p['lam_k1'],
                                 p['lam_q2'], p['lam_k2'], p['subln'], lam_init)
        else:
            y = conv_mixers(h, p['w_in'], p['w_out'], p['sc_w'], p['cf_w'], p['cf_b'],
                            p['ln_g'], p['ln_b'])
        x = x + gate1[:, None, :] * y
        h = modulate(rmsnorm(x, p['norm2']), shift2, scale2)
        x = x + gate2[:, None, :] * expert_choice_ffn(h, p['w_router'], p['w1'], p['w3'], p['w2'])
    return rmsnorm(x, final_norm)
```

```cpp
#include <hip/hip_runtime.h>
#include <cstdio>
#include <cstdint>

#define LAS __attribute__((address_space(3)))
#define GAS __attribute__((address_space(1)))
typedef _Float16 f16;
typedef _Float16 f16x8 __attribute__((ext_vector_type(8)));
typedef _Float16 f16x4 __attribute__((ext_vector_type(4)));
typedef _Float16 f16x2 __attribute__((ext_vector_type(2)));
typedef float f32x2 __attribute__((ext_vector_type(2)));
typedef float f32x4 __attribute__((ext_vector_type(4)));
typedef float f32x16 __attribute__((ext_vector_type(16)));
typedef unsigned u32x2 __attribute__((ext_vector_type(2)));
typedef unsigned u32x4 __attribute__((ext_vector_type(4)));
typedef short s16x4 __attribute__((ext_vector_type(4)));

#ifndef N_LAUNCH_MODE
#define N_LAUNCH_MODE 0
#endif

constexpr int NB = 16, SEQ = 2048, DM = 1024, NTOK = NB * SEQ, CTXL = 256, NCTX = NB * CTXL, NROWS = NTOK + NCTX;
constexpr int ZP0 = 3072, ZP1 = 2560;
constexpr int NE = 16, DE = 2816, CAP = 256, EROWS = NB * CAP;
constexpr float EPS = 1e-6f;
constexpr float LOG2E = 1.4426950408889634f;
constexpr float QSCALE = 0.125f * LOG2E;

constexpr size_t MiB = 1u << 20;
constexpr size_t WS_CTL = 0, CTL_ZERO_BYTES = 256 * 1024;
constexpr size_t WS_MOD = 1 * MiB;
constexpr size_t MOD0_OFF = 0, MOD1_OFF = 17 * 6144 * 4, ROPE_OFF = MOD1_OFF + 16 * 6144 * 4, LAM_OFF = ROPE_OFF + 64 * 16 * 2 * 4;
constexpr size_t WS_WIN0 = 2 * MiB, WS_WOUT0 = 8 * MiB, WS_WIN1 = 10 * MiB, WS_WOUT1 = 15 * MiB;
constexpr size_t WS_AFF = 17 * MiB;
constexpr size_t WS_IDX = 19 * MiB;
constexpr size_t WS_G = 19 * MiB + 512 * 1024;
constexpr size_t WS_INV = 20 * MiB;
constexpr size_t WS_W13 = 22 * MiB;
constexpr size_t WS_W2 = WS_W13 + 176 * MiB;
constexpr size_t WS_H = WS_W2 + 88 * MiB;
constexpr size_t WS_XIN = WS_H + 72 * MiB;
constexpr size_t WS_Y2 = WS_XIN + 128 * MiB;
constexpr size_t WS_BIG = WS_Y2 + 128 * MiB;
constexpr size_t WS_Z = WS_BIG, WS_Y = WS_BIG + 216 * MiB, WS_HID = WS_BIG;
constexpr size_t WS_END = WS_BIG + 352 * MiB;

constexpr int RING_BYTES = 131072;
constexpr int LDSCTL_OFF = RING_BYTES, MISC_OFF = LDSCTL_OFF + 320;
constexpr int LDS_BYTES = 147456;

#define RLX_AGENT __ATOMIC_RELAXED, __HIP_MEMORY_SCOPE_AGENT
#define LDS_WAIT() asm volatile("s_waitcnt lgkmcnt(0)" ::: "memory")
#define VM_WAIT() asm volatile("s_waitcnt vmcnt(0)" ::: "memory")

__device__ __forceinline__ unsigned pkh(float lo, float hi) { f16x2 v; v.x = (f16)lo; v.y = (f16)hi; return __builtin_bit_cast(unsigned, v); }
__device__ __forceinline__ float silu_f(float v) { return v / (1.f + __expf(-v)); }

#define XB_TMO      128
#define XB_XCNT(j)  (256  + 64 * (j))
#define XB_XSUB(j)  (1280 + 64 * (j))
#define XB_XGEN(j)  (2304 + 64 * (j))
#define XB_TOP      3328
#define XB_TOPGEN   3392
#define XCD_BAR_WORDS 3456
#define XB_SPIN_CAP (1u << 18)
__device__ __forceinline__ unsigned xb_ld(unsigned* p)              { return __hip_atomic_load(p, __ATOMIC_RELAXED, __HIP_MEMORY_SCOPE_AGENT); }
__device__ __forceinline__ unsigned xb_add(unsigned* p, unsigned v) { return __hip_atomic_fetch_add(p, v, __ATOMIC_RELAXED, __HIP_MEMORY_SCOPE_AGENT); }
__device__ __forceinline__ unsigned xb_xcc_id() { return (unsigned)__builtin_amdgcn_s_getreg((3 << 11) | 20) & 0xFu; }
#define XB_SPIN(cond, bar) do { unsigned _sp = 0; while (cond) { __builtin_amdgcn_s_sleep(1); \
    if ((++_sp & 255u) == 0u) { if (xb_ld(&(bar)[XB_TMO])) break; if (_sp > XB_SPIN_CAP) { atomicAdd(&(bar)[XB_TMO], 1u); break; } } } } while (0)
struct XcdBarrier { unsigned* bar; unsigned x; volatile LAS unsigned* st; };
__device__ __forceinline__ XcdBarrier xcd_barrier_post(unsigned* bar, volatile LAS unsigned* st) {
    XcdBarrier b; b.bar = bar; b.x = xb_xcc_id(); b.st = st;
    if (threadIdx.x == 0) (void)xb_add(&bar[XB_XCNT(b.x)], 1u);
    return b;
}
__device__ __forceinline__ void xcd_barrier_complete(unsigned* bar, unsigned x, unsigned& nloc, unsigned& nx) {
    const unsigned G = gridDim.x * gridDim.y * gridDim.z;
    unsigned sum, cnt, mine, sp = 0u;
    for (;;) {
        sum = 0u; cnt = 0u; mine = 0u;
#pragma unroll
        for (unsigned j = 0; j < 16; ++j) { const unsigned c = xb_ld(&bar[XB_XCNT(j)]); sum += c; cnt += (c > 0u) ? 1u : 0u; mine = (j == x) ? c : mine; }
        if (sum == G) break;
        __builtin_amdgcn_s_sleep(1);
        if ((++sp & 255u) == 0u) { if (xb_ld(&bar[XB_TMO])) break; if (sp > XB_SPIN_CAP) { atomicAdd(&bar[XB_TMO], 1u); break; } }
    }
    nloc = mine > 0u ? mine : 1u; nx = cnt > 0u ? cnt : 1u;
}
__device__ __forceinline__ void xcd_barrier(const XcdBarrier& b) {
    asm volatile("s_waitcnt vmcnt(0)" ::: "memory");
    __syncthreads();
    if (threadIdx.x == 0) {
        unsigned* bar = b.bar;
        __builtin_amdgcn_s_waitcnt(0);
        unsigned nloc = b.st[0], nx = b.st[1];
        if (nloc == 0u) { xcd_barrier_complete(bar, b.x, nloc, nx); b.st[0] = nloc; b.st[1] = nx; }
        const unsigned old = xb_add(&bar[XB_XSUB(b.x)], 1u);
        const unsigned gen = old / nloc;
        if (old + 1u == (gen + 1u) * nloc) {
            __builtin_amdgcn_fence(__ATOMIC_RELEASE, "agent");
            asm volatile("s_waitcnt vmcnt(0)" ::: "memory");
            const unsigned og = xb_add(&bar[XB_TOP], 1u);
            const unsigned tg = og / nx;
            if (og + 1u == (tg + 1u) * nx) xb_add(&bar[XB_TOPGEN], 1u);
            else XB_SPIN(xb_ld(&bar[XB_TOPGEN]) == tg, bar);
            __builtin_amdgcn_fence(__ATOMIC_ACQUIRE, "agent");
            xb_add(&bar[XB_XGEN(b.x)], 1u);
            asm volatile("s_waitcnt vmcnt(0)" ::: "memory");
        } else {
            XB_SPIN(xb_ld(&bar[XB_XGEN(b.x)]) == gen, bar);
            __builtin_amdgcn_fence(__ATOMIC_ACQUIRE, "agent");
            asm volatile("s_waitcnt vmcnt(0)" ::: "memory");
        }
    }
    __syncthreads();
}

namespace gm {
constexpr int BM = 256, BK = 64, HALF = 128, HTB = HALF * BK * 2, STAGE_BYTES = 8 * HTB, NXCD = 8, WGM = 8;
__host__ __device__ __forceinline__ int lds_byte(int r, int c) { const int st = (r >> 4) * 2 + (c >> 5), rr = r & 15, cc = c & 31, ob = rr * 64 + cc * 2; return st * 1024 + (ob ^ (((ob >> 9) & 1) << 5)); }
__host__ __device__ __forceinline__ void stage_rc(int b, int& R, int& C) { const int st = b / 1024, sb = b % 1024, swz = sb ^ (((sb >> 9) & 1) << 5); R = (st >> 1) * 16 + swz / 64; C = (st & 1) * 32 + (swz % 64) / 2; }
__host__ __device__ __forceinline__ int perm32(int rho) { const int n = rho >> 4, i = rho & 15; return 8 * (i >> 2) + 4 * n + (i & 3); }

struct Unit { int g, pm, pn; };
struct Gemm { const f16* A; const f16* Bt; int K; long sA, sB; };
struct Order {
    int nM, nN, tpg, total, G, c;
    __device__ void init(int M, int N, int groups, int G_, int c_) { nM = M / BM; nN = N / BM; tpg = nM * nN; total = tpg * groups; G = G_; c = c_; }
    __device__ bool next(int i, Unit& u) const {
        const long L = (long)i * G + c; if (L >= total) return false;
        const int g = (int)(L / tpg); int wgid = (int)(L % tpg);
        { const int q = tpg / NXCD, r = tpg % NXCD, xcd = wgid % NXCD, off = wgid / NXCD; wgid = (xcd < r ? xcd * (q + 1) : r * (q + 1) + (xcd - r) * q) + off; }
        const int nig = WGM * nN, gid = wgid / nig, fm = gid * WGM, gsz = (nM - fm) < WGM ? (nM - fm) : WGM;
        u.g = g; u.pm = fm + ((wgid % nig) % gsz); u.pn = (wgid % nig) / gsz; return true;
    }
};

typedef f32x4 Acc[2][2][4][2];

struct EpiF16 {
    static constexpr bool PERM = true;
    f16* O; int ldc;
    __device__ __forceinline__ void operator()(const Acc& acc, const Unit& u, int wr, int wc, int fr, int fq) const {
        const int row0 = u.pm * BM + wr * 64 + fr, col0 = u.pn * BM + wc * 32 + 8 * fq;
#pragma unroll
        for (int ai = 0; ai < 2; ++ai)
#pragma unroll
            for (int m = 0; m < 4; ++m) { f16* rowp = O + (size_t)(row0 + ai * HALF + m * 16) * ldc + col0;
#pragma unroll
                for (int bj = 0; bj < 2; ++bj) { const f32x4 v0 = acc[ai][bj][m][0], v1 = acc[ai][bj][m][1];
                    u32x4 w; w.x = pkh(v0[0], v0[1]); w.y = pkh(v0[2], v0[3]); w.z = pkh(v1[0], v1[1]); w.w = pkh(v1[2], v1[3]);
                    *(u32x4*)(rowp + bj * HALF) = w; } }
    }
};
struct EpiInProj0 {
    static constexpr bool PERM = true;
    f16* O; const float* rope;
    __device__ __forceinline__ void operator()(const Acc& acc, const Unit& u, int wr, int wc, int fr, int fq) const {
        const int row0 = u.pm * BM + wr * 64 + fr, col0 = u.pn * BM + wc * 32 + 8 * fq;
        const float sc = (u.pn < 4) ? QSCALE : 1.f;
        const bool dorope = (u.pn == 2 || u.pn == 3 || u.pn == 6 || u.pn == 7) && (u.pm * BM < NTOK);
#pragma unroll
        for (int ai = 0; ai < 2; ++ai)
#pragma unroll
            for (int m = 0; m < 4; ++m) { const int row = row0 + ai * HALF + m * 16; f16* rowp = O + (size_t)row * ZP0 + col0;
                const int t = row & (SEQ - 1), prow = t >> 6, pcol = t & 63;
#pragma unroll
                for (int bj = 0; bj < 2; ++bj) { f32x4 v0 = acc[ai][bj][m][0] * sc, v1 = acc[ai][bj][m][1] * sc;
                    if (dorope) { const int c = col0 + bj * HALF, half = (c >> 5) & 1, i0 = (c & 31) >> 1; const int pos = half ? pcol : prow;
                        const f32x4* tp = (const f32x4*)(rope + (pos * 16 + i0) * 2); const f32x4 t0 = tp[0], t1 = tp[1];
                        f32x4 r0, r1;
                        r0[0] = v0[0] * t0[0] - v0[1] * t0[1]; r0[1] = v0[0] * t0[1] + v0[1] * t0[0];
                        r0[2] = v0[2] * t0[2] - v0[3] * t0[3]; r0[3] = v0[2] * t0[3] + v0[3] * t0[2];
                        r1[0] = v1[0] * t1[0] - v1[1] * t1[1]; r1[1] = v1[0] * t1[1] + v1[1] * t1[0];
                        r1[2] = v1[2] * t1[2] - v1[3] * t1[3]; r1[3] = v1[2] * t1[3] + v1[3] * t1[2];
                        v0 = r0; v1 = r1; }
                    u32x4 w; w.x = pkh(v0[0], v0[1]); w.y = pkh(v0[2], v0[3]); w.z = pkh(v1[0], v1[1]); w.w = pkh(v1[2], v1[3]);
                    *(u32x4*)(rowp + bj * HALF) = w; } }
    }
};
struct EpiResGate {
    static constexpr bool PERM = false;
    const float* base; float* out; const float* gate; int gstride;
    __device__ __forceinline__ void operator()(const Acc& acc, const Unit& u, int wr, int wc, int fr, int fq) const {
        const int col0 = u.pn * BM + wc * 32 + 4 * fq; const int b = (u.pm * BM) / SEQ;
        f32x4 gv[2][2];
#pragma unroll
        for (int bj = 0; bj < 2; ++bj)
#pragma unroll
            for (int n = 0; n < 2; ++n) gv[bj][n] = *(const f32x4*)(gate + (size_t)b * gstride + col0 + bj * HALF + n * 16);
#pragma unroll
        for (int ai = 0; ai < 2; ++ai)
#pragma unroll
            for (int m = 0; m < 4; ++m) { const size_t off = (size_t)(u.pm * BM + ai * HALF + wr * 64 + m * 16 + fr) * DM + col0;
#pragma unroll
                for (int bj = 0; bj < 2; ++bj)
#pragma unroll
                    for (int n = 0; n < 2; ++n) { const f32x4 bs = *(const f32x4*)(base + off + bj * HALF + n * 16);
                        *(f32x4*)(out + off + bj * HALF + n * 16) = bs + gv[bj][n] * acc[ai][bj][m][n]; }
                if (m & 1) asm volatile("" ::: "memory"); }
    }
};
struct EpiSwiGLU {
    static constexpr bool PERM = true;
    f16* O;
    __device__ __forceinline__ void operator()(const Acc& acc, const Unit& u, int wr, int wc, int fr, int fq) const {
        const int row0 = u.pm * BM + wr * 64 + fr, col0 = u.pn * HALF + wc * 32 + 8 * fq;
        f16* Og = O + (size_t)u.g * EROWS * DE;
#pragma unroll
        for (int ai = 0; ai < 2; ++ai)
#pragma unroll
            for (int m = 0; m < 4; ++m) { f16* rowp = Og + (size_t)(row0 + ai * HALF + m * 16) * DE + col0;
                float h[8];
#pragma unroll
                for (int n = 0; n < 2; ++n)
#pragma unroll
                    for (int j = 0; j < 4; ++j) { const float g = acc[ai][0][m][n][j], up = acc[ai][1][m][n][j]; h[n * 4 + j] = g * up / (1.f + __expf(-g)); }
                u32x4 w; w.x = pkh(h[0], h[1]); w.y = pkh(h[2], h[3]); w.z = pkh(h[4], h[5]); w.w = pkh(h[6], h[7]);
                *(u32x4*)rowp = w; }
    }
};
struct EpiRowScale {
    static constexpr bool PERM = true;
    f16* O; const float* gv;
    __device__ __forceinline__ void operator()(const Acc& acc, const Unit& u, int wr, int wc, int fr, int fq) const {
        const int row0 = u.pm * BM + wr * 64 + fr, col0 = u.pn * BM + wc * 32 + 8 * fq;
        f16* Og = O + (size_t)u.g * EROWS * DM;
#pragma unroll
        for (int ai = 0; ai < 2; ++ai)
#pragma unroll
            for (int m = 0; m < 4; ++m) { const int row = row0 + ai * HALF + m * 16; const float s = gv[((row >> 8) * NE + u.g) * CAP + (row & 255)];
                f16* rowp = Og + (size_t)row * DM + col0;
#pragma unroll
                for (int bj = 0; bj < 2; ++bj) { const f32x4 v0 = acc[ai][bj][m][0] * s, v1 = acc[ai][bj][m][1] * s;
                    u32x4 w; w.x = pkh(v0[0], v0[1]); w.y = pkh(v0[2], v0[3]); w.z = pkh(v1[0], v1[1]); w.w = pkh(v1[2], v1[3]);
                    *(u32x4*)(rowp + bj * HALF) = w; } }
    }
};

template <class Epi>
__device__ __forceinline__ void gemm_phase(LAS unsigned char* lds, const Gemm g, const Order& S, const Epi& E) {
    const int tid = threadIdx.x, wid = __builtin_amdgcn_readfirstlane(tid >> 6), lane = tid & 63, wr = wid >> 2, wc = wid & 3, fr = lane & 15, fq = lane >> 4;
    const int K = g.K, nt = K / BK;
    unsigned voffA[2], voffB[2];
#pragma unroll
    for (int i = 0; i < 2; ++i) { int R, C; stage_rc(tid * 16 + i * 8192, R, C); const int Rb = Epi::PERM ? ((R & ~31) + perm32(R & 31)) : R;
        voffA[i] = (unsigned)(R * K + C) * 2u; voffB[i] = (unsigned)(Rb * K + C) * 2u; }
    const size_t kstep = (size_t)(BK * 2);
    const size_t hstep = (size_t)HALF * K * 2;
    const size_t tstep = 2 * hstep;
    const unsigned ldsw = (unsigned)wid * 1024u;
    const int aoff = lds_byte(wr * 64 + fr, fq * 8), boff = lds_byte(wc * 32 + fr, fq * 8);
#define GM_SA(b, h) (((b) * 2 + (h)) * HTB)
#define GM_SB(b, h) ((4 + (b) * 2 + (h)) * HTB)
#define GM_STAGE(bufoff, gbase, voff) do { _Pragma("unroll") for (int _i = 0; _i < 2; ++_i) \
        __builtin_amdgcn_global_load_lds((const unsigned*)((const char*)(gbase) + (voff)[_i]), (LAS unsigned*)(lds + (bufoff) + ldsw + _i * 8192), 16, 0, 0); } while (0)
#define GM_LDA(dst, b, h) do { _Pragma("unroll") for (int m = 0; m < 4; ++m) _Pragma("unroll") for (int k = 0; k < 2; ++k) dst[m][k] = *(const LAS f16x8*)(lds + GM_SA(b, h) + aoff + m * 2048 + k * 1024); } while (0)
#define GM_LDB(dst, b, h) do { _Pragma("unroll") for (int n = 0; n < 2; ++n) _Pragma("unroll") for (int k = 0; k < 2; ++k) dst[n][k] = *(const LAS f16x8*)(lds + GM_SB(b, h) + boff + n * 2048 + k * 1024); } while (0)
#define GM_MMA(ai, bj, At, Bt) do { __builtin_amdgcn_s_setprio(1); _Pragma("unroll") for (int m = 0; m < 4; ++m) _Pragma("unroll") for (int n = 0; n < 2; ++n) _Pragma("unroll") for (int k = 0; k < 2; ++k) \
        acc[ai][bj][m][n] = __builtin_amdgcn_mfma_f32_16x16x32_f16(Bt[n][k], At[m][k], acc[ai][bj][m][n], 0, 0, 0); __builtin_amdgcn_s_setprio(0); } while (0)
#define GM_WAIT_V(n) asm volatile("s_waitcnt vmcnt(" #n ")" ::: "memory")
#define GM_WAIT_L(n) asm volatile("s_waitcnt lgkmcnt(" #n ")" ::: "memory")
#define GM_BAR __builtin_amdgcn_s_barrier()
#define GM_SCHED __builtin_amdgcn_sched_barrier(0)
    Unit cur, nxt; int ui = 0;
    if (!S.next(0, cur)) return;
    Acc acc;
#pragma unroll
    for (int a = 0; a < 2; ++a)
#pragma unroll
        for (int b = 0; b < 2; ++b)
#pragma unroll
            for (int m = 0; m < 4; ++m)
#pragma unroll
                for (int n = 0; n < 2; ++n) acc[a][b][m][n] = (f32x4){0.f, 0.f, 0.f, 0.f};
    f16x8 At[4][2], B0[2][2], B1[2][2];
    const char* cA = (const char*)(g.A + (size_t)cur.g * g.sA) + (size_t)cur.pm * tstep; const char* cB = (const char*)(g.Bt + (size_t)cur.g * g.sB) + (size_t)cur.pn * tstep;
    GM_STAGE(GM_SB(0, 0), cB, voffB); GM_STAGE(GM_SB(0, 1), cB + hstep, voffB); GM_STAGE(GM_SA(0, 0), cA, voffA); GM_STAGE(GM_SA(0, 1), cA + hstep, voffA);
    if (wr == 1) GM_BAR;
    GM_WAIT_V(2); GM_BAR;
    GM_STAGE(GM_SB(1, 0), cB + kstep, voffB); GM_STAGE(GM_SA(1, 0), cA + kstep, voffA); GM_STAGE(GM_SB(1, 1), cB + hstep + kstep, voffB);
    GM_WAIT_V(6); GM_BAR;
    for (;;) {
        const bool has_next = S.next(ui + 1, nxt);
        const char* nA = has_next ? (const char*)(g.A + (size_t)nxt.g * g.sA) + (size_t)nxt.pm * tstep : cA; const char* nB = has_next ? (const char*)(g.Bt + (size_t)nxt.g * g.sB) + (size_t)nxt.pn * tstep : cB;
        for (int t = 0; t < nt; t += 2) {
            const bool last = (t == nt - 2);
            const char* a1 = cA + (size_t)(t + 1) * kstep;
            const char* a2 = last ? nA : cA + (size_t)(t + 2) * kstep; const char* b2 = last ? nB : cB + (size_t)(t + 2) * kstep;
            const char* a3 = a2 + kstep; const char* b3 = b2 + kstep;
            GM_LDB(B0, 0, 0); GM_LDB(B1, 0, 1); GM_SCHED; GM_LDA(At, 0, 0); GM_STAGE(GM_SA(1, 1), a1 + hstep, voffA);
            GM_WAIT_V(8); GM_WAIT_L(0); GM_BAR; GM_MMA(0, 0, At, B0); GM_MMA(0, 1, At, B1); GM_BAR; GM_SCHED;
            GM_LDA(At, 0, 1); GM_STAGE(GM_SB(0, 0), b2, voffB); GM_STAGE(GM_SB(0, 1), b2 + hstep, voffB); GM_STAGE(GM_SA(0, 0), a2, voffA);
            GM_WAIT_V(8); GM_WAIT_L(0); GM_BAR; GM_MMA(1, 0, At, B0); GM_MMA(1, 1, At, B1); GM_BAR; GM_SCHED;
            GM_LDB(B0, 1, 0); GM_LDB(B1, 1, 1); GM_SCHED; GM_LDA(At, 1, 0); GM_STAGE(GM_SA(0, 1), a2 + hstep, voffA);
            GM_WAIT_V(8); GM_WAIT_L(0); GM_BAR; GM_MMA(0, 0, At, B0); GM_MMA(0, 1, At, B1); GM_BAR; GM_SCHED;
            GM_LDA(At, 1, 1); GM_STAGE(GM_SB(1, 0), b3, voffB); GM_STAGE(GM_SB(1, 1), b3 + hstep, voffB); GM_STAGE(GM_SA(1, 0), a3, voffA);
            GM_WAIT_V(8); GM_WAIT_L(0); GM_BAR; GM_MMA(1, 0, At, B0); GM_MMA(1, 1, At, B1); GM_BAR; GM_SCHED;
        }
        if (wr == 0) GM_BAR;
        E(acc, cur, wr, wc, fr, fq);
        if (!has_next) break;
#pragma unroll
        for (int a = 0; a < 2; ++a)
#pragma unroll
            for (int b = 0; b < 2; ++b)
#pragma unroll
                for (int m = 0; m < 4; ++m)
#pragma unroll
                    for (int n = 0; n < 2; ++n) acc[a][b][m][n] = (f32x4){0.f, 0.f, 0.f, 0.f};
        cur = nxt; cA = nA; cB = nB; ++ui;
        if (wr == 1) GM_BAR;
    }
    GM_WAIT_V(0);
    GM_BAR;
#undef GM_SA
#undef GM_SB
#undef GM_STAGE
#undef GM_LDA
#undef GM_LDB
#undef GM_MMA
#undef GM_WAIT_V
#undef GM_WAIT_L
#undef GM_BAR
#undef GM_SCHED
}
}

struct Params { const float* in[36]; float* out; unsigned char* ws; int ph_lo, ph_hi; };
enum { I_X = 0, I_C, I_CTX, I_CCTX, I_L0_NORM1, I_L0_WMOD, I_L0_BMOD, I_L0_WIN, I_L0_WOUT, I_L0_RPB, I_L0_LQ1, I_L0_LK1, I_L0_LQ2, I_L0_LK2, I_L0_SUBLN,
       I_L0_NORM2, I_L0_WR, I_L0_W1, I_L0_W3, I_L0_W2, I_L1_NORM1, I_L1_WMOD, I_L1_BMOD, I_L1_WIN, I_L1_WOUT, I_L1_SCW, I_L1_CFW, I_L1_CFB, I_L1_LNG, I_L1_LNB,
       I_L1_NORM2, I_L1_WR, I_L1_W1, I_L1_W3, I_L1_W2, I_FNORM };

__device__ __forceinline__ float wave_sum(float v) {
#pragma unroll
    for (int o = 1; o < 64; o <<= 1) v += __shfl_xor(v, o);
    return v;
}

template <class RowMap>
__device__ __forceinline__ void cvt_item(const float* W, int K, int N, f16* WT, const RowMap& rm, int item, int lane) {
    const int nblk = N / 64, kb = item / nblk, nb = item % nblk, k0 = 64 * kb, n = 64 * nb + lane;
    const float* src = W + (size_t)k0 * N + n;
    f16* dst = WT + (size_t)rm(n) * K + k0;
#pragma unroll
    for (int c = 0; c < 8; c += 4) {
        float v[32];
#pragma unroll
        for (int j = 0; j < 32; ++j) v[j] = src[(size_t)(8 * c + j) * N];
#pragma unroll
        for (int cc = 0; cc < 4; ++cc) { u32x4 w; w.x = pkh(v[8 * cc + 0], v[8 * cc + 1]); w.y = pkh(v[8 * cc + 2], v[8 * cc + 3]); w.z = pkh(v[8 * cc + 4], v[8 * cc + 5]); w.w = pkh(v[8 * cc + 6], v[8 * cc + 7]);
            *(u32x4*)(dst + 8 * (c + cc)) = w; }
    }
}
struct MapPlain { __device__ __forceinline__ int operator()(int n) const { return n; } };
struct MapRope { __device__ __forceinline__ int operator()(int n) const {
    const bool rp = (n >= 512 && n < 1024) || (n >= 1536 && n < 2048); if (!rp) return n; const int i = n & 31; return (n & ~31) + (i < 16 ? 2 * i : 2 * (i - 16) + 1); } };
struct MapGLU { int add; __device__ __forceinline__ int operator()(int n) const { return (n >> 7) * 256 + (n & 127) + add; } };

__device__ __forceinline__ void cvt_moe(const float* w1, const float* w3, const float* w2, f16* W13, f16* W2T, int gw, int NGW, int lane) {
    constexpr int I13 = (DM / 64) * (DE / 64), I2 = (DE / 64) * (DM / 64);
    constexpr int NIT = NE * (2 * I13 + I2);
    for (int it = gw; it < NIT; it += NGW) {
        const int e = it / (2 * I13 + I2); int r = it % (2 * I13 + I2);
        if (r < I13) { cvt_item(w1 + (size_t)e * DM * DE, DM, DE, W13 + (size_t)e * 2 * DE * DM, MapGLU{0}, r, lane); continue; } r -= I13;
        if (r < I13) { cvt_item(w3 + (size_t)e * DM * DE, DM, DE, W13 + (size_t)e * 2 * DE * DM, MapGLU{128}, r, lane); continue; } r -= I13;
        cvt_item(w2 + (size_t)e * DE * DM, DE, DM, W2T + (size_t)e * DM * DE, MapPlain{}, r, lane);
    }
}

__device__ __forceinline__ void phase_prologue(const Params& p, LAS unsigned char* lds) {
    const int tid = threadIdx.x, lane = tid & 63, wave = __builtin_amdgcn_readfirstlane(tid >> 6);
    const int G = gridDim.x;
    unsigned char* ws = p.ws;
    LAS float* S = (LAS float*)lds;
    LAS float* red = (LAS float*)(lds + 17 * 1024 * 4);
    for (int u = blockIdx.x; u < 193; u += G) {
        if (u == 192) {
            float* rope = (float*)(ws + WS_MOD + ROPE_OFF);
            for (int idx = tid; idx < 1024; idx += 512) { const int pos = idx >> 4, i = idx & 15; const float fr = powf(10000.f, -(float)i / 16.f), ang = (float)pos * fr;
                rope[idx * 2] = cosf(ang); rope[idx * 2 + 1] = sinf(ang); }
            if (wave == 0) { const float s1 = wave_sum(p.in[I_L0_LQ1][lane] * p.in[I_L0_LK1][lane]), s2 = wave_sum(p.in[I_L0_LQ2][lane] * p.in[I_L0_LK2][lane]);
                if (lane == 0) *(float*)(ws + WS_MOD + LAM_OFF) = expf(s1) - expf(s2) + 0.2f; }
            continue;
        }
        const int l = u / 96, col0 = (u % 96) * 64;
        const float* wmod = p.in[l ? I_L1_WMOD : I_L0_WMOD]; const float* bmod = p.in[l ? I_L1_BMOD : I_L0_BMOD];
        float* mod = (float*)(ws + WS_MOD + (l ? MOD1_OFF : MOD0_OFF));
        for (int idx = tid; idx < 17 * 1024; idx += 512) { const float v = idx < 16 * 1024 ? p.in[I_C][idx] : p.in[I_CCTX][idx - 16 * 1024]; S[idx] = silu_f(v); }
        __syncthreads();
        float acc[17];
#pragma unroll
        for (int r = 0; r < 17; ++r) acc[r] = 0.f;
        const int kb = wave * 128;
        for (int kk = 0; kk < 128; kk += 4) {
            float wv[4];
#pragma unroll
            for (int i = 0; i < 4; ++i) wv[i] = wmod[(size_t)(kb + kk + i) * 6144 + col0 + lane];
#pragma unroll
            for (int r = 0; r < 17; ++r) { const f32x4 sv = *(const LAS f32x4*)(S + r * 1024 + kb + kk); acc[r] += sv[0] * wv[0] + sv[1] * wv[1] + sv[2] * wv[2] + sv[3] * wv[3]; }
        }
#pragma unroll
        for (int r = 0; r < 17; ++r) red[(wave * 17 + r) * 64 + lane] = acc[r];
        __syncthreads();
        for (int idx = tid; idx < 17 * 64; idx += 512) { const int r = idx >> 6, ln = idx & 63; float s = bmod[col0 + ln];
#pragma unroll
            for (int w = 0; w < 8; ++w) s += red[(w * 17 + r) * 64 + ln];
            if (r < 16 || l == 0) mod[(size_t)r * 6144 + col0 + ln] = s; }
        __syncthreads();
    }
    const int gw = blockIdx.x * 8 + wave, NGW = G * 8;
    constexpr int IT_IN0 = (DM / 64) * (ZP0 / 64), IT_OUT = (DM / 64) * (DM / 64), IT_IN1 = (DM / 64) * (ZP1 / 64);
    for (int it = gw; it < IT_IN0 + 2 * IT_OUT + IT_IN1; it += NGW) {
        int r = it;
        if (r < IT_IN0) { cvt_item(p.in[I_L0_WIN], DM, ZP0, (f16*)(ws + WS_WIN0), MapRope{}, r, lane); continue; } r -= IT_IN0;
        if (r < IT_OUT) { cvt_item(p.in[I_L0_WOUT], DM, DM, (f16*)(ws + WS_WOUT0), MapPlain{}, r, lane); continue; } r -= IT_OUT;
        if (r < IT_IN1) { cvt_item(p.in[I_L1_WIN], DM, ZP1, (f16*)(ws + WS_WIN1), MapPlain{}, r, lane); continue; } r -= IT_IN1;
        cvt_item(p.in[I_L1_WOUT], DM, DM, (f16*)(ws + WS_WOUT1), MapPlain{}, r, lane);
    }
    cvt_moe(p.in[I_L0_W1], p.in[I_L0_W3], p.in[I_L0_W2], (f16*)(ws + WS_W13), (f16*)(ws + WS_W2), gw, NGW, lane);
}

struct NormArgs {
    const float* src;
    float* xout;
    const f16* y2; const short* inv; const float* gate2;
    const float* gain;
    const float* shift; const float* scale; int mstride;
    f16* hout;
    float* fout;
    const float* wr; float* aff;
};

__device__ __forceinline__ void norm_phase(const NormArgs& a, LAS unsigned char* lds, int nrows_total, bool ctx_rows, const float* ctx_src, const float* ctx_shift, const float* ctx_scale) {
    const int tid = threadIdx.x, lane = tid & 63, wave = __builtin_amdgcn_readfirstlane(tid >> 6);
    const int G = gridDim.x;
    LAS float* wl = (LAS float*)lds;
    if (a.wr) {
        for (int idx = tid; idx < 16384; idx += 512) { const int k = idx >> 4, e = idx & 15; wl[e * 1028 + k] = a.wr[idx]; }
        __syncthreads();
    }
    const int gw = blockIdx.x * 8 + wave, NGW = G * 8;
    for (int chunk = gw; chunk < NTOK / 16; chunk += NGW) {
        const int row0 = chunk * 16, b = row0 / SEQ;
        f32x4 A[4], Sh[4], G2[4];
#pragma unroll
        for (int j = 0; j < 4; ++j) { const int c = 4 * lane + 256 * j; const f32x4 g = *(const f32x4*)(a.gain + c);
            if (a.shift) { const f32x4 sc = *(const f32x4*)(a.scale + (size_t)b * a.mstride + c); A[j] = g * (sc + 1.f); Sh[j] = *(const f32x4*)(a.shift + (size_t)b * a.mstride + c); }
            else { A[j] = g; Sh[j] = (f32x4){0.f, 0.f, 0.f, 0.f}; }
            if (a.y2) G2[j] = *(const f32x4*)(a.gate2 + (size_t)b * 6144 + c); else G2[j] = (f32x4){0.f, 0.f, 0.f, 0.f}; }
        for (int rr = 0; rr < 16; rr += 2) {
            f32x4 v[2][4];
#pragma unroll
            for (int q = 0; q < 2; ++q) { const int row = row0 + rr + q; const float* xr = a.src + (size_t)row * DM;
#pragma unroll
                for (int j = 0; j < 4; ++j) v[q][j] = *(const f32x4*)(xr + 4 * lane + 256 * j); }
            if (a.y2) {
#pragma unroll
                for (int q = 0; q < 2; ++q) { const int row = row0 + rr + q, t = row & (SEQ - 1);
                    int sl = -1; if (lane < 16) sl = a.inv[((size_t)b * NE + lane) * SEQ + t];
                    unsigned long long mask = __ballot(sl >= 0);
                    f32x4 cs[4];
#pragma unroll
                    for (int j = 0; j < 4; ++j) cs[j] = (f32x4){0.f, 0.f, 0.f, 0.f};
                    while (mask) {
                        int ee[4]; float wgt[4];
#pragma unroll
                        for (int i = 0; i < 4; ++i) { if (mask) { ee[i] = __builtin_ctzll(mask); mask &= mask - 1; wgt[i] = 1.f; } else { ee[i] = ee[0]; wgt[i] = 0.f; } }
                        f16x4 ld[4][4];
#pragma unroll
                        for (int i = 0; i < 4; ++i) { const int slot = __shfl(sl, ee[i]); const f16* yr = a.y2 + ((size_t)ee[i] * EROWS + b * CAP + slot) * DM + 4 * lane;
#pragma unroll
                            for (int j = 0; j < 4; ++j) ld[i][j] = *(const f16x4*)(yr + 256 * j); }
#pragma unroll
                        for (int i = 0; i < 4; ++i)
#pragma unroll
                            for (int j = 0; j < 4; ++j) { cs[j][0] += wgt[i] * (float)ld[i][j][0]; cs[j][1] += wgt[i] * (float)ld[i][j][1]; cs[j][2] += wgt[i] * (float)ld[i][j][2]; cs[j][3] += wgt[i] * (float)ld[i][j][3]; }
                    }
                    float* xo = a.xout + (size_t)row * DM;
#pragma unroll
                    for (int j = 0; j < 4; ++j) { v[q][j] = v[q][j] + G2[j] * cs[j]; if (!a.fout) *(f32x4*)(xo + 4 * lane + 256 * j) = v[q][j]; }
                }
            }
            float rstd[2];
#pragma unroll
            for (int q = 0; q < 2; ++q) { float ss = 0.f;
#pragma unroll
                for (int j = 0; j < 4; ++j) ss += (v[q][j][0] * v[q][j][0] + v[q][j][1] * v[q][j][1]) + (v[q][j][2] * v[q][j][2] + v[q][j][3] * v[q][j][3]);
                rstd[q] = 1.0f / sqrtf(wave_sum(ss) * (1.f / DM) + EPS); }
#pragma unroll
            for (int q = 0; q < 2; ++q) { const int row = row0 + rr + q;
#pragma unroll
                for (int j = 0; j < 4; ++j) v[q][j] = (v[q][j] * rstd[q]) * A[j] + Sh[j];
                if (a.fout) {
#pragma unroll
                    for (int j = 0; j < 4; ++j) *(f32x4*)(a.fout + (size_t)row * DM + 4 * lane + 256 * j) = v[q][j];
                }
                if (a.hout) {
#pragma unroll
                    for (int j = 0; j < 4; ++j) { u32x2 w; w.x = pkh(v[q][j][0], v[q][j][1]); w.y = pkh(v[q][j][2], v[q][j][3]); *(u32x2*)(a.hout + (size_t)row * DM + 4 * lane + 256 * j) = w; }
                }
            }
            if (a.wr) {
#pragma unroll 1
                for (int q = 0; q < 2; ++q) {
                    float lg[16];
                    const f32x4 h0 = q ? v[1][0] : v[0][0], h1 = q ? v[1][1] : v[0][1], h2 = q ? v[1][2] : v[0][2], h3 = q ? v[1][3] : v[0][3];
#pragma unroll
                    for (int e = 0; e < 16; ++e) { const LAS float* wp = wl + e * 1028 + 4 * lane;
                        const f32x4 w0 = *(const LAS f32x4*)(wp), w1 = *(const LAS f32x4*)(wp + 256), w2 = *(const LAS f32x4*)(wp + 512), w3 = *(const LAS f32x4*)(wp + 768);
                        lg[e] = ((h0[0] * w0[0] + h0[1] * w0[1]) + (h0[2] * w0[2] + h0[3] * w0[3])) + ((h1[0] * w1[0] + h1[1] * w1[1]) + (h1[2] * w1[2] + h1[3] * w1[3]))
                              + ((h2[0] * w2[0] + h2[1] * w2[1]) + (h2[2] * w2[2] + h2[3] * w2[3])) + ((h3[0] * w3[0] + h3[1] * w3[1]) + (h3[2] * w3[2] + h3[3] * w3[3]));
                        asm volatile("" ::: "memory"); }
#pragma unroll
                    for (int i = 0; i < 8; ++i) { const bool hi = lane & 32; const float send = hi ? lg[i] : lg[i + 8], keep = hi ? lg[i + 8] : lg[i]; lg[i] = keep + __shfl_xor(send, 32); }
#pragma unroll
                    for (int i = 0; i < 4; ++i) { const bool hi = lane & 16; const float send = hi ? lg[i] : lg[i + 4], keep = hi ? lg[i + 4] : lg[i]; lg[i] = keep + __shfl_xor(send, 16); }
#pragma unroll
                    for (int i = 0; i < 2; ++i) { const bool hi = lane & 8; const float send = hi ? lg[i] : lg[i + 2], keep = hi ? lg[i + 2] : lg[i]; lg[i] = keep + __shfl_xor(send, 8); }
                    { const bool hi = lane & 4; const float send = hi ? lg[0] : lg[1], keep = hi ? lg[1] : lg[0]; lg[0] = keep + __shfl_xor(send, 4); }
                    float lv = lg[0]; lv += __shfl_xor(lv, 2); lv += __shfl_xor(lv, 1);
                    float mx = lv;
#pragma unroll
                    for (int o = 4; o < 64; o <<= 1) mx = fmaxf(mx, __shfl_xor(mx, o));
                    const float ex = expf(lv - mx); float sm = ex;
#pragma unroll
                    for (int o = 4; o < 64; o <<= 1) sm += __shfl_xor(sm, o);
                    const int row = row0 + rr + q, t = row & (SEQ - 1), e = (lane >> 2) & 15;
                    if ((lane & 3) == 0) a.aff[((size_t)b * NE + e) * SEQ + t] = ex / sm;
                }
            }
        }
    }
    if (ctx_rows) {
        f32x4 A[4], Sh[4];
#pragma unroll
        for (int j = 0; j < 4; ++j) { const int c = 4 * lane + 256 * j; A[j] = *(const f32x4*)(a.gain + c) * (*(const f32x4*)(ctx_scale + c) + 1.f); Sh[j] = *(const f32x4*)(ctx_shift + c); }
        for (int row = gw; row < NCTX; row += NGW) {
            f32x4 v[4]; float ss = 0.f;
#pragma unroll
            for (int j = 0; j < 4; ++j) { v[j] = *(const f32x4*)(ctx_src + (size_t)row * DM + 4 * lane + 256 * j); ss += (v[j][0] * v[j][0] + v[j][1] * v[j][1]) + (v[j][2] * v[j][2] + v[j][3] * v[j][3]); }
            const float rstd = 1.0f / sqrtf(wave_sum(ss) * (1.f / DM) + EPS);
#pragma unroll
            for (int j = 0; j < 4; ++j) { const f32x4 h = (v[j] * rstd) * A[j] + Sh[j]; u32x2 w; w.x = pkh(h[0], h[1]); w.y = pkh(h[2], h[3]); *(u32x2*)(a.hout + (size_t)(NTOK + row) * DM + 4 * lane + 256 * j) = w; }
        }
    }
    (void)nrows_total;
    __syncthreads();
}

__device__ __forceinline__ void topk_phase(const float* aff, int* idx, float* gv, short* inv, const f16* H, f16* XIN, LAS unsigned char* lds) {
    const int tid = threadIdx.x, lane = tid & 63, wave = __builtin_amdgcn_readfirstlane(tid >> 6);
    LAS unsigned long long* key = (LAS unsigned long long*)lds;
    for (int u = blockIdx.x; u < NB * NE; u += gridDim.x) {
        const int b = u / NE, e = u % NE;
        const float* av = aff + (size_t)u * SEQ;
        for (int t = tid; t < SEQ; t += 512) key[t] = ((unsigned long long)(~__float_as_uint(av[t])) << 32) | (unsigned)t;
        __syncthreads();
        for (int k = 2; k <= SEQ; k <<= 1)
            for (int j = k >> 1; j > 0; j >>= 1) {
#pragma unroll
                for (int pp = 0; pp < 2; ++pp) { const int pr = tid + pp * 512; const int i = ((pr & ~(j - 1)) << 1) | (pr & (j - 1)), i2 = i | j;
                    const unsigned long long x = key[i], y = key[i2]; const bool up = (i & k) == 0;
                    if ((x > y) == up) { key[i] = y; key[i2] = x; } }
                __syncthreads();
            }
        for (int r = tid; r < SEQ; r += 512) { const unsigned long long kk = key[r]; const int t = (int)(unsigned)kk;
            inv[(size_t)u * SEQ + t] = (short)(r < CAP ? r : -1);
            if (r < CAP) { idx[u * CAP + r] = t; gv[u * CAP + r] = __uint_as_float(~(unsigned)(kk >> 32)); } }
        for (int r = wave; r < CAP; r += 8) { const int t = (int)(unsigned)key[r];
            const u32x4* s = (const u32x4*)(H + ((size_t)b * SEQ + t) * DM); u32x4* d = (u32x4*)(XIN + ((size_t)e * EROWS + b * CAP + r) * DM);
            const u32x4 v0 = s[lane], v1 = s[lane + 64]; d[lane] = v0; d[lane + 64] = v1; }
        __syncthreads();
    }
}

namespace at {
constexpr int KS = 272, VS = 320;
constexpr int KT_BYTES = 64 * KS, VT_BYTES = 64 * VS, BUF_BYTES = KT_BYTES + VT_BYTES;
constexpr int RPB_OFF = 2 * BUF_BYTES;
typedef _Float16 v4h __attribute__((ext_vector_type(4)));

__device__ __forceinline__ void stage_load(const f16* Z, long rowbase, int kcol, int vcol, u32x4 (&kr)[2], u32x4 (&vr)[2], int tid) {
#pragma unroll
    for (int i = 0; i < 2; ++i) { const int id = tid + 512 * i, row = id >> 4, ch = id & 15; const f16* rp = Z + (size_t)(rowbase + row) * ZP0 + 8 * ch;
        kr[i] = *(const u32x4*)(rp + kcol); vr[i] = *(const u32x4*)(rp + vcol); }
}
__device__ __forceinline__ void stage_store(LAS unsigned char* buf, const u32x4 (&kr)[2], const u32x4 (&vr)[2], int tid) {
#pragma unroll
    for (int i = 0; i < 2; ++i) { const int id = tid + 512 * i, row = id >> 4, ch = id & 15;
        *(LAS u32x4*)(buf + row * KS + ch * 16) = kr[i]; *(LAS u32x4*)(buf + KT_BYTES + row * VS + ch * 16) = vr[i]; }
}
__device__ __forceinline__ f32x16 qk(LAS unsigned char* buf, int kb, int kcolb, const f16x8 (&qf)[4], int lane) {
    const LAS unsigned char* kp = buf + (kb + (lane & 31)) * KS + kcolb + (lane >> 5) * 16;
    f32x16 s;
#pragma unroll
    for (int r = 0; r < 16; ++r) s[r] = 0.f;
#pragma unroll
    for (int st = 0; st < 4; ++st) { const f16x8 a = *(const LAS f16x8*)(kp + st * 32); s = __builtin_amdgcn_mfma_f32_32x32x16_f16(a, qf[st], s, 0, 0, 0); }
    return s;
}
template <int NDT>
__device__ __forceinline__ void softmax_pv(const f32x16& s, LAS unsigned char* buf, int kb, int vcolb, f32x16 (&o)[NDT], float& m, float& l, int lane) {
    float mx = s[0];
#pragma unroll
    for (int r = 1; r < 16; ++r) mx = fmaxf(mx, s[r]);
    mx = fmaxf(mx, __shfl_xor(mx, 32));
    const float mn = fmaxf(m, mx), alpha = __builtin_amdgcn_exp2f(m - mn); m = mn;
    f32x16 p; float ps = 0.f;
#pragma unroll
    for (int r = 0; r < 16; ++r) { p[r] = __builtin_amdgcn_exp2f(s[r] - mn); ps += p[r]; }
    l = l * alpha + ps;
#pragma unroll
    for (int dt = 0; dt < NDT; ++dt)
#pragma unroll
        for (int r = 0; r < 16; ++r) o[dt][r] *= alpha;
    const int hh = lane >> 5, i = lane & 15, q_ = i >> 2, p_ = i & 3, g1 = (lane >> 4) & 1;
#pragma unroll
    for (int s2 = 0; s2 < 2; ++s2) {
        f16x8 pb;
#pragma unroll
        for (int j = 0; j < 8; ++j) pb[j] = (f16)p[8 * s2 + j];
        const LAS unsigned char* vp = buf + KT_BYTES + (kb + 16 * s2 + 4 * hh + q_) * VS + vcolb + (16 * g1 + 4 * p_) * 2;
#pragma unroll
        for (int dt = 0; dt < NDT; ++dt) {
            const v4h lo = __builtin_bit_cast(v4h, __builtin_amdgcn_ds_read_tr16_b64_v4i16((LAS s16x4*)(vp + dt * 64)));
            const v4h hi = __builtin_bit_cast(v4h, __builtin_amdgcn_ds_read_tr16_b64_v4i16((LAS s16x4*)(vp + dt * 64 + 8 * VS)));
            const f16x8 a = {lo[0], lo[1], lo[2], lo[3], hi[0], hi[1], hi[2], hi[3]};
            o[dt] = __builtin_amdgcn_mfma_f32_32x32x16_f16(a, pb, o[dt], 0, 0, 0);
        }
    }
}

__device__ __forceinline__ void diff_unit(int u, const f16* Z, f16* Y, const float* subln, float lam, LAS unsigned char* lds) {
    const int tid = threadIdx.x, lane = tid & 63, wave = __builtin_amdgcn_readfirstlane(tid >> 6);
    const int qb = u & 15, h = (u >> 4) & 3, b = u >> 6;
    const int map = wave >> 2, r32 = lane & 31, hh = lane >> 5;
    const long tokbase = (long)b * SEQ;
    const long qrow = tokbase + qb * 128 + (wave & 3) * 32 + r32;
    f16x8 qf[4];
#pragma unroll
    for (int st = 0; st < 4; ++st) qf[st] = *(const f16x8*)(Z + (size_t)qrow * ZP0 + 512 + 128 * h + 64 * map + 16 * st + 8 * hh);
    f32x16 o[4];
#pragma unroll
    for (int dt = 0; dt < 4; ++dt)
#pragma unroll
        for (int r = 0; r < 16; ++r) o[dt][r] = 0.f;
    float m = -1e30f, l = 0.f;
    const int kcol = 1536 + 128 * h, vcol = 2560 + 128 * h;
    constexpr int NT = 36;
    u32x4 kr[2], vr[2];
    stage_load(Z, tokbase, kcol, vcol, kr, vr, tid);
    stage_store(lds, kr, vr, tid);
    __syncthreads();
    for (int t = 0; t < NT; ++t) {
        LAS unsigned char* buf = lds + (t & 1) * BUF_BYTES;
        if (t + 1 < NT) { const int tn = t + 1; const long rb = tn < 32 ? tokbase + 64 * tn : (long)NTOK + b * CTXL + 64 * (tn - 32); stage_load(Z, rb, kcol, vcol, kr, vr, tid); }
#pragma unroll
        for (int sub = 0; sub < 2; ++sub) { const f32x16 s = qk(buf, 32 * sub, 128 * map, qf, lane); softmax_pv<4>(s, buf, 32 * sub, 0, o, m, l, lane); }
        if (t + 1 < NT) stage_store(lds + ((t + 1) & 1) * BUF_BYTES, kr, vr, tid);
        __syncthreads();
    }
    const float linv = 1.f / (l + __shfl_xor(l, 32));
    LAS float* cb = (LAS float*)lds + (wave & 3) * 4096;
    if (map == 1) {
#pragma unroll
        for (int dt = 0; dt < 4; ++dt)
#pragma unroll
            for (int r = 0; r < 16; ++r) cb[(dt * 16 + r) * 64 + lane] = o[dt][r] * linv;
    }
    __syncthreads();
    if (map == 0) {
        float ss = 0.f;
#pragma unroll
        for (int dt = 0; dt < 4; ++dt)
#pragma unroll
            for (int r = 0; r < 16; ++r) { const float d = o[dt][r] * linv - lam * cb[(dt * 16 + r) * 64 + lane]; o[dt][r] = d; ss += d * d; }
        ss += __shfl_xor(ss, 32);
        const float rstd = 0.8f / sqrtf(ss * (1.f / 128.f) + EPS);
        f16* yr = Y + (size_t)qrow * DM + 512 + 128 * h;
#pragma unroll
        for (int dt = 0; dt < 4; ++dt)
#pragma unroll
            for (int rg = 0; rg < 4; ++rg) { const int d0 = 32 * dt + 8 * rg + 4 * hh; const f32x4 sg = *(const f32x4*)(subln + d0);
                u32x2 w; w.x = pkh(o[dt][4 * rg] * rstd * sg[0], o[dt][4 * rg + 1] * rstd * sg[1]); w.y = pkh(o[dt][4 * rg + 2] * rstd * sg[2], o[dt][4 * rg + 3] * rstd * sg[3]);
                *(u32x2*)(yr + d0) = w; }
    }
    __syncthreads();
}

__device__ __forceinline__ void na_unit(int u, const f16* Z, f16* Y, const float* rpb, LAS unsigned char* lds) {
    const int tid = threadIdx.x, lane = tid & 63, wave = __builtin_amdgcn_readfirstlane(tid >> 6);
    const int rp = u & 15, hp = (u >> 4) & 3, b = u >> 6;
    const int hs = wave >> 2, a = wave & 3, head = 2 * hp + hs, r32 = lane & 31, hh = lane >> 5;
    const int r0 = 2 * rp, qr = r0 + (r32 >> 4), qc = 16 * a + (r32 & 15);
    const int rsq = min(max(qr - 4, 0), 24), csq = min(max(qc - 8, 0), 48);
    const int lo = min(max(r0 - 4, 0), 24), hi = min(max(r0 + 1 - 4, 0), 24) + 8;
    const int seg = (a == 0) ? 0 : (a == 1) ? 8 : (a == 2) ? 24 : 32;
    const long tokbase = (long)b * SEQ;
    const long qrow = tokbase + qr * 64 + qc;
    LAS float* tab = (LAS float*)(lds + RPB_OFF);
    for (int i = tid; i < 2 * 465; i += 512) tab[i] = rpb[(2 * hp) * 465 + i] * LOG2E;
    f16x8 qf[4];
#pragma unroll
    for (int st = 0; st < 4; ++st) qf[st] = *(const f16x8*)(Z + (size_t)qrow * ZP0 + 64 * head + 16 * st + 8 * hh);
    f32x16 o[2];
#pragma unroll
    for (int dt = 0; dt < 2; ++dt)
#pragma unroll
        for (int r = 0; r < 16; ++r) o[dt][r] = 0.f;
    float m = -1e30f, l = 0.f;
    const int kcol = 1024 + 128 * hp, vcol = 2048 + 128 * hp;
    const int nwin = hi - lo, NT = nwin + 4;
    u32x4 kr[2], vr[2];
    stage_load(Z, tokbase + lo * 64, kcol, vcol, kr, vr, tid);
    stage_store(lds, kr, vr, tid);
    __syncthreads();
    for (int t = 0; t < NT; ++t) {
        LAS unsigned char* buf = lds + (t & 1) * BUF_BYTES;
        if (t + 1 < NT) { const int tn = t + 1; const long rb = tn < nwin ? tokbase + (lo + tn) * 64 : (long)NTOK + b * CTXL + 64 * (tn - nwin); stage_load(Z, rb, kcol, vcol, kr, vr, tid); }
        if (t < nwin) {
            const int krow = lo + t;
            f32x16 s = qk(buf, seg, 128 * hs, qf, lane);
            const bool rowok = (krow >= rsq) && (krow < rsq + 8);
            const int rbase = (krow - qr + 7) * 31 + 15 - qc;
#pragma unroll
            for (int r = 0; r < 16; ++r) { const int kc = seg + (r & 3) + 8 * (r >> 2) + 4 * hh; const bool ok = rowok && (kc >= csq) && (kc < csq + 16);
                const int bi = min(max(rbase + kc, 0), 464); const float bias = tab[hs * 465 + bi];
                s[r] = ok ? s[r] + bias : -INFINITY; }
            softmax_pv<2>(s, buf, seg, 128 * hs, o, m, l, lane);
        } else {
#pragma unroll
            for (int sub = 0; sub < 2; ++sub) { const f32x16 s = qk(buf, 32 * sub, 128 * hs, qf, lane); softmax_pv<2>(s, buf, 32 * sub, 128 * hs, o, m, l, lane); }
        }
        if (t + 1 < NT) stage_store(lds + ((t + 1) & 1) * BUF_BYTES, kr, vr, tid);
        __syncthreads();
    }
    const float linv = 1.f / (l + __shfl_xor(l, 32));
    f16* yr = Y + (size_t)qrow * DM + 64 * head;
#pragma unroll
    for (int dt = 0; dt < 2; ++dt)
#pragma unroll
        for (int rg = 0; rg < 4; ++rg) { const int d0 = 32 * dt + 8 * rg + 4 * hh;
            u32x2 w; w.x = pkh(o[dt][4 * rg] * linv, o[dt][4 * rg + 1] * linv); w.y = pkh(o[dt][4 * rg + 2] * linv, o[dt][4 * rg + 3] * linv);
            *(u32x2*)(yr + d0) = w; }
}

__device__ __forceinline__ void attn_phase(const f16* Z, f16* Y, const float* rpb, const float* subln, const float* lamp, LAS unsigned char* lds) {
    const float lam = *lamp;
    for (int u = blockIdx.x; u < 2048; u += gridDim.x) {
        if (u < 1024) diff_unit(u, Z, Y, subln, lam, lds);
        else na_unit(u - 1024, Z, Y, rpb, lds);
    }
}
}

__device__ __forceinline__ void conv_phase(const f16* Z1, f16* Y, const float* scw, const float* cfw, const float* cfb, const float* lng, const float* lnb, LAS unsigned char* lds) {
    const int tid = threadIdx.x, lane = tid & 63, wave = __builtin_amdgcn_readfirstlane(tid >> 6);
    LAS float* U = (LAS float*)lds;
    float cw[31];
#pragma unroll
    for (int k = 0; k < 31; ++k) cw[k] = cfw[k * 512 + tid];
    const float cb = cfb[tid];
    for (int u = blockIdx.x; u < NTOK / 32; u += gridDim.x) {
        const int b = u >> 6, t0 = (u & 63) * 32;
        const f16* zb = Z1 + (size_t)b * SEQ * ZP1;
        for (int pass = 0; pass < 16; ++pass) { const int row = pass * 4 + (tid >> 7), c4 = (tid & 127) * 4, tt = t0 - 15 + row;
            if (row < 62) { f32x4 uv = (f32x4){0.f, 0.f, 0.f, 0.f};
                if (tt >= 0 && tt < SEQ) { const f16x4 av = *(const f16x4*)(zb + (size_t)tt * ZP1 + 1536 + c4), gv = *(const f16x4*)(zb + (size_t)tt * ZP1 + 2048 + c4);
#pragma unroll
                    for (int j = 0; j < 4; ++j) uv[j] = (float)av[j] / (1.f + __expf(-(float)gv[j])); }
                *(LAS f32x4*)(U + row * 512 + c4) = uv; } }
        __syncthreads();
        float uu[62];
#pragma unroll
        for (int i = 0; i < 62; ++i) uu[i] = U[i * 512 + tid];
        __syncthreads();
#pragma unroll
        for (int tt = 0; tt < 32; ++tt) { float v = cb;
#pragma unroll
            for (int k = 0; k < 31; ++k) v += cw[k] * uu[tt + k];
            U[tt * 512 + tid] = v; }
        __syncthreads();
#pragma unroll
        for (int q = 0; q < 4; ++q) { const int tt = wave * 4 + q, t = t0 + tt, c8 = lane * 8;
            const f32x4 x0 = *(const LAS f32x4*)(U + tt * 512 + c8), x1 = *(const LAS f32x4*)(U + tt * 512 + c8 + 4);
            float x[8] = {x0[0], x0[1], x0[2], x0[3], x1[0], x1[1], x1[2], x1[3]};
            float s = 0.f;
#pragma unroll
            for (int j = 0; j < 8; ++j) s += x[j];
            const float mean = wave_sum(s) * (1.f / 512.f); float s2 = 0.f;
#pragma unroll
            for (int j = 0; j < 8; ++j) { x[j] -= mean; s2 += x[j] * x[j]; }
            const float rstd = 1.0f / sqrtf(wave_sum(s2) * (1.f / 512.f) + EPS);
            const f32x4 g0 = *(const f32x4*)(lng + c8), g1 = *(const f32x4*)(lng + c8 + 4), b0 = *(const f32x4*)(lnb + c8), b1 = *(const f32x4*)(lnb + c8 + 4);
            const float gg[8] = {g0[0], g0[1], g0[2], g0[3], g1[0], g1[1], g1[2], g1[3]}, bb[8] = {b0[0], b0[1], b0[2], b0[3], b1[0], b1[1], b1[2], b1[3]};
            float yd[8];
#pragma unroll
            for (int j = 0; j < 8; ++j) yd[j] = silu_f(x[j] * rstd * gg[j] + bb[j]);
            f16* yr = Y + ((size_t)b * SEQ + t) * DM;
            { u32x4 w; w.x = pkh(yd[0], yd[1]); w.y = pkh(yd[2], yd[3]); w.z = pkh(yd[4], yd[5]); w.w = pkh(yd[6], yd[7]); *(u32x4*)(yr + 512 + c8) = w; }
            float cacc[8];
#pragma unroll
            for (int j = 0; j < 8; ++j) cacc[j] = 0.f;
#pragma unroll
            for (int k = 0; k < 3; ++k) { const int ts = t + k - 1;
                if (ts >= 0 && ts < SEQ) { const f16x8 xc = *(const f16x8*)(zb + (size_t)ts * ZP1 + c8), gc = *(const f16x8*)(zb + (size_t)ts * ZP1 + 1024 + c8);
                    const f32x4 w0 = *(const f32x4*)(scw + k * 512 + c8), w1 = *(const f32x4*)(scw + k * 512 + c8 + 4);
                    const float ww[8] = {w0[0], w0[1], w0[2], w0[3], w1[0], w1[1], w1[2], w1[3]};
#pragma unroll
                    for (int j = 0; j < 8; ++j) cacc[j] += ww[j] * ((float)gc[j] * (float)xc[j]); } }
            const f16x8 gb = *(const f16x8*)(zb + (size_t)t * ZP1 + 512 + c8);
            { u32x4 w; w.x = pkh((float)gb[0] * cacc[0], (float)gb[1] * cacc[1]); w.y = pkh((float)gb[2] * cacc[2], (float)gb[3] * cacc[3]);
              w.z = pkh((float)gb[4] * cacc[4], (float)gb[5] * cacc[5]); w.w = pkh((float)gb[6] * cacc[6], (float)gb[7] * cacc[7]); *(u32x4*)(yr + c8) = w; }
        }
        __syncthreads();
    }
}

constexpr int NPHASE = 18;
__global__ void __launch_bounds__(512, 2) fwd(Params p) {
    extern __shared__ __attribute__((aligned(16))) unsigned char lds_raw[];
    LAS unsigned char* lds = (LAS unsigned char*)lds_raw;
    const int tid = threadIdx.x;
    unsigned char* ws = p.ws;
    for (int u = tid; u < (LDS_BYTES - LDSCTL_OFF) / 4; u += 512) ((LAS unsigned*)(lds + LDSCTL_OFF))[u] = 0u;
    __syncthreads();
    XcdBarrier bar; bar.bar = (unsigned*)(ws + WS_CTL) + 4096; bar.x = 0; bar.st = nullptr;
    if (N_LAUNCH_MODE == 1) bar = xcd_barrier_post((unsigned*)(ws + WS_CTL) + 4096, (volatile LAS unsigned*)(lds + MISC_OFF) + 8);
    const int lo = p.ph_lo, hi = p.ph_hi;
#ifndef ONLYP
#define ONLYP -1
#endif
#define IN(k) ((ONLYP < 0 || ONLYP == (k)) && lo <= (k) && (k) < hi)
#define SEAM(k) do { if (IN(k) && IN((k) + 1)) xcd_barrier(bar); } while (0)
    const int G = gridDim.x, c = blockIdx.x;
    float* mod0 = (float*)(ws + WS_MOD + MOD0_OFF); float* mod1 = (float*)(ws + WS_MOD + MOD1_OFF);
    f16* H = (f16*)(ws + WS_H); f16* Z = (f16*)(ws + WS_Z); f16* Y = (f16*)(ws + WS_Y); f16* XIN = (f16*)(ws + WS_XIN); f16* HID = (f16*)(ws + WS_HID); f16* Y2 = (f16*)(ws + WS_Y2);
    f16* W13 = (f16*)(ws + WS_W13); f16* W2T = (f16*)(ws + WS_W2);
    float* AFF = (float*)(ws + WS_AFF); int* IDX = (int*)(ws + WS_IDX); float* GV = (float*)(ws + WS_G); short* INV = (short*)(ws + WS_INV);

    if (IN(0)) { phase_prologue(p, lds); } SEAM(0);
    if (IN(1)) { NormArgs a{}; a.src = p.in[I_X]; a.gain = p.in[I_L0_NORM1]; a.shift = mod0; a.scale = mod0 + 1024; a.mstride = 6144; a.hout = H;
        norm_phase(a, lds, NTOK, true, p.in[I_CTX], mod0 + 16 * 6144, mod0 + 16 * 6144 + 1024); } SEAM(1);
    if (IN(2)) { gm::Gemm g{H, (const f16*)(ws + WS_WIN0), DM, 0, 0}; gm::Order S; S.init(NROWS, ZP0, 1, G, c);
        gm::EpiInProj0 E{Z, (const float*)(ws + WS_MOD + ROPE_OFF)}; gm::gemm_phase(lds, g, S, E); } SEAM(2);
    if (IN(3)) { at::attn_phase(Z, Y, p.in[I_L0_RPB], p.in[I_L0_SUBLN], (const float*)(ws + WS_MOD + LAM_OFF), lds); } SEAM(3);
    if (IN(4)) { gm::Gemm g{Y, (const f16*)(ws + WS_WOUT0), DM, 0, 0}; gm::Order S; S.init(NTOK, DM, 1, G, c);
        gm::EpiResGate E{p.in[I_X], p.out, mod0 + 2048, 6144}; gm::gemm_phase(lds, g, S, E); } SEAM(4);
    if (IN(5)) { NormArgs a{}; a.src = p.out; a.gain = p.in[I_L0_NORM2]; a.shift = mod0 + 3072; a.scale = mod0 + 4096; a.mstride = 6144; a.hout = H; a.wr = p.in[I_L0_WR]; a.aff = AFF;
        norm_phase(a, lds, NTOK, false, nullptr, nullptr, nullptr); } SEAM(5);
    if (IN(6)) { topk_phase(AFF, IDX, GV, INV, H, XIN, lds); } SEAM(6);
    if (IN(7)) { gm::Gemm g{XIN, W13, DM, (long)EROWS * DM, (long)2 * DE * DM}; gm::Order S; S.init(EROWS, 2 * DE, NE, G, c);
        gm::EpiSwiGLU E{HID}; gm::gemm_phase(lds, g, S, E); } SEAM(7);
    if (IN(8)) { gm::Gemm g{HID, W2T, DE, (long)EROWS * DE, (long)DM * DE}; gm::Order S; S.init(EROWS, DM, NE, G, c);
        gm::EpiRowScale E{Y2, GV}; gm::gemm_phase(lds, g, S, E); } SEAM(8);
    if (IN(9)) { NormArgs a{}; a.src = p.out; a.xout = p.out; a.y2 = Y2; a.inv = INV; a.gate2 = mod0 + 5120; a.gain = p.in[I_L1_NORM1]; a.shift = mod1; a.scale = mod1 + 1024; a.mstride = 6144; a.hout = H;
        norm_phase(a, lds, NTOK, false, nullptr, nullptr, nullptr);
        cvt_moe(p.in[I_L1_W1], p.in[I_L1_W3], p.in[I_L1_W2], W13, W2T, c * 8 + (tid >> 6), G * 8, tid & 63); } SEAM(9);
    if (IN(10)) { gm::Gemm g{H, (const f16*)(ws + WS_WIN1), DM, 0, 0}; gm::Order S; S.init(NTOK, ZP1, 1, G, c);
        gm::EpiF16 E{Z, ZP1}; gm::gemm_phase(lds, g, S, E); } SEAM(10);
    if (IN(11)) { conv_phase(Z, Y, p.in[I_L1_SCW], p.in[I_L1_CFW], p.in[I_L1_CFB], p.in[I_L1_LNG], p.in[I_L1_LNB], lds); } SEAM(11);
    if (IN(12)) { gm::Gemm g{Y, (const f16*)(ws + WS_WOUT1), DM, 0, 0}; gm::Order S; S.init(NTOK, DM, 1, G, c);
        gm::EpiResGate E{p.out, p.out, mod1 + 2048, 6144}; gm::gemm_phase(lds, g, S, E); } SEAM(12);
    if (IN(13)) { NormArgs a{}; a.src = p.out; a.gain = p.in[I_L1_NORM2]; a.shift = mod1 + 3072; a.scale = mod1 + 4096; a.mstride = 6144; a.hout = H; a.wr = p.in[I_L1_WR]; a.aff = AFF;
        norm_phase(a, lds, NTOK, false, nullptr, nullptr, nullptr); } SEAM(13);
    if (IN(14)) { topk_phase(AFF, IDX, GV, INV, H, XIN, lds); } SEAM(14);
    if (IN(15)) { gm::Gemm g{XIN, W13, DM, (long)EROWS * DM, (long)2 * DE * DM}; gm::Order S; S.init(EROWS, 2 * DE, NE, G, c);
        gm::EpiSwiGLU E{HID}; gm::gemm_phase(lds, g, S, E); } SEAM(15);
    if (IN(16)) { gm::Gemm g{HID, W2T, DE, (long)EROWS * DE, (long)DM * DE}; gm::Order S; S.init(EROWS, DM, NE, G, c);
        gm::EpiRowScale E{Y2, GV}; gm::gemm_phase(lds, g, S, E); } SEAM(16);
    if (IN(17)) { NormArgs a{}; a.src = p.out; a.xout = p.out; a.y2 = Y2; a.inv = INV; a.gate2 = mod1 + 5120; a.gain = p.in[I_FNORM]; a.fout = p.out;
        norm_phase(a, lds, NTOK, false, nullptr, nullptr, nullptr); }
#undef IN
#undef SEAM
}

extern "C" void kernel_launch(void* const* d_in, const int* in_sizes, int n_in, void* d_out, int out_size, void* d_ws, size_t ws_size, hipStream_t stream) {
    static int grid = 0;
    if (grid == 0) {
        if (n_in != 36 || out_size != NTOK * DM || ws_size < WS_END) { fprintf(stderr, "kernel_launch: unexpected shapes (n_in %d out %d ws %zu need %zu)\n", n_in, out_size, ws_size, (size_t)WS_END); grid = -1; return; }
        int dev = 0, cus = 0;
        if (hipGetDevice(&dev) != hipSuccess || hipDeviceGetAttribute(&cus, hipDeviceAttributeMultiprocessorCount, dev) != hipSuccess) { grid = -1; return; }
        if (hipFuncSetAttribute((const void*)fwd, hipFuncAttributeMaxDynamicSharedMemorySize, LDS_BYTES) != hipSuccess) { fprintf(stderr, "kernel_launch: hipFuncSetAttribute failed\n"); grid = -1; return; }
        int per_cu = 0;
        if (hipOccupancyMaxActiveBlocksPerMultiprocessor(&per_cu, (const void*)fwd, 512, LDS_BYTES) != hipSuccess || per_cu < 1) fprintf(stderr, "kernel_launch: occupancy query says %d\n", per_cu);
        (void)hipGetLastError();
        grid = cus;
    }
    if (grid < 0) return;
    (void)hipMemsetAsync((char*)d_ws + WS_CTL, 0, CTL_ZERO_BYTES, stream);
    Params p{};
    for (int i = 0; i < 36; ++i) p.in[i] = (const float*)d_in[i];
    p.out = (float*)d_out; p.ws = (unsigned char*)d_ws;
#if N_LAUNCH_MODE == 1
    p.ph_lo = 0; p.ph_hi = NPHASE;
    hipLaunchKernelGGL(fwd, dim3(grid), dim3(512), LDS_BYTES, stream, p);
#else
    for (int k = 0; k < NPHASE; ++k) { p.ph_lo = k; p.ph_hi = k + 1; hipLaunchKernelGGL(fwd, dim3(grid), dim3(512), LDS_BYTES, stream, p); }
#endif
}
```

```cpp
#include <hip/hip_runtime.h>
#include <cstdio>
#include <cstdint>

#define LAS __attribute__((address_space(3)))
#define GAS __attribute__((address_space(1)))
typedef _Float16 f16;
typedef _Float16 f16x8 __attribute__((ext_vector_type(8)));
typedef _Float16 f16x4 __attribute__((ext_vector_type(4)));
typedef _Float16 f16x2 __attribute__((ext_vector_type(2)));
typedef float f32x2 __attribute__((ext_vector_type(2)));
typedef float f32x4 __attribute__((ext_vector_type(4)));
typedef float f32x16 __attribute__((ext_vector_type(16)));
typedef unsigned u32x2 __attribute__((ext_vector_type(2)));
typedef unsigned u32x4 __attribute__((ext_vector_type(4)));
typedef short s16x4 __attribute__((ext_vector_type(4)));

#ifndef N_LAUNCH_MODE
#define N_LAUNCH_MODE 1
#endif

constexpr int NB = 16, SEQ = 2048, DM = 1024, NTOK = NB * SEQ, CTXL = 256, NCTX = NB * CTXL, NROWS = NTOK + NCTX;
constexpr int ZP0 = 3072, ZP1 = 2560;
constexpr int NE = 16, DE = 2816, CAP = 256, EROWS = NB * CAP;
constexpr float EPS = 1e-6f;
constexpr float LOG2E = 1.4426950408889634f;
constexpr float QSCALE = 0.125f * LOG2E;

constexpr size_t MiB = 1u << 20;
constexpr size_t WS_CTL = 0, CTL_ZERO_BYTES = 256 * 1024;
constexpr size_t WS_MOD = 1 * MiB;
constexpr size_t MOD0_OFF = 0, MOD1_OFF = 17 * 6144 * 4, ROPE_OFF = MOD1_OFF + 16 * 6144 * 4, LAM_OFF = ROPE_OFF + 64 * 16 * 2 * 4;
constexpr size_t WS_WIN0 = 2 * MiB, WS_WOUT0 = 8 * MiB, WS_WIN1 = 10 * MiB, WS_WOUT1 = 15 * MiB;
constexpr size_t WS_AFF = 17 * MiB;
constexpr size_t WS_IDX = 19 * MiB;
constexpr size_t WS_G = 19 * MiB + 512 * 1024;
constexpr size_t WS_INV = 20 * MiB;
constexpr size_t WS_W13 = 22 * MiB;
constexpr size_t WS_W2 = WS_W13 + 176 * MiB;
constexpr size_t WS_H = WS_W2 + 88 * MiB;
constexpr size_t WS_XIN = WS_H + 72 * MiB;
constexpr size_t WS_Y2 = WS_XIN + 128 * MiB;
constexpr size_t WS_BIG = WS_Y2 + 128 * MiB;
constexpr size_t WS_Z = WS_BIG, WS_Y = WS_BIG + 216 * MiB, WS_HID = WS_BIG;
constexpr size_t WS_END = WS_BIG + 352 * MiB;

constexpr int RING_BYTES = 131072;
constexpr int LDSCTL_OFF = RING_BYTES, MISC_OFF = LDSCTL_OFF + 320;
constexpr int LDS_BYTES = 147456;

#define RLX_AGENT __ATOMIC_RELAXED, __HIP_MEMORY_SCOPE_AGENT
#define LDS_WAIT() asm volatile("s_waitcnt lgkmcnt(0)" ::: "memory")
#define VM_WAIT() asm volatile("s_waitcnt vmcnt(0)" ::: "memory")

__device__ __forceinline__ unsigned pkh(float lo, float hi) { f16x2 v; v.x = (f16)lo; v.y = (f16)hi; return __builtin_bit_cast(unsigned, v); }
__device__ __forceinline__ float silu_f(float v) { return v / (1.f + __expf(-v)); }

#define XB_TMO      128
#define XB_XCNT(j)  (256  + 64 * (j))
#define XB_XSUB(j)  (1280 + 64 * (j))
#define XB_XGEN(j)  (2304 + 64 * (j))
#define XB_TOP      3328
#define XB_TOPGEN   3392
#define XCD_BAR_WORDS 3456
#define XB_SPIN_CAP (1u << 18)
__device__ __forceinline__ unsigned xb_ld(unsigned* p)              { return __hip_atomic_load(p, __ATOMIC_RELAXED, __HIP_MEMORY_SCOPE_AGENT); }
__device__ __forceinline__ unsigned xb_add(unsigned* p, unsigned v) { return __hip_atomic_fetch_add(p, v, __ATOMIC_RELAXED, __HIP_MEMORY_SCOPE_AGENT); }
__device__ __forceinline__ unsigned xb_xcc_id() { return (unsigned)__builtin_amdgcn_s_getreg((3 << 11) | 20) & 0xFu; }
#define XB_SPIN(cond, bar) do { unsigned _sp = 0; while (cond) { __builtin_amdgcn_s_sleep(1); \
    if ((++_sp & 255u) == 0u) { if (xb_ld(&(bar)[XB_TMO])) break; if (_sp > XB_SPIN_CAP) { atomicAdd(&(bar)[XB_TMO], 1u); break; } } } } while (0)
struct XcdBarrier { unsigned* bar; unsigned x; volatile LAS unsigned* st; };
__device__ __forceinline__ XcdBarrier xcd_barrier_post(unsigned* bar, volatile LAS unsigned* st) {
    XcdBarrier b; b.bar = bar; b.x = xb_xcc_id(); b.st = st;
    if (threadIdx.x == 0) (void)xb_add(&bar[XB_XCNT(b.x)], 1u);
    return b;
}
__device__ __forceinline__ void xcd_barrier_complete(unsigned* bar, unsigned x, unsigned& nloc, unsigned& nx) {
    const unsigned G = gridDim.x * gridDim.y * gridDim.z;
    unsigned sum, cnt, mine, sp = 0u;
    for (;;) {
        sum = 0u; cnt = 0u; mine = 0u;
#pragma unroll
        for (unsigned j = 0; j < 16; ++j) { const unsigned c = xb_ld(&bar[XB_XCNT(j)]); sum += c; cnt += (c > 0u) ? 1u : 0u; mine = (j == x) ? c : mine; }
        if (sum == G) break;
        __builtin_amdgcn_s_sleep(1);
        if ((++sp & 255u) == 0u) { if (xb_ld(&bar[XB_TMO])) break; if (sp > XB_SPIN_CAP) { atomicAdd(&bar[XB_TMO], 1u); break; } }
    }
    nloc = mine > 0u ? mine : 1u; nx = cnt > 0u ? cnt : 1u;
}
__device__ __forceinline__ void xcd_barrier(const XcdBarrier& b) {
    asm volatile("s_waitcnt vmcnt(0)" ::: "memory");
    __syncthreads();
    if (threadIdx.x == 0) {
        unsigned* bar = b.bar;
        __builtin_amdgcn_s_waitcnt(0);
        unsigned nloc = b.st[0], nx = b.st[1];
        if (nloc == 0u) { xcd_barrier_complete(bar, b.x, nloc, nx); b.st[0] = nloc; b.st[1] = nx; }
        const unsigned old = xb_add(&bar[XB_XSUB(b.x)], 1u);
        const unsigned gen = old / nloc;
        if (old + 1u == (gen + 1u) * nloc) {
            __builtin_amdgcn_fence(__ATOMIC_RELEASE, "agent");
            asm volatile("s_waitcnt vmcnt(0)" ::: "memory");
            const unsigned og = xb_add(&bar[XB_TOP], 1u);
            const unsigned tg = og / nx;
            if (og + 1u == (tg + 1u) * nx) xb_add(&bar[XB_TOPGEN], 1u);
            else XB_SPIN(xb_ld(&bar[XB_TOPGEN]) == tg, bar);
            __builtin_amdgcn_fence(__ATOMIC_ACQUIRE, "agent");
            xb_add(&bar[XB_XGEN(b.x)], 1u);
            asm volatile("s_waitcnt vmcnt(0)" ::: "memory");
        } else {
            XB_SPIN(xb_ld(&bar[XB_XGEN(b.x)]) == gen, bar);
            __builtin_amdgcn_fence(__ATOMIC_ACQUIRE, "agent");
            asm volatile("s_waitcnt vmcnt(0)" ::: "memory");
        }
    }
    __syncthreads();
}

namespace gm {
constexpr int BM = 256, BK = 64, HALF = 128, HTB = HALF * BK * 2, STAGE_BYTES = 8 * HTB, NXCD = 8, WGM = 8;
__host__ __device__ __forceinline__ int lds_byte(int r, int c) { const int st = (r >> 4) * 2 + (c >> 5), rr = r & 15, cc = c & 31, ob = rr * 64 + cc * 2; return st * 1024 + (ob ^ (((ob >> 9) & 1) << 5)); }
__host__ __device__ __forceinline__ void stage_rc(int b, int& R, int& C) { const int st = b / 1024, sb = b % 1024, swz = sb ^ (((sb >> 9) & 1) << 5); R = (st >> 1) * 16 + swz / 64; C = (st & 1) * 32 + (swz % 64) / 2; }
__host__ __device__ __forceinline__ int perm32(int rho) { const int n = rho >> 4, i = rho & 15; return 8 * (i >> 2) + 4 * n + (i & 3); }

struct Unit { int g, pm, pn; };
struct Gemm { const f16* A; const f16* Bt; int K; long sA, sB; };
struct Order {
    int nM, nN, tpg, total, G, c;
    __device__ void init(int M, int N, int groups, int G_, int c_) { nM = M / BM; nN = N / BM; tpg = nM * nN; total = tpg * groups; G = G_; c = c_; }
    __device__ bool next(int i, Unit& u) const {
        const long L = (long)i * G + c; if (L >= total) return false;
        const int g = (int)(L / tpg); int wgid = (int)(L % tpg);
        { const int q = tpg / NXCD, r = tpg % NXCD, xcd = wgid % NXCD, off = wgid / NXCD; wgid = (xcd < r ? xcd * (q + 1) : r * (q + 1) + (xcd - r) * q) + off; }
        const int nig = WGM * nN, gid = wgid / nig, fm = gid * WGM, gsz = (nM - fm) < WGM ? (nM - fm) : WGM;
        u.g = g; u.pm = fm + ((wgid % nig) % gsz); u.pn = (wgid % nig) / gsz; return true;
    }
};

typedef f32x4 Acc[2][2][4][2];

struct EpiF16 {
    static constexpr bool PERM = true;
    f16* O; int ldc;
    __device__ __forceinline__ void operator()(const Acc& acc, const Unit& u, int wr, int wc, int fr, int fq) const {
        const int row0 = u.pm * BM + wr * 64 + fr, col0 = u.pn * BM + wc * 32 + 8 * fq;
#pragma unroll
        for (int ai = 0; ai < 2; ++ai)
#pragma unroll
            for (int m = 0; m < 4; ++m) { f16* rowp = O + (size_t)(row0 + ai * HALF + m * 16) * ldc + col0;
#pragma unroll
                for (int bj = 0; bj < 2; ++bj) { const f32x4 v0 = acc[ai][bj][m][0], v1 = acc[ai][bj][m][1];
                    u32x4 w; w.x = pkh(v0[0], v0[1]); w.y = pkh(v0[2], v0[3]); w.z = pkh(v1[0], v1[1]); w.w = pkh(v1[2], v1[3]);
                    *(u32x4*)(rowp + bj * HALF) = w; } }
    }
};
struct EpiInProj0 {
    static constexpr bool PERM = true;
    f16* O; const float* rope;
    __device__ __forceinline__ void operator()(const Acc& acc, const Unit& u, int wr, int wc, int fr, int fq) const {
        const int row0 = u.pm * BM + wr * 64 + fr, col0 = u.pn * BM + wc * 32 + 8 * fq;
        const float sc = (u.pn < 4) ? QSCALE : 1.f;
        const bool dorope = (u.pn == 2 || u.pn == 3 || u.pn == 6 || u.pn == 7) && (u.pm * BM < NTOK);
#pragma unroll
        for (int ai = 0; ai < 2; ++ai)
#pragma unroll
            for (int m = 0; m < 4; ++m) { const int row = row0 + ai * HALF + m * 16; f16* rowp = O + (size_t)row * ZP0 + col0;
                const int t = row & (SEQ - 1), prow = t >> 6, pcol = t & 63;
#pragma unroll
                for (int bj = 0; bj < 2; ++bj) { f32x4 v0 = acc[ai][bj][m][0] * sc, v1 = acc[ai][bj][m][1] * sc;
                    if (dorope) { const int c = col0 + bj * HALF, half = (c >> 5) & 1, i0 = (c & 31) >> 1; const int pos = half ? pcol : prow;
                        const f32x4* tp = (const f32x4*)(rope + (pos * 16 + i0) * 2); const f32x4 t0 = tp[0], t1 = tp[1];
                        f32x4 r0, r1;
                        r0[0] = v0[0] * t0[0] - v0[1] * t0[1]; r0[1] = v0[0] * t0[1] + v0[1] * t0[0];
                        r0[2] = v0[2] * t0[2] - v0[3] * t0[3]; r0[3] = v0[2] * t0[3] + v0[3] * t0[2];
                        r1[0] = v1[0] * t1[0] - v1[1] * t1[1]; r1[1] = v1[0] * t1[1] + v1[1] * t1[0];
                        r1[2] = v1[2] * t1[2] - v1[3] * t1[3]; r1[3] = v1[2] * t1[3] + v1[3] * t1[2];
                        v0 = r0; v1 = r1; }
                    u32x4 w; w.x = pkh(v0[0], v0[1]); w.y = pkh(v0[2], v0[3]); w.z = pkh(v1[0], v1[1]); w.w = pkh(v1[2], v1[3]);
                    *(u32x4*)(rowp + bj * HALF) = w; } }
    }
};
struct EpiResGate {
    static constexpr bool PERM = false;
    const float* base; float* out; const float* gate; int gstride;
    __device__ __forceinline__ void operator()(const Acc& acc, const Unit& u, int wr, int wc, int fr, int fq) const {
        const int col0 = u.pn * BM + wc * 32 + 4 * fq; const int b = (u.pm * BM) / SEQ;
        f32x4 gv[2][2];
#pragma unroll
        for (int bj = 0; bj < 2; ++bj)
#pragma unroll
            for (int n = 0; n < 2; ++n) gv[bj][n] = *(const f32x4*)(gate + (size_t)b * gstride + col0 + bj * HALF + n * 16);
#pragma unroll
        for (int ai = 0; ai < 2; ++ai)
#pragma unroll
            for (int m = 0; m < 4; ++m) { const size_t off = (size_t)(u.pm * BM + ai * HALF + wr * 64 + m * 16 + fr) * DM + col0;
#pragma unroll
                for (int bj = 0; bj < 2; ++bj)
#pragma unroll
                    for (int n = 0; n < 2; ++n) { const f32x4 bs = *(const f32x4*)(base + off + bj * HALF + n * 16);
                        *(f32x4*)(out + off + bj * HALF + n * 16) = bs + gv[bj][n] * acc[ai][bj][m][n]; }
                if (m & 1) asm volatile("" ::: "memory"); }
    }
};
struct EpiSwiGLU {
    static constexpr bool PERM = true;
    f16* O;
    __device__ __forceinline__ void operator()(const Acc& acc, const Unit& u, int wr, int wc, int fr, int fq) const {
        const int row0 = u.pm * BM + wr * 64 + fr, col0 = u.pn * HALF + wc * 32 + 8 * fq;
        f16* Og = O + (size_t)u.g * EROWS * DE;
#pragma unroll
        for (int ai = 0; ai < 2; ++ai)
#pragma unroll
            for (int m = 0; m < 4; ++m) { f16* rowp = Og + (size_t)(row0 + ai * HALF + m * 16) * DE + col0;
                float h[8];
#pragma unroll
                for (int n = 0; n < 2; ++n)
#pragma unroll
                    for (int j = 0; j < 4; ++j) { const float g = acc[ai][0][m][n][j], up = acc[ai][1][m][n][j]; h[n * 4 + j] = g * up / (1.f + __expf(-g)); }
                u32x4 w; w.x = pkh(h[0], h[1]); w.y = pkh(h[2], h[3]); w.z = pkh(h[4], h[5]); w.w = pkh(h[6], h[7]);
                *(u32x4*)rowp = w; }
    }
};
struct EpiRowScale {
    static constexpr bool PERM = true;
    f16* O; const float* gv;
    __device__ __forceinline__ void operator()(const Acc& acc, const Unit& u, int wr, int wc, int fr, int fq) const {
        const int row0 = u.pm * BM + wr * 64 + fr, col0 = u.pn * BM + wc * 32 + 8 * fq;
        f16* Og = O + (size_t)u.g * EROWS * DM;
#pragma unroll
        for (int ai = 0; ai < 2; ++ai)
#pragma unroll
            for (int m = 0; m < 4; ++m) { const int row = row0 + ai * HALF + m * 16; const float s = gv[((row >> 8) * NE + u.g) * CAP + (row & 255)];
                f16* rowp = Og + (size_t)row * DM + col0;
#pragma unroll
                for (int bj = 0; bj < 2; ++bj) { const f32x4 v0 = acc[ai][bj][m][0] * s, v1 = acc[ai][bj][m][1] * s;
                    u32x4 w; w.x = pkh(v0[0], v0[1]); w.y = pkh(v0[2], v0[3]); w.z = pkh(v1[0], v1[1]); w.w = pkh(v1[2], v1[3]);
                    *(u32x4*)(rowp + bj * HALF) = w; } }
    }
};

template <class Epi>
__device__ __forceinline__ void gemm_phase(LAS unsigned char* lds, const Gemm g, const Order& S, const Epi& E) {
    const int tid = threadIdx.x, wid = __builtin_amdgcn_readfirstlane(tid >> 6), lane = tid & 63, wr = wid >> 2, wc = wid & 3, fr = lane & 15, fq = lane >> 4;
    const int K = g.K, nt = K / BK;
    unsigned voffA[2], voffB[2];
#pragma unroll
    for (int i = 0; i < 2; ++i) { int R, C; stage_rc(tid * 16 + i * 8192, R, C); const int Rb = Epi::PERM ? ((R & ~31) + perm32(R & 31)) : R;
        voffA[i] = (unsigned)(R * K + C) * 2u; voffB[i] = (unsigned)(Rb * K + C) * 2u; }
    const size_t kstep = (size_t)(BK * 2);
    const size_t hstep = (size_t)HALF * K * 2;
    const size_t tstep = 2 * hstep;
    const unsigned ldsw = (unsigned)wid * 1024u;
    const int aoff = lds_byte(wr * 64 + fr, fq * 8), boff = lds_byte(wc * 32 + fr, fq * 8);
#define GM_SA(b, h) (((b) * 2 + (h)) * HTB)
#define GM_SB(b, h) ((4 + (b) * 2 + (h)) * HTB)
#define GM_STAGE(bufoff, gbase, voff) do { _Pragma("unroll") for (int _i = 0; _i < 2; ++_i) \
        __builtin_amdgcn_global_load_lds((const unsigned*)((const char*)(gbase) + (voff)[_i]), (LAS unsigned*)(lds + (bufoff) + ldsw + _i * 8192), 16, 0, 0); } while (0)
#define GM_LDA(dst, b, h) do { _Pragma("unroll") for (int m = 0; m < 4; ++m) _Pragma("unroll") for (int k = 0; k < 2; ++k) dst[m][k] = *(const LAS f16x8*)(lds + GM_SA(b, h) + aoff + m * 2048 + k * 1024); } while (0)
#define GM_LDB(dst, b, h) do { _Pragma("unroll") for (int n = 0; n < 2; ++n) _Pragma("unroll") for (int k = 0; k < 2; ++k) dst[n][k] = *(const LAS f16x8*)(lds + GM_SB(b, h) + boff + n * 2048 + k * 1024); } while (0)
#define GM_MMA(ai, bj, At, Bt) do { __builtin_amdgcn_s_setprio(1); _Pragma("unroll") for (int m = 0; m < 4; ++m) _Pragma("unroll") for (int n = 0; n < 2; ++n) _Pragma("unroll") for (int k = 0; k < 2; ++k) \
        acc[ai][bj][m][n] = __builtin_amdgcn_mfma_f32_16x16x32_f16(Bt[n][k], At[m][k], acc[ai][bj][m][n], 0, 0, 0); __builtin_amdgcn_s_setprio(0); } while (0)
#define GM_WAIT_V(n) asm volatile("s_waitcnt vmcnt(" #n ")" ::: "memory")
#define GM_WAIT_L(n) asm volatile("s_waitcnt lgkmcnt(" #n ")" ::: "memory")
#define GM_BAR __builtin_amdgcn_s_barrier()
#define GM_SCHED __builtin_amdgcn_sched_barrier(0)
    Unit cur, nxt; int ui = 0;
    if (!S.next(0, cur)) return;
    Acc acc;
#pragma unroll
    for (int a = 0; a < 2; ++a)
#pragma unroll
        for (int b = 0; b < 2; ++b)
#pragma unroll
            for (int m = 0; m < 4; ++m)
#pragma unroll
                for (int n = 0; n < 2; ++n) acc[a][b][m][n] = (f32x4){0.f, 0.f, 0.f, 0.f};
    f16x8 At[4][2], B0[2][2], B1[2][2];
    const char* cA = (const char*)(g.A + (size_t)cur.g * g.sA) + (size_t)cur.pm * tstep; const char* cB = (const char*)(g.Bt + (size_t)cur.g * g.sB) + (size_t)cur.pn * tstep;
    GM_STAGE(GM_SB(0, 0), cB, voffB); GM_STAGE(GM_SB(0, 1), cB + hstep, voffB); GM_STAGE(GM_SA(0, 0), cA, voffA); GM_STAGE(GM_SA(0, 1), cA + hstep, voffA);
    if (wr == 1) GM_BAR;
    GM_WAIT_V(2); GM_BAR;
    GM_STAGE(GM_SB(1, 0), cB + kstep, voffB); GM_STAGE(GM_SA(1, 0), cA + kstep, voffA); GM_STAGE(GM_SB(1, 1), cB + hstep + kstep, voffB);
    GM_WAIT_V(6); GM_BAR;
    for (;;) {
        const bool has_next = S.next(ui + 1, nxt);
        const char* nA = has_next ? (const char*)(g.A + (size_t)nxt.g * g.sA) + (size_t)nxt.pm * tstep : cA; const char* nB = has_next ? (const char*)(g.Bt + (size_t)nxt.g * g.sB) + (size_t)nxt.pn * tstep : cB;
        for (int t = 0; t < nt; t += 2) {
            const bool last = (t == nt - 2);
            const char* a1 = cA + (size_t)(t + 1) * kstep;
            const char* a2 = last ? nA : cA + (size_t)(t + 2) * kstep; const char* b2 = last ? nB : cB + (size_t)(t + 2) * kstep;
            const char* a3 = a2 + kstep; const char* b3 = b2 + kstep;
            GM_LDB(B0, 0, 0); GM_LDB(B1, 0, 1); GM_SCHED; GM_LDA(At, 0, 0); GM_STAGE(GM_SA(1, 1), a1 + hstep, voffA);
            GM_WAIT_V(8); GM_WAIT_L(0); GM_BAR; GM_MMA(0, 0, At, B0); GM_MMA(0, 1, At, B1); GM_BAR; GM_SCHED;
            GM_LDA(At, 0, 1); GM_STAGE(GM_SB(0, 0), b2, voffB); GM_STAGE(GM_SB(0, 1), b2 + hstep, voffB); GM_STAGE(GM_SA(0, 0), a2, voffA);
            GM_WAIT_V(8); GM_WAIT_L(0); GM_BAR; GM_MMA(1, 0, At, B0); GM_MMA(1, 1, At, B1); GM_BAR; GM_SCHED;
            GM_LDB(B0, 1, 0); GM_LDB(B1, 1, 1); GM_SCHED; GM_LDA(At, 1, 0); GM_STAGE(GM_SA(0, 1), a2 + hstep, voffA);
            GM_WAIT_V(8); GM_WAIT_L(0); GM_BAR; GM_MMA(0, 0, At, B0); GM_MMA(0, 1, At, B1); GM_BAR; GM_SCHED;
            GM_LDA(At, 1, 1); GM_STAGE(GM_SB(1, 0), b3, voffB); GM_STAGE(GM_SB(1, 1), b3 + hstep, voffB); GM_STAGE(GM_SA(1, 0), a3, voffA);
            GM_WAIT_V(8); GM_WAIT_L(0); GM_BAR; GM_MMA(1, 0, At, B0); GM_MMA(1, 1, At, B1); GM_BAR; GM_SCHED;
        }
        if (wr == 0) GM_BAR;
        E(acc, cur, wr, wc, fr, fq);
        if (!has_next) break;
#pragma unroll
        for (int a = 0; a < 2; ++a)
#pragma unroll
            for (int b = 0; b < 2; ++b)
#pragma unroll
                for (int m = 0; m < 4; ++m)
#pragma unroll
                    for (int n = 0; n < 2; ++n) acc[a][b][m][n] = (f32x4){0.f, 0.f, 0.f, 0.f};
        cur = nxt; cA = nA; cB = nB; ++ui;
        if (wr == 1) GM_BAR;
    }
    GM_WAIT_V(0);
    GM_BAR;
#undef GM_SA
#undef GM_SB
#undef GM_STAGE
#undef GM_LDA
#undef GM_LDB
#undef GM_MMA
#undef GM_WAIT_V
#undef GM_WAIT_L
#undef GM_BAR
#undef GM_SCHED
}
}

struct Params { const float* in[36]; float* out; unsigned char* ws; int ph_lo, ph_hi; };
enum { I_X = 0, I_C, I_CTX, I_CCTX, I_L0_NORM1, I_L0_WMOD, I_L0_BMOD, I_L0_WIN, I_L0_WOUT, I_L0_RPB, I_L0_LQ1, I_L0_LK1, I_L0_LQ2, I_L0_LK2, I_L0_SUBLN,
       I_L0_NORM2, I_L0_WR, I_L0_W1, I_L0_W3, I_L0_W2, I_L1_NORM1, I_L1_WMOD, I_L1_BMOD, I_L1_WIN, I_L1_WOUT, I_L1_SCW, I_L1_CFW, I_L1_CFB, I_L1_LNG, I_L1_LNB,
       I_L1_NORM2, I_L1_WR, I_L1_W1, I_L1_W3, I_L1_W2, I_FNORM };

__device__ __forceinline__ float wave_sum(float v) {
#pragma unroll
    for (int o = 1; o < 64; o <<= 1) v += __shfl_xor(v, o);
    return v;
}

template <class RowMap>
__device__ __forceinline__ void cvt_item(const float* W, int K, int N, f16* WT, const RowMap& rm, int item, int lane) {
    const int nblk = N / 64, kb = item / nblk, nb = item % nblk, k0 = 64 * kb, n = 64 * nb + lane;
    const float* src = W + (size_t)k0 * N + n;
    f16* dst = WT + (size_t)rm(n) * K + k0;
#pragma unroll
    for (int c = 0; c < 8; c += 4) {
        float v[32];
#pragma unroll
        for (int j = 0; j < 32; ++j) v[j] = src[(size_t)(8 * c + j) * N];
#pragma unroll
        for (int cc = 0; cc < 4; ++cc) { u32x4 w; w.x = pkh(v[8 * cc + 0], v[8 * cc + 1]); w.y = pkh(v[8 * cc + 2], v[8 * cc + 3]); w.z = pkh(v[8 * cc + 4], v[8 * cc + 5]); w.w = pkh(v[8 * cc + 6], v[8 * cc + 7]);
            *(u32x4*)(dst + 8 * (c + cc)) = w; }
    }
}
struct MapPlain { __device__ __forceinline__ int operator()(int n) const { return n; } };
struct MapRope { __device__ __forceinline__ int operator()(int n) const {
    const bool rp = (n >= 512 && n < 1024) || (n >= 1536 && n < 2048); if (!rp) return n; const int i = n & 31; return (n & ~31) + (i < 16 ? 2 * i : 2 * (i - 16) + 1); } };
struct MapGLU { int add; __device__ __forceinline__ int operator()(int n) const { return (n >> 7) * 256 + (n & 127) + add; } };

__device__ __forceinline__ void cvt_moe(const float* w1, const float* w3, const float* w2, f16* W13, f16* W2T, int gw, int NGW, int lane) {
    constexpr int I13 = (DM / 64) * (DE / 64), I2 = (DE / 64) * (DM / 64);
    constexpr int NIT = NE * (2 * I13 + I2);
    for (int it = gw; it < NIT; it += NGW) {
        const int e = it / (2 * I13 + I2); int r = it % (2 * I13 + I2);
        if (r < I13) { cvt_item(w1 + (size_t)e * DM * DE, DM, DE, W13 + (size_t)e * 2 * DE * DM, MapGLU{0}, r, lane); continue; } r -= I13;
        if (r < I13) { cvt_item(w3 + (size_t)e * DM * DE, DM, DE, W13 + (size_t)e * 2 * DE * DM, MapGLU{128}, r, lane); continue; } r -= I13;
        cvt_item(w2 + (size_t)e * DE * DM, DE, DM, W2T + (size_t)e * DM * DE, MapPlain{}, r, lane);
    }
}

__device__ __forceinline__ void phase_prologue(const Params& p, LAS unsigned char* lds) {
    const int tid = threadIdx.x, lane = tid & 63, wave = __builtin_amdgcn_readfirstlane(tid >> 6);
    const int G = gridDim.x;
    unsigned char* ws = p.ws;
    LAS float* S = (LAS float*)lds;
    LAS float* red = (LAS float*)(lds + 17 * 1024 * 4);
    for (int u = blockIdx.x; u < 193; u += G) {
        if (u == 192) {
            float* rope = (float*)(ws + WS_MOD + ROPE_OFF);
            for (int idx = tid; idx < 1024; idx += 512) { const int pos = idx >> 4, i = idx & 15; const float fr = powf(10000.f, -(float)i / 16.f), ang = (float)pos * fr;
                rope[idx * 2] = cosf(ang); rope[idx * 2 + 1] = sinf(ang); }
            if (wave == 0) { const float s1 = wave_sum(p.in[I_L0_LQ1][lane] * p.in[I_L0_LK1][lane]), s2 = wave_sum(p.in[I_L0_LQ2][lane] * p.in[I_L0_LK2][lane]);
                if (lane == 0) *(float*)(ws + WS_MOD + LAM_OFF) = expf(s1) - expf(s2) + 0.2f; }
            continue;
        }
        const int l = u / 96, col0 = (u % 96) * 64;
        const float* wmod = p.in[l ? I_L1_WMOD : I_L0_WMOD]; const float* bmod = p.in[l ? I_L1_BMOD : I_L0_BMOD];
        float* mod = (float*)(ws + WS_MOD + (l ? MOD1_OFF : MOD0_OFF));
        for (int idx = tid; idx < 17 * 1024; idx += 512) { const float v = idx < 16 * 1024 ? p.in[I_C][idx] : p.in[I_CCTX][idx - 16 * 1024]; S[idx] = silu_f(v); }
        __syncthreads();
        float acc[17];
#pragma unroll
        for (int r = 0; r < 17; ++r) acc[r] = 0.f;
        const int kb = wave * 128;
        for (int kk = 0; kk < 128; kk += 4) {
            float wv[4];
#pragma unroll
            for (int i = 0; i < 4; ++i) wv[i] = wmod[(size_t)(kb + kk + i) * 6144 + col0 + lane];
#pragma unroll
            for (int r = 0; r < 17; ++r) { const f32x4 sv = *(const LAS f32x4*)(S + r * 1024 + kb + kk); acc[r] += sv[0] * wv[0] + sv[1] * wv[1] + sv[2] * wv[2] + sv[3] * wv[3]; }
        }
#pragma unroll
        for (int r = 0; r < 17; ++r) red[(wave * 17 + r) * 64 + lane] = acc[r];
        __syncthreads();
        for (int idx = tid; idx < 17 * 64; idx += 512) { const int r = idx >> 6, ln = idx & 63; float s = bmod[col0 + ln];
#pragma unroll
            for (int w = 0; w < 8; ++w) s += red[(w * 17 + r) * 64 + ln];
            if (r < 16 || l == 0) mod[(size_t)r * 6144 + col0 + ln] = s; }
        __syncthreads();
    }
    const int gw = blockIdx.x * 8 + wave, NGW = G * 8;
    constexpr int IT_IN0 = (DM / 64) * (ZP0 / 64), IT_OUT = (DM / 64) * (DM / 64), IT_IN1 = (DM / 64) * (ZP1 / 64);
    for (int it = gw; it < IT_IN0 + 2 * IT_OUT + IT_IN1; it += NGW) {
        int r = it;
        if (r < IT_IN0) { cvt_item(p.in[I_L0_WIN], DM, ZP0, (f16*)(ws + WS_WIN0), MapRope{}, r, lane); continue; } r -= IT_IN0;
        if (r < IT_OUT) { cvt_item(p.in[I_L0_WOUT], DM, DM, (f16*)(ws + WS_WOUT0), MapPlain{}, r, lane); continue; } r -= IT_OUT;
        if (r < IT_IN1) { cvt_item(p.in[I_L1_WIN], DM, ZP1, (f16*)(ws + WS_WIN1), MapPlain{}, r, lane); continue; } r -= IT_IN1;
        cvt_item(p.in[I_L1_WOUT], DM, DM, (f16*)(ws + WS_WOUT1), MapPlain{}, r, lane);
    }
    cvt_moe(p.in[I_L0_W1], p.in[I_L0_W3], p.in[I_L0_W2], (f16*)(ws + WS_W13), (f16*)(ws + WS_W2), gw, NGW, lane);
}

struct NormArgs {
    const float* src;
    float* xout;
    const f16* y2; const short* inv; const float* gate2;
    const float* gain;
    const float* shift; const float* scale; int mstride;
    f16* hout;
    float* fout;
    const float* wr; float* aff;
};

__device__ __forceinline__ void norm_phase(const NormArgs& a, LAS unsigned char* lds, int nrows_total, bool ctx_rows, const float* ctx_src, const float* ctx_shift, const float* ctx_scale) {
    const int tid = threadIdx.x, lane = tid & 63, wave = __builtin_amdgcn_readfirstlane(tid >> 6);
    const int G = gridDim.x;
    LAS float* wl = (LAS float*)lds;
    if (a.wr) {
        for (int idx = tid; idx < 16384; idx += 512) { const int k = idx >> 4, e = idx & 15; wl[e * 1028 + k] = a.wr[idx]; }
        __syncthreads();
    }
    const int gw = blockIdx.x * 8 + wave, NGW = G * 8;
    for (int chunk = gw; chunk < NTOK / 16; chunk += NGW) {
        const int row0 = chunk * 16, b = row0 / SEQ;
        f32x4 A[4], Sh[4], G2[4];
#pragma unroll
        for (int j = 0; j < 4; ++j) { const int c = 4 * lane + 256 * j; const f32x4 g = *(const f32x4*)(a.gain + c);
            if (a.shift) { const f32x4 sc = *(const f32x4*)(a.scale + (size_t)b * a.mstride + c); A[j] = g * (sc + 1.f); Sh[j] = *(const f32x4*)(a.shift + (size_t)b * a.mstride + c); }
            else { A[j] = g; Sh[j] = (f32x4){0.f, 0.f, 0.f, 0.f}; }
            if (a.y2) G2[j] = *(const f32x4*)(a.gate2 + (size_t)b * 6144 + c); else G2[j] = (f32x4){0.f, 0.f, 0.f, 0.f}; }
        for (int rr = 0; rr < 16; rr += 2) {
            f32x4 v[2][4];
#pragma unroll
            for (int q = 0; q < 2; ++q) { const int row = row0 + rr + q; const float* xr = a.src + (size_t)row * DM;
#pragma unroll
                for (int j = 0; j < 4; ++j) v[q][j] = *(const f32x4*)(xr + 4 * lane + 256 * j); }
            if (a.y2) {
#pragma unroll
                for (int q = 0; q < 2; ++q) { const int row = row0 + rr + q, t = row & (SEQ - 1);
                    int sl = -1; if (lane < 16) sl = a.inv[((size_t)b * NE + lane) * SEQ + t];
                    unsigned long long mask = __ballot(sl >= 0);
                    f32x4 cs[4];
#pragma unroll
                    for (int j = 0; j < 4; ++j) cs[j] = (f32x4){0.f, 0.f, 0.f, 0.f};
                    while (mask) {
                        int ee[4]; float wgt[4];
#pragma unroll
                        for (int i = 0; i < 4; ++i) { if (mask) { ee[i] = __builtin_ctzll(mask); mask &= mask - 1; wgt[i] = 1.f; } else { ee[i] = ee[0]; wgt[i] = 0.f; } }
                        f16x4 ld[4][4];
#pragma unroll
                        for (int i = 0; i < 4; ++i) { const int slot = __shfl(sl, ee[i]); const f16* yr = a.y2 + ((size_t)ee[i] * EROWS + b * CAP + slot) * DM + 4 * lane;
#pragma unroll
                            for (int j = 0; j < 4; ++j) ld[i][j] = *(const f16x4*)(yr + 256 * j); }
#pragma unroll
                        for (int i = 0; i < 4; ++i)
#pragma unroll
                            for (int j = 0; j < 4; ++j) { cs[j][0] += wgt[i] * (float)ld[i][j][0]; cs[j][1] += wgt[i] * (float)ld[i][j][1]; cs[j][2] += wgt[i] * (float)ld[i][j][2]; cs[j][3] += wgt[i] * (float)ld[i][j][3]; }
                    }
                    float* xo = a.xout + (size_t)row * DM;
#pragma unroll
                    for (int j = 0; j < 4; ++j) { v[q][j] = v[q][j] + G2[j] * cs[j]; if (!a.fout) *(f32x4*)(xo + 4 * lane + 256 * j) = v[q][j]; }
                }
            }
            float rstd[2];
#pragma unroll
            for (int q = 0; q < 2; ++q) { float ss = 0.f;
#pragma unroll
                for (int j = 0; j < 4; ++j) ss += (v[q][j][0] * v[q][j][0] + v[q][j][1] * v[q][j][1]) + (v[q][j][2] * v[q][j][2] + v[q][j][3] * v[q][j][3]);
                rstd[q] = 1.0f / sqrtf(wave_sum(ss) * (1.f / DM) + EPS); }
#pragma unroll
            for (int q = 0; q < 2; ++q) { const int row = row0 + rr + q;
#pragma unroll
                for (int j = 0; j < 4; ++j) v[q][j] = (v[q][j] * rstd[q]) * A[j] + Sh[j];
                if (a.fout) {
#pragma unroll
                    for (int j = 0; j < 4; ++j) *(f32x4*)(a.fout + (size_t)row * DM + 4 * lane + 256 * j) = v[q][j];
                }
                if (a.hout) {
#pragma unroll
                    for (int j = 0; j < 4; ++j) { u32x2 w; w.x = pkh(v[q][j][0], v[q][j][1]); w.y = pkh(v[q][j][2], v[q][j][3]); *(u32x2*)(a.hout + (size_t)row * DM + 4 * lane + 256 * j) = w; }
                }
            }
            if (a.wr) {
#pragma unroll 1
                for (int q = 0; q < 2; ++q) {
                    float lg[16];
                    const f32x4 h0 = q ? v[1][0] : v[0][0], h1 = q ? v[1][1] : v[0][1], h2 = q ? v[1][2] : v[0][2], h3 = q ? v[1][3] : v[0][3];
#pragma unroll
                    for (int e = 0; e < 16; ++e) { const LAS float* wp = wl + e * 1028 + 4 * lane;
                        const f32x4 w0 = *(const LAS f32x4*)(wp), w1 = *(const LAS f32x4*)(wp + 256), w2 = *(const LAS f32x4*)(wp + 512), w3 = *(const LAS f32x4*)(wp + 768);
                        lg[e] = ((h0[0] * w0[0] + h0[1] * w0[1]) + (h0[2] * w0[2] + h0[3] * w0[3])) + ((h1[0] * w1[0] + h1[1] * w1[1]) + (h1[2] * w1[2] + h1[3] * w1[3]))
                              + ((h2[0] * w2[0] + h2[1] * w2[1]) + (h2[2] * w2[2] + h2[3] * w2[3])) + ((h3[0] * w3[0] + h3[1] * w3[1]) + (h3[2] * w3[2] + h3[3] * w3[3]));
                        asm volatile("" ::: "memory"); }
#pragma unroll
                    for (int i = 0; i < 8; ++i) { const bool hi = lane & 32; const float send = hi ? lg[i] : lg[i + 8], keep = hi ? lg[i + 8] : lg[i]; lg[i] = keep + __shfl_xor(send, 32); }
#pragma unroll
                    for (int i = 0; i < 4; ++i) { const bool hi = lane & 16; const float send = hi ? lg[i] : lg[i + 4], keep = hi ? lg[i + 4] : lg[i]; lg[i] = keep + __shfl_xor(send, 16); }
#pragma unroll
                    for (int i = 0; i < 2; ++i) { const bool hi = lane & 8; const float send = hi ? lg[i] : lg[i + 2], keep = hi ? lg[i + 2] : lg[i]; lg[i] = keep + __shfl_xor(send, 8); }
                    { const bool hi = lane & 4; const float send = hi ? lg[0] : lg[1], keep = hi ? lg[1] : lg[0]; lg[0] = keep + __shfl_xor(send, 4); }
                    float lv = lg[0]; lv += __shfl_xor(lv, 2); lv += __shfl_xor(lv, 1);
                    float mx = lv;
#pragma unroll
                    for (int o = 4; o < 64; o <<= 1) mx = fmaxf(mx, __shfl_xor(mx, o));
                    const float ex = expf(lv - mx); float sm = ex;
#pragma unroll
                    for (int o = 4; o < 64; o <<= 1) sm += __shfl_xor(sm, o);
                    const int row = row0 + rr + q, t = row & (SEQ - 1), e = (lane >> 2) & 15;
                    if ((lane & 3) == 0) a.aff[((size_t)b * NE + e) * SEQ + t] = ex / sm;
                }
            }
        }
    }
    if (ctx_rows) {
        f32x4 A[4], Sh[4];
#pragma unroll
        for (int j = 0; j < 4; ++j) { const int c = 4 * lane + 256 * j; A[j] = *(const f32x4*)(a.gain + c) * (*(const f32x4*)(ctx_scale + c) + 1.f); Sh[j] = *(const f32x4*)(ctx_shift + c); }
        for (int row = gw; row < NCTX; row += NGW) {
            f32x4 v[4]; float ss = 0.f;
#pragma unroll
            for (int j = 0; j < 4; ++j) { v[j] = *(const f32x4*)(ctx_src + (size_t)row * DM + 4 * lane + 256 * j); ss += (v[j][0] * v[j][0] + v[j][1] * v[j][1]) + (v[j][2] * v[j][2] + v[j][3] * v[j][3]); }
            const float rstd = 1.0f / sqrtf(wave_sum(ss) * (1.f / DM) + EPS);
#pragma unroll
            for (int j = 0; j < 4; ++j) { const f32x4 h = (v[j] * rstd) * A[j] + Sh[j]; u32x2 w; w.x = pkh(h[0], h[1]); w.y = pkh(h[2], h[3]); *(u32x2*)(a.hout + (size_t)(NTOK + row) * DM + 4 * lane + 256 * j) = w; }
        }
    }
    (void)nrows_total;
    __syncthreads();
}

__device__ __forceinline__ void topk_phase(const float* aff, int* idx, float* gv, short* inv, const f16* H, f16* XIN, LAS unsigned char* lds) {
    const int tid = threadIdx.x, lane = tid & 63, wave = __builtin_amdgcn_readfirstlane(tid >> 6);
    LAS unsigned long long* key = (LAS unsigned long long*)lds;
    for (int u = blockIdx.x; u < NB * NE; u += gridDim.x) {
        const int b = u / NE, e = u % NE;
        const float* av = aff + (size_t)u * SEQ;
        for (int t = tid; t < SEQ; t += 512) key[t] = ((unsigned long long)(~__float_as_uint(av[t])) << 32) | (unsigned)t;
        __syncthreads();
        for (int k = 2; k <= SEQ; k <<= 1)
            for (int j = k >> 1; j > 0; j >>= 1) {
#pragma unroll
                for (int pp = 0; pp < 2; ++pp) { const int pr = tid + pp * 512; const int i = ((pr & ~(j - 1)) << 1) | (pr & (j - 1)), i2 = i | j;
                    const unsigned long long x = key[i], y = key[i2]; const bool up = (i & k) == 0;
                    if ((x > y) == up) { key[i] = y; key[i2] = x; } }
                __syncthreads();
            }
        for (int r = tid; r < SEQ; r += 512) { const unsigned long long kk = key[r]; const int t = (int)(unsigned)kk;
            inv[(size_t)u * SEQ + t] = (short)(r < CAP ? r : -1);
            if (r < CAP) { idx[u * CAP + r] = t; gv[u * CAP + r] = __uint_as_float(~(unsigned)(kk >> 32)); } }
        for (int r = wave; r < CAP; r += 8) { const int t = (int)(unsigned)key[r];
            const u32x4* s = (const u32x4*)(H + ((size_t)b * SEQ + t) * DM); u32x4* d = (u32x4*)(XIN + ((size_t)e * EROWS + b * CAP + r) * DM);
            const u32x4 v0 = s[lane], v1 = s[lane + 64]; d[lane] = v0; d[lane + 64] = v1; }
        __syncthreads();
    }
}

namespace at {
constexpr int KS = 272, VS = 320;
constexpr int KT_BYTES = 64 * KS, VT_BYTES = 64 * VS, BUF_BYTES = KT_BYTES + VT_BYTES;
constexpr int RPB_OFF = 2 * BUF_BYTES;
typedef _Float16 v4h __attribute__((ext_vector_type(4)));

__device__ __forceinline__ void stage_load(const f16* Z, long rowbase, int kcol, int vcol, u32x4 (&kr)[2], u32x4 (&vr)[2], int tid) {
#pragma unroll
    for (int i = 0; i < 2; ++i) { const int id = tid + 512 * i, row = id >> 4, ch = id & 15; const f16* rp = Z + (size_t)(rowbase + row) * ZP0 + 8 * ch;
        kr[i] = *(const u32x4*)(rp + kcol); vr[i] = *(const u32x4*)(rp + vcol); }
}
__device__ __forceinline__ void stage_store(LAS unsigned char* buf, const u32x4 (&kr)[2], const u32x4 (&vr)[2], int tid) {
#pragma unroll
    for (int i = 0; i < 2; ++i) { const int id = tid + 512 * i, row = id >> 4, ch = id & 15;
        *(LAS u32x4*)(buf + row * KS + ch * 16) = kr[i]; *(LAS u32x4*)(buf + KT_BYTES + row * VS + ch * 16) = vr[i]; }
}
__device__ __forceinline__ f32x16 qk(LAS unsigned char* buf, int kb, int kcolb, const f16x8 (&qf)[4], int lane) {
    const LAS unsigned char* kp = buf + (kb + (lane & 31)) * KS + kcolb + (lane >> 5) * 16;
    f32x16 s;
#pragma unroll
    for (int r = 0; r < 16; ++r) s[r] = 0.f;
#pragma unroll
    for (int st = 0; st < 4; ++st) { const f16x8 a = *(const LAS f16x8*)(kp + st * 32); s = __builtin_amdgcn_mfma_f32_32x32x16_f16(a, qf[st], s, 0, 0, 0); }
    return s;
}
template <int NDT>
__device__ __forceinline__ void softmax_pv(const f32x16& s, LAS unsigned char* buf, int kb, int vcolb, f32x16 (&o)[NDT], float& m, float& l, int lane) {
    float mx = s[0];
#pragma unroll
    for (int r = 1; r < 16; ++r) mx = fmaxf(mx, s[r]);
    mx = fmaxf(mx, __shfl_xor(mx, 32));
    const float mn = fmaxf(m, mx), alpha = __builtin_amdgcn_exp2f(m - mn); m = mn;
    f32x16 p; float ps = 0.f;
#pragma unroll
    for (int r = 0; r < 16; ++r) { p[r] = __builtin_amdgcn_exp2f(s[r] - mn); ps += p[r]; }
    l = l * alpha + ps;
#pragma unroll
    for (int dt = 0; dt < NDT; ++dt)
#pragma unroll
        for (int r = 0; r < 16; ++r) o[dt][r] *= alpha;
    const int hh = lane >> 5, i = lane & 15, q_ = i >> 2, p_ = i & 3, g1 = (lane >> 4) & 1;
#pragma unroll
    for (int s2 = 0; s2 < 2; ++s2) {
        f16x8 pb;
#pragma unroll
        for (int j = 0; j < 8; ++j) pb[j] = (f16)p[8 * s2 + j];
        const LAS unsigned char* vp = buf + KT_BYTES + (kb + 16 * s2 + 4 * hh + q_) * VS + vcolb + (16 * g1 + 4 * p_) * 2;
#pragma unroll
        for (int dt = 0; dt < NDT; ++dt) {
            const v4h lo = __builtin_bit_cast(v4h, __builtin_amdgcn_ds_read_tr16_b64_v4i16((LAS s16x4*)(vp + dt * 64)));
            const v4h hi = __builtin_bit_cast(v4h, __builtin_amdgcn_ds_read_tr16_b64_v4i16((LAS s16x4*)(vp + dt * 64 + 8 * VS)));
            const f16x8 a = {lo[0], lo[1], lo[2], lo[3], hi[0], hi[1], hi[2], hi[3]};
            o[dt] = __builtin_amdgcn_mfma_f32_32x32x16_f16(a, pb, o[dt], 0, 0, 0);
        }
    }
}

__device__ __forceinline__ void diff_unit(int u, const f16* Z, f16* Y, const float* subln, float lam, LAS unsigned char* lds) {
    const int tid = threadIdx.x, lane = tid & 63, wave = __builtin_amdgcn_readfirstlane(tid >> 6);
    const int qb = u & 15, h = (u >> 4) & 3, b = u >> 6;
    const int map = wave >> 2, r32 = lane & 31, hh = lane >> 5;
    const long tokbase = (long)b * SEQ;
    const long qrow = tokbase + qb * 128 + (wave & 3) * 32 + r32;
    f16x8 qf[4];
#pragma unroll
    for (int st = 0; st < 4; ++st) qf[st] = *(const f16x8*)(Z + (size_t)qrow * ZP0 + 512 + 128 * h + 64 * map + 16 * st + 8 * hh);
    f32x16 o[4];
#pragma unroll
    for (int dt = 0; dt < 4; ++dt)
#pragma unroll
        for (int r = 0; r < 16; ++r) o[dt][r] = 0.f;
    float m = -1e30f, l = 0.f;
    const int kcol = 1536 + 128 * h, vcol = 2560 + 128 * h;
    constexpr int NT = 36;
    u32x4 kr[2], vr[2];
    stage_load(Z, tokbase, kcol, vcol, kr, vr, tid);
    stage_store(lds, kr, vr, tid);
    __syncthreads();
    for (int t = 0; t < NT; ++t) {
        LAS unsigned char* buf = lds + (t & 1) * BUF_BYTES;
        if (t + 1 < NT) { const int tn = t + 1; const long rb = tn < 32 ? tokbase + 64 * tn : (long)NTOK + b * CTXL + 64 * (tn - 32); stage_load(Z, rb, kcol, vcol, kr, vr, tid); }
#pragma unroll
        for (int sub = 0; sub < 2; ++sub) { const f32x16 s = qk(buf, 32 * sub, 128 * map, qf, lane); softmax_pv<4>(s, buf, 32 * sub, 0, o, m, l, lane); }
        if (t + 1 < NT) stage_store(lds + ((t + 1) & 1) * BUF_BYTES, kr, vr, tid);
        __syncthreads();
    }
    const float linv = 1.f / (l + __shfl_xor(l, 32));
    LAS float* cb = (LAS float*)lds + (wave & 3) * 4096;
    if (map == 1) {
#pragma unroll
        for (int dt = 0; dt < 4; ++dt)
#pragma unroll
            for (int r = 0; r < 16; ++r) cb[(dt * 16 + r) * 64 + lane] = o[dt][r] * linv;
    }
    __syncthreads();
    if (map == 0) {
        float ss = 0.f;
#pragma unroll
        for (int dt = 0; dt < 4; ++dt)
#pragma unroll
            for (int r = 0; r < 16; ++r) { const float d = o[dt][r] * linv - lam * cb[(dt * 16 + r) * 64 + lane]; o[dt][r] = d; ss += d * d; }
        ss += __shfl_xor(ss, 32);
        const float rstd = 0.8f / sqrtf(ss * (1.f / 128.f) + EPS);
        f16* yr = Y + (size_t)qrow * DM + 512 + 128 * h;
#pragma unroll
        for (int dt = 0; dt < 4; ++dt)
#pragma unroll
            for (int rg = 0; rg < 4; ++rg) { const int d0 = 32 * dt + 8 * rg + 4 * hh; const f32x4 sg = *(const f32x4*)(subln + d0);
                u32x2 w; w.x = pkh(o[dt][4 * rg] * rstd * sg[0], o[dt][4 * rg + 1] * rstd * sg[1]); w.y = pkh(o[dt][4 * rg + 2] * rstd * sg[2], o[dt][4 * rg + 3] * rstd * sg[3]);
                *(u32x2*)(yr + d0) = w; }
    }
    __syncthreads();
}

__device__ __forceinline__ void na_unit(int u, const f16* Z, f16* Y, const float* rpb, LAS unsigned char* lds) {
    const int tid = threadIdx.x, lane = tid & 63, wave = __builtin_amdgcn_readfirstlane(tid >> 6);
    const int rp = u & 15, hp = (u >> 4) & 3, b = u >> 6;
    const int hs = wave >> 2, a = wave & 3, head = 2 * hp + hs, r32 = lane & 31, hh = lane >> 5;
    const int r0 = 2 * rp, qr = r0 + (r32 >> 4), qc = 16 * a + (r32 & 15);
    const int rsq = min(max(qr - 4, 0), 24), csq = min(max(qc - 8, 0), 48);
    const int lo = min(max(r0 - 4, 0), 24), hi = min(max(r0 + 1 - 4, 0), 24) + 8;
    const int seg = (a == 0) ? 0 : (a == 1) ? 8 : (a == 2) ? 24 : 32;
    const long tokbase = (long)b * SEQ;
    const long qrow = tokbase + qr * 64 + qc;
    LAS float* tab = (LAS float*)(lds + RPB_OFF);
    for (int i = tid; i < 2 * 465; i += 512) tab[i] = rpb[(2 * hp) * 465 + i] * LOG2E;
    f16x8 qf[4];
#pragma unroll
    for (int st = 0; st < 4; ++st) qf[st] = *(const f16x8*)(Z + (size_t)qrow * ZP0 + 64 * head + 16 * st + 8 * hh);
    f32x16 o[2];
#pragma unroll
    for (int dt = 0; dt < 2; ++dt)
#pragma unroll
        for (int r = 0; r < 16; ++r) o[dt][r] = 0.f;
    float m = -1e30f, l = 0.f;
    const int kcol = 1024 + 128 * hp, vcol = 2048 + 128 * hp;
    const int nwin = hi - lo, NT = nwin + 4;
    u32x4 kr[2], vr[2];
    stage_load(Z, tokbase + lo * 64, kcol, vcol, kr, vr, tid);
    stage_store(lds, kr, vr, tid);
    __syncthreads();
    for (int t = 0; t < NT; ++t) {
        LAS unsigned char* buf = lds + (t & 1) * BUF_BYTES;
        if (t + 1 < NT) { const int tn = t + 1; const long rb = tn < nwin ? tokbase + (lo + tn) * 64 : (long)NTOK + b * CTXL + 64 * (tn - nwin); stage_load(Z, rb, kcol, vcol, kr, vr, tid); }
        if (t < nwin) {
            const int krow = lo + t;
            f32x16 s = qk(buf, seg, 128 * hs, qf, lane);
            const bool rowok = (krow >= rsq) && (krow < rsq + 8);
            const int rbase = (krow - qr + 7) * 31 + 15 - qc;
#pragma unroll
            for (int r = 0; r < 16; ++r) { const int kc = seg + (r & 3) + 8 * (r >> 2) + 4 * hh; const bool ok = rowok && (kc >= csq) && (kc < csq + 16);
                const int bi = min(max(rbase + kc, 0), 464); const float bias = tab[hs * 465 + bi];
                s[r] = ok ? s[r] + bias : -INFINITY; }
            softmax_pv<2>(s, buf, seg, 128 * hs, o, m, l, lane);
        } else {
#pragma unroll
            for (int sub = 0; sub < 2; ++sub) { const f32x16 s = qk(buf, 32 * sub, 128 * hs, qf, lane); softmax_pv<2>(s, buf, 32 * sub, 128 * hs, o, m, l, lane); }
        }
        if (t + 1 < NT) stage_store(lds + ((t + 1) & 1) * BUF_BYTES, kr, vr, tid);
        __syncthreads();
    }
    const float linv = 1.f / (l + __shfl_xor(l, 32));
    f16* yr = Y + (size_t)qrow * DM + 64 * head;
#pragma unroll
    for (int dt = 0; dt < 2; ++dt)
#pragma unroll
        for (int rg = 0; rg < 4; ++rg) { const int d0 = 32 * dt + 8 * rg + 4 * hh;
            u32x2 w; w.x = pkh(o[dt][4 * rg] * linv, o[dt][4 * rg + 1] * linv); w.y = pkh(o[dt][4 * rg + 2] * linv, o[dt][4 * rg + 3] * linv);
            *(u32x2*)(yr + d0) = w; }
}

__device__ __forceinline__ void attn_phase(const f16* Z, f16* Y, const float* rpb, const float* subln, const float* lamp, LAS unsigned char* lds) {
    const float lam = *lamp;
    for (int u = blockIdx.x; u < 2048; u += gridDim.x) {
        if (u < 1024) diff_unit(u, Z, Y, subln, lam, lds);
        else na_unit(u - 1024, Z, Y, rpb, lds);
    }
}
}

__device__ __forceinline__ void conv_phase(const f16* Z1, f16* Y, const float* scw, const float* cfw, const float* cfb, const float* lng, const float* lnb, LAS unsigned char* lds) {
    const int tid = threadIdx.x, lane = tid & 63, wave = __builtin_amdgcn_readfirstlane(tid >> 6);
    LAS float* U = (LAS float*)lds;
    float cw[31];
#pragma unroll
    for (int k = 0; k < 31; ++k) cw[k] = cfw[k * 512 + tid];
    const float cb = cfb[tid];
    for (int u = blockIdx.x; u < NTOK / 32; u += gridDim.x) {
        const int b = u >> 6, t0 = (u & 63) * 32;
        const f16* zb = Z1 + (size_t)b * SEQ * ZP1;
        for (int pass = 0; pass < 16; ++pass) { const int row = pass * 4 + (tid >> 7), c4 = (tid & 127) * 4, tt = t0 - 15 + row;
            if (row < 62) { f32x4 uv = (f32x4){0.f, 0.f, 0.f, 0.f};
                if (tt >= 0 && tt < SEQ) { const f16x4 av = *(const f16x4*)(zb + (size_t)tt * ZP1 + 1536 + c4), gv = *(const f16x4*)(zb + (size_t)tt * ZP1 + 2048 + c4);
#pragma unroll
                    for (int j = 0; j < 4; ++j) uv[j] = (float)av[j] / (1.f + __expf(-(float)gv[j])); }
                *(LAS f32x4*)(U + row * 512 + c4) = uv; } }
        __syncthreads();
        float uu[62];
#pragma unroll
        for (int i = 0; i < 62; ++i) uu[i] = U[i * 512 + tid];
        __syncthreads();
#pragma unroll
        for (int tt = 0; tt < 32; ++tt) { float v = cb;
#pragma unroll
            for (int k = 0; k < 31; ++k) v += cw[k] * uu[tt + k];
            U[tt * 512 + tid] = v; }
        __syncthreads();
#pragma unroll
        for (int q = 0; q < 4; ++q) { const int tt = wave * 4 + q, t = t0 + tt, c8 = lane * 8;
            const f32x4 x0 = *(const LAS f32x4*)(U + tt * 512 + c8), x1 = *(const LAS f32x4*)(U + tt * 512 + c8 + 4);
            float x[8] = {x0[0], x0[1], x0[2], x0[3], x1[0], x1[1], x1[2], x1[3]};
            float s = 0.f;
#pragma unroll
            for (int j = 0; j < 8; ++j) s += x[j];
            const float mean = wave_sum(s) * (1.f / 512.f); float s2 = 0.f;
#pragma unroll
            for (int j = 0; j < 8; ++j) { x[j] -= mean; s2 += x[j] * x[j]; }
            const float rstd = 1.0f / sqrtf(wave_sum(s2) * (1.f / 512.f) + EPS);
            const f32x4 g0 = *(const f32x4*)(lng + c8), g1 = *(const f32x4*)(lng + c8 + 4), b0 = *(const f32x4*)(lnb + c8), b1 = *(const f32x4*)(lnb + c8 + 4);
            const float gg[8] = {g0[0], g0[1], g0[2], g0[3], g1[0], g1[1], g1[2], g1[3]}, bb[8] = {b0[0], b0[1], b0[2], b0[3], b1[0], b1[1], b1[2], b1[3]};
            float yd[8];
#pragma unroll
            for (int j = 0; j < 8; ++j) yd[j] = silu_f(x[j] * rstd * gg[j] + bb[j]);
            f16* yr = Y + ((size_t)b * SEQ + t) * DM;
            { u32x4 w; w.x = pkh(yd[0], yd[1]); w.y = pkh(yd[2], yd[3]); w.z = pkh(yd[4], yd[5]); w.w = pkh(yd[6], yd[7]); *(u32x4*)(yr + 512 + c8) = w; }
            float cacc[8];
#pragma unroll
            for (int j = 0; j < 8; ++j) cacc[j] = 0.f;
#pragma unroll
            for (int k = 0; k < 3; ++k) { const int ts = t + k - 1;
                if (ts >= 0 && ts < SEQ) { const f16x8 xc = *(const f16x8*)(zb + (size_t)ts * ZP1 + c8), gc = *(const f16x8*)(zb + (size_t)ts * ZP1 + 1024 + c8);
                    const f32x4 w0 = *(const f32x4*)(scw + k * 512 + c8), w1 = *(const f32x4*)(scw + k * 512 + c8 + 4);
                    const float ww[8] = {w0[0], w0[1], w0[2], w0[3], w1[0], w1[1], w1[2], w1[3]};
#pragma unroll
                    for (int j = 0; j < 8; ++j) cacc[j] += ww[j] * ((float)gc[j] * (float)xc[j]); } }
            const f16x8 gb = *(const f16x8*)(zb + (size_t)t * ZP1 + 512 + c8);
            { u32x4 w; w.x = pkh((float)gb[0] * cacc[0], (float)gb[1] * cacc[1]); w.y = pkh((float)gb[2] * cacc[2], (float)gb[3] * cacc[3]);
              w.z = pkh((float)gb[4] * cacc[4], (float)gb[5] * cacc[5]); w.w = pkh((float)gb[6] * cacc[6], (float)gb[7] * cacc[7]); *(u32x4*)(yr + c8) = w; }
        }
        __syncthreads();
    }
}

constexpr int NPHASE = 18;
__global__ void __launch_bounds__(512, 2) fwd(Params p) {
    extern __shared__ __attribute__((aligned(16))) unsigned char lds_raw[];
    LAS unsigned char* lds = (LAS unsigned char*)lds_raw;
    const int tid = threadIdx.x;
    unsigned char* ws = p.ws;
    for (int u = tid; u < (LDS_BYTES - LDSCTL_OFF) / 4; u += 512) ((LAS unsigned*)(lds + LDSCTL_OFF))[u] = 0u;
    __syncthreads();
    XcdBarrier bar; bar.bar = (unsigned*)(ws + WS_CTL) + 4096; bar.x = 0; bar.st = nullptr;
    if (N_LAUNCH_MODE == 1) bar = xcd_barrier_post((unsigned*)(ws + WS_CTL) + 4096, (volatile LAS unsigned*)(lds + MISC_OFF) + 8);
    const int lo = p.ph_lo, hi = p.ph_hi;
#ifndef ONLYP
#define ONLYP -1
#endif
#define IN(k) ((ONLYP < 0 || ONLYP == (k)) && lo <= (k) && (k) < hi)
#define SEAM(k) do { if (IN(k) && IN((k) + 1)) xcd_barrier(bar); } while (0)
    const int G = gridDim.x, c = blockIdx.x;
    float* mod0 = (float*)(ws + WS_MOD + MOD0_OFF); float* mod1 = (float*)(ws + WS_MOD + MOD1_OFF);
    f16* H = (f16*)(ws + WS_H); f16* Z = (f16*)(ws + WS_Z); f16* Y = (f16*)(ws + WS_Y); f16* XIN = (f16*)(ws + WS_XIN); f16* HID = (f16*)(ws + WS_HID); f16* Y2 = (f16*)(ws + WS_Y2);
    f16* W13 = (f16*)(ws + WS_W13); f16* W2T = (f16*)(ws + WS_W2);
    float* AFF = (float*)(ws + WS_AFF); int* IDX = (int*)(ws + WS_IDX); float* GV = (float*)(ws + WS_G); short* INV = (short*)(ws + WS_INV);

    if (IN(0)) { phase_prologue(p, lds); } SEAM(0);
    if (IN(1)) { NormArgs a{}; a.src = p.in[I_X]; a.gain = p.in[I_L0_NORM1]; a.shift = mod0; a.scale = mod0 + 1024; a.mstride = 6144; a.hout = H;
        norm_phase(a, lds, NTOK, true, p.in[I_CTX], mod0 + 16 * 6144, mod0 + 16 * 6144 + 1024); } SEAM(1);
    if (IN(2)) { gm::Gemm g{H, (const f16*)(ws + WS_WIN0), DM, 0, 0}; gm::Order S; S.init(NROWS, ZP0, 1, G, c);
        gm::EpiInProj0 E{Z, (const float*)(ws + WS_MOD + ROPE_OFF)}; gm::gemm_phase(lds, g, S, E); } SEAM(2);
    if (IN(3)) { at::attn_phase(Z, Y, p.in[I_L0_RPB], p.in[I_L0_SUBLN], (const float*)(ws + WS_MOD + LAM_OFF), lds); } SEAM(3);
    if (IN(4)) { gm::Gemm g{Y, (const f16*)(ws + WS_WOUT0), DM, 0, 0}; gm::Order S; S.init(NTOK, DM, 1, G, c);
        gm::EpiResGate E{p.in[I_X], p.out, mod0 + 2048, 6144}; gm::gemm_phase(lds, g, S, E); } SEAM(4);
    if (IN(5)) { NormArgs a{}; a.src = p.out; a.gain = p.in[I_L0_NORM2]; a.shift = mod0 + 3072; a.scale = mod0 + 4096; a.mstride = 6144; a.hout = H; a.wr = p.in[I_L0_WR]; a.aff = AFF;
        norm_phase(a, lds, NTOK, false, nullptr, nullptr, nullptr); } SEAM(5);
    if (IN(6)) { topk_phase(AFF, IDX, GV, INV, H, XIN, lds); } SEAM(6);
    if (IN(7)) { gm::Gemm g{XIN, W13, DM, (long)EROWS * DM, (long)2 * DE * DM}; gm::Order S; S.init(EROWS, 2 * DE, NE, G, c);
        gm::EpiSwiGLU E{HID}; gm::gemm_phase(lds, g, S, E); } SEAM(7);
    if (IN(8)) { gm::Gemm g{HID, W2T, DE, (long)EROWS * DE, (long)DM * DE}; gm::Order S; S.init(EROWS, DM, NE, G, c);
        gm::EpiRowScale E{Y2, GV}; gm::gemm_phase(lds, g, S, E); } SEAM(8);
    if (IN(9)) { NormArgs a{}; a.src = p.out; a.xout = p.out; a.y2 = Y2; a.inv = INV; a.gate2 = mod0 + 5120; a.gain = p.in[I_L1_NORM1]; a.shift = mod1; a.scale = mod1 + 1024; a.mstride = 6144; a.hout = H;
        norm_phase(a, lds, NTOK, false, nullptr, nullptr, nullptr);
        cvt_moe(p.in[I_L1_W1], p.in[I_L1_W3], p.in[I_L1_W2], W13, W2T, c * 8 + (tid >> 6), G * 8, tid & 63); } SEAM(9);
    if (IN(10)) { gm::Gemm g{H, (const f16*)(ws + WS_WIN1), DM, 0, 0}; gm::Order S; S.init(NTOK, ZP1, 1, G, c);
        gm::EpiF16 E{Z, ZP1}; gm::gemm_phase(lds, g, S, E); } SEAM(10);
    if (IN(11)) { conv_phase(Z, Y, p.in[I_L1_SCW], p.in[I_L1_CFW], p.in[I_L1_CFB], p.in[I_L1_LNG], p.in[I_L1_LNB], lds); } SEAM(11);
    if (IN(12)) { gm::Gemm g{Y, (const f16*)(ws + WS_WOUT1), DM, 0, 0}; gm::Order S; S.init(NTOK, DM, 1, G, c);
        gm::EpiResGate E{p.out, p.out, mod1 + 2048, 6144}; gm::gemm_phase(lds, g, S, E); } SEAM(12);
    if (IN(13)) { NormArgs a{}; a.src = p.out; a.gain = p.in[I_L1_NORM2]; a.shift = mod1 + 3072; a.scale = mod1 + 4096; a.mstride = 6144; a.hout = H; a.wr = p.in[I_L1_WR]; a.aff = AFF;
        norm_phase(a, lds, NTOK, false, nullptr, nullptr, nullptr); } SEAM(13);
    if (IN(14)) { topk_phase(AFF, IDX, GV, INV, H, XIN, lds); } SEAM(14);
    if (IN(15)) { gm::Gemm g{XIN, W13, DM, (long)EROWS * DM, (long)2 * DE * DM}; gm::Order S; S.init(EROWS, 2 * DE, NE, G, c);
        gm::EpiSwiGLU E{HID}; gm::gemm_phase(lds, g, S, E); } SEAM(15);
    if (IN(16)) { gm::Gemm g{HID, W2T, DE, (long)EROWS * DE, (long)DM * DE}; gm::Order S; S.init(EROWS, DM, NE, G, c);
        gm::EpiRowScale E{Y2, GV}; gm::gemm_phase(lds, g, S, E); } SEAM(16);
    if (IN(17)) { NormArgs a{}; a.src = p.out; a.xout = p.out; a.y2 = Y2; a.inv = INV; a.gate2 = mod1 + 5120; a.gain = p.in[I_FNORM]; a.fout = p.out;
        norm_phase(a, lds, NTOK, false, nullptr, nullptr, nullptr); }
#undef IN
#undef SEAM
}

extern "C" void kernel_launch(void* const* d_in, const int* in_sizes, int n_in, void* d_out, int out_size, void* d_ws, size_t ws_size, hipStream_t stream) {
    static int grid = 0;
    if (grid == 0) {
        if (n_in != 36 || out_size != NTOK * DM || ws_size < WS_END) { fprintf(stderr, "kernel_launch: unexpected shapes (n_in %d out %d ws %zu need %zu)\n", n_in, out_size, ws_size, (size_t)WS_END); grid = -1; return; }
        int dev = 0, cus = 0;
        if (hipGetDevice(&dev) != hipSuccess || hipDeviceGetAttribute(&cus, hipDeviceAttributeMultiprocessorCount, dev) != hipSuccess) { grid = -1; return; }
        if (hipFuncSetAttribute((const void*)fwd, hipFuncAttributeMaxDynamicSharedMemorySize, LDS_BYTES) != hipSuccess) { fprintf(stderr, "kernel_launch: hipFuncSetAttribute failed\n"); grid = -1; return; }
        int per_cu = 0;
        if (hipOccupancyMaxActiveBlocksPerMultiprocessor(&per_cu, (const void*)fwd, 512, LDS_BYTES) != hipSuccess || per_cu < 1) fprintf(stderr, "kernel_launch: occupancy query says %d\n", per_cu);
        (void)hipGetLastError();
        grid = cus;
    }
    if (grid < 0) return;
    (void)hipMemsetAsync((char*)d_ws + WS_CTL, 0, CTL_ZERO_BYTES, stream);
    Params p{};
    for (int i = 0; i < 36; ++i) p.in[i] = (const float*)d_in[i];
    p.out = (float*)d_out; p.ws = (unsigned char*)d_ws;
#if N_LAUNCH_MODE == 1
    p.ph_lo = 0; p.ph_hi = NPHASE;
    hipLaunchKernelGGL(fwd, dim3(grid), dim3(512), LDS_BYTES, stream, p);
#else
    for (int k = 0; k < NPHASE; ++k) { p.ph_lo = k; p.ph_hi = k + 1; hipLaunchKernelGGL(fwd, dim3(grid), dim3(512), LDS_BYTES, stream, p); }
#endif
}
```

```cpp
#include <hip/hip_runtime.h>
#include <cstdio>
#include <cstdint>

#define LAS __attribute__((address_space(3)))
#define GAS __attribute__((address_space(1)))
typedef _Float16 f16;
typedef _Float16 f16x8 __attribute__((ext_vector_type(8)));
typedef _Float16 f16x4 __attribute__((ext_vector_type(4)));
typedef _Float16 f16x2 __attribute__((ext_vector_type(2)));
typedef float f32x2 __attribute__((ext_vector_type(2)));
typedef float f32x4 __attribute__((ext_vector_type(4)));
typedef float f32x16 __attribute__((ext_vector_type(16)));
typedef unsigned u32x2 __attribute__((ext_vector_type(2)));
typedef unsigned u32x4 __attribute__((ext_vector_type(4)));
typedef short s16x4 __attribute__((ext_vector_type(4)));

#ifndef HOSTDUP
#define HOSTDUP 0
#endif
#ifndef HOSTDUP_ALT
#define HOSTDUP_ALT 1
#endif
#ifndef HOSTDUP_N
#define HOSTDUP_N 1
#endif
#ifndef N_LAUNCH_MODE
#define N_LAUNCH_MODE 1
#endif

constexpr int NB = 16, SEQ = 2048, DM = 1024, NTOK = NB * SEQ, CTXL = 256, NCTX = NB * CTXL, NROWS = NTOK + NCTX;
constexpr int ZP0 = 3072, ZP1 = 2560;
constexpr int NE = 16, DE = 2816, CAP = 256, EROWS = NB * CAP;
constexpr float EPS = 1e-6f;
constexpr float LOG2E = 1.4426950408889634f;
constexpr float QSCALE = 0.125f * LOG2E;

constexpr size_t MiB = 1u << 20;
constexpr size_t WS_CTL = 0, CTL_ZERO_BYTES = 256 * 1024;
constexpr size_t WS_MOD = 1 * MiB;
constexpr size_t MOD0_OFF = 0, MOD1_OFF = 17 * 6144 * 4, ROPE_OFF = MOD1_OFF + 16 * 6144 * 4, LAM_OFF = ROPE_OFF + 64 * 16 * 2 * 4;
constexpr size_t WS_WIN0 = 2 * MiB, WS_WOUT0 = 8 * MiB, WS_WIN1 = 10 * MiB, WS_WOUT1 = 15 * MiB;
constexpr size_t WS_AFF = 17 * MiB;
constexpr size_t WS_IDX = 19 * MiB;
constexpr size_t WS_G = 19 * MiB + 512 * 1024;
constexpr size_t WS_INV = 20 * MiB;
constexpr size_t WS_W13 = 22 * MiB;
constexpr size_t WS_W2 = WS_W13 + 176 * MiB;
constexpr size_t WS_H = WS_W2 + 88 * MiB;
constexpr size_t WS_XIN = WS_H + 72 * MiB;
constexpr size_t WS_Y2 = WS_XIN + 128 * MiB;
constexpr size_t WS_BIG = WS_Y2 + 128 * MiB;
constexpr size_t WS_Z = WS_BIG, WS_Y = WS_BIG + 216 * MiB, WS_HID = WS_BIG;
constexpr size_t WS_END = WS_BIG + 352 * MiB;

constexpr int RING_BYTES = 131072;
constexpr int LDSCTL_OFF = RING_BYTES, MISC_OFF = LDSCTL_OFF + 320;
constexpr int LDS_BYTES = 147456;

#define RLX_AGENT __ATOMIC_RELAXED, __HIP_MEMORY_SCOPE_AGENT
#define LDS_WAIT() asm volatile("s_waitcnt lgkmcnt(0)" ::: "memory")
#define VM_WAIT() asm volatile("s_waitcnt vmcnt(0)" ::: "memory")

__device__ __forceinline__ unsigned pkh(float lo, float hi) { f16x2 v; v.x = (f16)lo; v.y = (f16)hi; return __builtin_bit_cast(unsigned, v); }
__device__ __forceinline__ float silu_f(float v) { return v / (1.f + __expf(-v)); }

#define XB_TMO      128
#define XB_XCNT(j)  (256  + 64 * (j))
#define XB_XSUB(j)  (1280 + 64 * (j))
#define XB_XGEN(j)  (2304 + 64 * (j))
#define XB_TOP      3328
#define XB_TOPGEN   3392
#define XCD_BAR_WORDS 3456
#define XB_SPIN_CAP (1u << 18)
__device__ __forceinline__ unsigned xb_ld(unsigned* p)              { return __hip_atomic_load(p, __ATOMIC_RELAXED, __HIP_MEMORY_SCOPE_AGENT); }
__device__ __forceinline__ unsigned xb_add(unsigned* p, unsigned v) { return __hip_atomic_fetch_add(p, v, __ATOMIC_RELAXED, __HIP_MEMORY_SCOPE_AGENT); }
__device__ __forceinline__ unsigned xb_xcc_id() { return (unsigned)__builtin_amdgcn_s_getreg((3 << 11) | 20) & 0xFu; }
#define XB_SPIN(cond, bar) do { unsigned _sp = 0; while (cond) { __builtin_amdgcn_s_sleep(1); \
    if ((++_sp & 255u) == 0u) { if (xb_ld(&(bar)[XB_TMO])) break; if (_sp > XB_SPIN_CAP) { atomicAdd(&(bar)[XB_TMO], 1u); break; } } } } while (0)
struct XcdBarrier { unsigned* bar; unsigned x; volatile LAS unsigned* st; };
__device__ __forceinline__ XcdBarrier xcd_barrier_post(unsigned* bar, volatile LAS unsigned* st) {
    XcdBarrier b; b.bar = bar; b.x = xb_xcc_id(); b.st = st;
    if (threadIdx.x == 0) (void)xb_add(&bar[XB_XCNT(b.x)], 1u);
    return b;
}
__device__ __forceinline__ void xcd_barrier_complete(unsigned* bar, unsigned x, unsigned& nloc, unsigned& nx) {
    const unsigned G = gridDim.x * gridDim.y * gridDim.z;
    unsigned sum, cnt, mine, sp = 0u;
    for (;;) {
        sum = 0u; cnt = 0u; mine = 0u;
#pragma unroll
        for (unsigned j = 0; j < 16; ++j) { const unsigned c = xb_ld(&bar[XB_XCNT(j)]); sum += c; cnt += (c > 0u) ? 1u : 0u; mine = (j == x) ? c : mine; }
        if (sum == G) break;
        __builtin_amdgcn_s_sleep(1);
        if ((++sp & 255u) == 0u) { if (xb_ld(&bar[XB_TMO])) break; if (sp > XB_SPIN_CAP) { atomicAdd(&bar[XB_TMO], 1u); break; } }
    }
    nloc = mine > 0u ? mine : 1u; nx = cnt > 0u ? cnt : 1u;
}
__device__ __forceinline__ void xcd_barrier(const XcdBarrier& b) {
    asm volatile("s_waitcnt vmcnt(0)" ::: "memory");
    __syncthreads();
    if (threadIdx.x == 0) {
        unsigned* bar = b.bar;
        __builtin_amdgcn_s_waitcnt(0);
        unsigned nloc = b.st[0], nx = b.st[1];
        if (nloc == 0u) { xcd_barrier_complete(bar, b.x, nloc, nx); b.st[0] = nloc; b.st[1] = nx; }
        const unsigned old = xb_add(&bar[XB_XSUB(b.x)], 1u);
        const unsigned gen = old / nloc;
        if (old + 1u == (gen + 1u) * nloc) {
            __builtin_amdgcn_fence(__ATOMIC_RELEASE, "agent");
            asm volatile("s_waitcnt vmcnt(0)" ::: "memory");
            const unsigned og = xb_add(&bar[XB_TOP], 1u);
            const unsigned tg = og / nx;
            if (og + 1u == (tg + 1u) * nx) xb_add(&bar[XB_TOPGEN], 1u);
            else XB_SPIN(xb_ld(&bar[XB_TOPGEN]) == tg, bar);
            __builtin_amdgcn_fence(__ATOMIC_ACQUIRE, "agent");
            xb_add(&bar[XB_XGEN(b.x)], 1u);
            asm volatile("s_waitcnt vmcnt(0)" ::: "memory");
        } else {
            XB_SPIN(xb_ld(&bar[XB_XGEN(b.x)]) == gen, bar);
            __builtin_amdgcn_fence(__ATOMIC_ACQUIRE, "agent");
            asm volatile("s_waitcnt vmcnt(0)" ::: "memory");
        }
    }
    __syncthreads();
}

__device__ __forceinline__ int opaque_tid0() { int t = threadIdx.x; asm volatile("" : "+v"(t)); return t; }
namespace gm {
constexpr int BM = 256, BK = 64, HALF = 128, HTB = HALF * BK * 2, STAGE_BYTES = 8 * HTB, NXCD = 8, WGM = 8;
__host__ __device__ __forceinline__ int lds_byte(int r, int c) { const int st = (r >> 4) * 2 + (c >> 5), rr = r & 15, cc = c & 31, ob = rr * 64 + cc * 2; return st * 1024 + (ob ^ (((ob >> 9) & 1) << 5)); }
__host__ __device__ __forceinline__ void stage_rc(int b, int& R, int& C) { const int st = b / 1024, sb = b % 1024, swz = sb ^ (((sb >> 9) & 1) << 5); R = (st >> 1) * 16 + swz / 64; C = (st & 1) * 32 + (swz % 64) / 2; }
__host__ __device__ __forceinline__ int perm32(int rho) { const int n = rho >> 4, i = rho & 15; return 8 * (i >> 2) + 4 * n + (i & 3); }

struct Unit { int g, pm, pn; };
struct Gemm { const f16* A; const f16* Bt; int K; long sA, sB; };
struct Order {
    int nM, nN, tpg, total, G, c, mode;
    __device__ void init(int M, int N, int groups, int G_, int c_, int mode_ = 0) { nM = M / BM; nN = N / BM; tpg = nM * nN; total = tpg * groups; G = G_; c = c_; mode = (mode_ == 1 && G_ == 256 && nM == 16 && nN == 4) ? 1 : 0; }
    __device__ bool next(int i, Unit& u) const {
        const long L = (long)i * G + c; if (L >= total) return false;
        if (mode == 1) { const int x = c & 7, j = c >> 3; u.g = 4 * i + (x >> 1); u.pm = 8 * (x & 1) + (j >> 2); u.pn = j & 3; return true; }
        const int g = (int)(L / tpg); int wgid = (int)(L % tpg);
        { const int q = tpg / NXCD, r = tpg % NXCD, xcd = wgid % NXCD, off = wgid / NXCD; wgid = (xcd < r ? xcd * (q + 1) : r * (q + 1) + (xcd - r) * q) + off; }
        const int nig = WGM * nN, gid = wgid / nig, fm = gid * WGM, gsz = (nM - fm) < WGM ? (nM - fm) : WGM;
        u.g = g; u.pm = fm + ((wgid % nig) % gsz); u.pn = (wgid % nig) / gsz; return true;
    }
};

typedef f32x4 Acc[2][2][4][2];

struct EpiF16 {
    static constexpr bool PERM = true;
    f16* O; int ldc;
    __device__ __forceinline__ void operator()(const Acc& acc, const Unit& u, int wr, int wc, int fr, int fq) const {
        const int row0 = u.pm * BM + wr * 64 + fr, col0 = u.pn * BM + wc * 32 + 8 * fq;
#pragma unroll
        for (int ai = 0; ai < 2; ++ai)
#pragma unroll
            for (int m = 0; m < 4; ++m) { f16* rowp = O + (size_t)(row0 + ai * HALF + m * 16) * ldc + col0;
#pragma unroll
                for (int bj = 0; bj < 2; ++bj) { const f32x4 v0 = acc[ai][bj][m][0], v1 = acc[ai][bj][m][1];
                    u32x4 w; w.x = pkh(v0[0], v0[1]); w.y = pkh(v0[2], v0[3]); w.z = pkh(v1[0], v1[1]); w.w = pkh(v1[2], v1[3]);
                    *(u32x4*)(rowp + bj * HALF) = w; } }
    }
};
struct EpiInProj0 {
    static constexpr bool PERM = true;
    f16* O; const float* rope;
    __device__ __forceinline__ void operator()(const Acc& acc, const Unit& u, int wr, int wc, int fr, int fq) const {
        const int row0 = u.pm * BM + wr * 64 + fr, col0 = u.pn * BM + wc * 32 + 8 * fq;
        const float sc = (u.pn < 4) ? QSCALE : 1.f;
        const bool dorope = (u.pn == 2 || u.pn == 3 || u.pn == 6 || u.pn == 7) && (u.pm * BM < NTOK);
#pragma unroll
        for (int ai = 0; ai < 2; ++ai)
#pragma unroll
            for (int m = 0; m < 4; ++m) { const int row = row0 + ai * HALF + m * 16; f16* rowp = O + (size_t)row * ZP0 + col0;
                const int t = row & (SEQ - 1), prow = t >> 6, pcol = t & 63;
#pragma unroll
                for (int bj = 0; bj < 2; ++bj) { f32x4 v0 = acc[ai][bj][m][0] * sc, v1 = acc[ai][bj][m][1] * sc;
                    if (dorope) { const int c = col0 + bj * HALF, half = (c >> 5) & 1, i0 = (c & 31) >> 1; const int pos = half ? pcol : prow;
                        const f32x4* tp = (const f32x4*)(rope + (pos * 16 + i0) * 2); const f32x4 t0 = tp[0], t1 = tp[1];
                        f32x4 r0, r1;
                        r0[0] = v0[0] * t0[0] - v0[1] * t0[1]; r0[1] = v0[0] * t0[1] + v0[1] * t0[0];
                        r0[2] = v0[2] * t0[2] - v0[3] * t0[3]; r0[3] = v0[2] * t0[3] + v0[3] * t0[2];
                        r1[0] = v1[0] * t1[0] - v1[1] * t1[1]; r1[1] = v1[0] * t1[1] + v1[1] * t1[0];
                        r1[2] = v1[2] * t1[2] - v1[3] * t1[3]; r1[3] = v1[2] * t1[3] + v1[3] * t1[2];
                        v0 = r0; v1 = r1; }
                    u32x4 w; w.x = pkh(v0[0], v0[1]); w.y = pkh(v0[2], v0[3]); w.z = pkh(v1[0], v1[1]); w.w = pkh(v1[2], v1[3]);
                    *(u32x4*)(rowp + bj * HALF) = w; } }
    }
};
struct EpiResGate {
    static constexpr bool PERM = false;
    const float* base; float* out; const float* gate; int gstride;
    __device__ __forceinline__ void operator()(const Acc& acc, const Unit& u, int wr, int wc, int fr, int fq) const {
        const int col0 = u.pn * BM + wc * 32 + 4 * fq; const int b = (u.pm * BM) / SEQ;
        f32x4 gv[2][2];
#pragma unroll
        for (int bj = 0; bj < 2; ++bj)
#pragma unroll
            for (int n = 0; n < 2; ++n) gv[bj][n] = *(const f32x4*)(gate + (size_t)b * gstride + col0 + bj * HALF + n * 16);
#pragma unroll
        for (int ai = 0; ai < 2; ++ai)
#pragma unroll
            for (int m = 0; m < 4; ++m) { const size_t off = (size_t)(u.pm * BM + ai * HALF + wr * 64 + m * 16 + fr) * DM + col0;
#pragma unroll
                for (int bj = 0; bj < 2; ++bj)
#pragma unroll
                    for (int n = 0; n < 2; ++n) { const f32x4 bs = *(const f32x4*)(base + off + bj * HALF + n * 16);
                        *(f32x4*)(out + off + bj * HALF + n * 16) = bs + gv[bj][n] * acc[ai][bj][m][n]; }
                if (m & 1) asm volatile("" ::: "memory"); }
    }
};
struct EpiSwiGLU {
    static constexpr bool PERM = true;
    f16* O;
    __device__ __forceinline__ void operator()(const Acc& acc, const Unit& u, int wr, int wc, int fr, int fq) const {
        const int row0 = u.pm * BM + wr * 64 + fr, col0 = u.pn * HALF + wc * 32 + 8 * fq;
        f16* Og = O + (size_t)u.g * EROWS * DE;
#pragma unroll
        for (int ai = 0; ai < 2; ++ai)
#pragma unroll
            for (int m = 0; m < 4; ++m) { f16* rowp = Og + (size_t)(row0 + ai * HALF + m * 16) * DE + col0;
                float h[8];
#pragma unroll
                for (int n = 0; n < 2; ++n)
#pragma unroll
                    for (int j = 0; j < 4; ++j) { const float g = acc[ai][0][m][n][j], up = acc[ai][1][m][n][j]; h[n * 4 + j] = g * up * __builtin_amdgcn_rcpf(1.f + __builtin_amdgcn_exp2f(-LOG2E * g)); }
                u32x4 w; w.x = pkh(h[0], h[1]); w.y = pkh(h[2], h[3]); w.z = pkh(h[4], h[5]); w.w = pkh(h[6], h[7]);
                *(u32x4*)rowp = w; }
    }
};
struct EpiRowScale {
    static constexpr bool PERM = true;
    f16* O; const float* gv;
    __device__ __forceinline__ void operator()(const Acc& acc, const Unit& u, int wr, int wc, int fr, int fq) const {
        const int row0 = u.pm * BM + wr * 64 + fr, col0 = u.pn * BM + wc * 32 + 8 * fq;
        f16* Og = O + (size_t)u.g * EROWS * DM;
#pragma unroll
        for (int ai = 0; ai < 2; ++ai)
#pragma unroll
            for (int m = 0; m < 4; ++m) { const int row = row0 + ai * HALF + m * 16; const float s = gv[((row >> 8) * NE + u.g) * CAP + (row & 255)];
                f16* rowp = Og + (size_t)row * DM + col0;
#pragma unroll
                for (int bj = 0; bj < 2; ++bj) { const f32x4 v0 = acc[ai][bj][m][0] * s, v1 = acc[ai][bj][m][1] * s;
                    u32x4 w; w.x = pkh(v0[0], v0[1]); w.y = pkh(v0[2], v0[3]); w.z = pkh(v1[0], v1[1]); w.w = pkh(v1[2], v1[3]);
                    *(u32x4*)(rowp + bj * HALF) = w; } }
    }
};

template <class Epi>
__device__ __forceinline__ void gemm_phase(LAS unsigned char* lds, const Gemm g, const Order& S, const Epi& E) {
    const int tid = opaque_tid0(), wid = __builtin_amdgcn_readfirstlane(tid >> 6), lane = tid & 63, wr = wid >> 2, wc = wid & 3, fr = lane & 15, fq = lane >> 4;
    const int K = g.K, nt = K / BK;
    unsigned voffA[2], voffB[2];
#pragma unroll
    for (int i = 0; i < 2; ++i) { int R, C; stage_rc(tid * 16 + i * 8192, R, C); const int Rb = Epi::PERM ? ((R & ~31) + perm32(R & 31)) : R;
        voffA[i] = (unsigned)(R * K + C) * 2u; voffB[i] = (unsigned)(Rb * K + C) * 2u; }
    const size_t kstep = (size_t)(BK * 2);
    const size_t hstep = (size_t)HALF * K * 2;
    const size_t tstep = 2 * hstep;
    const unsigned ldsw = (unsigned)wid * 1024u;
    const int aoff = lds_byte(wr * 64 + fr, fq * 8), boff = lds_byte(wc * 32 + fr, fq * 8);
#define GM_SA(b, h) (((b) * 2 + (h)) * HTB)
#define GM_SB(b, h) ((4 + (b) * 2 + (h)) * HTB)
#define GM_STAGE(bufoff, gbase, voff) do { _Pragma("unroll") for (int _i = 0; _i < 2; ++_i) \
        __builtin_amdgcn_global_load_lds((const unsigned*)((const char*)(gbase) + (voff)[_i]), (LAS unsigned*)(lds + (bufoff) + ldsw + _i * 8192), 16, 0, 0); } while (0)
#define GM_LDA(dst, b, h) do { _Pragma("unroll") for (int m = 0; m < 4; ++m) _Pragma("unroll") for (int k = 0; k < 2; ++k) dst[m][k] = *(const LAS f16x8*)(lds + GM_SA(b, h) + aoff + m * 2048 + k * 1024); } while (0)
#define GM_LDB(dst, b, h) do { _Pragma("unroll") for (int n = 0; n < 2; ++n) _Pragma("unroll") for (int k = 0; k < 2; ++k) dst[n][k] = *(const LAS f16x8*)(lds + GM_SB(b, h) + boff + n * 2048 + k * 1024); } while (0)
#define GM_MMA(ai, bj, At, Bt) do { __builtin_amdgcn_s_setprio(1); _Pragma("unroll") for (int m = 0; m < 4; ++m) _Pragma("unroll") for (int n = 0; n < 2; ++n) _Pragma("unroll") for (int k = 0; k < 2; ++k) \
        acc[ai][bj][m][n] = __builtin_amdgcn_mfma_f32_16x16x32_f16(Bt[n][k], At[m][k], acc[ai][bj][m][n], 0, 0, 0); __builtin_amdgcn_s_setprio(0); } while (0)
#define GM_WAIT_V(n) asm volatile("s_waitcnt vmcnt(" #n ")" ::: "memory")
#define GM_WAIT_L(n) asm volatile("s_waitcnt lgkmcnt(" #n ")" ::: "memory")
#define GM_BAR __builtin_amdgcn_s_barrier()
#define GM_SCHED __builtin_amdgcn_sched_barrier(0)
    Unit cur, nxt; int ui = 0;
    if (!S.next(0, cur)) return;
    Acc acc;
#pragma unroll
    for (int a = 0; a < 2; ++a)
#pragma unroll
        for (int b = 0; b < 2; ++b)
#pragma unroll
            for (int m = 0; m < 4; ++m)
#pragma unroll
                for (int n = 0; n < 2; ++n) acc[a][b][m][n] = (f32x4){0.f, 0.f, 0.f, 0.f};
    f16x8 At[4][2], B0[2][2], B1[2][2];
    const char* cA = (const char*)(g.A + (size_t)cur.g * g.sA) + (size_t)cur.pm * tstep; const char* cB = (const char*)(g.Bt + (size_t)cur.g * g.sB) + (size_t)cur.pn * tstep;
    GM_STAGE(GM_SB(0, 0), cB, voffB); GM_STAGE(GM_SB(0, 1), cB + hstep, voffB); GM_STAGE(GM_SA(0, 0), cA, voffA); GM_STAGE(GM_SA(0, 1), cA + hstep, voffA);
    if (wr == 1) GM_BAR;
    GM_WAIT_V(2); GM_BAR;
    GM_STAGE(GM_SB(1, 0), cB + kstep, voffB); GM_STAGE(GM_SA(1, 0), cA + kstep, voffA); GM_STAGE(GM_SB(1, 1), cB + hstep + kstep, voffB);
    GM_WAIT_V(6); GM_BAR;
    for (;;) {
        const bool has_next = S.next(ui + 1, nxt);
        const char* nA = has_next ? (const char*)(g.A + (size_t)nxt.g * g.sA) + (size_t)nxt.pm * tstep : cA; const char* nB = has_next ? (const char*)(g.Bt + (size_t)nxt.g * g.sB) + (size_t)nxt.pn * tstep : cB;
        for (int t = 0; t < nt; t += 2) {
            const bool last = (t == nt - 2);
            const char* a1 = cA + (size_t)(t + 1) * kstep;
            const char* a2 = last ? nA : cA + (size_t)(t + 2) * kstep; const char* b2 = last ? nB : cB + (size_t)(t + 2) * kstep;
            const char* a3 = a2 + kstep; const char* b3 = b2 + kstep;
            GM_LDB(B0, 0, 0); GM_LDB(B1, 0, 1); GM_SCHED; GM_LDA(At, 0, 0); GM_STAGE(GM_SA(1, 1), a1 + hstep, voffA);
            GM_WAIT_V(8); GM_WAIT_L(0); GM_BAR; GM_MMA(0, 0, At, B0); GM_MMA(0, 1, At, B1); GM_BAR; GM_SCHED;
            GM_LDA(At, 0, 1); GM_STAGE(GM_SB(0, 0), b2, voffB); GM_STAGE(GM_SB(0, 1), b2 + hstep, voffB); GM_STAGE(GM_SA(0, 0), a2, voffA);
            GM_WAIT_V(8); GM_WAIT_L(0); GM_BAR; GM_MMA(1, 0, At, B0); GM_MMA(1, 1, At, B1); GM_BAR; GM_SCHED;
            GM_LDB(B0, 1, 0); GM_LDB(B1, 1, 1); GM_SCHED; GM_LDA(At, 1, 0); GM_STAGE(GM_SA(0, 1), a2 + hstep, voffA);
            GM_WAIT_V(8); GM_WAIT_L(0); GM_BAR; GM_MMA(0, 0, At, B0); GM_MMA(0, 1, At, B1); GM_BAR; GM_SCHED;
            GM_LDA(At, 1, 1); GM_STAGE(GM_SB(1, 0), b3, voffB); GM_STAGE(GM_SB(1, 1), b3 + hstep, voffB); GM_STAGE(GM_SA(1, 0), a3, voffA);
            GM_WAIT_V(8); GM_WAIT_L(0); GM_BAR; GM_MMA(1, 0, At, B0); GM_MMA(1, 1, At, B1); GM_BAR; GM_SCHED;
        }
        if (wr == 0) GM_BAR;
        E(acc, cur, wr, wc, fr, fq);
        if (!has_next) break;
#pragma unroll
        for (int a = 0; a < 2; ++a)
#pragma unroll
            for (int b = 0; b < 2; ++b)
#pragma unroll
                for (int m = 0; m < 4; ++m)
#pragma unroll
                    for (int n = 0; n < 2; ++n) acc[a][b][m][n] = (f32x4){0.f, 0.f, 0.f, 0.f};
        cur = nxt; cA = nA; cB = nB; ++ui;
        if (wr == 1) GM_BAR;
    }
    GM_WAIT_V(0);
    GM_BAR;
#undef GM_SA
#undef GM_SB
#undef GM_STAGE
#undef GM_LDA
#undef GM_LDB
#undef GM_MMA
#undef GM_WAIT_V
#undef GM_WAIT_L
#undef GM_BAR
#undef GM_SCHED
}
}

struct Params { const float* in[36]; float* out; unsigned char* ws; int ph_lo, ph_hi, alt, pad; };
enum { I_X = 0, I_C, I_CTX, I_CCTX, I_L0_NORM1, I_L0_WMOD, I_L0_BMOD, I_L0_WIN, I_L0_WOUT, I_L0_RPB, I_L0_LQ1, I_L0_LK1, I_L0_LQ2, I_L0_LK2, I_L0_SUBLN,
       I_L0_NORM2, I_L0_WR, I_L0_W1, I_L0_W3, I_L0_W2, I_L1_NORM1, I_L1_WMOD, I_L1_BMOD, I_L1_WIN, I_L1_WOUT, I_L1_SCW, I_L1_CFW, I_L1_CFB, I_L1_LNG, I_L1_LNB,
       I_L1_NORM2, I_L1_WR, I_L1_W1, I_L1_W3, I_L1_W2, I_FNORM };

__device__ __forceinline__ int opaque_tid() { int t = threadIdx.x; asm volatile("" : "+v"(t)); return t; }
__device__ __forceinline__ float wave_sum(float v) {
#pragma unroll
    for (int o = 1; o < 64; o <<= 1) v += __shfl_xor(v, o);
    return v;
}

constexpr int CVT_RS = 136, CVT_SCR = 64 * CVT_RS;
template <class RowMap>
__device__ __forceinline__ void cvt_item(const float* W, int K, int N, f16* WT, const RowMap& rm, int item, int lane, LAS unsigned char* scr) {
    const int nblk = N / 64, kb = item / nblk, nb = item % nblk, k0 = 64 * kb, n0 = 64 * nb;
    const float* src = W + (size_t)(k0 + (lane >> 4)) * N + n0 + 4 * (lane & 15);
    f32x4 v[16];
#pragma unroll
    for (int i = 0; i < 16; ++i) v[i] = *(const f32x4*)(src + (size_t)(4 * i) * N);
#pragma unroll
    for (int i = 0; i < 16; ++i) { u32x2 w; w.x = pkh(v[i][0], v[i][1]); w.y = pkh(v[i][2], v[i][3]);
        *(LAS u32x2*)(scr + (4 * i + (lane >> 4)) * CVT_RS + 8 * (lane & 15)) = w; }
    const int g = lane >> 4, i16 = lane & 15, q_ = i16 >> 2, p_ = i16 & 3;
#pragma unroll
    for (int st = 0; st < 8; ++st) {
        const int nl = 16 * (st >> 1), ch = 4 * (st & 1) + g;
        const LAS unsigned char* ap = scr + (8 * ch + q_) * CVT_RS + (nl + 4 * p_) * 2;
        const s16x4 lo = __builtin_amdgcn_ds_read_tr16_b64_v4i16((LAS s16x4*)ap);
        const s16x4 hi = __builtin_amdgcn_ds_read_tr16_b64_v4i16((LAS s16x4*)(ap + 4 * CVT_RS));
        u32x4 w; const u32x2 l2 = __builtin_bit_cast(u32x2, lo), h2 = __builtin_bit_cast(u32x2, hi); w.x = l2.x; w.y = l2.y; w.z = h2.x; w.w = h2.y;
        *(u32x4*)(WT + (size_t)rm(n0 + nl + i16) * K + k0 + 8 * ch) = w;
    }
}
struct MapPlain { __device__ __forceinline__ int operator()(int n) const { return n; } };
struct MapRope { __device__ __forceinline__ int operator()(int n) const {
    const bool rp = (n >= 512 && n < 1024) || (n >= 1536 && n < 2048); if (!rp) return n; const int i = n & 31; return (n & ~31) + (i < 16 ? 2 * i : 2 * (i - 16) + 1); } };
struct MapGLU { int add; __device__ __forceinline__ int operator()(int n) const { return (n >> 7) * 256 + (n & 127) + add; } };

__device__ __forceinline__ void cvt_moe(const float* w1, const float* w3, const float* w2, f16* W13, f16* W2T, int gw, int NGW, int lane, LAS unsigned char* scr) {
    constexpr int I13 = (DM / 64) * (DE / 64), I2 = (DE / 64) * (DM / 64);
    constexpr int NIT = NE * (2 * I13 + I2);
    for (int it = gw; it < NIT; it += NGW) {
        const int e = it / (2 * I13 + I2); int r = it % (2 * I13 + I2);
        if (r < I13) { cvt_item(w1 + (size_t)e * DM * DE, DM, DE, W13 + (size_t)e * 2 * DE * DM, MapGLU{0}, r, lane, scr); continue; } r -= I13;
        if (r < I13) { cvt_item(w3 + (size_t)e * DM * DE, DM, DE, W13 + (size_t)e * 2 * DE * DM, MapGLU{128}, r, lane, scr); continue; } r -= I13;
        cvt_item(w2 + (size_t)e * DE * DM, DE, DM, W2T + (size_t)e * DM * DE, MapPlain{}, r, lane, scr);
    }
}

__device__ __forceinline__ void phase_prologue(const Params& p, LAS unsigned char* lds) {
    const int tid = opaque_tid(), lane = tid & 63, wave = __builtin_amdgcn_readfirstlane(tid >> 6);
    const int G = gridDim.x;
    unsigned char* ws = p.ws;
    LAS float* S = (LAS float*)lds;
    LAS float* red = (LAS float*)(lds + 17 * 1024 * 4);
    for (int u = blockIdx.x; u < 193; u += G) {
        if (u == 192) {
            float* rope = (float*)(ws + WS_MOD + ROPE_OFF);
            for (int idx = tid; idx < 1024; idx += 512) { const int pos = idx >> 4, i = idx & 15; const float fr = powf(10000.f, -(float)i / 16.f), ang = (float)pos * fr;
                rope[idx * 2] = cosf(ang); rope[idx * 2 + 1] = sinf(ang); }
            if (wave == 0) { const float s1 = wave_sum(p.in[I_L0_LQ1][lane] * p.in[I_L0_LK1][lane]), s2 = wave_sum(p.in[I_L0_LQ2][lane] * p.in[I_L0_LK2][lane]);
                if (lane == 0) *(float*)(ws + WS_MOD + LAM_OFF) = expf(s1) - expf(s2) + 0.2f; }
            continue;
        }
        const int l = u / 96, col0 = (u % 96) * 64;
        const float* wmod = p.in[l ? I_L1_WMOD : I_L0_WMOD]; const float* bmod = p.in[l ? I_L1_BMOD : I_L0_BMOD];
        float* mod = (float*)(ws + WS_MOD + (l ? MOD1_OFF : MOD0_OFF));
        for (int idx = tid; idx < 17 * 1024; idx += 512) { const float v = idx < 16 * 1024 ? p.in[I_C][idx] : p.in[I_CCTX][idx - 16 * 1024]; S[idx] = silu_f(v); }
        __syncthreads();
        float acc[17];
#pragma unroll
        for (int r = 0; r < 17; ++r) acc[r] = 0.f;
        const int kb = wave * 128;
        for (int kk = 0; kk < 128; kk += 4) {
            float wv[4];
#pragma unroll
            for (int i = 0; i < 4; ++i) wv[i] = wmod[(size_t)(kb + kk + i) * 6144 + col0 + lane];
#pragma unroll
            for (int r = 0; r < 17; ++r) { const f32x4 sv = *(const LAS f32x4*)(S + r * 1024 + kb + kk); acc[r] += sv[0] * wv[0] + sv[1] * wv[1] + sv[2] * wv[2] + sv[3] * wv[3]; }
        }
#pragma unroll
        for (int r = 0; r < 17; ++r) red[(wave * 17 + r) * 64 + lane] = acc[r];
        __syncthreads();
        for (int idx = tid; idx < 17 * 64; idx += 512) { const int r = idx >> 6, ln = idx & 63; float s = bmod[col0 + ln];
#pragma unroll
            for (int w = 0; w < 8; ++w) s += red[(w * 17 + r) * 64 + ln];
            if (r < 16 || l == 0) mod[(size_t)r * 6144 + col0 + ln] = s; }
        __syncthreads();
    }
    const int gw = blockIdx.x * 8 + wave, NGW = G * 8;
    LAS unsigned char* scr = lds + wave * CVT_SCR;
    constexpr int IT_IN0 = (DM / 64) * (ZP0 / 64), IT_OUT = (DM / 64) * (DM / 64), IT_IN1 = (DM / 64) * (ZP1 / 64);
    for (int it = gw; it < IT_IN0 + 2 * IT_OUT + IT_IN1; it += NGW) {
        int r = it;
        if (r < IT_IN0) { cvt_item(p.in[I_L0_WIN], DM, ZP0, (f16*)(ws + WS_WIN0), MapRope{}, r, lane, scr); continue; } r -= IT_IN0;
        if (r < IT_OUT) { cvt_item(p.in[I_L0_WOUT], DM, DM, (f16*)(ws + WS_WOUT0), MapPlain{}, r, lane, scr); continue; } r -= IT_OUT;
        if (r < IT_IN1) { cvt_item(p.in[I_L1_WIN], DM, ZP1, (f16*)(ws + WS_WIN1), MapPlain{}, r, lane, scr); continue; } r -= IT_IN1;
        cvt_item(p.in[I_L1_WOUT], DM, DM, (f16*)(ws + WS_WOUT1), MapPlain{}, r, lane, scr);
    }
    cvt_moe(p.in[I_L0_W1], p.in[I_L0_W3], p.in[I_L0_W2], (f16*)(ws + WS_W13), (f16*)(ws + WS_W2), gw, NGW, lane, scr);
}

struct NormArgs {
    const float* src;
    float* xout;
    const f16* y2; const short* inv; const float* gate2;
    const float* gain;
    const float* shift; const float* scale; int mstride;
    f16* hout;
    float* fout;
    const float* wr; float* aff;
};

template <int R>
__device__ __forceinline__ void norm_phase(const NormArgs& a, LAS unsigned char* lds, bool ctx_rows, const float* ctx_src, const float* ctx_shift, const float* ctx_scale) {
    const int tid = opaque_tid(), lane = tid & 63, wave = __builtin_amdgcn_readfirstlane(tid >> 6);
    const int G = gridDim.x;
    LAS float* wl = (LAS float*)lds;
    if (a.wr) {
        for (int idx = tid; idx < 16384; idx += 512) { const int k = idx >> 4, e = idx & 15; wl[e * 1028 + k] = a.wr[idx]; }
        __syncthreads();
    }
    const int gw = blockIdx.x * 8 + wave, NGW = G * 8;
    for (int chunk = gw; chunk < NTOK / 16; chunk += NGW) {
        const int row0 = chunk * 16, b = row0 / SEQ;
        f32x4 A[4], Sh[4], G2[4];
#pragma unroll
        for (int j = 0; j < 4; ++j) { const int c = 4 * lane + 256 * j; const f32x4 g = *(const f32x4*)(a.gain + c);
            if (a.shift) { const f32x4 sc = *(const f32x4*)(a.scale + (size_t)b * a.mstride + c); A[j] = g * (sc + 1.f); Sh[j] = *(const f32x4*)(a.shift + (size_t)b * a.mstride + c); }
            else { A[j] = g; Sh[j] = (f32x4){0.f, 0.f, 0.f, 0.f}; }
            if (a.y2) G2[j] = *(const f32x4*)(a.gate2 + (size_t)b * 6144 + c); else G2[j] = (f32x4){0.f, 0.f, 0.f, 0.f}; }
        for (int rr = 0; rr < 16; rr += R) {
            f32x4 v[R][4];
            int sl[R];
#pragma unroll
            for (int q = 0; q < R; ++q) { sl[q] = -1; if (a.y2 && lane < 16) sl[q] = a.inv[((size_t)b * NE + lane) * SEQ + ((row0 + rr + q) & (SEQ - 1))]; }
#pragma unroll
            for (int q = 0; q < R; ++q) { const int row = row0 + rr + q; const float* xr = a.src + (size_t)row * DM;
#pragma unroll
                for (int j = 0; j < 4; ++j) v[q][j] = *(const f32x4*)(xr + 4 * lane + 256 * j); }
            if (a.y2) {
                unsigned long long mask[R]; int ee[R][4]; float wgt[R][4]; f16x4 ld[R][4][4];
#pragma unroll
                for (int q = 0; q < R; ++q) { mask[q] = __ballot(sl[q] >= 0);
#pragma unroll
                    for (int i = 0; i < 4; ++i) { if (mask[q]) { ee[q][i] = __builtin_ctzll(mask[q]); mask[q] &= mask[q] - 1; wgt[q][i] = 1.f; } else { ee[q][i] = i ? ee[q][0] : 0; wgt[q][i] = 0.f; } }
#pragma unroll
                    for (int i = 0; i < 4; ++i) { int slot = __shfl(sl[q], ee[q][i]); slot = slot < 0 ? 0 : slot; const f16* yr = a.y2 + ((size_t)ee[q][i] * EROWS + b * CAP + slot) * DM + 4 * lane;
#pragma unroll
                        for (int j = 0; j < 4; ++j) ld[q][i][j] = *(const f16x4*)(yr + 256 * j); } }
#pragma unroll
                for (int q = 0; q < R; ++q) { const int row = row0 + rr + q;
                    f32x4 cs[4];
#pragma unroll
                    for (int j = 0; j < 4; ++j) cs[j] = (f32x4){0.f, 0.f, 0.f, 0.f};
#pragma unroll
                    for (int i = 0; i < 4; ++i)
#pragma unroll
                        for (int j = 0; j < 4; ++j) { cs[j][0] += wgt[q][i] * (float)ld[q][i][j][0]; cs[j][1] += wgt[q][i] * (float)ld[q][i][j][1]; cs[j][2] += wgt[q][i] * (float)ld[q][i][j][2]; cs[j][3] += wgt[q][i] * (float)ld[q][i][j][3]; }
                    while (mask[q]) {
                        const int e2 = __builtin_ctzll(mask[q]); mask[q] &= mask[q] - 1; const int slot = __shfl(sl[q], e2); const f16* yr = a.y2 + ((size_t)e2 * EROWS + b * CAP + slot) * DM + 4 * lane;
#pragma unroll
                        for (int j = 0; j < 4; ++j) { const f16x4 t = *(const f16x4*)(yr + 256 * j); cs[j][0] += (float)t[0]; cs[j][1] += (float)t[1]; cs[j][2] += (float)t[2]; cs[j][3] += (float)t[3]; }
                    }
                    float* xo = a.xout + (size_t)row * DM;
#pragma unroll
                    for (int j = 0; j < 4; ++j) { v[q][j] = v[q][j] + G2[j] * cs[j]; if (!a.fout) *(f32x4*)(xo + 4 * lane + 256 * j) = v[q][j]; }
                }
            }
            float rstd[R];
#pragma unroll
            for (int q = 0; q < R; ++q) { float ss = 0.f;
#pragma unroll
                for (int j = 0; j < 4; ++j) ss += (v[q][j][0] * v[q][j][0] + v[q][j][1] * v[q][j][1]) + (v[q][j][2] * v[q][j][2] + v[q][j][3] * v[q][j][3]);
                rstd[q] = 1.0f / sqrtf(wave_sum(ss) * (1.f / DM) + EPS); }
#pragma unroll
            for (int q = 0; q < R; ++q) { const int row = row0 + rr + q;
#pragma unroll
                for (int j = 0; j < 4; ++j) v[q][j] = (v[q][j] * rstd[q]) * A[j] + Sh[j];
                if (a.fout) {
#pragma unroll
                    for (int j = 0; j < 4; ++j) *(f32x4*)(a.fout + (size_t)row * DM + 4 * lane + 256 * j) = v[q][j];
                }
                if (a.hout) {
#pragma unroll
                    for (int j = 0; j < 4; ++j) { u32x2 w; w.x = pkh(v[q][j][0], v[q][j][1]); w.y = pkh(v[q][j][2], v[q][j][3]); *(u32x2*)(a.hout + (size_t)row * DM + 4 * lane + 256 * j) = w; }
                }
            }
            if (a.wr) {
#pragma unroll 1
                for (int q = 0; q < R; ++q) {
                    float lg[16];
                    f32x4 h0 = v[0][0], h1 = v[0][1], h2 = v[0][2], h3 = v[0][3];
#pragma unroll
                    for (int qq = 1; qq < R; ++qq) if (q == qq) { h0 = v[qq][0]; h1 = v[qq][1]; h2 = v[qq][2]; h3 = v[qq][3]; }
#pragma unroll
                    for (int e = 0; e < 16; ++e) { const LAS float* wp = wl + e * 1028 + 4 * lane;
                        const f32x4 w0 = *(const LAS f32x4*)(wp), w1 = *(const LAS f32x4*)(wp + 256), w2 = *(const LAS f32x4*)(wp + 512), w3 = *(const LAS f32x4*)(wp + 768);
                        lg[e] = ((h0[0] * w0[0] + h0[1] * w0[1]) + (h0[2] * w0[2] + h0[3] * w0[3])) + ((h1[0] * w1[0] + h1[1] * w1[1]) + (h1[2] * w1[2] + h1[3] * w1[3]))
                              + ((h2[0] * w2[0] + h2[1] * w2[1]) + (h2[2] * w2[2] + h2[3] * w2[3])) + ((h3[0] * w3[0] + h3[1] * w3[1]) + (h3[2] * w3[2] + h3[3] * w3[3]));
                        asm volatile("" ::: "memory"); }
#pragma unroll
                    for (int i = 0; i < 8; ++i) { const bool hi = lane & 32; const float send = hi ? lg[i] : lg[i + 8], keep = hi ? lg[i + 8] : lg[i]; lg[i] = keep + __shfl_xor(send, 32); }
#pragma unroll
                    for (int i = 0; i < 4; ++i) { const bool hi = lane & 16; const float send = hi ? lg[i] : lg[i + 4], keep = hi ? lg[i + 4] : lg[i]; lg[i] = keep + __shfl_xor(send, 16); }
#pragma unroll
                    for (int i = 0; i < 2; ++i) { const bool hi = lane & 8; const float send = hi ? lg[i] : lg[i + 2], keep = hi ? lg[i + 2] : lg[i]; lg[i] = keep + __shfl_xor(send, 8); }
                    { const bool hi = lane & 4; const float send = hi ? lg[0] : lg[1], keep = hi ? lg[1] : lg[0]; lg[0] = keep + __shfl_xor(send, 4); }
                    float lv = lg[0]; lv += __shfl_xor(lv, 2); lv += __shfl_xor(lv, 1);
                    float mx = lv;
#pragma unroll
                    for (int o = 4; o < 64; o <<= 1) mx = fmaxf(mx, __shfl_xor(mx, o));
                    const float ex = expf(lv - mx); float sm = ex;
#pragma unroll
                    for (int o = 4; o < 64; o <<= 1) sm += __shfl_xor(sm, o);
                    const int row = row0 + rr + q, t = row & (SEQ - 1), e = (lane >> 2) & 15;
                    if ((lane & 3) == 0) a.aff[((size_t)b * NE + e) * SEQ + t] = ex / sm;
                }
            }
        }
    }
    if (ctx_rows) {
        f32x4 A[4], Sh[4];
#pragma unroll
        for (int j = 0; j < 4; ++j) { const int c = 4 * lane + 256 * j; A[j] = *(const f32x4*)(a.gain + c) * (*(const f32x4*)(ctx_scale + c) + 1.f); Sh[j] = *(const f32x4*)(ctx_shift + c); }
        for (int row = gw; row < NCTX; row += NGW) {
            f32x4 v[4]; float ss = 0.f;
#pragma unroll
            for (int j = 0; j < 4; ++j) { v[j] = *(const f32x4*)(ctx_src + (size_t)row * DM + 4 * lane + 256 * j); ss += (v[j][0] * v[j][0] + v[j][1] * v[j][1]) + (v[j][2] * v[j][2] + v[j][3] * v[j][3]); }
            const float rstd = 1.0f / sqrtf(wave_sum(ss) * (1.f / DM) + EPS);
#pragma unroll
            for (int j = 0; j < 4; ++j) { const f32x4 h = (v[j] * rstd) * A[j] + Sh[j]; u32x2 w; w.x = pkh(h[0], h[1]); w.y = pkh(h[2], h[3]); *(u32x2*)(a.hout + (size_t)(NTOK + row) * DM + 4 * lane + 256 * j) = w; }
        }
    }
    __syncthreads();
}

__device__ __forceinline__ void topk_phase(const float* aff, int* idx, float* gv, short* inv, const f16* H, f16* XIN, LAS unsigned char* lds) {
    const int tid = opaque_tid(), lane = tid & 63, wave = __builtin_amdgcn_readfirstlane(tid >> 6);
    LAS unsigned long long* key = (LAS unsigned long long*)lds;
    for (int u = blockIdx.x; u < NB * NE; u += gridDim.x) {
        const int b = u / NE, e = u % NE;
        const float* av = aff + (size_t)u * SEQ;
        for (int t = tid; t < SEQ; t += 512) key[t] = ((unsigned long long)(~__float_as_uint(av[t])) << 32) | (unsigned)t;
        __syncthreads();
        for (int k = 2; k <= SEQ; k <<= 1)
            for (int j = k >> 1; j > 0; j >>= 1) {
#pragma unroll
                for (int pp = 0; pp < 2; ++pp) { const int pr = tid + pp * 512; const int i = ((pr & ~(j - 1)) << 1) | (pr & (j - 1)), i2 = i | j;
                    const unsigned long long x = key[i], y = key[i2]; const bool up = (i & k) == 0;
                    if ((x > y) == up) { key[i] = y; key[i2] = x; } }
                __syncthreads();
            }
        for (int r = tid; r < SEQ; r += 512) { const unsigned long long kk = key[r]; const int t = (int)(unsigned)kk;
            inv[(size_t)u * SEQ + t] = (short)(r < CAP ? r : -1);
            if (r < CAP) { idx[u * CAP + r] = t; gv[u * CAP + r] = __uint_as_float(~(unsigned)(kk >> 32)); } }
        for (int r0 = wave * 32; r0 < wave * 32 + 32; r0 += 8) {
            u32x4 v0[8], v1[8];
#pragma unroll
            for (int q = 0; q < 8; ++q) { const int t = (int)(unsigned)key[r0 + q]; const u32x4* sp = (const u32x4*)(H + ((size_t)b * SEQ + t) * DM); v0[q] = sp[lane]; v1[q] = sp[lane + 64]; }
#pragma unroll
            for (int q = 0; q < 8; ++q) { u32x4* d = (u32x4*)(XIN + ((size_t)e * EROWS + b * CAP + r0 + q) * DM); d[lane] = v0[q]; d[lane + 64] = v1[q]; }
        }
        __syncthreads();
    }
}

namespace at {
constexpr int SLOT = 32768, NSLOT = 4;
constexpr int RPB_OFF = 132096;
constexpr float THR = 8.f;
typedef _Float16 v4h __attribute__((ext_vector_type(4)));
__device__ __forceinline__ int fsw(int row) { return ((row & 3) << 2) | ((row >> 2) & 3); }

__device__ __forceinline__ void glds16(const void* gsrc, unsigned lds_dst) { unsigned keep;
    asm volatile("s_mov_b32 %0, m0\n\ts_mov_b32 m0, %2\n\ts_nop 0\n\tglobal_load_lds_dwordx4 %1, off\n\ts_mov_b32 m0, %0" : "=&s"(keep) : "v"(gsrc), "s"(lds_dst) : "memory"); }
__device__ __forceinline__ void dma_tile(const f16* Z, long rowbase, int kcol, int vcol, LAS unsigned char* slot, int wave, int lane) {
    const unsigned sbase = (unsigned)__builtin_amdgcn_readfirstlane((int)(unsigned)(uintptr_t)slot);
#pragma unroll
    for (int i = 0; i < 2; ++i) { const int piece = wave + 8 * i, row = 4 * piece + (lane >> 4), c = (lane & 15) ^ fsw(row);
        const f16* gp = Z + (size_t)(rowbase + row) * ZP0 + 8 * c;
        glds16(gp + kcol, sbase + piece * 1024);
        glds16(gp + vcol, sbase + 16384 + piece * 1024); }
}
#define AT_WAIT(n) asm volatile("s_waitcnt vmcnt(" #n ") lgkmcnt(0)" ::: "memory")
__device__ __forceinline__ void wait_tile(int younger) { if (younger >= 2) AT_WAIT(8); else if (younger == 1) AT_WAIT(4); else AT_WAIT(0); }

template <int NDT> struct Addr { int k[4]; int v[NDT][2]; };
template <int NDT>
__device__ __forceinline__ Addr<NDT> make_addr(int kb0, int kchunk0, int vchunk0, int lane) {
    Addr<NDT> a; const int r32 = lane & 31, hh = lane >> 5, i = lane & 15, q_ = i >> 2, p_ = i & 3, g1 = (lane >> 4) & 1;
    const int kr = kb0 + r32, fk = fsw(kr);
#pragma unroll
    for (int st = 0; st < 4; ++st) a.k[st] = kr * 256 + 16 * ((kchunk0 + 2 * st + hh) ^ fk);
    const int vr = kb0 + 4 * hh + q_, f0 = fsw(vr), f1 = fsw(vr + 8);
#pragma unroll
    for (int dt = 0; dt < NDT; ++dt) { const int c = vchunk0 + 4 * dt + 2 * g1 + (p_ >> 1);
        a.v[dt][0] = 16384 + vr * 256 + 16 * (c ^ f0) + 8 * (p_ & 1); a.v[dt][1] = 16384 + (vr + 8) * 256 + 16 * (c ^ f1) + 8 * (p_ & 1); }
    return a;
}
template <int NDT>
__device__ __forceinline__ f32x16 qk32(LAS unsigned char* slot, const Addr<NDT>& a, int off, const f16x8 (&qf)[4]) {
    f32x16 s;
#pragma unroll
    for (int r = 0; r < 16; ++r) s[r] = 0.f;
#pragma unroll
    for (int st = 0; st < 4; ++st) { const f16x8 kf = *(const LAS f16x8*)(slot + a.k[st] + off); s = __builtin_amdgcn_mfma_f32_32x32x16_f16(kf, qf[st], s, 0, 0, 0); }
    return s;
}
template <int NDT>
__device__ __forceinline__ void pv32(LAS unsigned char* slot, const Addr<NDT>& a, int off, const f32x16& p, f32x16 (&o)[NDT]) {
#pragma unroll
    for (int s2 = 0; s2 < 2; ++s2) {
        f16x8 pb;
#pragma unroll
        for (int j = 0; j < 8; ++j) pb[j] = (f16)p[8 * s2 + j];
#pragma unroll
        for (int dt = 0; dt < NDT; ++dt) {
            const v4h lo = __builtin_bit_cast(v4h, __builtin_amdgcn_ds_read_tr16_b64_v4i16((LAS s16x4*)(slot + a.v[dt][0] + off + s2 * 4096)));
            const v4h hi = __builtin_bit_cast(v4h, __builtin_amdgcn_ds_read_tr16_b64_v4i16((LAS s16x4*)(slot + a.v[dt][1] + off + s2 * 4096)));
            const f16x8 vf = {lo[0], lo[1], lo[2], lo[3], hi[0], hi[1], hi[2], hi[3]};
            o[dt] = __builtin_amdgcn_mfma_f32_32x32x16_f16(vf, pb, o[dt], 0, 0, 0);
        }
    }
}
__device__ __forceinline__ float rowmax16(const f32x16& s) { float a = fmaxf(fmaxf(s[0], s[1]), fmaxf(s[2], s[3]));
#pragma unroll
    for (int r = 4; r < 16; r += 4) a = fmaxf(a, fmaxf(fmaxf(s[r], s[r + 1]), fmaxf(s[r + 2], s[r + 3])));
    return a; }
template <int NDT>
__device__ __forceinline__ void rescale(float mx, float& m, float& l, f32x16 (&o)[NDT]) {
    if (!__all(mx - m <= THR)) { const float mn = fmaxf(m, mx), alpha = __builtin_amdgcn_exp2f(m - mn); m = mn; l *= alpha;
#pragma unroll
        for (int dt = 0; dt < NDT; ++dt)
#pragma unroll
            for (int r = 0; r < 16; ++r) o[dt][r] *= alpha; }
}
__device__ __forceinline__ float expsum(f32x16& s, float m) { float ps = 0.f;
#pragma unroll
    for (int r = 0; r < 16; ++r) { s[r] = __builtin_amdgcn_exp2f(s[r] - m); ps += s[r]; }
    return ps; }
template <int NDT>
__device__ __forceinline__ void step64(LAS unsigned char* slot, const Addr<NDT>& a, const f16x8 (&qf)[4], f32x16 (&o)[NDT], float& m, float& l) {
    f32x16 s0 = qk32<NDT>(slot, a, 0, qf), s1 = qk32<NDT>(slot, a, 8192, qf);
    float mx = fmaxf(rowmax16(s0), rowmax16(s1)); mx = fmaxf(mx, __shfl_xor(mx, 32));
    rescale<NDT>(mx, m, l, o);
    l += expsum(s0, m) + expsum(s1, m);
    pv32<NDT>(slot, a, 0, s0, o); pv32<NDT>(slot, a, 8192, s1, o);
}

__device__ __forceinline__ void diff_unit(int u, const f16* Z, f16* Y, const float* subln, float lam, LAS unsigned char* lds) {
    const int tid = opaque_tid(), lane = tid & 63, wave = __builtin_amdgcn_readfirstlane(tid >> 6);
    const int qb = u & 15, h = (u >> 4) & 3, b = u >> 6;
    const int map = wave >> 2, r32 = lane & 31, hh = lane >> 5;
    const long tokbase = (long)b * SEQ;
    const long qrow = tokbase + qb * 128 + (wave & 3) * 32 + r32;
    const int kcol = 1536 + 128 * h, vcol = 2560 + 128 * h;
    constexpr int NT = 36;
#define DIFF_ROWBASE(t) ((t) < 32 ? tokbase + 64 * (t) : (long)NTOK + b * CTXL + 64 * ((t) - 32))
#pragma unroll
    for (int t = 0; t < 3; ++t) dma_tile(Z, DIFF_ROWBASE(t), kcol, vcol, lds + t * SLOT, wave, lane);
    f16x8 qf[4];
#pragma unroll
    for (int st = 0; st < 4; ++st) qf[st] = *(const f16x8*)(Z + (size_t)qrow * ZP0 + 512 + 128 * h + 64 * map + 16 * st + 8 * hh);
    asm volatile("" : "+v"(qf[0]), "+v"(qf[1]), "+v"(qf[2]), "+v"(qf[3]));
    const Addr<4> ad = make_addr<4>(0, 8 * map, 0, lane);
    f32x16 o[4];
#pragma unroll
    for (int dt = 0; dt < 4; ++dt)
#pragma unroll
        for (int r = 0; r < 16; ++r) o[dt][r] = 0.f;
    float m = -1e30f, l = 0.f;
    for (int t = 0; t < NT; ++t) {
        wait_tile(NT - 1 - t);
        __builtin_amdgcn_s_barrier();
        if (t + 3 < NT) dma_tile(Z, DIFF_ROWBASE(t + 3), kcol, vcol, lds + ((t + 3) & 3) * SLOT, wave, lane);
        step64<4>(lds + (t & 3) * SLOT, ad, qf, o, m, l);
    }
#undef DIFF_ROWBASE
    __syncthreads();
    const float linv = 1.f / (l + __shfl_xor(l, 32));
    LAS float* cb = (LAS float*)lds + (wave & 3) * 4096;
    if (map == 1) {
#pragma unroll
        for (int dt = 0; dt < 4; ++dt)
#pragma unroll
            for (int r = 0; r < 16; ++r) cb[(dt * 16 + r) * 64 + lane] = o[dt][r] * linv;
    }
    __syncthreads();
    if (map == 0) {
        float ss = 0.f;
#pragma unroll
        for (int dt = 0; dt < 4; ++dt)
#pragma unroll
            for (int r = 0; r < 16; ++r) { const float d = o[dt][r] * linv - lam * cb[(dt * 16 + r) * 64 + lane]; o[dt][r] = d; ss += d * d; }
        ss += __shfl_xor(ss, 32);
        const float rstd = 0.8f / sqrtf(ss * (1.f / 128.f) + EPS);
        f16* yr = Y + (size_t)qrow * DM + 512 + 128 * h;
#pragma unroll
        for (int dt = 0; dt < 4; ++dt)
#pragma unroll
            for (int rg = 0; rg < 4; ++rg) { const int d0 = 32 * dt + 8 * rg + 4 * hh; const f32x4 sg = *(const f32x4*)(subln + d0);
                u32x2 w; w.x = pkh(o[dt][4 * rg] * rstd * sg[0], o[dt][4 * rg + 1] * rstd * sg[1]); w.y = pkh(o[dt][4 * rg + 2] * rstd * sg[2], o[dt][4 * rg + 3] * rstd * sg[3]);
                *(u32x2*)(yr + d0) = w; }
    }
    __syncthreads();
}

__device__ __forceinline__ void na_unit(int u, const f16* Z, f16* Y, const float* rpb, LAS unsigned char* lds) {
    const int tid = opaque_tid(), lane = tid & 63, wave = __builtin_amdgcn_readfirstlane(tid >> 6);
    const int rp = u & 15, hp = (u >> 4) & 3, b = u >> 6;
    const int hs = wave >> 2, a = wave & 3, head = 2 * hp + hs, r32 = lane & 31, hh = lane >> 5;
    const int r0 = 2 * rp, qr = r0 + (r32 >> 4), qc = 16 * a + (r32 & 15);
    const int rsq = min(max(qr - 4, 0), 24), csq = min(max(qc - 8, 0), 48);
    const int lo = min(max(r0 - 4, 0), 24), hi = min(max(r0 + 1 - 4, 0), 24) + 8;
    const int seg = (a == 0) ? 0 : (a == 1) ? 8 : (a == 2) ? 24 : 32;
    const long tokbase = (long)b * SEQ;
    const long qrow = tokbase + qr * 64 + qc;
    const int kcol = 1024 + 128 * hp, vcol = 2048 + 128 * hp;
    const int nwin = hi - lo, NT = nwin + 4;
#define NA_ROWBASE(t) ((t) < nwin ? tokbase + (lo + (t)) * 64 : (long)NTOK + b * CTXL + 64 * ((t) - nwin))
    LAS float* tab = (LAS float*)(lds + RPB_OFF);
    for (int i = tid; i < 2 * 465; i += 512) tab[i] = rpb[(2 * hp) * 465 + i] * LOG2E;
#pragma unroll
    for (int t = 0; t < 3; ++t) dma_tile(Z, NA_ROWBASE(t), kcol, vcol, lds + t * SLOT, wave, lane);
    f16x8 qf[4];
#pragma unroll
    for (int st = 0; st < 4; ++st) qf[st] = *(const f16x8*)(Z + (size_t)qrow * ZP0 + 64 * head + 16 * st + 8 * hh);
    asm volatile("" : "+v"(qf[0]), "+v"(qf[1]), "+v"(qf[2]), "+v"(qf[3]));
    const Addr<2> aw = make_addr<2>(seg, 8 * hs, 8 * hs, lane), ac = make_addr<2>(0, 8 * hs, 8 * hs, lane);
    f32x16 o[2];
#pragma unroll
    for (int dt = 0; dt < 2; ++dt)
#pragma unroll
        for (int r = 0; r < 16; ++r) o[dt][r] = 0.f;
    float m = -1e30f, l = 0.f;
    for (int t = 0; t < NT; ++t) {
        wait_tile(NT - 1 - t);
        __builtin_amdgcn_s_barrier();
        if (t + 3 < NT) dma_tile(Z, NA_ROWBASE(t + 3), kcol, vcol, lds + ((t + 3) & 3) * SLOT, wave, lane);
        LAS unsigned char* slot = lds + (t & 3) * SLOT;
        if (t < nwin) {
            const int krow = lo + t;
            f32x16 s = qk32<2>(slot, aw, 0, qf);
            const bool rowok = (krow >= rsq) && (krow < rsq + 8);
            const int rbase = (krow - qr + 7) * 31 + 15 - qc;
#pragma unroll
            for (int r = 0; r < 16; ++r) { const int kc = seg + (r & 3) + 8 * (r >> 2) + 4 * hh; const bool ok = rowok && (kc >= csq) && (kc < csq + 16);
                const int bi = min(max(rbase + kc, 0), 464); const float bias = tab[hs * 465 + bi];
                s[r] = ok ? s[r] + bias : -INFINITY; }
            float mx = rowmax16(s); mx = fmaxf(mx, __shfl_xor(mx, 32));
            rescale<2>(mx, m, l, o);
            l += expsum(s, m);
            pv32<2>(slot, aw, 0, s, o);
        } else {
            step64<2>(slot, ac, qf, o, m, l);
        }
    }
#undef NA_ROWBASE
    const float linv = 1.f / (l + __shfl_xor(l, 32));
    f16* yr = Y + (size_t)qrow * DM + 64 * head;
#pragma unroll
    for (int dt = 0; dt < 2; ++dt)
#pragma unroll
        for (int rg = 0; rg < 4; ++rg) { const int d0 = 32 * dt + 8 * rg + 4 * hh;
            u32x2 w; w.x = pkh(o[dt][4 * rg] * linv, o[dt][4 * rg + 1] * linv); w.y = pkh(o[dt][4 * rg + 2] * linv, o[dt][4 * rg + 3] * linv);
            *(u32x2*)(yr + d0) = w; }
    __syncthreads();
}

__device__ __forceinline__ void attn_phase(const f16* Z, f16* Y, const float* rpb, const float* subln, const float* lamp, LAS unsigned char* lds, int rep = 0) {
    const float lam = *lamp;
    const int ulo = (rep == 3) ? 1024 : 0, uhi = (rep == 2) ? 1024 : 2048;
    for (int u = ulo + blockIdx.x; u < uhi; u += gridDim.x) {
        if (u < 1024) diff_unit(u, Z, Y, subln, lam, lds);
        else na_unit(u - 1024, Z, Y, rpb, lds);
    }
}
}

__device__ __forceinline__ void conv_phase(const f16* Z1, f16* Y, const float* scw, const float* cfw, const float* cfb, const float* lng, const float* lnb, LAS unsigned char* lds) {
    const int tid = opaque_tid(), lane = tid & 63, wave = __builtin_amdgcn_readfirstlane(tid >> 6);
    LAS float* U = (LAS float*)lds;
    float cw[31];
#pragma unroll
    for (int k = 0; k < 31; ++k) cw[k] = cfw[k * 512 + tid];
    const float cb = cfb[tid];
    for (int u = blockIdx.x; u < NTOK / 32; u += gridDim.x) {
        const int b = u >> 6, t0 = (u & 63) * 32;
        const f16* zb = Z1 + (size_t)b * SEQ * ZP1;
        {
            f16x4 av[16], gv[16];
#pragma unroll
            for (int pass = 0; pass < 16; ++pass) { const int row = pass * 4 + (tid >> 7), c4 = (tid & 127) * 4, tt = t0 - 15 + row; const bool ok = row < 62 && tt >= 0 && tt < SEQ;
                const int tc = ok ? tt : (t0 < SEQ ? t0 : 0);
                av[pass] = *(const f16x4*)(zb + (size_t)tc * ZP1 + 1536 + c4); gv[pass] = *(const f16x4*)(zb + (size_t)tc * ZP1 + 2048 + c4); }
#pragma unroll
            for (int pass = 0; pass < 16; ++pass) { const int row = pass * 4 + (tid >> 7), c4 = (tid & 127) * 4, tt = t0 - 15 + row; const bool ok = tt >= 0 && tt < SEQ;
                if (row < 62) { f32x4 uv;
#pragma unroll
                    for (int j = 0; j < 4; ++j) uv[j] = ok ? (float)av[pass][j] * __builtin_amdgcn_rcpf(1.f + __builtin_amdgcn_exp2f(-LOG2E * (float)gv[pass][j])) : 0.f;
                    *(LAS f32x4*)(U + row * 512 + c4) = uv; } }
        }
        __syncthreads();
        float uu[62];
#pragma unroll
        for (int i = 0; i < 62; ++i) uu[i] = U[i * 512 + tid];
        __syncthreads();
#pragma unroll
        for (int tt = 0; tt < 32; ++tt) { float v = cb;
#pragma unroll
            for (int k = 0; k < 31; ++k) v += cw[k] * uu[tt + k];
            U[tt * 512 + tid] = v; }
        __syncthreads();
#pragma unroll
        for (int q = 0; q < 4; ++q) { const int tt = wave * 4 + q, t = t0 + tt, c8 = lane * 8;
            const f32x4 x0 = *(const LAS f32x4*)(U + tt * 512 + c8), x1 = *(const LAS f32x4*)(U + tt * 512 + c8 + 4);
            float x[8] = {x0[0], x0[1], x0[2], x0[3], x1[0], x1[1], x1[2], x1[3]};
            float s = 0.f;
#pragma unroll
            for (int j = 0; j < 8; ++j) s += x[j];
            const float mean = wave_sum(s) * (1.f / 512.f); float s2 = 0.f;
#pragma unroll
            for (int j = 0; j < 8; ++j) { x[j] -= mean; s2 += x[j] * x[j]; }
            const float rstd = 1.0f / sqrtf(wave_sum(s2) * (1.f / 512.f) + EPS);
            const f32x4 g0 = *(const f32x4*)(lng + c8), g1 = *(const f32x4*)(lng + c8 + 4), b0 = *(const f32x4*)(lnb + c8), b1 = *(const f32x4*)(lnb + c8 + 4);
            const float gg[8] = {g0[0], g0[1], g0[2], g0[3], g1[0], g1[1], g1[2], g1[3]}, bb[8] = {b0[0], b0[1], b0[2], b0[3], b1[0], b1[1], b1[2], b1[3]};
            float yd[8];
#pragma unroll
            for (int j = 0; j < 8; ++j) yd[j] = silu_f(x[j] * rstd * gg[j] + bb[j]);
            f16* yr = Y + ((size_t)b * SEQ + t) * DM;
            { u32x4 w; w.x = pkh(yd[0], yd[1]); w.y = pkh(yd[2], yd[3]); w.z = pkh(yd[4], yd[5]); w.w = pkh(yd[6], yd[7]); *(u32x4*)(yr + 512 + c8) = w; }
            float cacc[8];
#pragma unroll
            for (int j = 0; j < 8; ++j) cacc[j] = 0.f;
#pragma unroll
            for (int k = 0; k < 3; ++k) { const int ts = t + k - 1;
                if (ts >= 0 && ts < SEQ) { const f16x8 xc = *(const f16x8*)(zb + (size_t)ts * ZP1 + c8), gc = *(const f16x8*)(zb + (size_t)ts * ZP1 + 1024 + c8);
                    const f32x4 w0 = *(const f32x4*)(scw + k * 512 + c8), w1 = *(const f32x4*)(scw + k * 512 + c8 + 4);
                    const float ww[8] = {w0[0], w0[1], w0[2], w0[3], w1[0], w1[1], w1[2], w1[3]};
#pragma unroll
                    for (int j = 0; j < 8; ++j) cacc[j] += ww[j] * ((float)gc[j] * (float)xc[j]); } }
            const f16x8 gb = *(const f16x8*)(zb + (size_t)t * ZP1 + 512 + c8);
            { u32x4 w; w.x = pkh((float)gb[0] * cacc[0], (float)gb[1] * cacc[1]); w.y = pkh((float)gb[2] * cacc[2], (float)gb[3] * cacc[3]);
              w.z = pkh((float)gb[4] * cacc[4], (float)gb[5] * cacc[5]); w.w = pkh((float)gb[6] * cacc[6], (float)gb[7] * cacc[7]); *(u32x4*)(yr + c8) = w; }
        }
        __syncthreads();
    }
}

constexpr int NPHASE = 18;
__global__ void __launch_bounds__(512, 2) fwd(Params p) {
    extern __shared__ __attribute__((aligned(16))) unsigned char lds_raw[];
    LAS unsigned char* lds = (LAS unsigned char*)lds_raw;
    const int tid = threadIdx.x;
    unsigned char* ws = p.ws;
    for (int u = tid; u < (LDS_BYTES - LDSCTL_OFF) / 4; u += 512) ((LAS unsigned*)(lds + LDSCTL_OFF))[u] = 0u;
    __syncthreads();
    XcdBarrier bar; bar.bar = (unsigned*)(ws + WS_CTL) + 4096; bar.x = 0; bar.st = nullptr;
    if (N_LAUNCH_MODE == 1) bar = xcd_barrier_post((unsigned*)(ws + WS_CTL) + 4096, (volatile LAS unsigned*)(lds + MISC_OFF) + 8);
    const int lo = p.ph_lo, hi = p.ph_hi, rep = p.alt;
#ifndef ONLYP
#define ONLYP -1
#endif
#define IN(k) ((ONLYP < 0 || ONLYP == (k)) && lo <= (k) && (k) < hi)
#define SEAM(k) do { if (IN(k) && IN((k) + 1)) xcd_barrier(bar); } while (0)
    const int G = gridDim.x, c = blockIdx.x;
    float* mod0 = (float*)(ws + WS_MOD + MOD0_OFF); float* mod1 = (float*)(ws + WS_MOD + MOD1_OFF);
    f16* H = (f16*)(ws + WS_H); f16* Z = (f16*)(ws + WS_Z); f16* Y = (f16*)(ws + WS_Y); f16* XIN = (f16*)(ws + WS_XIN); f16* HID = (f16*)(ws + WS_HID); f16* Y2 = (f16*)(ws + WS_Y2);
    f16* W13 = (f16*)(ws + WS_W13); f16* W2T = (f16*)(ws + WS_W2);
    float* AFF = (float*)(ws + WS_AFF); int* IDX = (int*)(ws + WS_IDX); float* GV = (float*)(ws + WS_G); short* INV = (short*)(ws + WS_INV);

    if (IN(0)) { phase_prologue(p, lds); } SEAM(0);
    if (IN(1)) { NormArgs a{}; a.src = p.in[I_X]; a.gain = p.in[I_L0_NORM1]; a.shift = mod0; a.scale = mod0 + 1024; a.mstride = 6144; a.hout = H;
        norm_phase<4>(a, lds, true, p.in[I_CTX], mod0 + 16 * 6144, mod0 + 16 * 6144 + 1024); } SEAM(1);
    if (IN(2)) { gm::Gemm g{H, (const f16*)(ws + WS_WIN0), DM, 0, 0}; gm::Order S; S.init(NROWS, ZP0, 1, G, c);
        gm::EpiInProj0 E{Z, (const float*)(ws + WS_MOD + ROPE_OFF)}; gm::gemm_phase(lds, g, S, E); } SEAM(2);
    if (IN(3)) { at::attn_phase(Z, Y, p.in[I_L0_RPB], p.in[I_L0_SUBLN], (const float*)(ws + WS_MOD + LAM_OFF), lds, rep); } SEAM(3);
    if (IN(4)) { gm::Gemm g{Y, (const f16*)(ws + WS_WOUT0), DM, 0, 0}; gm::Order S; S.init(NTOK, DM, 1, G, c);
        gm::EpiResGate E{p.in[I_X], p.out, mod0 + 2048, 6144}; gm::gemm_phase(lds, g, S, E); } SEAM(4);
    if (IN(5)) { NormArgs a{}; a.src = p.out; a.gain = p.in[I_L0_NORM2]; a.shift = mod0 + 3072; a.scale = mod0 + 4096; a.mstride = 6144; a.hout = H; a.wr = p.in[I_L0_WR]; a.aff = AFF;
        norm_phase<4>(a, lds, false, nullptr, nullptr, nullptr); } SEAM(5);
    if (IN(6)) { topk_phase(AFF, IDX, GV, INV, H, XIN, lds); } SEAM(6);
    if (IN(7)) { gm::Gemm g{XIN, W13, DM, (long)EROWS * DM, (long)2 * DE * DM}; gm::Order S; S.init(EROWS, 2 * DE, NE, G, c);
        gm::EpiSwiGLU E{HID}; gm::gemm_phase(lds, g, S, E); } SEAM(7);
    if (IN(8)) { gm::Gemm g{HID, W2T, DE, (long)EROWS * DE, (long)DM * DE}; gm::Order S; S.init(EROWS, DM, NE, G, c, 1);
        gm::EpiRowScale E{Y2, GV}; gm::gemm_phase(lds, g, S, E); } SEAM(8);
    if (IN(9)) { NormArgs a{}; a.src = p.out; a.xout = rep ? (float*)(ws + WS_BIG) : p.out; a.y2 = Y2; a.inv = INV; a.gate2 = mod0 + 5120; a.gain = p.in[I_L1_NORM1]; a.shift = mod1; a.scale = mod1 + 1024; a.mstride = 6144; a.hout = rep ? (f16*)(ws + WS_BIG + 128 * MiB) : H;
        norm_phase<2>(a, lds, false, nullptr, nullptr, nullptr);
        cvt_moe(p.in[I_L1_W1], p.in[I_L1_W3], p.in[I_L1_W2], W13, W2T, c * 8 + (tid >> 6), G * 8, tid & 63, lds + (tid >> 6) * CVT_SCR); } SEAM(9);
    if (IN(10)) { gm::Gemm g{H, (const f16*)(ws + WS_WIN1), DM, 0, 0}; gm::Order S; S.init(NTOK, ZP1, 1, G, c);
        gm::EpiF16 E{Z, ZP1}; gm::gemm_phase(lds, g, S, E); } SEAM(10);
    if (IN(11)) { conv_phase(Z, Y, p.in[I_L1_SCW], p.in[I_L1_CFW], p.in[I_L1_CFB], p.in[I_L1_LNG], p.in[I_L1_LNB], lds); } SEAM(11);
    if (IN(12)) { gm::Gemm g{Y, (const f16*)(ws + WS_WOUT1), DM, 0, 0}; gm::Order S; S.init(NTOK, DM, 1, G, c);
        gm::EpiResGate E{p.out, rep ? (float*)(ws + WS_XIN) : p.out, mod1 + 2048, 6144}; gm::gemm_phase(lds, g, S, E); } SEAM(12);
    if (IN(13)) { NormArgs a{}; a.src = p.out; a.gain = p.in[I_L1_NORM2]; a.shift = mod1 + 3072; a.scale = mod1 + 4096; a.mstride = 6144; a.hout = H; a.wr = p.in[I_L1_WR]; a.aff = AFF;
        norm_phase<4>(a, lds, false, nullptr, nullptr, nullptr); } SEAM(13);
    if (IN(14)) { topk_phase(AFF, IDX, GV, INV, H, XIN, lds); } SEAM(14);
    if (IN(15)) { gm::Gemm g{XIN, W13, DM, (long)EROWS * DM, (long)2 * DE * DM}; gm::Order S; S.init(EROWS, 2 * DE, NE, G, c);
        gm::EpiSwiGLU E{HID}; gm::gemm_phase(lds, g, S, E); } SEAM(15);
    if (IN(16)) { gm::Gemm g{HID, W2T, DE, (long)EROWS * DE, (long)DM * DE}; gm::Order S; S.init(EROWS, DM, NE, G, c, 1);
        gm::EpiRowScale E{Y2, GV}; gm::gemm_phase(lds, g, S, E); } SEAM(16);
    if (IN(17)) { NormArgs a{}; a.src = p.out; a.xout = p.out; a.y2 = Y2; a.inv = INV; a.gate2 = mod1 + 5120; a.gain = p.in[I_FNORM]; a.fout = rep ? (float*)(ws + WS_BIG) : p.out;
        norm_phase<2>(a, lds, false, nullptr, nullptr, nullptr); }
#undef IN
#undef SEAM
}

extern "C" void kernel_launch(void* const* d_in, const int* in_sizes, int n_in, void* d_out, int out_size, void* d_ws, size_t ws_size, hipStream_t stream) {
    static int grid = 0;
    if (grid == 0) {
        if (n_in != 36 || out_size != NTOK * DM || ws_size < WS_END) { fprintf(stderr, "kernel_launch: unexpected shapes (n_in %d out %d ws %zu need %zu)\n", n_in, out_size, ws_size, (size_t)WS_END); grid = -1; return; }
        int dev = 0, cus = 0;
        if (hipGetDevice(&dev) != hipSuccess || hipDeviceGetAttribute(&cus, hipDeviceAttributeMultiprocessorCount, dev) != hipSuccess) { grid = -1; return; }
        if (hipFuncSetAttribute((const void*)fwd, hipFuncAttributeMaxDynamicSharedMemorySize, LDS_BYTES) != hipSuccess) { fprintf(stderr, "kernel_launch: hipFuncSetAttribute failed\n"); grid = -1; return; }
        int per_cu = 0;
        if (hipOccupancyMaxActiveBlocksPerMultiprocessor(&per_cu, (const void*)fwd, 512, LDS_BYTES) != hipSuccess || per_cu < 1) fprintf(stderr, "kernel_launch: occupancy query says %d\n", per_cu);
        (void)hipGetLastError();
        grid = cus;
    }
    if (grid < 0) return;
    (void)hipMemsetAsync((char*)d_ws + WS_CTL, 0, CTL_ZERO_BYTES, stream);
    Params p{};
    for (int i = 0; i < 36; ++i) p.in[i] = (const float*)d_in[i];
    p.out = (float*)d_out; p.ws = (unsigned char*)d_ws;
#if N_LAUNCH_MODE == 1
    p.ph_lo = 0; p.ph_hi = NPHASE;
    hipLaunchKernelGGL(fwd, dim3(grid), dim3(512), LDS_BYTES, stream, p);
#else
    for (int k = 0; k < NPHASE; ++k) { p.ph_lo = k; p.ph_hi = k + 1; p.alt = 0; hipLaunchKernelGGL(fwd, dim3(grid), dim3(512), LDS_BYTES, stream, p);
        for (int r = 0; r < HOSTDUP_N; ++r) if ((HOSTDUP >> k) & 1) { p.alt = HOSTDUP_ALT; hipLaunchKernelGGL(fwd, dim3(grid), dim3(512), LDS_BYTES, stream, p); } }
#endif
}
```

```cpp
#include <hip/hip_runtime.h>
#include <cstdio>
#include <cstdint>

#define LAS __attribute__((address_space(3)))
#define GAS __attribute__((address_space(1)))
typedef _Float16 f16;
typedef _Float16 f16x8 __attribute__((ext_vector_type(8)));
typedef _Float16 f16x4 __attribute__((ext_vector_type(4)));
typedef _Float16 f16x2 __attribute__((ext_vector_type(2)));
typedef float f32x2 __attribute__((ext_vector_type(2)));
typedef float f32x4 __attribute__((ext_vector_type(4)));
typedef float f32x16 __attribute__((ext_vector_type(16)));
typedef unsigned u32x2 __attribute__((ext_vector_type(2)));
typedef unsigned u32x4 __attribute__((ext_vector_type(4)));
typedef short s16x4 __attribute__((ext_vector_type(4)));

#ifndef MOE_BF16
#define MOE_BF16 true
#endif
#ifndef HOSTDUP
#define HOSTDUP 0
#endif
#ifndef HOSTDUP_ALT
#define HOSTDUP_ALT 1
#endif
#ifndef HOSTDUP_N
#define HOSTDUP_N 1
#endif
#ifndef N_LAUNCH_MODE
#define N_LAUNCH_MODE 1
#endif

constexpr int NB = 16, SEQ = 2048, DM = 1024, NTOK = NB * SEQ, CTXL = 256, NCTX = NB * CTXL, NROWS = NTOK + NCTX;
constexpr int ZP0 = 3072, ZP1 = 2560;
constexpr int NE = 16, DE = 2816, CAP = 256, EROWS = NB * CAP;
constexpr float EPS = 1e-6f;
constexpr float LOG2E = 1.4426950408889634f;
constexpr float QSCALE = 0.125f * LOG2E;

constexpr size_t MiB = 1u << 20;
constexpr size_t WS_CTL = 0, CTL_ZERO_BYTES = 256 * 1024;
constexpr size_t WS_MOD = 1 * MiB;
constexpr size_t MOD0_OFF = 0, MOD1_OFF = 17 * 6144 * 4, ROPE_OFF = MOD1_OFF + 16 * 6144 * 4, LAM_OFF = ROPE_OFF + 64 * 16 * 2 * 4;
constexpr size_t WS_WIN0 = 2 * MiB, WS_WOUT0 = 8 * MiB, WS_WIN1 = 10 * MiB, WS_WOUT1 = 15 * MiB;
constexpr size_t WS_AFF = 17 * MiB;
constexpr size_t WS_IDX = 19 * MiB;
constexpr size_t WS_G = 19 * MiB + 512 * 1024;
constexpr size_t WS_INV = 20 * MiB;
constexpr size_t WS_W13 = 22 * MiB;
constexpr size_t WS_W2 = WS_W13 + 176 * MiB;
constexpr size_t WS_H = WS_W2 + 88 * MiB;
constexpr size_t WS_XIN = WS_H + 72 * MiB;
constexpr size_t WS_Y2 = WS_XIN + 128 * MiB;
constexpr size_t WS_BIG = WS_Y2 + 128 * MiB;
constexpr size_t WS_Z = WS_BIG, WS_Y = WS_BIG + 216 * MiB, WS_HID = WS_BIG;
constexpr size_t WS_END = WS_BIG + 352 * MiB;

constexpr int RING_BYTES = 131072;
constexpr int LDSCTL_OFF = RING_BYTES, MISC_OFF = LDSCTL_OFF + 320;
constexpr int LDS_BYTES = 147456;

#define RLX_AGENT __ATOMIC_RELAXED, __HIP_MEMORY_SCOPE_AGENT
#define LDS_WAIT() asm volatile("s_waitcnt lgkmcnt(0)" ::: "memory")
#define VM_WAIT() asm volatile("s_waitcnt vmcnt(0)" ::: "memory")

__device__ __forceinline__ unsigned pkh(float lo, float hi) { f16x2 v; v.x = (f16)lo; v.y = (f16)hi; return __builtin_bit_cast(unsigned, v); }
typedef __bf16 bf16x2_t __attribute__((ext_vector_type(2)));
typedef short s16x8 __attribute__((ext_vector_type(8)));
__device__ __forceinline__ unsigned pkb(float lo, float hi) { f32x2 v = {lo, hi}; bf16x2_t b = __builtin_convertvector(v, bf16x2_t); return __builtin_bit_cast(unsigned, b); }
template <bool BF> __device__ __forceinline__ unsigned pk16(float lo, float hi) { return BF ? pkb(lo, hi) : pkh(lo, hi); }
__device__ __forceinline__ float silu_f(float v) { return v / (1.f + __expf(-v)); }

#define XB_TMO      128
#define XB_XCNT(j)  (256  + 64 * (j))
#define XB_XSUB(j)  (1280 + 64 * (j))
#define XB_XGEN(j)  (2304 + 64 * (j))
#define XB_TOP      3328
#define XB_TOPGEN   3392
#define XCD_BAR_WORDS 3456
#define XB_SPIN_CAP (1u << 18)
__device__ __forceinline__ unsigned xb_ld(unsigned* p)              { return __hip_atomic_load(p, __ATOMIC_RELAXED, __HIP_MEMORY_SCOPE_AGENT); }
__device__ __forceinline__ unsigned xb_add(unsigned* p, unsigned v) { return __hip_atomic_fetch_add(p, v, __ATOMIC_RELAXED, __HIP_MEMORY_SCOPE_AGENT); }
__device__ __forceinline__ unsigned xb_xcc_id() { return (unsigned)__builtin_amdgcn_s_getreg((3 << 11) | 20) & 0xFu; }
#define XB_SPIN(cond, bar) do { unsigned _sp = 0; while (cond) { __builtin_amdgcn_s_sleep(1); \
    if ((++_sp & 255u) == 0u) { if (xb_ld(&(bar)[XB_TMO])) break; if (_sp > XB_SPIN_CAP) { atomicAdd(&(bar)[XB_TMO], 1u); break; } } } } while (0)
struct XcdBarrier { unsigned* bar; unsigned x; volatile LAS unsigned* st; };
__device__ __forceinline__ XcdBarrier xcd_barrier_post(unsigned* bar, volatile LAS unsigned* st) {
    XcdBarrier b; b.bar = bar; b.x = xb_xcc_id(); b.st = st;
    if (threadIdx.x == 0) (void)xb_add(&bar[XB_XCNT(b.x)], 1u);
    return b;
}
__device__ __forceinline__ void xcd_barrier_complete(unsigned* bar, unsigned x, unsigned& nloc, unsigned& nx) {
    const unsigned G = gridDim.x * gridDim.y * gridDim.z;
    unsigned sum, cnt, mine, sp = 0u;
    for (;;) {
        sum = 0u; cnt = 0u; mine = 0u;
#pragma unroll
        for (unsigned j = 0; j < 16; ++j) { const unsigned c = xb_ld(&bar[XB_XCNT(j)]); sum += c; cnt += (c > 0u) ? 1u : 0u; mine = (j == x) ? c : mine; }
        if (sum == G) break;
        __builtin_amdgcn_s_sleep(1);
        if ((++sp & 255u) == 0u) { if (xb_ld(&bar[XB_TMO])) break; if (sp > XB_SPIN_CAP) { atomicAdd(&bar[XB_TMO], 1u); break; } }
    }
    nloc = mine > 0u ? mine : 1u; nx = cnt > 0u ? cnt : 1u;
}
__device__ __forceinline__ void xcd_barrier(const XcdBarrier& b) {
    asm volatile("s_waitcnt vmcnt(0)" ::: "memory");
    __syncthreads();
    if (threadIdx.x == 0) {
        unsigned* bar = b.bar;
        __builtin_amdgcn_s_waitcnt(0);
        unsigned nloc = b.st[0], nx = b.st[1];
        if (nloc == 0u) { xcd_barrier_complete(bar, b.x, nloc, nx); b.st[0] = nloc; b.st[1] = nx; }
        const unsigned old = xb_add(&bar[XB_XSUB(b.x)], 1u);
        const unsigned gen = old / nloc;
        if (old + 1u == (gen + 1u) * nloc) {
            __builtin_amdgcn_fence(__ATOMIC_RELEASE, "agent");
            asm volatile("s_waitcnt vmcnt(0)" ::: "memory");
            const unsigned og = xb_add(&bar[XB_TOP], 1u);
            const unsigned tg = og / nx;
            if (og + 1u == (tg + 1u) * nx) xb_add(&bar[XB_TOPGEN], 1u);
            else XB_SPIN(xb_ld(&bar[XB_TOPGEN]) == tg, bar);
            __builtin_amdgcn_fence(__ATOMIC_ACQUIRE, "agent");
            xb_add(&bar[XB_XGEN(b.x)], 1u);
            asm volatile("s_waitcnt vmcnt(0)" ::: "memory");
        } else {
            XB_SPIN(xb_ld(&bar[XB_XGEN(b.x)]) == gen, bar);
            __builtin_amdgcn_fence(__ATOMIC_ACQUIRE, "agent");
            asm volatile("s_waitcnt vmcnt(0)" ::: "memory");
        }
    }
    __syncthreads();
}

__device__ __forceinline__ int opaque_tid0() { int t = threadIdx.x; asm volatile("" : "+v"(t)); return t; }
namespace gm {
constexpr int BM = 256, BK = 64, HALF = 128, HTB = HALF * BK * 2, STAGE_BYTES = 8 * HTB, NXCD = 8, WGM = 8;
__host__ __device__ __forceinline__ int lds_byte(int r, int c) { const int st = (r >> 4) * 2 + (c >> 5), rr = r & 15, cc = c & 31, ob = rr * 64 + cc * 2; return st * 1024 + (ob ^ (((ob >> 9) & 1) << 5)); }
__host__ __device__ __forceinline__ void stage_rc(int b, int& R, int& C) { const int st = b / 1024, sb = b % 1024, swz = sb ^ (((sb >> 9) & 1) << 5); R = (st >> 1) * 16 + swz / 64; C = (st & 1) * 32 + (swz % 64) / 2; }
__host__ __device__ __forceinline__ int perm32(int rho) { const int n = rho >> 4, i = rho & 15; return 8 * (i >> 2) + 4 * n + (i & 3); }

struct Unit { int g, pm, pn; };
struct Gemm { const f16* A; const f16* Bt; int K; long sA, sB; };
struct Order {
    int nM, nN, tpg, total, G, c, mode;
    __device__ void init(int M, int N, int groups, int G_, int c_, int mode_ = 0) { nM = M / BM; nN = N / BM; tpg = nM * nN; total = tpg * groups; G = G_; c = c_; mode = (mode_ == 1 && G_ == 256 && nM == 16 && nN == 4) ? 1 : 0; }
    __device__ bool next(int i, Unit& u) const {
        const long L = (long)i * G + c; if (L >= total) return false;
        if (mode == 1) { const int x = c & 7, j = c >> 3; u.g = 4 * i + (x >> 1); u.pm = 8 * (x & 1) + (j >> 2); u.pn = j & 3; return true; }
        const int g = (int)(L / tpg); int wgid = (int)(L % tpg);
        { const int q = tpg / NXCD, r = tpg % NXCD, xcd = wgid % NXCD, off = wgid / NXCD; wgid = (xcd < r ? xcd * (q + 1) : r * (q + 1) + (xcd - r) * q) + off; }
        const int nig = WGM * nN, gid = wgid / nig, fm = gid * WGM, gsz = (nM - fm) < WGM ? (nM - fm) : WGM;
        u.g = g; u.pm = fm + ((wgid % nig) % gsz); u.pn = (wgid % nig) / gsz; return true;
    }
};

typedef f32x4 Acc[2][2][4][2];
typedef __bf16 bf16x8_t __attribute__((ext_vector_type(8)));
template <bool BF> __device__ __forceinline__ f32x4 mma16(const s16x8& a, const s16x8& b, const f32x4& c) {
    if constexpr (BF) return __builtin_amdgcn_mfma_f32_16x16x32_bf16(__builtin_bit_cast(bf16x8_t, a), __builtin_bit_cast(bf16x8_t, b), c, 0, 0, 0);
    else return __builtin_amdgcn_mfma_f32_16x16x32_f16(__builtin_bit_cast(f16x8, a), __builtin_bit_cast(f16x8, b), c, 0, 0, 0);
}

struct EpiF16 {
    static constexpr bool PERM = true;
    f16* O; int ldc;
    __device__ __forceinline__ void operator()(const Acc& acc, const Unit& u, int wr, int wc, int fr, int fq) const {
        const int row0 = u.pm * BM + wr * 64 + fr, col0 = u.pn * BM + wc * 32 + 8 * fq;
#pragma unroll
        for (int ai = 0; ai < 2; ++ai)
#pragma unroll
            for (int m = 0; m < 4; ++m) { f16* rowp = O + (size_t)(row0 + ai * HALF + m * 16) * ldc + col0;
#pragma unroll
                for (int bj = 0; bj < 2; ++bj) { const f32x4 v0 = acc[ai][bj][m][0], v1 = acc[ai][bj][m][1];
                    u32x4 w; w.x = pkh(v0[0], v0[1]); w.y = pkh(v0[2], v0[3]); w.z = pkh(v1[0], v1[1]); w.w = pkh(v1[2], v1[3]);
                    *(u32x4*)(rowp + bj * HALF) = w; } }
    }
};
struct EpiInProj0 {
    static constexpr bool PERM = true;
    f16* O; const float* rope;
    __device__ __forceinline__ void operator()(const Acc& acc, const Unit& u, int wr, int wc, int fr, int fq) const {
        const int row0 = u.pm * BM + wr * 64 + fr, col0 = u.pn * BM + wc * 32 + 8 * fq;
        const float sc = (u.pn < 4) ? QSCALE : 1.f;
        const bool dorope = (u.pn == 2 || u.pn == 3 || u.pn == 6 || u.pn == 7) && (u.pm * BM < NTOK);
#pragma unroll
        for (int ai = 0; ai < 2; ++ai)
#pragma unroll
            for (int m = 0; m < 4; ++m) { const int row = row0 + ai * HALF + m * 16; f16* rowp = O + (size_t)row * ZP0 + col0;
                const int t = row & (SEQ - 1), prow = t >> 6, pcol = t & 63;
#pragma unroll
                for (int bj = 0; bj < 2; ++bj) { f32x4 v0 = acc[ai][bj][m][0] * sc, v1 = acc[ai][bj][m][1] * sc;
                    if (dorope) { const int c = col0 + bj * HALF, half = (c >> 5) & 1, i0 = (c & 31) >> 1; const int pos = half ? pcol : prow;
                        const f32x4* tp = (const f32x4*)(rope + (pos * 16 + i0) * 2); const f32x4 t0 = tp[0], t1 = tp[1];
                        f32x4 r0, r1;
                        r0[0] = v0[0] * t0[0] - v0[1] * t0[1]; r0[1] = v0[0] * t0[1] + v0[1] * t0[0];
                        r0[2] = v0[2] * t0[2] - v0[3] * t0[3]; r0[3] = v0[2] * t0[3] + v0[3] * t0[2];
                        r1[0] = v1[0] * t1[0] - v1[1] * t1[1]; r1[1] = v1[0] * t1[1] + v1[1] * t1[0];
                        r1[2] = v1[2] * t1[2] - v1[3] * t1[3]; r1[3] = v1[2] * t1[3] + v1[3] * t1[2];
                        v0 = r0; v1 = r1; }
                    u32x4 w; w.x = pkh(v0[0], v0[1]); w.y = pkh(v0[2], v0[3]); w.z = pkh(v1[0], v1[1]); w.w = pkh(v1[2], v1[3]);
                    *(u32x4*)(rowp + bj * HALF) = w; } }
    }
};
struct EpiResGate {
    static constexpr bool PERM = false;
    const float* base; float* out; const float* gate; int gstride;
    __device__ __forceinline__ void operator()(const Acc& acc, const Unit& u, int wr, int wc, int fr, int fq) const {
        const int col0 = u.pn * BM + wc * 32 + 4 * fq; const int b = (u.pm * BM) / SEQ;
        f32x4 gv[2][2];
#pragma unroll
        for (int bj = 0; bj < 2; ++bj)
#pragma unroll
            for (int n = 0; n < 2; ++n) gv[bj][n] = *(const f32x4*)(gate + (size_t)b * gstride + col0 + bj * HALF + n * 16);
#pragma unroll
        for (int ai = 0; ai < 2; ++ai)
#pragma unroll
            for (int m = 0; m < 4; ++m) { const size_t off = (size_t)(u.pm * BM + ai * HALF + wr * 64 + m * 16 + fr) * DM + col0;
#pragma unroll
                for (int bj = 0; bj < 2; ++bj)
#pragma unroll
                    for (int n = 0; n < 2; ++n) { const f32x4 bs = *(const f32x4*)(base + off + bj * HALF + n * 16);
                        *(f32x4*)(out + off + bj * HALF + n * 16) = bs + gv[bj][n] * acc[ai][bj][m][n]; }
                if (m & 1) asm volatile("" ::: "memory"); }
    }
};
struct EpiSwiGLU {
    static constexpr bool PERM = true;
    f16* O;
    __device__ __forceinline__ void operator()(const Acc& acc, const Unit& u, int wr, int wc, int fr, int fq) const {
        const int row0 = u.pm * BM + wr * 64 + fr, col0 = u.pn * HALF + wc * 32 + 8 * fq;
        f16* Og = O + (size_t)u.g * EROWS * DE;
#pragma unroll
        for (int ai = 0; ai < 2; ++ai)
#pragma unroll
            for (int m = 0; m < 4; ++m) { f16* rowp = Og + (size_t)(row0 + ai * HALF + m * 16) * DE + col0;
                float h[8];
#pragma unroll
                for (int n = 0; n < 2; ++n)
#pragma unroll
                    for (int j = 0; j < 4; ++j) { const float g = acc[ai][0][m][n][j], up = acc[ai][1][m][n][j]; h[n * 4 + j] = g * up * __builtin_amdgcn_rcpf(1.f + __builtin_amdgcn_exp2f(-LOG2E * g)); }
                u32x4 w; w.x = pk16<MOE_BF16>(h[0], h[1]); w.y = pk16<MOE_BF16>(h[2], h[3]); w.z = pk16<MOE_BF16>(h[4], h[5]); w.w = pk16<MOE_BF16>(h[6], h[7]);
                *(u32x4*)rowp = w; }
    }
};
struct EpiRowScale {
    static constexpr bool PERM = true;
    f16* O; const float* gv;
    __device__ __forceinline__ void operator()(const Acc& acc, const Unit& u, int wr, int wc, int fr, int fq) const {
        const int row0 = u.pm * BM + wr * 64 + fr, col0 = u.pn * BM + wc * 32 + 8 * fq;
        f16* Og = O + (size_t)u.g * EROWS * DM;
#pragma unroll
        for (int ai = 0; ai < 2; ++ai)
#pragma unroll
            for (int m = 0; m < 4; ++m) { const int row = row0 + ai * HALF + m * 16; const float s = gv[((row >> 8) * NE + u.g) * CAP + (row & 255)];
                f16* rowp = Og + (size_t)row * DM + col0;
#pragma unroll
                for (int bj = 0; bj < 2; ++bj) { const f32x4 v0 = acc[ai][bj][m][0] * s, v1 = acc[ai][bj][m][1] * s;
                    u32x4 w; w.x = pkh(v0[0], v0[1]); w.y = pkh(v0[2], v0[3]); w.z = pkh(v1[0], v1[1]); w.w = pkh(v1[2], v1[3]);
                    *(u32x4*)(rowp + bj * HALF) = w; } }
    }
};

template <bool BF, class Epi>
__device__ __forceinline__ void gemm_phase(LAS unsigned char* lds, const Gemm g, const Order& S, const Epi& E) {
    const int tid = opaque_tid0(), wid = __builtin_amdgcn_readfirstlane(tid >> 6), lane = tid & 63, wr = wid >> 2, wc = wid & 3, fr = lane & 15, fq = lane >> 4;
    const int K = g.K, nt = K / BK;
    unsigned voffA[2], voffB[2];
#pragma unroll
    for (int i = 0; i < 2; ++i) { int R, C; stage_rc(tid * 16 + i * 8192, R, C); const int Rb = Epi::PERM ? ((R & ~31) + perm32(R & 31)) : R;
        voffA[i] = (unsigned)(R * K + C) * 2u; voffB[i] = (unsigned)(Rb * K + C) * 2u; }
    const size_t kstep = (size_t)(BK * 2);
    const size_t hstep = (size_t)HALF * K * 2;
    const size_t tstep = 2 * hstep;
    const unsigned ldsw = (unsigned)wid * 1024u;
    const int aoff = lds_byte(wr * 64 + fr, fq * 8), boff = lds_byte(wc * 32 + fr, fq * 8);
#define GM_SA(b, h) (((b) * 2 + (h)) * HTB)
#define GM_SB(b, h) ((4 + (b) * 2 + (h)) * HTB)
#define GM_STAGE(bufoff, gbase, voff) do { _Pragma("unroll") for (int _i = 0; _i < 2; ++_i) \
        __builtin_amdgcn_global_load_lds((const unsigned*)((const char*)(gbase) + (voff)[_i]), (LAS unsigned*)(lds + (bufoff) + ldsw + _i * 8192), 16, 0, 0); } while (0)
#define GM_LDA(dst, b, h) do { _Pragma("unroll") for (int m = 0; m < 4; ++m) _Pragma("unroll") for (int k = 0; k < 2; ++k) dst[m][k] = *(const LAS s16x8*)(lds + GM_SA(b, h) + aoff + m * 2048 + k * 1024); } while (0)
#define GM_LDB(dst, b, h) do { _Pragma("unroll") for (int n = 0; n < 2; ++n) _Pragma("unroll") for (int k = 0; k < 2; ++k) dst[n][k] = *(const LAS s16x8*)(lds + GM_SB(b, h) + boff + n * 2048 + k * 1024); } while (0)
#define GM_MMA(ai, bj, At, Bt) do { __builtin_amdgcn_s_setprio(1); _Pragma("unroll") for (int m = 0; m < 4; ++m) _Pragma("unroll") for (int n = 0; n < 2; ++n) _Pragma("unroll") for (int k = 0; k < 2; ++k) \
        acc[ai][bj][m][n] = mma16<BF>(Bt[n][k], At[m][k], acc[ai][bj][m][n]); __builtin_amdgcn_s_setprio(0); } while (0)
#define GM_WAIT_V(n) asm volatile("s_waitcnt vmcnt(" #n ")" ::: "memory")
#define GM_WAIT_L(n) asm volatile("s_waitcnt lgkmcnt(" #n ")" ::: "memory")
#define GM_BAR __builtin_amdgcn_s_barrier()
#define GM_SCHED __builtin_amdgcn_sched_barrier(0)
    Unit cur, nxt; int ui = 0;
    if (!S.next(0, cur)) return;
    Acc acc;
#pragma unroll
    for (int a = 0; a < 2; ++a)
#pragma unroll
        for (int b = 0; b < 2; ++b)
#pragma unroll
            for (int m = 0; m < 4; ++m)
#pragma unroll
                for (int n = 0; n < 2; ++n) acc[a][b][m][n] = (f32x4){0.f, 0.f, 0.f, 0.f};
    s16x8 At[4][2], B0[2][2], B1[2][2];
    const char* cA = (const char*)(g.A + (size_t)cur.g * g.sA) + (size_t)cur.pm * tstep; const char* cB = (const char*)(g.Bt + (size_t)cur.g * g.sB) + (size_t)cur.pn * tstep;
    GM_STAGE(GM_SB(0, 0), cB, voffB); GM_STAGE(GM_SB(0, 1), cB + hstep, voffB); GM_STAGE(GM_SA(0, 0), cA, voffA); GM_STAGE(GM_SA(0, 1), cA + hstep, voffA);
    if (wr == 1) GM_BAR;
    GM_WAIT_V(2); GM_BAR;
    GM_STAGE(GM_SB(1, 0), cB + kstep, voffB); GM_STAGE(GM_SA(1, 0), cA + kstep, voffA); GM_STAGE(GM_SB(1, 1), cB + hstep + kstep, voffB);
    GM_WAIT_V(6); GM_BAR;
    for (;;) {
        const bool has_next = S.next(ui + 1, nxt);
        const char* nA = has_next ? (const char*)(g.A + (size_t)nxt.g * g.sA) + (size_t)nxt.pm * tstep : cA; const char* nB = has_next ? (const char*)(g.Bt + (size_t)nxt.g * g.sB) + (size_t)nxt.pn * tstep : cB;
        for (int t = 0; t < nt; t += 2) {
            const bool last = (t == nt - 2);
            const char* a1 = cA + (size_t)(t + 1) * kstep;
            const char* a2 = last ? nA : cA + (size_t)(t + 2) * kstep; const char* b2 = last ? nB : cB + (size_t)(t + 2) * kstep;
            const char* a3 = a2 + kstep; const char* b3 = b2 + kstep;
            GM_LDB(B0, 0, 0); GM_LDB(B1, 0, 1); GM_SCHED; GM_LDA(At, 0, 0); GM_STAGE(GM_SA(1, 1), a1 + hstep, voffA);
            GM_WAIT_V(8); GM_WAIT_L(0); GM_BAR; GM_MMA(0, 0, At, B0); GM_MMA(0, 1, At, B1); GM_BAR; GM_SCHED;
            GM_LDA(At, 0, 1); GM_STAGE(GM_SB(0, 0), b2, voffB); GM_STAGE(GM_SB(0, 1), b2 + hstep, voffB); GM_STAGE(GM_SA(0, 0), a2, voffA);
            GM_WAIT_V(8); GM_WAIT_L(0); GM_BAR; GM_MMA(1, 0, At, B0); GM_MMA(1, 1, At, B1); GM_BAR; GM_SCHED;
            GM_LDB(B0, 1, 0); GM_LDB(B1, 1, 1); GM_SCHED; GM_LDA(At, 1, 0); GM_STAGE(GM_SA(0, 1), a2 + hstep, voffA);
            GM_WAIT_V(8); GM_WAIT_L(0); GM_BAR; GM_MMA(0, 0, At, B0); GM_MMA(0, 1, At, B1); GM_BAR; GM_SCHED;
            GM_LDA(At, 1, 1); GM_STAGE(GM_SB(1, 0), b3, voffB); GM_STAGE(GM_SB(1, 1), b3 + hstep, voffB); GM_STAGE(GM_SA(1, 0), a3, voffA);
            GM_WAIT_V(8); GM_WAIT_L(0); GM_BAR; GM_MMA(1, 0, At, B0); GM_MMA(1, 1, At, B1); GM_BAR; GM_SCHED;
        }
        if (wr == 0) GM_BAR;
        E(acc, cur, wr, wc, fr, fq);
        if (!has_next) break;
#pragma unroll
        for (int a = 0; a < 2; ++a)
#pragma unroll
            for (int b = 0; b < 2; ++b)
#pragma unroll
                for (int m = 0; m < 4; ++m)
#pragma unroll
                    for (int n = 0; n < 2; ++n) acc[a][b][m][n] = (f32x4){0.f, 0.f, 0.f, 0.f};
        cur = nxt; cA = nA; cB = nB; ++ui;
        if (wr == 1) GM_BAR;
    }
    GM_WAIT_V(0);
    GM_BAR;
#undef GM_SA
#undef GM_SB
#undef GM_STAGE
#undef GM_LDA
#undef GM_LDB
#undef GM_MMA
#undef GM_WAIT_V
#undef GM_WAIT_L
#undef GM_BAR
#undef GM_SCHED
}
}

struct Params { const float* in[36]; float* out; unsigned char* ws; int ph_lo, ph_hi, alt, pad; };
enum { I_X = 0, I_C, I_CTX, I_CCTX, I_L0_NORM1, I_L0_WMOD, I_L0_BMOD, I_L0_WIN, I_L0_WOUT, I_L0_RPB, I_L0_LQ1, I_L0_LK1, I_L0_LQ2, I_L0_LK2, I_L0_SUBLN,
       I_L0_NORM2, I_L0_WR, I_L0_W1, I_L0_W3, I_L0_W2, I_L1_NORM1, I_L1_WMOD, I_L1_BMOD, I_L1_WIN, I_L1_WOUT, I_L1_SCW, I_L1_CFW, I_L1_CFB, I_L1_LNG, I_L1_LNB,
       I_L1_NORM2, I_L1_WR, I_L1_W1, I_L1_W3, I_L1_W2, I_FNORM };

__device__ __forceinline__ int opaque_tid() { int t = threadIdx.x; asm volatile("" : "+v"(t)); return t; }
__device__ __forceinline__ float wave_sum(float v) {
#pragma unroll
    for (int o = 1; o < 64; o <<= 1) v += __shfl_xor(v, o);
    return v;
}

constexpr int CVT_RS = 136, CVT_SCR = 64 * CVT_RS;
template <bool BF, class RowMap>
__device__ __forceinline__ void cvt_item(const float* W, int K, int N, f16* WT, const RowMap& rm, int item, int lane, LAS unsigned char* scr) {
    const int nblk = N / 64, kb = item / nblk, nb = item % nblk, k0 = 64 * kb, n0 = 64 * nb;
    const float* src = W + (size_t)(k0 + (lane >> 4)) * N + n0 + 4 * (lane & 15);
    f32x4 v[16];
#pragma unroll
    for (int i = 0; i < 16; ++i) v[i] = *(const f32x4*)(src + (size_t)(4 * i) * N);
#pragma unroll
    for (int i = 0; i < 16; ++i) { u32x2 w; w.x = pk16<BF>(v[i][0], v[i][1]); w.y = pk16<BF>(v[i][2], v[i][3]);
        *(LAS u32x2*)(scr + (4 * i + (lane >> 4)) * CVT_RS + 8 * (lane & 15)) = w; }
    const int g = lane >> 4, i16 = lane & 15, q_ = i16 >> 2, p_ = i16 & 3;
#pragma unroll
    for (int st = 0; st < 8; ++st) {
        const int nl = 16 * (st >> 1), ch = 4 * (st & 1) + g;
        const LAS unsigned char* ap = scr + (8 * ch + q_) * CVT_RS + (nl + 4 * p_) * 2;
        const s16x4 lo = __builtin_amdgcn_ds_read_tr16_b64_v4i16((LAS s16x4*)ap);
        const s16x4 hi = __builtin_amdgcn_ds_read_tr16_b64_v4i16((LAS s16x4*)(ap + 4 * CVT_RS));
        u32x4 w; const u32x2 l2 = __builtin_bit_cast(u32x2, lo), h2 = __builtin_bit_cast(u32x2, hi); w.x = l2.x; w.y = l2.y; w.z = h2.x; w.w = h2.y;
        *(u32x4*)(WT + (size_t)rm(n0 + nl + i16) * K + k0 + 8 * ch) = w;
    }
}
struct MapPlain { __device__ __forceinline__ int operator()(int n) const { return n; } };
struct MapRope { __device__ __forceinline__ int operator()(int n) const {
    const bool rp = (n >= 512 && n < 1024) || (n >= 1536 && n < 2048); if (!rp) return n; const int i = n & 31; return (n & ~31) + (i < 16 ? 2 * i : 2 * (i - 16) + 1); } };
struct MapGLU { int add; __device__ __forceinline__ int operator()(int n) const { return (n >> 7) * 256 + (n & 127) + add; } };

__device__ __forceinline__ void cvt_moe(const float* w1, const float* w3, const float* w2, f16* W13, f16* W2T, int gw, int NGW, int lane, LAS unsigned char* scr) {
    constexpr int I13 = (DM / 64) * (DE / 64), I2 = (DE / 64) * (DM / 64);
    constexpr int NIT = NE * (2 * I13 + I2);
    for (int it = gw; it < NIT; it += NGW) {
        const int e = it / (2 * I13 + I2); int r = it % (2 * I13 + I2);
        if (r < I13) { cvt_item<MOE_BF16>(w1 + (size_t)e * DM * DE, DM, DE, W13 + (size_t)e * 2 * DE * DM, MapGLU{0}, r, lane, scr); continue; } r -= I13;
        if (r < I13) { cvt_item<MOE_BF16>(w3 + (size_t)e * DM * DE, DM, DE, W13 + (size_t)e * 2 * DE * DM, MapGLU{128}, r, lane, scr); continue; } r -= I13;
        cvt_item<MOE_BF16>(w2 + (size_t)e * DE * DM, DE, DM, W2T + (size_t)e * DM * DE, MapPlain{}, r, lane, scr);
    }
}

__device__ __forceinline__ void phase_prologue(const Params& p, LAS unsigned char* lds) {
    const int tid = opaque_tid(), lane = tid & 63, wave = __builtin_amdgcn_readfirstlane(tid >> 6);
    const int G = gridDim.x;
    unsigned char* ws = p.ws;
    LAS float* S = (LAS float*)lds;
    LAS float* red = (LAS float*)(lds + 17 * 1024 * 4);
    for (int u = blockIdx.x; u < 193; u += G) {
        if (u == 192) {
            float* rope = (float*)(ws + WS_MOD + ROPE_OFF);
            for (int idx = tid; idx < 1024; idx += 512) { const int pos = idx >> 4, i = idx & 15; const float fr = powf(10000.f, -(float)i / 16.f), ang = (float)pos * fr;
                rope[idx * 2] = cosf(ang); rope[idx * 2 + 1] = sinf(ang); }
            if (wave == 0) { const float s1 = wave_sum(p.in[I_L0_LQ1][lane] * p.in[I_L0_LK1][lane]), s2 = wave_sum(p.in[I_L0_LQ2][lane] * p.in[I_L0_LK2][lane]);
                if (lane == 0) *(float*)(ws + WS_MOD + LAM_OFF) = expf(s1) - expf(s2) + 0.2f; }
            continue;
        }
        const int l = u / 96, col0 = (u % 96) * 64;
        const float* wmod = p.in[l ? I_L1_WMOD : I_L0_WMOD]; const float* bmod = p.in[l ? I_L1_BMOD : I_L0_BMOD];
        float* mod = (float*)(ws + WS_MOD + (l ? MOD1_OFF : MOD0_OFF));
        for (int idx = tid; idx < 17 * 1024; idx += 512) { const float v = idx < 16 * 1024 ? p.in[I_C][idx] : p.in[I_CCTX][idx - 16 * 1024]; S[idx] = silu_f(v); }
        __syncthreads();
        float acc[17];
#pragma unroll
        for (int r = 0; r < 17; ++r) acc[r] = 0.f;
        const int kb = wave * 128;
        for (int kk = 0; kk < 128; kk += 4) {
            float wv[4];
#pragma unroll
            for (int i = 0; i < 4; ++i) wv[i] = wmod[(size_t)(kb + kk + i) * 6144 + col0 + lane];
#pragma unroll
            for (int r = 0; r < 17; ++r) { const f32x4 sv = *(const LAS f32x4*)(S + r * 1024 + kb + kk); acc[r] += sv[0] * wv[0] + sv[1] * wv[1] + sv[2] * wv[2] + sv[3] * wv[3]; }
        }
#pragma unroll
        for (int r = 0; r < 17; ++r) red[(wave * 17 + r) * 64 + lane] = acc[r];
        __syncthreads();
        for (int idx = tid; idx < 17 * 64; idx += 512) { const int r = idx >> 6, ln = idx & 63; float s = bmod[col0 + ln];
#pragma unroll
            for (int w = 0; w < 8; ++w) s += red[(w * 17 + r) * 64 + ln];
            if (r < 16 || l == 0) mod[(size_t)r * 6144 + col0 + ln] = s; }
        __syncthreads();
    }
    const int gw = blockIdx.x * 8 + wave, NGW = G * 8;
    LAS unsigned char* scr = lds + wave * CVT_SCR;
    constexpr int IT_IN0 = (DM / 64) * (ZP0 / 64), IT_OUT = (DM / 64) * (DM / 64), IT_IN1 = (DM / 64) * (ZP1 / 64);
    for (int it = gw; it < IT_IN0 + 2 * IT_OUT + IT_IN1; it += NGW) {
        int r = it;
        if (r < IT_IN0) { cvt_item<false>(p.in[I_L0_WIN], DM, ZP0, (f16*)(ws + WS_WIN0), MapRope{}, r, lane, scr); continue; } r -= IT_IN0;
        if (r < IT_OUT) { cvt_item<false>(p.in[I_L0_WOUT], DM, DM, (f16*)(ws + WS_WOUT0), MapPlain{}, r, lane, scr); continue; } r -= IT_OUT;
        if (r < IT_IN1) { cvt_item<false>(p.in[I_L1_WIN], DM, ZP1, (f16*)(ws + WS_WIN1), MapPlain{}, r, lane, scr); continue; } r -= IT_IN1;
        cvt_item<false>(p.in[I_L1_WOUT], DM, DM, (f16*)(ws + WS_WOUT1), MapPlain{}, r, lane, scr);
    }
    cvt_moe(p.in[I_L0_W1], p.in[I_L0_W3], p.in[I_L0_W2], (f16*)(ws + WS_W13), (f16*)(ws + WS_W2), gw, NGW, lane, scr);
}

struct NormArgs {
    const float* src;
    float* xout;
    const f16* y2; const short* inv; const float* gate2;
    const float* gain;
    const float* shift; const float* scale; int mstride;
    f16* hout;
    float* fout;
    const float* wr; float* aff;
    bool hbf;
};

template <int R>
__device__ __forceinline__ void norm_phase(const NormArgs& a, LAS unsigned char* lds, bool ctx_rows, const float* ctx_src, const float* ctx_shift, const float* ctx_scale) {
    const int tid = opaque_tid(), lane = tid & 63, wave = __builtin_amdgcn_readfirstlane(tid >> 6);
    const int G = gridDim.x;
    LAS float* wl = (LAS float*)lds;
    if (a.wr) {
        for (int idx = tid; idx < 16384; idx += 512) { const int k = idx >> 4, e = idx & 15; wl[e * 1028 + k] = a.wr[idx]; }
        __syncthreads();
    }
    const int gw = blockIdx.x * 8 + wave, NGW = G * 8;
    for (int chunk = gw; chunk < NTOK / 16; chunk += NGW) {
        const int row0 = chunk * 16, b = row0 / SEQ;
        f32x4 A[4], Sh[4], G2[4];
#pragma unroll
        for (int j = 0; j < 4; ++j) { const int c = 4 * lane + 256 * j; const f32x4 g = *(const f32x4*)(a.gain + c);
            if (a.shift) { const f32x4 sc = *(const f32x4*)(a.scale + (size_t)b * a.mstride + c); A[j] = g * (sc + 1.f); Sh[j] = *(const f32x4*)(a.shift + (size_t)b * a.mstride + c); }
            else { A[j] = g; Sh[j] = (f32x4){0.f, 0.f, 0.f, 0.f}; }
            if (a.y2) G2[j] = *(const f32x4*)(a.gate2 + (size_t)b * 6144 + c); else G2[j] = (f32x4){0.f, 0.f, 0.f, 0.f}; }
        for (int rr = 0; rr < 16; rr += R) {
            f32x4 v[R][4];
            int sl[R];
#pragma unroll
            for (int q = 0; q < R; ++q) { sl[q] = -1; if (a.y2 && lane < 16) sl[q] = a.inv[((size_t)b * NE + lane) * SEQ + ((row0 + rr + q) & (SEQ - 1))]; }
#pragma unroll
            for (int q = 0; q < R; ++q) { const int row = row0 + rr + q; const float* xr = a.src + (size_t)row * DM;
#pragma unroll
                for (int j = 0; j < 4; ++j) v[q][j] = *(const f32x4*)(xr + 4 * lane + 256 * j); }
            if (a.y2) {
                unsigned long long mask[R]; int ee[R][4]; float wgt[R][4]; f16x4 ld[R][4][4];
#pragma unroll
                for (int q = 0; q < R; ++q) { mask[q] = __ballot(sl[q] >= 0);
#pragma unroll
                    for (int i = 0; i < 4; ++i) { if (mask[q]) { ee[q][i] = __builtin_ctzll(mask[q]); mask[q] &= mask[q] - 1; wgt[q][i] = 1.f; } else { ee[q][i] = i ? ee[q][0] : 0; wgt[q][i] = 0.f; } }
#pragma unroll
                    for (int i = 0; i < 4; ++i) { int slot = __shfl(sl[q], ee[q][i]); slot = slot < 0 ? 0 : slot; const f16* yr = a.y2 + ((size_t)ee[q][i] * EROWS + b * CAP + slot) * DM + 4 * lane;
#pragma unroll
                        for (int j = 0; j < 4; ++j) ld[q][i][j] = *(const f16x4*)(yr + 256 * j); } }
#pragma unroll
                for (int q = 0; q < R; ++q) { const int row = row0 + rr + q;
                    f32x4 cs[4];
#pragma unroll
                    for (int j = 0; j < 4; ++j) cs[j] = (f32x4){0.f, 0.f, 0.f, 0.f};
#pragma unroll
                    for (int i = 0; i < 4; ++i)
#pragma unroll
                        for (int j = 0; j < 4; ++j) { cs[j][0] += wgt[q][i] * (float)ld[q][i][j][0]; cs[j][1] += wgt[q][i] * (float)ld[q][i][j][1]; cs[j][2] += wgt[q][i] * (float)ld[q][i][j][2]; cs[j][3] += wgt[q][i] * (float)ld[q][i][j][3]; }
                    while (mask[q]) {
                        const int e2 = __builtin_ctzll(mask[q]); mask[q] &= mask[q] - 1; const int slot = __shfl(sl[q], e2); const f16* yr = a.y2 + ((size_t)e2 * EROWS + b * CAP + slot) * DM + 4 * lane;
#pragma unroll
                        for (int j = 0; j < 4; ++j) { const f16x4 t = *(const f16x4*)(yr + 256 * j); cs[j][0] += (float)t[0]; cs[j][1] += (float)t[1]; cs[j][2] += (float)t[2]; cs[j][3] += (float)t[3]; }
                    }
                    float* xo = a.xout + (size_t)row * DM;
#pragma unroll
                    for (int j = 0; j < 4; ++j) { v[q][j] = v[q][j] + G2[j] * cs[j]; if (!a.fout) *(f32x4*)(xo + 4 * lane + 256 * j) = v[q][j]; }
                }
            }
            float rstd[R];
#pragma unroll
            for (int q = 0; q < R; ++q) { float ss = 0.f;
#pragma unroll
                for (int j = 0; j < 4; ++j) ss += (v[q][j][0] * v[q][j][0] + v[q][j][1] * v[q][j][1]) + (v[q][j][2] * v[q][j][2] + v[q][j][3] * v[q][j][3]);
                rstd[q] = 1.0f / sqrtf(wave_sum(ss) * (1.f / DM) + EPS); }
#pragma unroll
            for (int q = 0; q < R; ++q) { const int row = row0 + rr + q;
#pragma unroll
                for (int j = 0; j < 4; ++j) v[q][j] = (v[q][j] * rstd[q]) * A[j] + Sh[j];
                if (a.fout) {
#pragma unroll
                    for (int j = 0; j < 4; ++j) *(f32x4*)(a.fout + (size_t)row * DM + 4 * lane + 256 * j) = v[q][j];
                }
                if (a.hout) {
#pragma unroll
                    for (int j = 0; j < 4; ++j) { u32x2 w; if (a.hbf) { w.x = pkb(v[q][j][0], v[q][j][1]); w.y = pkb(v[q][j][2], v[q][j][3]); } else { w.x = pkh(v[q][j][0], v[q][j][1]); w.y = pkh(v[q][j][2], v[q][j][3]); } *(u32x2*)(a.hout + (size_t)row * DM + 4 * lane + 256 * j) = w; }
                }
            }
            if (a.wr) {
#pragma unroll 1
                for (int q = 0; q < R; ++q) {
                    float lg[16];
                    f32x4 h0 = v[0][0], h1 = v[0][1], h2 = v[0][2], h3 = v[0][3];
#pragma unroll
                    for (int qq = 1; qq < R; ++qq) if (q == qq) { h0 = v[qq][0]; h1 = v[qq][1]; h2 = v[qq][2]; h3 = v[qq][3]; }
#pragma unroll
                    for (int e = 0; e < 16; ++e) { const LAS float* wp = wl + e * 1028 + 4 * lane;
                        const f32x4 w0 = *(const LAS f32x4*)(wp), w1 = *(const LAS f32x4*)(wp + 256), w2 = *(const LAS f32x4*)(wp + 512), w3 = *(const LAS f32x4*)(wp + 768);
                        lg[e] = ((h0[0] * w0[0] + h0[1] * w0[1]) + (h0[2] * w0[2] + h0[3] * w0[3])) + ((h1[0] * w1[0] + h1[1] * w1[1]) + (h1[2] * w1[2] + h1[3] * w1[3]))
                              + ((h2[0] * w2[0] + h2[1] * w2[1]) + (h2[2] * w2[2] + h2[3] * w2[3])) + ((h3[0] * w3[0] + h3[1] * w3[1]) + (h3[2] * w3[2] + h3[3] * w3[3]));
                        asm volatile("" ::: "memory"); }
#pragma unroll
                    for (int i = 0; i < 8; ++i) { const bool hi = lane & 32; const float send = hi ? lg[i] : lg[i + 8], keep = hi ? lg[i + 8] : lg[i]; lg[i] = keep + __shfl_xor(send, 32); }
#pragma unroll
                    for (int i = 0; i < 4; ++i) { const bool hi = lane & 16; const float send = hi ? lg[i] : lg[i + 4], keep = hi ? lg[i + 4] : lg[i]; lg[i] = keep + __shfl_xor(send, 16); }
#pragma unroll
                    for (int i = 0; i < 2; ++i) { const bool hi = lane & 8; const float send = hi ? lg[i] : lg[i + 2], keep = hi ? lg[i + 2] : lg[i]; lg[i] = keep + __shfl_xor(send, 8); }
                    { const bool hi = lane & 4; const float send = hi ? lg[0] : lg[1], keep = hi ? lg[1] : lg[0]; lg[0] = keep + __shfl_xor(send, 4); }
                    float lv = lg[0]; lv += __shfl_xor(lv, 2); lv += __shfl_xor(lv, 1);
                    float mx = lv;
#pragma unroll
                    for (int o = 4; o < 64; o <<= 1) mx = fmaxf(mx, __shfl_xor(mx, o));
                    const float ex = expf(lv - mx); float sm = ex;
#pragma unroll
                    for (int o = 4; o < 64; o <<= 1) sm += __shfl_xor(sm, o);
                    const int row = row0 + rr + q, t = row & (SEQ - 1), e = (lane >> 2) & 15;
                    if ((lane & 3) == 0) a.aff[((size_t)b * NE + e) * SEQ + t] = ex / sm;
                }
            }
        }
    }
    if (ctx_rows) {
        f32x4 A[4], Sh[4];
#pragma unroll
        for (int j = 0; j < 4; ++j) { const int c = 4 * lane + 256 * j; A[j] = *(const f32x4*)(a.gain + c) * (*(const f32x4*)(ctx_scale + c) + 1.f); Sh[j] = *(const f32x4*)(ctx_shift + c); }
        for (int row = gw; row < NCTX; row += NGW) {
            f32x4 v[4]; float ss = 0.f;
#pragma unroll
            for (int j = 0; j < 4; ++j) { v[j] = *(const f32x4*)(ctx_src + (size_t)row * DM + 4 * lane + 256 * j); ss += (v[j][0] * v[j][0] + v[j][1] * v[j][1]) + (v[j][2] * v[j][2] + v[j][3] * v[j][3]); }
            const float rstd = 1.0f / sqrtf(wave_sum(ss) * (1.f / DM) + EPS);
#pragma unroll
            for (int j = 0; j < 4; ++j) { const f32x4 h = (v[j] * rstd) * A[j] + Sh[j]; u32x2 w; w.x = pkh(h[0], h[1]); w.y = pkh(h[2], h[3]); *(u32x2*)(a.hout + (size_t)(NTOK + row) * DM + 4 * lane + 256 * j) = w; }
        }
    }
    __syncthreads();
}

__device__ __forceinline__ void topk_phase(const float* aff, int* idx, float* gv, short* inv, const f16* H, f16* XIN, LAS unsigned char* lds) {
    const int tid = opaque_tid(), lane = tid & 63, wave = __builtin_amdgcn_readfirstlane(tid >> 6);
    LAS unsigned long long* key = (LAS unsigned long long*)lds;
    for (int u = blockIdx.x; u < NB * NE; u += gridDim.x) {
        const int b = u / NE, e = u % NE;
        const float* av = aff + (size_t)u * SEQ;
        for (int t = tid; t < SEQ; t += 512) key[t] = ((unsigned long long)(~__float_as_uint(av[t])) << 32) | (unsigned)t;
        __syncthreads();
        for (int k = 2; k <= SEQ; k <<= 1)
            for (int j = k >> 1; j > 0; j >>= 1) {
#pragma unroll
                for (int pp = 0; pp < 2; ++pp) { const int pr = tid + pp * 512; const int i = ((pr & ~(j - 1)) << 1) | (pr & (j - 1)), i2 = i | j;
                    const unsigned long long x = key[i], y = key[i2]; const bool up = (i & k) == 0;
                    if ((x > y) == up) { key[i] = y; key[i2] = x; } }
                __syncthreads();
            }
        for (int r = tid; r < SEQ; r += 512) { const unsigned long long kk = key[r]; const int t = (int)(unsigned)kk;
            inv[(size_t)u * SEQ + t] = (short)(r < CAP ? r : -1);
            if (r < CAP) { idx[u * CAP + r] = t; gv[u * CAP + r] = __uint_as_float(~(unsigned)(kk >> 32)); } }
        for (int r0 = wave * 32; r0 < wave * 32 + 32; r0 += 8) {
            u32x4 v0[8], v1[8];
#pragma unroll
            for (int q = 0; q < 8; ++q) { const int t = (int)(unsigned)key[r0 + q]; const u32x4* sp = (const u32x4*)(H + ((size_t)b * SEQ + t) * DM); v0[q] = sp[lane]; v1[q] = sp[lane + 64]; }
#pragma unroll
            for (int q = 0; q < 8; ++q) { u32x4* d = (u32x4*)(XIN + ((size_t)e * EROWS + b * CAP + r0 + q) * DM); d[lane] = v0[q]; d[lane + 64] = v1[q]; }
        }
        __syncthreads();
    }
}

namespace at {
constexpr int SLOT = 32768, NSLOT = 4;
constexpr int RPB_OFF = 132096;
constexpr float THR = 8.f;
typedef _Float16 v4h __attribute__((ext_vector_type(4)));
__device__ __forceinline__ int fsw(int row) { return ((row & 3) << 2) | ((row >> 2) & 3); }

__device__ __forceinline__ void glds16(const void* gsrc, unsigned lds_dst) { unsigned keep;
    asm volatile("s_mov_b32 %0, m0\n\ts_mov_b32 m0, %2\n\ts_nop 0\n\tglobal_load_lds_dwordx4 %1, off\n\ts_mov_b32 m0, %0" : "=&s"(keep) : "v"(gsrc), "s"(lds_dst) : "memory"); }
__device__ __forceinline__ void dma_tile(const f16* Z, long rowbase, int kcol, int vcol, LAS unsigned char* slot, int wave, int lane) {
    const unsigned sbase = (unsigned)__builtin_amdgcn_readfirstlane((int)(unsigned)(uintptr_t)slot);
#pragma unroll
    for (int i = 0; i < 2; ++i) { const int piece = wave + 8 * i, row = 4 * piece + (lane >> 4), c = (lane & 15) ^ fsw(row);
        const f16* gp = Z + (size_t)(rowbase + row) * ZP0 + 8 * c;
        glds16(gp + kcol, sbase + piece * 1024);
        glds16(gp + vcol, sbase + 16384 + piece * 1024); }
}
#define AT_WAIT(n) asm volatile("s_waitcnt vmcnt(" #n ") lgkmcnt(0)" ::: "memory")
__device__ __forceinline__ void wait_tile(int younger) { if (younger >= 2) AT_WAIT(8); else if (younger == 1) AT_WAIT(4); else AT_WAIT(0); }

template <int NDT> struct Addr { int k[4]; int v[NDT][2]; };
template <int NDT>
__device__ __forceinline__ Addr<NDT> make_addr(int kb0, int kchunk0, int vchunk0, int lane) {
    Addr<NDT> a; const int r32 = lane & 31, hh = lane >> 5, i = lane & 15, q_ = i >> 2, p_ = i & 3, g1 = (lane >> 4) & 1;
    const int kr = kb0 + r32, fk = fsw(kr);
#pragma unroll
    for (int st = 0; st < 4; ++st) a.k[st] = kr * 256 + 16 * ((kchunk0 + 2 * st + hh) ^ fk);
    const int vr = kb0 + 4 * hh + q_, f0 = fsw(vr), f1 = fsw(vr + 8);
#pragma unroll
    for (int dt = 0; dt < NDT; ++dt) { const int c = vchunk0 + 4 * dt + 2 * g1 + (p_ >> 1);
        a.v[dt][0] = 16384 + vr * 256 + 16 * (c ^ f0) + 8 * (p_ & 1); a.v[dt][1] = 16384 + (vr + 8) * 256 + 16 * (c ^ f1) + 8 * (p_ & 1); }
    return a;
}
#define AT_SCHED() __builtin_amdgcn_sched_barrier(0)
template <int NDT>
__device__ __forceinline__ void load_k(LAS unsigned char* slot, const Addr<NDT>& a, int off, f16x8* kf) {
#pragma unroll
    for (int st = 0; st < 4; ++st) kf[st] = *(const LAS f16x8*)(slot + a.k[st] + off);
}
template <int NDT>
__device__ __forceinline__ void load_v(LAS unsigned char* slot, const Addr<NDT>& a, int off, f16x8* vf) {
#pragma unroll
    for (int s2 = 0; s2 < 2; ++s2)
#pragma unroll
        for (int dt = 0; dt < NDT; ++dt) {
            const v4h lo = __builtin_bit_cast(v4h, __builtin_amdgcn_ds_read_tr16_b64_v4i16((LAS s16x4*)(slot + a.v[dt][0] + off + s2 * 4096)));
            const v4h hi = __builtin_bit_cast(v4h, __builtin_amdgcn_ds_read_tr16_b64_v4i16((LAS s16x4*)(slot + a.v[dt][1] + off + s2 * 4096)));
            vf[s2 * NDT + dt] = (f16x8){lo[0], lo[1], lo[2], lo[3], hi[0], hi[1], hi[2], hi[3]};
        }
}
__device__ __forceinline__ f32x16 qk32(const f16x8* kf, const f16x8 (&qf)[4]) {
    f32x16 s;
#pragma unroll
    for (int r = 0; r < 16; ++r) s[r] = 0.f;
#pragma unroll
    for (int st = 0; st < 4; ++st) s = __builtin_amdgcn_mfma_f32_32x32x16_f16(kf[st], qf[st], s, 0, 0, 0);
    return s;
}
template <int NDT>
__device__ __forceinline__ void pv32(const f16x8* vf, const f32x16& p, f32x16 (&o)[NDT]) {
#pragma unroll
    for (int s2 = 0; s2 < 2; ++s2) {
        f16x8 pb;
#pragma unroll
        for (int j = 0; j < 8; ++j) pb[j] = (f16)p[8 * s2 + j];
#pragma unroll
        for (int dt = 0; dt < NDT; ++dt) o[dt] = __builtin_amdgcn_mfma_f32_32x32x16_f16(vf[s2 * NDT + dt], pb, o[dt], 0, 0, 0);
    }
}
__device__ __forceinline__ float rowmax16(const f32x16& s) { float a = fmaxf(fmaxf(s[0], s[1]), fmaxf(s[2], s[3]));
#pragma unroll
    for (int r = 4; r < 16; r += 4) a = fmaxf(a, fmaxf(fmaxf(s[r], s[r + 1]), fmaxf(s[r + 2], s[r + 3])));
    return a; }
template <int NDT>
__device__ __forceinline__ void rescale(float mx, float& m, float& l, f32x16 (&o)[NDT]) {
    if (!__all(mx - m <= THR)) { const float mn = fmaxf(m, mx), alpha = __builtin_amdgcn_exp2f(m - mn); m = mn; l *= alpha;
#pragma unroll
        for (int dt = 0; dt < NDT; ++dt)
#pragma unroll
            for (int r = 0; r < 16; ++r) o[dt][r] *= alpha; }
}
__device__ __forceinline__ float expsum(f32x16& s, float m) { float ps = 0.f;
#pragma unroll
    for (int r = 0; r < 16; ++r) { s[r] = __builtin_amdgcn_exp2f(s[r] - m); ps += s[r]; }
    return ps; }
template <int NDT>
__device__ __forceinline__ void step64(LAS unsigned char* slot, const Addr<NDT>& a, const f16x8 (&qf)[4], f32x16 (&o)[NDT], float& m, float& l) {
    f16x8 kf[8], va[2 * NDT], vb[2 * NDT];
    load_k<NDT>(slot, a, 0, kf); load_k<NDT>(slot, a, 8192, kf + 4);
    load_v<NDT>(slot, a, 0, va);
    AT_SCHED();
    f32x16 s0 = qk32(kf, qf), s1 = qk32(kf + 4, qf);
    AT_SCHED();
    load_v<NDT>(slot, a, 8192, vb);
    float mx = fmaxf(rowmax16(s0), rowmax16(s1)); mx = fmaxf(mx, __shfl_xor(mx, 32));
    rescale<NDT>(mx, m, l, o);
    l += expsum(s0, m) + expsum(s1, m);
    AT_SCHED();
    pv32<NDT>(va, s0, o); pv32<NDT>(vb, s1, o);
    AT_SCHED();
}

__device__ __forceinline__ void diff_unit(int u, const f16* Z, f16* Y, const float* subln, float lam, LAS unsigned char* lds) {
    const int tid = opaque_tid(), lane = tid & 63, wave = __builtin_amdgcn_readfirstlane(tid >> 6);
    const int qb = u & 15, h = (u >> 4) & 3, b = u >> 6;
    const int map = wave >> 2, r32 = lane & 31, hh = lane >> 5;
    const long tokbase = (long)b * SEQ;
    const long qrow = tokbase + qb * 128 + (wave & 3) * 32 + r32;
    const int kcol = 1536 + 128 * h, vcol = 2560 + 128 * h;
    constexpr int NT = 36;
#define DIFF_ROWBASE(t) ((t) < 32 ? tokbase + 64 * (t) : (long)NTOK + b * CTXL + 64 * ((t) - 32))
#pragma unroll
    for (int t = 0; t < 3; ++t) dma_tile(Z, DIFF_ROWBASE(t), kcol, vcol, lds + t * SLOT, wave, lane);
    f16x8 qf[4];
#pragma unroll
    for (int st = 0; st < 4; ++st) qf[st] = *(const f16x8*)(Z + (size_t)qrow * ZP0 + 512 + 128 * h + 64 * map + 16 * st + 8 * hh);
    asm volatile("" : "+v"(qf[0]), "+v"(qf[1]), "+v"(qf[2]), "+v"(qf[3]));
    const Addr<4> ad = make_addr<4>(0, 8 * map, 0, lane);
    f32x16 o[4];
#pragma unroll
    for (int dt = 0; dt < 4; ++dt)
#pragma unroll
        for (int r = 0; r < 16; ++r) o[dt][r] = 0.f;
    float m = -1e30f, l = 0.f;
    for (int t = 0; t < NT; ++t) {
        wait_tile(NT - 1 - t);
        __builtin_amdgcn_s_barrier();
        if (t + 3 < NT) dma_tile(Z, DIFF_ROWBASE(t + 3), kcol, vcol, lds + ((t + 3) & 3) * SLOT, wave, lane);
        step64<4>(lds + (t & 3) * SLOT, ad, qf, o, m, l);
    }
#undef DIFF_ROWBASE
    __syncthreads();
    const float linv = 1.f / (l + __shfl_xor(l, 32));
    LAS float* cb = (LAS float*)lds + (wave & 3) * 4096;
    if (map == 1) {
#pragma unroll
        for (int dt = 0; dt < 4; ++dt)
#pragma unroll
            for (int r = 0; r < 16; ++r) cb[(dt * 16 + r) * 64 + lane] = o[dt][r] * linv;
    }
    __syncthreads();
    if (map == 0) {
        float ss = 0.f;
#pragma unroll
        for (int dt = 0; dt < 4; ++dt)
#pragma unroll
            for (int r = 0; r < 16; ++r) { const float d = o[dt][r] * linv - lam * cb[(dt * 16 + r) * 64 + lane]; o[dt][r] = d; ss += d * d; }
        ss += __shfl_xor(ss, 32);
        const float rstd = 0.8f / sqrtf(ss * (1.f / 128.f) + EPS);
        f16* yr = Y + (size_t)qrow * DM + 512 + 128 * h;
#pragma unroll
        for (int dt = 0; dt < 4; ++dt)
#pragma unroll
            for (int rg = 0; rg < 4; ++rg) { const int d0 = 32 * dt + 8 * rg + 4 * hh; const f32x4 sg = *(const f32x4*)(subln + d0);
                u32x2 w; w.x = pkh(o[dt][4 * rg] * rstd * sg[0], o[dt][4 * rg + 1] * rstd * sg[1]); w.y = pkh(o[dt][4 * rg + 2] * rstd * sg[2], o[dt][4 * rg + 3] * rstd * sg[3]);
                *(u32x2*)(yr + d0) = w; }
    }
    __syncthreads();
}

__device__ __forceinline__ void na_unit(int u, const f16* Z, f16* Y, const float* rpb, LAS unsigned char* lds) {
    const int tid = opaque_tid(), lane = tid & 63, wave = __builtin_amdgcn_readfirstlane(tid >> 6);
    const int rp = u & 15, hp = (u >> 4) & 3, b = u >> 6;
    const int hs = wave >> 2, a = wave & 3, head = 2 * hp + hs, r32 = lane & 31, hh = lane >> 5;
    const int r0 = 2 * rp, qr = r0 + (r32 >> 4), qc = 16 * a + (r32 & 15);
    const int rsq = min(max(qr - 4, 0), 24), csq = min(max(qc - 8, 0), 48);
    const int lo = min(max(r0 - 4, 0), 24), hi = min(max(r0 + 1 - 4, 0), 24) + 8;
    const int seg = (a == 0) ? 0 : (a == 1) ? 8 : (a == 2) ? 24 : 32;
    const long tokbase = (long)b * SEQ;
    const long qrow = tokbase + qr * 64 + qc;
    const int kcol = 1024 + 128 * hp, vcol = 2048 + 128 * hp;
    const int nwin = hi - lo, NT = nwin + 4;
#define NA_ROWBASE(t) ((t) < nwin ? tokbase + (lo + (t)) * 64 : (long)NTOK + b * CTXL + 64 * ((t) - nwin))
    LAS float* tab = (LAS float*)(lds + RPB_OFF);
    for (int i = tid; i < 2 * 465; i += 512) tab[i] = rpb[(2 * hp) * 465 + i] * LOG2E;
#pragma unroll
    for (int t = 0; t < 3; ++t) dma_tile(Z, NA_ROWBASE(t), kcol, vcol, lds + t * SLOT, wave, lane);
    f16x8 qf[4];
#pragma unroll
    for (int st = 0; st < 4; ++st) qf[st] = *(const f16x8*)(Z + (size_t)qrow * ZP0 + 64 * head + 16 * st + 8 * hh);
    asm volatile("" : "+v"(qf[0]), "+v"(qf[1]), "+v"(qf[2]), "+v"(qf[3]));
    const Addr<2> aw = make_addr<2>(seg, 8 * hs, 8 * hs, lane), ac = make_addr<2>(0, 8 * hs, 8 * hs, lane);
    f32x16 o[2];
#pragma unroll
    for (int dt = 0; dt < 2; ++dt)
#pragma unroll
        for (int r = 0; r < 16; ++r) o[dt][r] = 0.f;
    float m = -1e30f, l = 0.f;
    for (int t = 0; t < NT; ++t) {
        wait_tile(NT - 1 - t);
        __builtin_amdgcn_s_barrier();
        if (t + 3 < NT) dma_tile(Z, NA_ROWBASE(t + 3), kcol, vcol, lds + ((t + 3) & 3) * SLOT, wave, lane);
        LAS unsigned char* slot = lds + (t & 3) * SLOT;
        if (t < nwin) {
            const int krow = lo + t;
            f16x8 kf[4], va[4];
            load_k<2>(slot, aw, 0, kf); load_v<2>(slot, aw, 0, va);
            AT_SCHED();
            f32x16 s = qk32(kf, qf);
            const bool rowok = (krow >= rsq) && (krow < rsq + 8);
            const int rbase = (krow - qr + 7) * 31 + 15 - qc;
#pragma unroll
            for (int r = 0; r < 16; ++r) { const int kc = seg + (r & 3) + 8 * (r >> 2) + 4 * hh; const bool ok = rowok && (kc >= csq) && (kc < csq + 16);
                const int bi = min(max(rbase + kc, 0), 464); const float bias = tab[hs * 465 + bi];
                s[r] = ok ? s[r] + bias : -INFINITY; }
            float mx = rowmax16(s); mx = fmaxf(mx, __shfl_xor(mx, 32));
            rescale<2>(mx, m, l, o);
            l += expsum(s, m);
            pv32<2>(va, s, o);
        } else {
            step64<2>(slot, ac, qf, o, m, l);
        }
    }
#undef NA_ROWBASE
    const float linv = 1.f / (l + __shfl_xor(l, 32));
    f16* yr = Y + (size_t)qrow * DM + 64 * head;
#pragma unroll
    for (int dt = 0; dt < 2; ++dt)
#pragma unroll
        for (int rg = 0; rg < 4; ++rg) { const int d0 = 32 * dt + 8 * rg + 4 * hh;
            u32x2 w; w.x = pkh(o[dt][4 * rg] * linv, o[dt][4 * rg + 1] * linv); w.y = pkh(o[dt][4 * rg + 2] * linv, o[dt][4 * rg + 3] * linv);
            *(u32x2*)(yr + d0) = w; }
    __syncthreads();
}

__device__ __forceinline__ void attn_phase(const f16* Z, f16* Y, const float* rpb, const float* subln, const float* lamp, LAS unsigned char* lds, int rep = 0) {
    const float lam = *lamp;
    const int ulo = (rep == 3) ? 1024 : 0, uhi = (rep == 2) ? 1024 : 2048;
    for (int u = ulo + blockIdx.x; u < uhi; u += gridDim.x) {
        if (u < 1024) diff_unit(u, Z, Y, subln, lam, lds);
        else na_unit(u - 1024, Z, Y, rpb, lds);
    }
}
}

__device__ __forceinline__ void conv_phase(const f16* Z1, f16* Y, const float* scw, const float* cfw, const float* cfb, const float* lng, const float* lnb, LAS unsigned char* lds) {
    const int tid = opaque_tid(), lane = tid & 63, wave = __builtin_amdgcn_readfirstlane(tid >> 6);
    LAS float* U = (LAS float*)lds;
    float cw[31];
#pragma unroll
    for (int k = 0; k < 31; ++k) cw[k] = cfw[k * 512 + tid];
    const float cb = cfb[tid];
    for (int u = blockIdx.x; u < NTOK / 32; u += gridDim.x) {
        const int b = u >> 6, t0 = (u & 63) * 32;
        const f16* zb = Z1 + (size_t)b * SEQ * ZP1;
        {
            f16x4 av[16], gv[16];
#pragma unroll
            for (int pass = 0; pass < 16; ++pass) { const int row = pass * 4 + (tid >> 7), c4 = (tid & 127) * 4, tt = t0 - 15 + row; const bool ok = row < 62 && tt >= 0 && tt < SEQ;
                const int tc = ok ? tt : (t0 < SEQ ? t0 : 0);
                av[pass] = *(const f16x4*)(zb + (size_t)tc * ZP1 + 1536 + c4); gv[pass] = *(const f16x4*)(zb + (size_t)tc * ZP1 + 2048 + c4); }
#pragma unroll
            for (int pass = 0; pass < 16; ++pass) { const int row = pass * 4 + (tid >> 7), c4 = (tid & 127) * 4, tt = t0 - 15 + row; const bool ok = tt >= 0 && tt < SEQ;
                if (row < 62) { f32x4 uv;
#pragma unroll
                    for (int j = 0; j < 4; ++j) uv[j] = ok ? (float)av[pass][j] * __builtin_amdgcn_rcpf(1.f + __builtin_amdgcn_exp2f(-LOG2E * (float)gv[pass][j])) : 0.f;
                    *(LAS f32x4*)(U + row * 512 + c4) = uv; } }
        }
        __syncthreads();
        float uu[62];
#pragma unroll
        for (int i = 0; i < 62; ++i) uu[i] = U[i * 512 + tid];
        __syncthreads();
#pragma unroll
        for (int tt = 0; tt < 32; ++tt) { float v = cb;
#pragma unroll
            for (int k = 0; k < 31; ++k) v += cw[k] * uu[tt + k];
            U[tt * 512 + tid] = v; }
        __syncthreads();
#pragma unroll
        for (int q = 0; q < 4; ++q) { const int tt = wave * 4 + q, t = t0 + tt, c8 = lane * 8;
            const f32x4 x0 = *(const LAS f32x4*)(U + tt * 512 + c8), x1 = *(const LAS f32x4*)(U + tt * 512 + c8 + 4);
            float x[8] = {x0[0], x0[1], x0[2], x0[3], x1[0], x1[1], x1[2], x1[3]};
            float s = 0.f;
#pragma unroll
            for (int j = 0; j < 8; ++j) s += x[j];
            const float mean = wave_sum(s) * (1.f / 512.f); float s2 = 0.f;
#pragma unroll
            for (int j = 0; j < 8; ++j) { x[j] -= mean; s2 += x[j] * x[j]; }
            const float rstd = 1.0f / sqrtf(wave_sum(s2) * (1.f / 512.f) + EPS);
            const f32x4 g0 = *(const f32x4*)(lng + c8), g1 = *(const f32x4*)(lng + c8 + 4), b0 = *(const f32x4*)(lnb + c8), b1 = *(const f32x4*)(lnb + c8 + 4);
            const float gg[8] = {g0[0], g0[1], g0[2], g0[3], g1[0], g1[1], g1[2], g1[3]}, bb[8] = {b0[0], b0[1], b0[2], b0[3], b1[0], b1[1], b1[2], b1[3]};
            float yd[8];
#pragma unroll
            for (int j = 0; j < 8; ++j) yd[j] = silu_f(x[j] * rstd * gg[j] + bb[j]);
            f16* yr = Y + ((size_t)b * SEQ + t) * DM;
            { u32x4 w; w.x = pkh(yd[0], yd[1]); w.y = pkh(yd[2], yd[3]); w.z = pkh(yd[4], yd[5]); w.w = pkh(yd[6], yd[7]); *(u32x4*)(yr + 512 + c8) = w; }
            float cacc[8];
#pragma unroll
            for (int j = 0; j < 8; ++j) cacc[j] = 0.f;
#pragma unroll
            for (int k = 0; k < 3; ++k) { const int ts = t + k - 1;
                if (ts >= 0 && ts < SEQ) { const f16x8 xc = *(const f16x8*)(zb + (size_t)ts * ZP1 + c8), gc = *(const f16x8*)(zb + (size_t)ts * ZP1 + 1024 + c8);
                    const f32x4 w0 = *(const f32x4*)(scw + k * 512 + c8), w1 = *(const f32x4*)(scw + k * 512 + c8 + 4);
                    const float ww[8] = {w0[0], w0[1], w0[2], w0[3], w1[0], w1[1], w1[2], w1[3]};
#pragma unroll
                    for (int j = 0; j < 8; ++j) cacc[j] += ww[j] * ((float)gc[j] * (float)xc[j]); } }
            const f16x8 gb = *(const f16x8*)(zb + (size_t)t * ZP1 + 512 + c8);
            { u32x4 w; w.x = pkh((float)gb[0] * cacc[0], (float)gb[1] * cacc[1]); w.y = pkh((float)gb[2] * cacc[2], (float)gb[3] * cacc[3]);
              w.z = pkh((float)gb[4] * cacc[4], (float)gb[5] * cacc[5]); w.w = pkh((float)gb[6] * cacc[6], (float)gb[7] * cacc[7]); *(u32x4*)(yr + c8) = w; }
        }
        __syncthreads();
    }
}

constexpr int NPHASE = 18;
__global__ void __launch_bounds__(512, 2) fwd(Params p) {
    extern __shared__ __attribute__((aligned(16))) unsigned char lds_raw[];
    LAS unsigned char* lds = (LAS unsigned char*)lds_raw;
    const int tid = threadIdx.x;
    unsigned char* ws = p.ws;
    for (int u = tid; u < (LDS_BYTES - LDSCTL_OFF) / 4; u += 512) ((LAS unsigned*)(lds + LDSCTL_OFF))[u] = 0u;
    __syncthreads();
    XcdBarrier bar; bar.bar = (unsigned*)(ws + WS_CTL) + 4096; bar.x = 0; bar.st = nullptr;
    if (N_LAUNCH_MODE == 1) bar = xcd_barrier_post((unsigned*)(ws + WS_CTL) + 4096, (volatile LAS unsigned*)(lds + MISC_OFF) + 8);
    const int lo = p.ph_lo, hi = p.ph_hi, rep = p.alt;
#ifndef ONLYP
#define ONLYP -1
#endif
#define IN(k) ((ONLYP < 0 || ONLYP == (k)) && lo <= (k) && (k) < hi)
#define SEAM(k) do { if (IN(k) && IN((k) + 1)) xcd_barrier(bar); } while (0)
    const int G = gridDim.x, c = blockIdx.x;
    float* mod0 = (float*)(ws + WS_MOD + MOD0_OFF); float* mod1 = (float*)(ws + WS_MOD + MOD1_OFF);
    f16* H = (f16*)(ws + WS_H); f16* Z = (f16*)(ws + WS_Z); f16* Y = (f16*)(ws + WS_Y); f16* XIN = (f16*)(ws + WS_XIN); f16* HID = (f16*)(ws + WS_HID); f16* Y2 = (f16*)(ws + WS_Y2);
    f16* W13 = (f16*)(ws + WS_W13); f16* W2T = (f16*)(ws + WS_W2);
    float* AFF = (float*)(ws + WS_AFF); int* IDX = (int*)(ws + WS_IDX); float* GV = (float*)(ws + WS_G); short* INV = (short*)(ws + WS_INV);

    if (IN(0)) { phase_prologue(p, lds); } SEAM(0);
    if (IN(1)) { NormArgs a{}; a.src = p.in[I_X]; a.gain = p.in[I_L0_NORM1]; a.shift = mod0; a.scale = mod0 + 1024; a.mstride = 6144; a.hout = H;
        norm_phase<4>(a, lds, true, p.in[I_CTX], mod0 + 16 * 6144, mod0 + 16 * 6144 + 1024); } SEAM(1);
    if (IN(2)) { gm::Gemm g{H, (const f16*)(ws + WS_WIN0), DM, 0, 0}; gm::Order S; S.init(NROWS, ZP0, 1, G, c);
        gm::EpiInProj0 E{Z, (const float*)(ws + WS_MOD + ROPE_OFF)}; gm::gemm_phase<false>(lds, g, S, E); } SEAM(2);
    if (IN(3)) { at::attn_phase(Z, Y, p.in[I_L0_RPB], p.in[I_L0_SUBLN], (const float*)(ws + WS_MOD + LAM_OFF), lds, rep); } SEAM(3);
    if (IN(4)) { gm::Gemm g{Y, (const f16*)(ws + WS_WOUT0), DM, 0, 0}; gm::Order S; S.init(NTOK, DM, 1, G, c);
        gm::EpiResGate E{p.in[I_X], p.out, mod0 + 2048, 6144}; gm::gemm_phase<false>(lds, g, S, E); } SEAM(4);
    if (IN(5)) { NormArgs a{}; a.src = p.out; a.gain = p.in[I_L0_NORM2]; a.shift = mod0 + 3072; a.scale = mod0 + 4096; a.mstride = 6144; a.hout = H; a.wr = p.in[I_L0_WR]; a.aff = AFF; a.hbf = MOE_BF16;
        norm_phase<4>(a, lds, false, nullptr, nullptr, nullptr); } SEAM(5);
    if (IN(6)) { topk_phase(AFF, IDX, GV, INV, H, XIN, lds); } SEAM(6);
    if (IN(7)) { gm::Gemm g{XIN, W13, DM, (long)EROWS * DM, (long)2 * DE * DM}; gm::Order S; S.init(EROWS, 2 * DE, NE, G, c);
        gm::EpiSwiGLU E{HID}; gm::gemm_phase<MOE_BF16>(lds, g, S, E); } SEAM(7);
    if (IN(8)) { gm::Gemm g{HID, W2T, DE, (long)EROWS * DE, (long)DM * DE}; gm::Order S; S.init(EROWS, DM, NE, G, c, 1);
        gm::EpiRowScale E{Y2, GV}; gm::gemm_phase<MOE_BF16>(lds, g, S, E); } SEAM(8);
    if (IN(9)) { NormArgs a{}; a.src = p.out; a.xout = rep ? (float*)(ws + WS_BIG) : p.out; a.y2 = Y2; a.inv = INV; a.gate2 = mod0 + 5120; a.gain = p.in[I_L1_NORM1]; a.shift = mod1; a.scale = mod1 + 1024; a.mstride = 6144; a.hout = rep ? (f16*)(ws + WS_BIG + 128 * MiB) : H;
        norm_phase<2>(a, lds, false, nullptr, nullptr, nullptr);
        cvt_moe(p.in[I_L1_W1], p.in[I_L1_W3], p.in[I_L1_W2], W13, W2T, c * 8 + (tid >> 6), G * 8, tid & 63, lds + (tid >> 6) * CVT_SCR); } SEAM(9);
    if (IN(10)) { gm::Gemm g{H, (const f16*)(ws + WS_WIN1), DM, 0, 0}; gm::Order S; S.init(NTOK, ZP1, 1, G, c);
        gm::EpiF16 E{Z, ZP1}; gm::gemm_phase<false>(lds, g, S, E); } SEAM(10);
    if (IN(11)) { conv_phase(Z, Y, p.in[I_L1_SCW], p.in[I_L1_CFW], p.in[I_L1_CFB], p.in[I_L1_LNG], p.in[I_L1_LNB], lds); } SEAM(11);
    if (IN(12)) { gm::Gemm g{Y, (const f16*)(ws + WS_WOUT1), DM, 0, 0}; gm::Order S; S.init(NTOK, DM, 1, G, c);
        gm::EpiResGate E{p.out, rep ? (float*)(ws + WS_XIN) : p.out, mod1 + 2048, 6144}; gm::gemm_phase<false>(lds, g, S, E); } SEAM(12);
    if (IN(13)) { NormArgs a{}; a.src = p.out; a.gain = p.in[I_L1_NORM2]; a.shift = mod1 + 3072; a.scale = mod1 + 4096; a.mstride = 6144; a.hout = H; a.wr = p.in[I_L1_WR]; a.aff = AFF; a.hbf = MOE_BF16;
        norm_phase<4>(a, lds, false, nullptr, nullptr, nullptr); } SEAM(13);
    if (IN(14)) { topk_phase(AFF, IDX, GV, INV, H, XIN, lds); } SEAM(14);
    if (IN(15)) { gm::Gemm g{XIN, W13, DM, (long)EROWS * DM, (long)2 * DE * DM}; gm::Order S; S.init(EROWS, 2 * DE, NE, G, c);
        gm::EpiSwiGLU E{HID}; gm::gemm_phase<MOE_BF16>(lds, g, S, E); } SEAM(15);
    if (IN(16)) { gm::Gemm g{HID, W2T, DE, (long)EROWS * DE, (long)DM * DE}; gm::Order S; S.init(EROWS, DM, NE, G, c, 1);
        gm::EpiRowScale E{Y2, GV}; gm::gemm_phase<MOE_BF16>(lds, g, S, E); } SEAM(16);
    if (IN(17)) { NormArgs a{}; a.src = p.out; a.xout = p.out; a.y2 = Y2; a.inv = INV; a.gate2 = mod1 + 5120; a.gain = p.in[I_FNORM]; a.fout = rep ? (float*)(ws + WS_BIG) : p.out;
        norm_phase<2>(a, lds, false, nullptr, nullptr, nullptr); }
#undef IN
#undef SEAM
}

extern "C" void kernel_launch(void* const* d_in, const int* in_sizes, int n_in, void* d_out, int out_size, void* d_ws, size_t ws_size, hipStream_t stream) {
    static int grid = 0;
    if (grid == 0) {
        if (n_in != 36 || out_size != NTOK * DM || ws_size < WS_END) { fprintf(stderr, "kernel_launch: unexpected shapes (n_in %d out %d ws %zu need %zu)\n", n_in, out_size, ws_size, (size_t)WS_END); grid = -1; return; }
        int dev = 0, cus = 0;
        if (hipGetDevice(&dev) != hipSuccess || hipDeviceGetAttribute(&cus, hipDeviceAttributeMultiprocessorCount, dev) != hipSuccess) { grid = -1; return; }
        if (hipFuncSetAttribute((const void*)fwd, hipFuncAttributeMaxDynamicSharedMemorySize, LDS_BYTES) != hipSuccess) { fprintf(stderr, "kernel_launch: hipFuncSetAttribute failed\n"); grid = -1; return; }
        int per_cu = 0;
        if (hipOccupancyMaxActiveBlocksPerMultiprocessor(&per_cu, (const void*)fwd, 512, LDS_BYTES) != hipSuccess || per_cu < 1) fprintf(stderr, "kernel_launch: occupancy query says %d\n", per_cu);
        (void)hipGetLastError();
        grid = cus;
    }
    if (grid < 0) return;
    (void)hipMemsetAsync((char*)d_ws + WS_CTL, 0, CTL_ZERO_BYTES, stream);
    Params p{};
    for (int i = 0; i < 36; ++i) p.in[i] = (const float*)d_in[i];
    p.out = (float*)d_out; p.ws = (unsigned char*)d_ws;
#if N_LAUNCH_MODE == 1
    p.ph_lo = 0; p.ph_hi = NPHASE;
    hipLaunchKernelGGL(fwd, dim3(grid), dim3(512), LDS_BYTES, stream, p);
#else
    for (int k = 0; k < NPHASE; ++k) { p.ph_lo = k; p.ph_hi = k + 1; p.alt = 0; hipLaunchKernelGGL(fwd, dim3(grid), dim3(512), LDS_BYTES, stream, p);
        for (int r = 0; r < HOSTDUP_N; ++r) if ((HOSTDUP >> k) & 1) { p.alt = HOSTDUP_ALT; hipLaunchKernelGGL(fwd, dim3(grid), dim3(512), LDS_BYTES, stream, p); } }
#endif
}
```

```cpp
#include <hip/hip_runtime.h>
#include <cstdio>
#include <cstdint>

#define LAS __attribute__((address_space(3)))
#define GAS __attribute__((address_space(1)))
typedef _Float16 f16;
typedef _Float16 f16x8 __attribute__((ext_vector_type(8)));
typedef _Float16 f16x4 __attribute__((ext_vector_type(4)));
typedef _Float16 f16x2 __attribute__((ext_vector_type(2)));
typedef float f32x2 __attribute__((ext_vector_type(2)));
typedef float f32x4 __attribute__((ext_vector_type(4)));
typedef float f32x16 __attribute__((ext_vector_type(16)));
typedef unsigned u32x2 __attribute__((ext_vector_type(2)));
typedef unsigned u32x4 __attribute__((ext_vector_type(4)));
typedef short s16x4 __attribute__((ext_vector_type(4)));

#ifndef MOE_BF16
#define MOE_BF16 true
#endif
#ifndef HOSTDUP
#define HOSTDUP 0
#endif
#ifndef HOSTDUP_ALT
#define HOSTDUP_ALT 1
#endif
#ifndef HOSTDUP_N
#define HOSTDUP_N 1
#endif
#ifndef N_LAUNCH_MODE
#define N_LAUNCH_MODE 1
#endif

constexpr int NB = 16, SEQ = 2048, DM = 1024, NTOK = NB * SEQ, CTXL = 256, NCTX = NB * CTXL, NROWS = NTOK + NCTX;
constexpr int ZP0 = 3072, ZP1 = 2560;
constexpr int NE = 16, DE = 2816, CAP = 256, EROWS = NB * CAP;
constexpr float EPS = 1e-6f;
constexpr float LOG2E = 1.4426950408889634f;
constexpr float QSCALE = 0.125f * LOG2E;

constexpr size_t MiB = 1u << 20;
constexpr size_t WS_CTL = 0, CTL_ZERO_BYTES = 256 * 1024;
constexpr size_t WS_MOD = 1 * MiB;
constexpr size_t MOD0_OFF = 0, MOD1_OFF = 17 * 6144 * 4, ROPE_OFF = MOD1_OFF + 16 * 6144 * 4, LAM_OFF = ROPE_OFF + 64 * 16 * 2 * 4;
constexpr size_t WS_WIN0 = 2 * MiB, WS_WOUT0 = 8 * MiB, WS_WIN1 = 10 * MiB, WS_WOUT1 = 15 * MiB;
constexpr size_t WS_AFF = 17 * MiB;
constexpr size_t WS_IDX = 19 * MiB;
constexpr size_t WS_G = 19 * MiB + 512 * 1024;
constexpr size_t WS_INV = 20 * MiB;
constexpr size_t WS_W13 = 22 * MiB;
constexpr size_t WS_W2 = WS_W13 + 176 * MiB;
constexpr size_t WS_H = WS_W2 + 88 * MiB;
constexpr size_t WS_XIN = WS_H + 72 * MiB;
constexpr size_t WS_Y2 = WS_XIN + 128 * MiB;
constexpr size_t WS_BIG = WS_Y2 + 128 * MiB;
constexpr size_t WS_Z = WS_BIG, WS_Y = WS_BIG + 216 * MiB, WS_HID = WS_BIG;
constexpr size_t WS_END = WS_BIG + 352 * MiB;

constexpr int RING_BYTES = 131072;
constexpr int LDSCTL_OFF = RING_BYTES, MISC_OFF = LDSCTL_OFF + 320;
constexpr int LDS_BYTES = 147456;

#define RLX_AGENT __ATOMIC_RELAXED, __HIP_MEMORY_SCOPE_AGENT
#define LDS_WAIT() asm volatile("s_waitcnt lgkmcnt(0)" ::: "memory")
#define VM_WAIT() asm volatile("s_waitcnt vmcnt(0)" ::: "memory")

__device__ __forceinline__ unsigned pkh(float lo, float hi) { f16x2 v; v.x = (f16)lo; v.y = (f16)hi; return __builtin_bit_cast(unsigned, v); }
typedef __bf16 bf16x2_t __attribute__((ext_vector_type(2)));
typedef short s16x8 __attribute__((ext_vector_type(8)));
__device__ __forceinline__ unsigned pkb(float lo, float hi) { f32x2 v = {lo, hi}; bf16x2_t b = __builtin_convertvector(v, bf16x2_t); return __builtin_bit_cast(unsigned, b); }
template <bool BF> __device__ __forceinline__ unsigned pk16(float lo, float hi) { return BF ? pkb(lo, hi) : pkh(lo, hi); }
__device__ __forceinline__ float silu_f(float v) { return v / (1.f + __expf(-v)); }

#define XB_TMO      128
#define XB_XCNT(j)  (256  + 64 * (j))
#define XB_XSUB(j)  (1280 + 64 * (j))
#define XB_XGEN(j)  (2304 + 64 * (j))
#define XB_TOP      3328
#define XB_TOPGEN   3392
#define XCD_BAR_WORDS 3456
#define XB_SPIN_CAP (1u << 18)
__device__ __forceinline__ unsigned xb_ld(unsigned* p)              { return __hip_atomic_load(p, __ATOMIC_RELAXED, __HIP_MEMORY_SCOPE_AGENT); }
__device__ __forceinline__ unsigned xb_add(unsigned* p, unsigned v) { return __hip_atomic_fetch_add(p, v, __ATOMIC_RELAXED, __HIP_MEMORY_SCOPE_AGENT); }
__device__ __forceinline__ unsigned xb_xcc_id() { return (unsigned)__builtin_amdgcn_s_getreg((3 << 11) | 20) & 0xFu; }
#define XB_SPIN(cond, bar) do { unsigned _sp = 0; while (cond) { __builtin_amdgcn_s_sleep(1); \
    if ((++_sp & 255u) == 0u) { if (xb_ld(&(bar)[XB_TMO])) break; if (_sp > XB_SPIN_CAP) { atomicAdd(&(bar)[XB_TMO], 1u); break; } } } } while (0)
struct XcdBarrier { unsigned* bar; unsigned x; volatile LAS unsigned* st; };
__device__ __forceinline__ XcdBarrier xcd_barrier_post(unsigned* bar, volatile LAS unsigned* st) {
    XcdBarrier b; b.bar = bar; b.x = xb_xcc_id(); b.st = st;
    if (threadIdx.x == 0) (void)xb_add(&bar[XB_XCNT(b.x)], 1u);
    return b;
}
__device__ __forceinline__ void xcd_barrier_complete(unsigned* bar, unsigned x, unsigned& nloc, unsigned& nx) {
    const unsigned G = gridDim.x * gridDim.y * gridDim.z;
    unsigned sum, cnt, mine, sp = 0u;
    for (;;) {
        sum = 0u; cnt = 0u; mine = 0u;
#pragma unroll
        for (unsigned j = 0; j < 16; ++j) { const unsigned c = xb_ld(&bar[XB_XCNT(j)]); sum += c; cnt += (c > 0u) ? 1u : 0u; mine = (j == x) ? c : mine; }
        if (sum == G) break;
        __builtin_amdgcn_s_sleep(1);
        if ((++sp & 255u) == 0u) { if (xb_ld(&bar[XB_TMO])) break; if (sp > XB_SPIN_CAP) { atomicAdd(&bar[XB_TMO], 1u); break; } }
    }
    nloc = mine > 0u ? mine : 1u; nx = cnt > 0u ? cnt : 1u;
}
__device__ __forceinline__ void xcd_barrier(const XcdBarrier& b) {
    asm volatile("s_waitcnt vmcnt(0)" ::: "memory");
    __syncthreads();
    if (threadIdx.x == 0) {
        unsigned* bar = b.bar;
        __builtin_amdgcn_s_waitcnt(0);
        unsigned nloc = b.st[0], nx = b.st[1];
        if (nloc == 0u) { xcd_barrier_complete(bar, b.x, nloc, nx); b.st[0] = nloc; b.st[1] = nx; }
        const unsigned old = xb_add(&bar[XB_XSUB(b.x)], 1u);
        const unsigned gen = old / nloc;
        if (old + 1u == (gen + 1u) * nloc) {
            __builtin_amdgcn_fence(__ATOMIC_RELEASE, "agent");
            asm volatile("s_waitcnt vmcnt(0)" ::: "memory");
            const unsigned og = xb_add(&bar[XB_TOP], 1u);
            const unsigned tg = og / nx;
            if (og + 1u == (tg + 1u) * nx) xb_add(&bar[XB_TOPGEN], 1u);
            else XB_SPIN(xb_ld(&bar[XB_TOPGEN]) == tg, bar);
            __builtin_amdgcn_fence(__ATOMIC_ACQUIRE, "agent");
            xb_add(&bar[XB_XGEN(b.x)], 1u);
            asm volatile("s_waitcnt vmcnt(0)" ::: "memory");
        } else {
            XB_SPIN(xb_ld(&bar[XB_XGEN(b.x)]) == gen, bar);
            __builtin_amdgcn_fence(__ATOMIC_ACQUIRE, "agent");
            asm volatile("s_waitcnt vmcnt(0)" ::: "memory");
        }
    }
    __syncthreads();
}

__device__ __forceinline__ int opaque_tid0() { int t = threadIdx.x; asm volatile("" : "+v"(t)); return t; }
namespace gm {
constexpr int BM = 256, BK = 64, HALF = 128, HTB = HALF * BK * 2, STAGE_BYTES = 8 * HTB, NXCD = 8, WGM = 8;
__host__ __device__ __forceinline__ int lds_byte(int r, int c) { const int st = (r >> 4) * 2 + (c >> 5), rr = r & 15, cc = c & 31, ob = rr * 64 + cc * 2; return st * 1024 + (ob ^ (((ob >> 9) & 1) << 5)); }
__host__ __device__ __forceinline__ void stage_rc(int b, int& R, int& C) { const int st = b / 1024, sb = b % 1024, swz = sb ^ (((sb >> 9) & 1) << 5); R = (st >> 1) * 16 + swz / 64; C = (st & 1) * 32 + (swz % 64) / 2; }
__host__ __device__ __forceinline__ int perm32(int rho) { const int n = rho >> 4, i = rho & 15; return 8 * (i >> 2) + 4 * n + (i & 3); }

struct Unit { int g, pm, pn; };
struct Gemm { const f16* A; const f16* Bt; int K; long sA, sB; const int* gidx; };
struct Order {
    int nM, nN, tpg, total, G, c, mode;
    __device__ void init(int M, int N, int groups, int G_, int c_, int mode_ = 0) { nM = M / BM; nN = N / BM; tpg = nM * nN; total = tpg * groups; G = G_; c = c_; mode = (mode_ == 1 && G_ == 256 && nM == 16 && nN == 4) ? 1 : 0; }
    __device__ bool next(int i, Unit& u) const {
        const long L = (long)i * G + c; if (L >= total) return false;
        if (mode == 1) { const int x = c & 7, j = c >> 3; u.g = 4 * i + (x >> 1); u.pm = 8 * (x & 1) + (j >> 2); u.pn = j & 3; return true; }
        const int g = (int)(L / tpg); int wgid = (int)(L % tpg);
        { const int q = tpg / NXCD, r = tpg % NXCD, xcd = wgid % NXCD, off = wgid / NXCD; wgid = (xcd < r ? xcd * (q + 1) : r * (q + 1) + (xcd - r) * q) + off; }
        const int nig = WGM * nN, gid = wgid / nig, fm = gid * WGM, gsz = (nM - fm) < WGM ? (nM - fm) : WGM;
        u.g = g; u.pm = fm + ((wgid % nig) % gsz); u.pn = (wgid % nig) / gsz; return true;
    }
};

typedef f32x4 Acc[2][2][4][2];
typedef __bf16 bf16x8_t __attribute__((ext_vector_type(8)));
template <bool BF> __device__ __forceinline__ f32x4 mma16(const s16x8& a, const s16x8& b, const f32x4& c) {
    if constexpr (BF) return __builtin_amdgcn_mfma_f32_16x16x32_bf16(__builtin_bit_cast(bf16x8_t, a), __builtin_bit_cast(bf16x8_t, b), c, 0, 0, 0);
    else return __builtin_amdgcn_mfma_f32_16x16x32_f16(__builtin_bit_cast(f16x8, a), __builtin_bit_cast(f16x8, b), c, 0, 0, 0);
}

struct EpiF16 {
    static constexpr bool PERM = true;
    f16* O; int ldc;
    __device__ __forceinline__ void operator()(const Acc& acc, const Unit& u, int wr, int wc, int fr, int fq) const {
        const int row0 = u.pm * BM + wr * 64 + fr, col0 = u.pn * BM + wc * 32 + 8 * fq;
#pragma unroll
        for (int ai = 0; ai < 2; ++ai)
#pragma unroll
            for (int m = 0; m < 4; ++m) { f16* rowp = O + (size_t)(row0 + ai * HALF + m * 16) * ldc + col0;
#pragma unroll
                for (int bj = 0; bj < 2; ++bj) { const f32x4 v0 = acc[ai][bj][m][0], v1 = acc[ai][bj][m][1];
                    u32x4 w; w.x = pkh(v0[0], v0[1]); w.y = pkh(v0[2], v0[3]); w.z = pkh(v1[0], v1[1]); w.w = pkh(v1[2], v1[3]);
                    *(u32x4*)(rowp + bj * HALF) = w; } }
    }
};
struct EpiInProj0 {
    static constexpr bool PERM = true;
    f16* O; const float* rope;
    __device__ __forceinline__ void operator()(const Acc& acc, const Unit& u, int wr, int wc, int fr, int fq) const {
        const int row0 = u.pm * BM + wr * 64 + fr, col0 = u.pn * BM + wc * 32 + 8 * fq;
        const float sc = (u.pn < 4) ? QSCALE : 1.f;
        const bool dorope = (u.pn == 2 || u.pn == 3 || u.pn == 6 || u.pn == 7) && (u.pm * BM < NTOK);
#pragma unroll
        for (int ai = 0; ai < 2; ++ai)
#pragma unroll
            for (int m = 0; m < 4; ++m) { const int row = row0 + ai * HALF + m * 16; f16* rowp = O + (size_t)row * ZP0 + col0;
                const int t = row & (SEQ - 1), prow = t >> 6, pcol = t & 63;
#pragma unroll
                for (int bj = 0; bj < 2; ++bj) { f32x4 v0 = acc[ai][bj][m][0] * sc, v1 = acc[ai][bj][m][1] * sc;
                    if (dorope) { const int c = col0 + bj * HALF, half = (c >> 5) & 1, i0 = (c & 31) >> 1; const int pos = half ? pcol : prow;
                        const f32x4* tp = (const f32x4*)(rope + (pos * 16 + i0) * 2); const f32x4 t0 = tp[0], t1 = tp[1];
                        f32x4 r0, r1;
                        r0[0] = v0[0] * t0[0] - v0[1] * t0[1]; r0[1] = v0[0] * t0[1] + v0[1] * t0[0];
                        r0[2] = v0[2] * t0[2] - v0[3] * t0[3]; r0[3] = v0[2] * t0[3] + v0[3] * t0[2];
                        r1[0] = v1[0] * t1[0] - v1[1] * t1[1]; r1[1] = v1[0] * t1[1] + v1[1] * t1[0];
                        r1[2] = v1[2] * t1[2] - v1[3] * t1[3]; r1[3] = v1[2] * t1[3] + v1[3] * t1[2];
                        v0 = r0; v1 = r1; }
                    u32x4 w; w.x = pkh(v0[0], v0[1]); w.y = pkh(v0[2], v0[3]); w.z = pkh(v1[0], v1[1]); w.w = pkh(v1[2], v1[3]);
                    *(u32x4*)(rowp + bj * HALF) = w; } }
    }
};
struct EpiResGate {
    static constexpr bool PERM = false;
    const float* base; float* out; const float* gate; int gstride;
    __device__ __forceinline__ void operator()(const Acc& acc, const Unit& u, int wr, int wc, int fr, int fq) const {
        const int col0 = u.pn * BM + wc * 32 + 4 * fq; const int b = (u.pm * BM) / SEQ;
        f32x4 gv[2][2];
#pragma unroll
        for (int bj = 0; bj < 2; ++bj)
#pragma unroll
            for (int n = 0; n < 2; ++n) gv[bj][n] = *(const f32x4*)(gate + (size_t)b * gstride + col0 + bj * HALF + n * 16);
#pragma unroll
        for (int ai = 0; ai < 2; ++ai)
#pragma unroll
            for (int m = 0; m < 4; ++m) { const size_t off = (size_t)(u.pm * BM + ai * HALF + wr * 64 + m * 16 + fr) * DM + col0;
#pragma unroll
                for (int bj = 0; bj < 2; ++bj)
#pragma unroll
                    for (int n = 0; n < 2; ++n) { const f32x4 bs = *(const f32x4*)(base + off + bj * HALF + n * 16);
                        *(f32x4*)(out + off + bj * HALF + n * 16) = bs + gv[bj][n] * acc[ai][bj][m][n]; }
                if (m & 1) asm volatile("" ::: "memory"); }
    }
};
struct EpiSwiGLU {
    static constexpr bool PERM = true;
    f16* O;
    __device__ __forceinline__ void operator()(const Acc& acc, const Unit& u, int wr, int wc, int fr, int fq) const {
        const int row0 = u.pm * BM + wr * 64 + fr, col0 = u.pn * HALF + wc * 32 + 8 * fq;
        f16* Og = O + (size_t)u.g * EROWS * DE;
#pragma unroll
        for (int ai = 0; ai < 2; ++ai)
#pragma unroll
            for (int m = 0; m < 4; ++m) { f16* rowp = Og + (size_t)(row0 + ai * HALF + m * 16) * DE + col0;
                float h[8];
#pragma unroll
                for (int n = 0; n < 2; ++n)
#pragma unroll
                    for (int j = 0; j < 4; ++j) { const float g = acc[ai][0][m][n][j], up = acc[ai][1][m][n][j]; h[n * 4 + j] = g * up * __builtin_amdgcn_rcpf(1.f + __builtin_amdgcn_exp2f(-LOG2E * g)); }
                u32x4 w; w.x = pk16<MOE_BF16>(h[0], h[1]); w.y = pk16<MOE_BF16>(h[2], h[3]); w.z = pk16<MOE_BF16>(h[4], h[5]); w.w = pk16<MOE_BF16>(h[6], h[7]);
                *(u32x4*)rowp = w; }
    }
};
struct EpiRowScale {
    static constexpr bool PERM = true;
    f16* O; const float* gv;
    __device__ __forceinline__ void operator()(const Acc& acc, const Unit& u, int wr, int wc, int fr, int fq) const {
        const int row0 = u.pm * BM + wr * 64 + fr, col0 = u.pn * BM + wc * 32 + 8 * fq;
        f16* Og = O + (size_t)u.g * EROWS * DM;
#pragma unroll
        for (int ai = 0; ai < 2; ++ai)
#pragma unroll
            for (int m = 0; m < 4; ++m) { const int row = row0 + ai * HALF + m * 16; const float s = gv[((row >> 8) * NE + u.g) * CAP + (row & 255)];
                f16* rowp = Og + (size_t)row * DM + col0;
#pragma unroll
                for (int bj = 0; bj < 2; ++bj) { const f32x4 v0 = acc[ai][bj][m][0] * s, v1 = acc[ai][bj][m][1] * s;
                    u32x4 w; w.x = pkh(v0[0], v0[1]); w.y = pkh(v0[2], v0[3]); w.z = pkh(v1[0], v1[1]); w.w = pkh(v1[2], v1[3]);
                    *(u32x4*)(rowp + bj * HALF) = w; } }
    }
};

template <bool BF, bool GATHER = false, class Epi>
__device__ __forceinline__ void gemm_phase(LAS unsigned char* lds, const Gemm g, const Order& S, const Epi& E) {
    const int tid = opaque_tid0(), wid = __builtin_amdgcn_readfirstlane(tid >> 6), lane = tid & 63, wr = wid >> 2, wc = wid & 3, fr = lane & 15, fq = lane >> 4;
    const int K = g.K, nt = K / BK;
    unsigned voffA[2], voffB[2];
#pragma unroll
    for (int i = 0; i < 2; ++i) { int R, C; stage_rc(tid * 16 + i * 8192, R, C); const int Rb = Epi::PERM ? ((R & ~31) + perm32(R & 31)) : R;
        voffA[i] = (unsigned)(R * K + C) * 2u; voffB[i] = (unsigned)(Rb * K + C) * 2u; }
    int gR[2], gC[2];
#pragma unroll
    for (int i = 0; i < 2; ++i) { int R, C; stage_rc(tid * 16 + i * 8192, R, C); gR[i] = R; gC[i] = C; }
    unsigned gA0[2] = {0u, 0u}, gA1[2] = {0u, 0u}, nA0[2] = {0u, 0u}, nA1[2] = {0u, 0u};
    LAS unsigned short* gtab = (LAS unsigned short*)(lds + 132096);
    constexpr int GT_MAXU = 22;
#define GM_GCVT(dst0, dst1, uu, ui_) do { const LAS unsigned short* _tp = gtab + (ui_) * 256; _Pragma("unroll") for (int _i = 0; _i < 2; ++_i) { const int _t0 = _tp[gR[_i]], _t1 = _tp[128 + gR[_i]]; \
        dst0[_i] = (unsigned)((((uu).pm * SEQ + _t0) * K + gC[_i]) * 2); dst1[_i] = (unsigned)((((uu).pm * SEQ + _t1) * K + gC[_i]) * 2); } } while (0)
    const size_t kstep = (size_t)(BK * 2);
    const size_t hstep = GATHER ? (size_t)0 : (size_t)HALF * K * 2;
    const size_t hstepB = (size_t)HALF * K * 2;
    const size_t tstep = 2 * hstepB;
    const unsigned ldsw = (unsigned)wid * 1024u;
    const int aoff = lds_byte(wr * 64 + fr, fq * 8), boff = lds_byte(wc * 32 + fr, fq * 8);
#define GM_SA(b, h) (((b) * 2 + (h)) * HTB)
#define GM_SB(b, h) ((4 + (b) * 2 + (h)) * HTB)
#define GM_STAGE(bufoff, gbase, voff) do { _Pragma("unroll") for (int _i = 0; _i < 2; ++_i) \
        __builtin_amdgcn_global_load_lds((const unsigned*)((const char*)(gbase) + (voff)[_i]), (LAS unsigned*)(lds + (bufoff) + ldsw + _i * 8192), 16, 0, 0); } while (0)
#define GM_LDA(dst, b, h) do { _Pragma("unroll") for (int m = 0; m < 4; ++m) _Pragma("unroll") for (int k = 0; k < 2; ++k) dst[m][k] = *(const LAS s16x8*)(lds + GM_SA(b, h) + aoff + m * 2048 + k * 1024); } while (0)
#define GM_LDB(dst, b, h) do { _Pragma("unroll") for (int n = 0; n < 2; ++n) _Pragma("unroll") for (int k = 0; k < 2; ++k) dst[n][k] = *(const LAS s16x8*)(lds + GM_SB(b, h) + boff + n * 2048 + k * 1024); } while (0)
#define GM_MMA(ai, bj, At, Bt) do { __builtin_amdgcn_s_setprio(1); _Pragma("unroll") for (int m = 0; m < 4; ++m) _Pragma("unroll") for (int n = 0; n < 2; ++n) _Pragma("unroll") for (int k = 0; k < 2; ++k) \
        acc[ai][bj][m][n] = mma16<BF>(Bt[n][k], At[m][k], acc[ai][bj][m][n]); __builtin_amdgcn_s_setprio(0); } while (0)
#define GM_WAIT_V(n) asm volatile("s_waitcnt vmcnt(" #n ")" ::: "memory")
#define GM_WAIT_L(n) asm volatile("s_waitcnt lgkmcnt(" #n ")" ::: "memory")
#define GM_BAR __builtin_amdgcn_s_barrier()
#define GM_SCHED __builtin_amdgcn_sched_barrier(0)
    Unit cur, nxt; int ui = 0;
    if (!S.next(0, cur)) return;
    Acc acc;
#pragma unroll
    for (int a = 0; a < 2; ++a)
#pragma unroll
        for (int b = 0; b < 2; ++b)
#pragma unroll
            for (int m = 0; m < 4; ++m)
#pragma unroll
                for (int n = 0; n < 2; ++n) acc[a][b][m][n] = (f32x4){0.f, 0.f, 0.f, 0.f};
    s16x8 At[4][2], B0[2][2], B1[2][2];
    const char* cA = GATHER ? (const char*)g.A : (const char*)(g.A + (size_t)cur.g * g.sA) + (size_t)cur.pm * tstep; const char* cB = (const char*)(g.Bt + (size_t)cur.g * g.sB) + (size_t)cur.pn * tstep;
    if constexpr (GATHER) {
        int tv[GT_MAXU / 2];
#pragma unroll
        for (int j = 0; j < GT_MAXU / 2; ++j) { const int ui_ = 2 * j + (tid >> 8); Unit uu; const bool okk = S.next(ui_, uu); tv[j] = g.gidx[(okk ? (uu.pm * NE + uu.g) * CAP : 0) + (tid & 255)]; }
#pragma unroll
        for (int j = 0; j < GT_MAXU / 2; ++j) gtab[(2 * j + (tid >> 8)) * 256 + (tid & 255)] = (unsigned short)tv[j];
        __syncthreads();
        GM_GCVT(gA0, gA1, cur, 0);
    }
#define GM_STA_H0(buf, p, o0) do { if constexpr (GATHER) GM_STAGE(buf, p, o0); else GM_STAGE(buf, p, voffA); } while (0)
#define GM_STA_H1(buf, p, o1) do { if constexpr (GATHER) GM_STAGE(buf, p, o1); else GM_STAGE(buf, (p) + hstepB, voffA); } while (0)
    GM_STAGE(GM_SB(0, 0), cB, voffB); GM_STAGE(GM_SB(0, 1), cB + hstepB, voffB); GM_STA_H0(GM_SA(0, 0), cA, gA0); GM_STA_H1(GM_SA(0, 1), cA, gA1);
    if (wr == 1) GM_BAR;
    GM_WAIT_V(2); GM_BAR;
    GM_STAGE(GM_SB(1, 0), cB + kstep, voffB); GM_STA_H0(GM_SA(1, 0), cA + kstep, gA0); GM_STAGE(GM_SB(1, 1), cB + hstepB + kstep, voffB);
    GM_WAIT_V(6); GM_BAR;
    for (;;) {
        const bool has_next = S.next(ui + 1, nxt);
        const char* nA = GATHER ? cA : (has_next ? (const char*)(g.A + (size_t)nxt.g * g.sA) + (size_t)nxt.pm * tstep : cA); const char* nB = has_next ? (const char*)(g.Bt + (size_t)nxt.g * g.sB) + (size_t)nxt.pn * tstep : cB;
        if constexpr (GATHER) { if (has_next) GM_GCVT(nA0, nA1, nxt, ui + 1); else { nA0[0] = gA0[0]; nA0[1] = gA0[1]; nA1[0] = gA1[0]; nA1[1] = gA1[1]; } }
        for (int t = 0; t < nt; t += 2) {
            const bool last = (t == nt - 2);
            const char* a1 = cA + (size_t)(t + 1) * kstep;
            const char* a2 = last ? nA : cA + (size_t)(t + 2) * kstep; const char* b2 = last ? nB : cB + (size_t)(t + 2) * kstep;
            const char* a3 = a2 + kstep; const char* b3 = b2 + kstep;
            unsigned s0[2], s1[2];
            if constexpr (GATHER) { s0[0] = last ? nA0[0] : gA0[0]; s0[1] = last ? nA0[1] : gA0[1]; s1[0] = last ? nA1[0] : gA1[0]; s1[1] = last ? nA1[1] : gA1[1]; }
            GM_LDB(B0, 0, 0); GM_LDB(B1, 0, 1); GM_SCHED; GM_LDA(At, 0, 0); GM_STA_H1(GM_SA(1, 1), a1, gA1);
            GM_WAIT_V(8); GM_WAIT_L(0); GM_BAR; GM_MMA(0, 0, At, B0); GM_MMA(0, 1, At, B1); GM_BAR; GM_SCHED;
            GM_LDA(At, 0, 1); GM_STAGE(GM_SB(0, 0), b2, voffB); GM_STAGE(GM_SB(0, 1), b2 + hstepB, voffB); GM_STA_H0(GM_SA(0, 0), a2, s0);
            GM_WAIT_V(8); GM_WAIT_L(0); GM_BAR; GM_MMA(1, 0, At, B0); GM_MMA(1, 1, At, B1); GM_BAR; GM_SCHED;
            GM_LDB(B0, 1, 0); GM_LDB(B1, 1, 1); GM_SCHED; GM_LDA(At, 1, 0); GM_STA_H1(GM_SA(0, 1), a2, s1);
            GM_WAIT_V(8); GM_WAIT_L(0); GM_BAR; GM_MMA(0, 0, At, B0); GM_MMA(0, 1, At, B1); GM_BAR; GM_SCHED;
            GM_LDA(At, 1, 1); GM_STAGE(GM_SB(1, 0), b3, voffB); GM_STAGE(GM_SB(1, 1), b3 + hstepB, voffB); GM_STA_H0(GM_SA(1, 0), a3, s0);
            GM_WAIT_V(8); GM_WAIT_L(0); GM_BAR; GM_MMA(1, 0, At, B0); GM_MMA(1, 1, At, B1); GM_BAR; GM_SCHED;
        }
        if (wr == 0) GM_BAR;
        E(acc, cur, wr, wc, fr, fq);
        if (!has_next) break;
#pragma unroll
        for (int a = 0; a < 2; ++a)
#pragma unroll
            for (int b = 0; b < 2; ++b)
#pragma unroll
                for (int m = 0; m < 4; ++m)
#pragma unroll
                    for (int n = 0; n < 2; ++n) acc[a][b][m][n] = (f32x4){0.f, 0.f, 0.f, 0.f};
        cur = nxt; cA = nA; cB = nB; ++ui;
        if constexpr (GATHER) { gA0[0] = nA0[0]; gA0[1] = nA0[1]; gA1[0] = nA1[0]; gA1[1] = nA1[1]; }
        if (wr == 1) GM_BAR;
    }
    GM_WAIT_V(0);
    GM_BAR;
#undef GM_SA
#undef GM_STA_H0
#undef GM_STA_H1
#undef GM_GCVT
#undef GM_SB
#undef GM_STAGE
#undef GM_LDA
#undef GM_LDB
#undef GM_MMA
#undef GM_WAIT_V
#undef GM_WAIT_L
#undef GM_BAR
#undef GM_SCHED
}
}

struct Params { const float* in[36]; float* out; unsigned char* ws; int ph_lo, ph_hi, alt, pad; };
enum { I_X = 0, I_C, I_CTX, I_CCTX, I_L0_NORM1, I_L0_WMOD, I_L0_BMOD, I_L0_WIN, I_L0_WOUT, I_L0_RPB, I_L0_LQ1, I_L0_LK1, I_L0_LQ2, I_L0_LK2, I_L0_SUBLN,
       I_L0_NORM2, I_L0_WR, I_L0_W1, I_L0_W3, I_L0_W2, I_L1_NORM1, I_L1_WMOD, I_L1_BMOD, I_L1_WIN, I_L1_WOUT, I_L1_SCW, I_L1_CFW, I_L1_CFB, I_L1_LNG, I_L1_LNB,
       I_L1_NORM2, I_L1_WR, I_L1_W1, I_L1_W3, I_L1_W2, I_FNORM };

__device__ __forceinline__ int opaque_tid() { int t = threadIdx.x; asm volatile("" : "+v"(t)); return t; }
__device__ __forceinline__ float wave_sum(float v) {
#pragma unroll
    for (int o = 1; o < 64; o <<= 1) v += __shfl_xor(v, o);
    return v;
}

constexpr int CVT_RS = 136, CVT_SCR = 64 * CVT_RS;
template <bool BF, class RowMap>
__device__ __forceinline__ void cvt_item(const float* W, int K, int N, f16* WT, const RowMap& rm, int item, int lane, LAS unsigned char* scr) {
    const int nblk = N / 64, kb = item / nblk, nb = item % nblk, k0 = 64 * kb, n0 = 64 * nb;
    const float* src = W + (size_t)(k0 + (lane >> 4)) * N + n0 + 4 * (lane & 15);
    f32x4 v[16];
#pragma unroll
    for (int i = 0; i < 16; ++i) v[i] = *(const f32x4*)(src + (size_t)(4 * i) * N);
#pragma unroll
    for (int i = 0; i < 16; ++i) { u32x2 w; w.x = pk16<BF>(v[i][0], v[i][1]); w.y = pk16<BF>(v[i][2], v[i][3]);
        *(LAS u32x2*)(scr + (4 * i + (lane >> 4)) * CVT_RS + 8 * (lane & 15)) = w; }
    const int g = lane >> 4, i16 = lane & 15, q_ = i16 >> 2, p_ = i16 & 3;
#pragma unroll
    for (int st = 0; st < 8; ++st) {
        const int nl = 16 * (st >> 1), ch = 4 * (st & 1) + g;
        const LAS unsigned char* ap = scr + (8 * ch + q_) * CVT_RS + (nl + 4 * p_) * 2;
        const s16x4 lo = __builtin_amdgcn_ds_read_tr16_b64_v4i16((LAS s16x4*)ap);
        const s16x4 hi = __builtin_amdgcn_ds_read_tr16_b64_v4i16((LAS s16x4*)(ap + 4 * CVT_RS));
        u32x4 w; const u32x2 l2 = __builtin_bit_cast(u32x2, lo), h2 = __builtin_bit_cast(u32x2, hi); w.x = l2.x; w.y = l2.y; w.z = h2.x; w.w = h2.y;
        *(u32x4*)(WT + (size_t)rm(n0 + nl + i16) * K + k0 + 8 * ch) = w;
    }
}
struct MapPlain { __device__ __forceinline__ int operator()(int n) const { return n; } };
struct MapRope { __device__ __forceinline__ int operator()(int n) const {
    const bool rp = (n >= 512 && n < 1024) || (n >= 1536 && n < 2048); if (!rp) return n; const int i = n & 31; return (n & ~31) + (i < 16 ? 2 * i : 2 * (i - 16) + 1); } };
struct MapGLU { int add; __device__ __forceinline__ int operator()(int n) const { return (n >> 7) * 256 + (n & 127) + add; } };

__device__ __forceinline__ void cvt_moe(const float* w1, const float* w3, const float* w2, f16* W13, f16* W2T, int gw, int NGW, int lane, LAS unsigned char* scr) {
    constexpr int I13 = (DM / 64) * (DE / 64), I2 = (DE / 64) * (DM / 64);
    constexpr int NIT = NE * (2 * I13 + I2);
    for (int it = gw; it < NIT; it += NGW) {
        const int e = it / (2 * I13 + I2); int r = it % (2 * I13 + I2);
        if (r < I13) { cvt_item<MOE_BF16>(w1 + (size_t)e * DM * DE, DM, DE, W13 + (size_t)e * 2 * DE * DM, MapGLU{0}, r, lane, scr); continue; } r -= I13;
        if (r < I13) { cvt_item<MOE_BF16>(w3 + (size_t)e * DM * DE, DM, DE, W13 + (size_t)e * 2 * DE * DM, MapGLU{128}, r, lane, scr); continue; } r -= I13;
        cvt_item<MOE_BF16>(w2 + (size_t)e * DE * DM, DE, DM, W2T + (size_t)e * DM * DE, MapPlain{}, r, lane, scr);
    }
}

__device__ __forceinline__ void phase_prologue(const Params& p, LAS unsigned char* lds) {
    const int tid = opaque_tid(), lane = tid & 63, wave = __builtin_amdgcn_readfirstlane(tid >> 6);
    const int G = gridDim.x;
    unsigned char* ws = p.ws;
    LAS float* S = (LAS float*)lds;
    LAS float* red = (LAS float*)(lds + 17 * 1024 * 4);
    for (int u = blockIdx.x; u < 193; u += G) {
        if (u == 192) {
            float* rope = (float*)(ws + WS_MOD + ROPE_OFF);
            for (int idx = tid; idx < 1024; idx += 512) { const int pos = idx >> 4, i = idx & 15; const float fr = powf(10000.f, -(float)i / 16.f), ang = (float)pos * fr;
                rope[idx * 2] = cosf(ang); rope[idx * 2 + 1] = sinf(ang); }
            if (wave == 0) { const float s1 = wave_sum(p.in[I_L0_LQ1][lane] * p.in[I_L0_LK1][lane]), s2 = wave_sum(p.in[I_L0_LQ2][lane] * p.in[I_L0_LK2][lane]);
                if (lane == 0) *(float*)(ws + WS_MOD + LAM_OFF) = expf(s1) - expf(s2) + 0.2f; }
            continue;
        }
        const int l = u / 96, col0 = (u % 96) * 64;
        const float* wmod = p.in[l ? I_L1_WMOD : I_L0_WMOD]; const float* bmod = p.in[l ? I_L1_BMOD : I_L0_BMOD];
        float* mod = (float*)(ws + WS_MOD + (l ? MOD1_OFF : MOD0_OFF));
        for (int idx = tid; idx < 17 * 1024; idx += 512) { const float v = idx < 16 * 1024 ? p.in[I_C][idx] : p.in[I_CCTX][idx - 16 * 1024]; S[idx] = silu_f(v); }
        __syncthreads();
        float acc[17];
#pragma unroll
        for (int r = 0; r < 17; ++r) acc[r] = 0.f;
        const int kb = wave * 128;
        for (int kk = 0; kk < 128; kk += 4) {
            float wv[4];
#pragma unroll
            for (int i = 0; i < 4; ++i) wv[i] = wmod[(size_t)(kb + kk + i) * 6144 + col0 + lane];
#pragma unroll
            for (int r = 0; r < 17; ++r) { const f32x4 sv = *(const LAS f32x4*)(S + r * 1024 + kb + kk); acc[r] += sv[0] * wv[0] + sv[1] * wv[1] + sv[2] * wv[2] + sv[3] * wv[3]; }
        }
#pragma unroll
        for (int r = 0; r < 17; ++r) red[(wave * 17 + r) * 64 + lane] = acc[r];
        __syncthreads();
        for (int idx = tid; idx < 17 * 64; idx += 512) { const int r = idx >> 6, ln = idx & 63; float s = bmod[col0 + ln];
#pragma unroll
            for (int w = 0; w < 8; ++w) s += red[(w * 17 + r) * 64 + ln];
            if (r < 16 || l == 0) mod[(size_t)r * 6144 + col0 + ln] = s; }
        __syncthreads();
    }
    const int gw = blockIdx.x * 8 + wave, NGW = G * 8;
    LAS unsigned char* scr = lds + wave * CVT_SCR;
    constexpr int IT_IN0 = (DM / 64) * (ZP0 / 64), IT_OUT = (DM / 64) * (DM / 64), IT_IN1 = (DM / 64) * (ZP1 / 64);
    for (int it = gw; it < IT_IN0 + 2 * IT_OUT + IT_IN1; it += NGW) {
        int r = it;
        if (r < IT_IN0) { cvt_item<false>(p.in[I_L0_WIN], DM, ZP0, (f16*)(ws + WS_WIN0), MapRope{}, r, lane, scr); continue; } r -= IT_IN0;
        if (r < IT_OUT) { cvt_item<false>(p.in[I_L0_WOUT], DM, DM, (f16*)(ws + WS_WOUT0), MapPlain{}, r, lane, scr); continue; } r -= IT_OUT;
        if (r < IT_IN1) { cvt_item<false>(p.in[I_L1_WIN], DM, ZP1, (f16*)(ws + WS_WIN1), MapPlain{}, r, lane, scr); continue; } r -= IT_IN1;
        cvt_item<false>(p.in[I_L1_WOUT], DM, DM, (f16*)(ws + WS_WOUT1), MapPlain{}, r, lane, scr);
    }
    cvt_moe(p.in[I_L0_W1], p.in[I_L0_W3], p.in[I_L0_W2], (f16*)(ws + WS_W13), (f16*)(ws + WS_W2), gw, NGW, lane, scr);
}

struct NormArgs {
    const float* src;
    float* xout;
    const f16* y2; const short* inv; const float* gate2;
    const float* gain;
    const float* shift; const float* scale; int mstride;
    f16* hout;
    float* fout;
    const float* wr; float* aff;
    bool hbf;
};

template <int R>
__device__ __forceinline__ void norm_phase(const NormArgs& a, LAS unsigned char* lds, bool ctx_rows, const float* ctx_src, const float* ctx_shift, const float* ctx_scale) {
    const int tid = opaque_tid(), lane = tid & 63, wave = __builtin_amdgcn_readfirstlane(tid >> 6);
    const int G = gridDim.x;
    LAS float* wl = (LAS float*)lds;
    if (a.wr) {
        for (int idx = tid; idx < 16384; idx += 512) { const int k = idx >> 4, e = idx & 15; wl[e * 1028 + k] = a.wr[idx]; }
        __syncthreads();
    }
    const int gw = blockIdx.x * 8 + wave, NGW = G * 8;
    for (int chunk = gw; chunk < NTOK / 16; chunk += NGW) {
        const int row0 = chunk * 16, b = row0 / SEQ;
        f32x4 A[4], Sh[4], G2[4];
#pragma unroll
        for (int j = 0; j < 4; ++j) { const int c = 4 * lane + 256 * j; const f32x4 g = *(const f32x4*)(a.gain + c);
            if (a.shift) { const f32x4 sc = *(const f32x4*)(a.scale + (size_t)b * a.mstride + c); A[j] = g * (sc + 1.f); Sh[j] = *(const f32x4*)(a.shift + (size_t)b * a.mstride + c); }
            else { A[j] = g; Sh[j] = (f32x4){0.f, 0.f, 0.f, 0.f}; }
            if (a.y2) G2[j] = *(const f32x4*)(a.gate2 + (size_t)b * 6144 + c); else G2[j] = (f32x4){0.f, 0.f, 0.f, 0.f}; }
        for (int rr = 0; rr < 16; rr += R) {
            f32x4 v[R][4];
            int sl[R];
#pragma unroll
            for (int q = 0; q < R; ++q) { sl[q] = -1; if (a.y2 && lane < 16) sl[q] = a.inv[((size_t)b * NE + lane) * SEQ + ((row0 + rr + q) & (SEQ - 1))]; }
#pragma unroll
            for (int q = 0; q < R; ++q) { const int row = row0 + rr + q; const float* xr = a.src + (size_t)row * DM;
#pragma unroll
                for (int j = 0; j < 4; ++j) v[q][j] = *(const f32x4*)(xr + 4 * lane + 256 * j); }
            if (a.y2) {
                unsigned long long mask[R]; int ee[R][4]; float wgt[R][4]; f16x4 ld[R][4][4];
#pragma unroll
                for (int q = 0; q < R; ++q) { mask[q] = __ballot(sl[q] >= 0);
#pragma unroll
                    for (int i = 0; i < 4; ++i) { if (mask[q]) { ee[q][i] = __builtin_ctzll(mask[q]); mask[q] &= mask[q] - 1; wgt[q][i] = 1.f; } else { ee[q][i] = i ? ee[q][0] : 0; wgt[q][i] = 0.f; } }
#pragma unroll
                    for (int i = 0; i < 4; ++i) { int slot = __shfl(sl[q], ee[q][i]); slot = slot < 0 ? 0 : slot; const f16* yr = a.y2 + ((size_t)ee[q][i] * EROWS + b * CAP + slot) * DM + 4 * lane;
#pragma unroll
                        for (int j = 0; j < 4; ++j) ld[q][i][j] = *(const f16x4*)(yr + 256 * j); } }
#pragma unroll
                for (int q = 0; q < R; ++q) { const int row = row0 + rr + q;
                    f32x4 cs[4];
#pragma unroll
                    for (int j = 0; j < 4; ++j) cs[j] = (f32x4){0.f, 0.f, 0.f, 0.f};
#pragma unroll
                    for (int i = 0; i < 4; ++i)
#pragma unroll
                        for (int j = 0; j < 4; ++j) { cs[j][0] += wgt[q][i] * (float)ld[q][i][j][0]; cs[j][1] += wgt[q][i] * (float)ld[q][i][j][1]; cs[j][2] += wgt[q][i] * (float)ld[q][i][j][2]; cs[j][3] += wgt[q][i] * (float)ld[q][i][j][3]; }
                    while (mask[q]) {
                        const int e2 = __builtin_ctzll(mask[q]); mask[q] &= mask[q] - 1; const int slot = __shfl(sl[q], e2); const f16* yr = a.y2 + ((size_t)e2 * EROWS + b * CAP + slot) * DM + 4 * lane;
#pragma unroll
                        for (int j = 0; j < 4; ++j) { const f16x4 t = *(const f16x4*)(yr + 256 * j); cs[j][0] += (float)t[0]; cs[j][1] += (float)t[1]; cs[j][2] += (float)t[2]; cs[j][3] += (float)t[3]; }
                    }
                    float* xo = a.xout + (size_t)row * DM;
#pragma unroll
                    for (int j = 0; j < 4; ++j) { v[q][j] = v[q][j] + G2[j] * cs[j]; if (!a.fout) *(f32x4*)(xo + 4 * lane + 256 * j) = v[q][j]; }
                }
            }
            float rstd[R];
#pragma unroll
            for (int q = 0; q < R; ++q) { float ss = 0.f;
#pragma unroll
                for (int j = 0; j < 4; ++j) ss += (v[q][j][0] * v[q][j][0] + v[q][j][1] * v[q][j][1]) + (v[q][j][2] * v[q][j][2] + v[q][j][3] * v[q][j][3]);
                rstd[q] = 1.0f / sqrtf(wave_sum(ss) * (1.f / DM) + EPS); }
#pragma unroll
            for (int q = 0; q < R; ++q) { const int row = row0 + rr + q;
#pragma unroll
                for (int j = 0; j < 4; ++j) v[q][j] = (v[q][j] * rstd[q]) * A[j] + Sh[j];
                if (a.fout) {
#pragma unroll
                    for (int j = 0; j < 4; ++j) *(f32x4*)(a.fout + (size_t)row * DM + 4 * lane + 256 * j) = v[q][j];
                }
                if (a.hout) {
#pragma unroll
                    for (int j = 0; j < 4; ++j) { u32x2 w; if (a.hbf) { w.x = pkb(v[q][j][0], v[q][j][1]); w.y = pkb(v[q][j][2], v[q][j][3]); } else { w.x = pkh(v[q][j][0], v[q][j][1]); w.y = pkh(v[q][j][2], v[q][j][3]); } *(u32x2*)(a.hout + (size_t)row * DM + 4 * lane + 256 * j) = w; }
                }
            }
            if (a.wr) {
#pragma unroll 1
                for (int q = 0; q < R; ++q) {
                    float lg[16];
                    f32x4 h0 = v[0][0], h1 = v[0][1], h2 = v[0][2], h3 = v[0][3];
#pragma unroll
                    for (int qq = 1; qq < R; ++qq) if (q == qq) { h0 = v[qq][0]; h1 = v[qq][1]; h2 = v[qq][2]; h3 = v[qq][3]; }
#pragma unroll
                    for (int e = 0; e < 16; ++e) { const LAS float* wp = wl + e * 1028 + 4 * lane;
                        const f32x4 w0 = *(const LAS f32x4*)(wp), w1 = *(const LAS f32x4*)(wp + 256), w2 = *(const LAS f32x4*)(wp + 512), w3 = *(const LAS f32x4*)(wp + 768);
                        lg[e] = ((h0[0] * w0[0] + h0[1] * w0[1]) + (h0[2] * w0[2] + h0[3] * w0[3])) + ((h1[0] * w1[0] + h1[1] * w1[1]) + (h1[2] * w1[2] + h1[3] * w1[3]))
                              + ((h2[0] * w2[0] + h2[1] * w2[1]) + (h2[2] * w2[2] + h2[3] * w2[3])) + ((h3[0] * w3[0] + h3[1] * w3[1]) + (h3[2] * w3[2] + h3[3] * w3[3]));
                        asm volatile("" ::: "memory"); }
#pragma unroll
                    for (int i = 0; i < 8; ++i) { const bool hi = lane & 32; const float send = hi ? lg[i] : lg[i + 8], keep = hi ? lg[i + 8] : lg[i]; lg[i] = keep + __shfl_xor(send, 32); }
#pragma unroll
                    for (int i = 0; i < 4; ++i) { const bool hi = lane & 16; const float send = hi ? lg[i] : lg[i + 4], keep = hi ? lg[i + 4] : lg[i]; lg[i] = keep + __shfl_xor(send, 16); }
#pragma unroll
                    for (int i = 0; i < 2; ++i) { const bool hi = lane & 8; const float send = hi ? lg[i] : lg[i + 2], keep = hi ? lg[i + 2] : lg[i]; lg[i] = keep + __shfl_xor(send, 8); }
                    { const bool hi = lane & 4; const float send = hi ? lg[0] : lg[1], keep = hi ? lg[1] : lg[0]; lg[0] = keep + __shfl_xor(send, 4); }
                    float lv = lg[0]; lv += __shfl_xor(lv, 2); lv += __shfl_xor(lv, 1);
                    float mx = lv;
#pragma unroll
                    for (int o = 4; o < 64; o <<= 1) mx = fmaxf(mx, __shfl_xor(mx, o));
                    const float ex = expf(lv - mx); float sm = ex;
#pragma unroll
                    for (int o = 4; o < 64; o <<= 1) sm += __shfl_xor(sm, o);
                    const int row = row0 + rr + q, t = row & (SEQ - 1), e = (lane >> 2) & 15;
                    if ((lane & 3) == 0) a.aff[((size_t)b * NE + e) * SEQ + t] = ex / sm;
                }
            }
        }
    }
    if (ctx_rows) {
        f32x4 A[4], Sh[4];
#pragma unroll
        for (int j = 0; j < 4; ++j) { const int c = 4 * lane + 256 * j; A[j] = *(const f32x4*)(a.gain + c) * (*(const f32x4*)(ctx_scale + c) + 1.f); Sh[j] = *(const f32x4*)(ctx_shift + c); }
        for (int row = gw; row < NCTX; row += NGW) {
            f32x4 v[4]; float ss = 0.f;
#pragma unroll
            for (int j = 0; j < 4; ++j) { v[j] = *(const f32x4*)(ctx_src + (size_t)row * DM + 4 * lane + 256 * j); ss += (v[j][0] * v[j][0] + v[j][1] * v[j][1]) + (v[j][2] * v[j][2] + v[j][3] * v[j][3]); }
            const float rstd = 1.0f / sqrtf(wave_sum(ss) * (1.f / DM) + EPS);
#pragma unroll
            for (int j = 0; j < 4; ++j) { const f32x4 h = (v[j] * rstd) * A[j] + Sh[j]; u32x2 w; w.x = pkh(h[0], h[1]); w.y = pkh(h[2], h[3]); *(u32x2*)(a.hout + (size_t)(NTOK + row) * DM + 4 * lane + 256 * j) = w; }
        }
    }
    __syncthreads();
}

__device__ __forceinline__ void topk_phase(const float* aff, int* idx, float* gv, short* inv, const f16* H, f16* XIN, LAS unsigned char* lds) {
    const int tid = opaque_tid(), lane = tid & 63, wave = __builtin_amdgcn_readfirstlane(tid >> 6);
    LAS unsigned long long* key = (LAS unsigned long long*)lds;
    for (int u = blockIdx.x; u < NB * NE; u += gridDim.x) {
        const int b = u / NE, e = u % NE;
        const float* av = aff + (size_t)u * SEQ;
        for (int t = tid; t < SEQ; t += 512) key[t] = ((unsigned long long)(~__float_as_uint(av[t])) << 32) | (unsigned)t;
        __syncthreads();
        for (int k = 2; k <= SEQ; k <<= 1)
            for (int j = k >> 1; j > 0; j >>= 1) {
#pragma unroll
                for (int pp = 0; pp < 2; ++pp) { const int pr = tid + pp * 512; const int i = ((pr & ~(j - 1)) << 1) | (pr & (j - 1)), i2 = i | j;
                    const unsigned long long x = key[i], y = key[i2]; const bool up = (i & k) == 0;
                    if ((x > y) == up) { key[i] = y; key[i2] = x; } }
                __syncthreads();
            }
        for (int r = tid; r < SEQ; r += 512) { const unsigned long long kk = key[r]; const int t = (int)(unsigned)kk;
            inv[(size_t)u * SEQ + t] = (short)(r < CAP ? r : -1);
            if (r < CAP) { idx[u * CAP + r] = t; gv[u * CAP + r] = __uint_as_float(~(unsigned)(kk >> 32)); } }
        __syncthreads();
    }
}

namespace at {
constexpr int SLOT = 32768, NSLOT = 4;
constexpr int RPB_OFF = 132096;
constexpr float THR = 8.f;
typedef _Float16 v4h __attribute__((ext_vector_type(4)));
__device__ __forceinline__ int fsw(int row) { return ((row & 3) << 2) | ((row >> 2) & 3); }

__device__ __forceinline__ void glds16(const void* gsrc, unsigned lds_dst) { unsigned keep;
    asm volatile("s_mov_b32 %0, m0\n\ts_mov_b32 m0, %2\n\ts_nop 0\n\tglobal_load_lds_dwordx4 %1, off\n\ts_mov_b32 m0, %0" : "=&s"(keep) : "v"(gsrc), "s"(lds_dst) : "memory"); }
__device__ __forceinline__ void dma_tile(const f16* Z, long rowbase, int kcol, int vcol, LAS unsigned char* slot, int wave, int lane) {
    const unsigned sbase = (unsigned)__builtin_amdgcn_readfirstlane((int)(unsigned)(uintptr_t)slot);
#pragma unroll
    for (int i = 0; i < 2; ++i) { const int piece = wave + 8 * i, row = 4 * piece + (lane >> 4), c = (lane & 15) ^ fsw(row);
        const f16* gp = Z + (size_t)(rowbase + row) * ZP0 + 8 * c;
        glds16(gp + kcol, sbase + piece * 1024);
        glds16(gp + vcol, sbase + 16384 + piece * 1024); }
}
#define AT_WAIT(n) asm volatile("s_waitcnt vmcnt(" #n ") lgkmcnt(0)" ::: "memory")
__device__ __forceinline__ void wait_tile(int younger) { if (younger >= 2) AT_WAIT(8); else if (younger == 1) AT_WAIT(4); else AT_WAIT(0); }

template <int NDT> struct Addr { int k[4]; int v[NDT][2]; };
template <int NDT>
__device__ __forceinline__ Addr<NDT> make_addr(int kb0, int kchunk0, int vchunk0, int lane) {
    Addr<NDT> a; const int r32 = lane & 31, hh = lane >> 5, i = lane & 15, q_ = i >> 2, p_ = i & 3, g1 = (lane >> 4) & 1;
    const int kr = kb0 + r32, fk = fsw(kr);
#pragma unroll
    for (int st = 0; st < 4; ++st) a.k[st] = kr * 256 + 16 * ((kchunk0 + 2 * st + hh) ^ fk);
    const int vr = kb0 + 4 * hh + q_, f0 = fsw(vr), f1 = fsw(vr + 8);
#pragma unroll
    for (int dt = 0; dt < NDT; ++dt) { const int c = vchunk0 + 4 * dt + 2 * g1 + (p_ >> 1);
        a.v[dt][0] = 16384 + vr * 256 + 16 * (c ^ f0) + 8 * (p_ & 1); a.v[dt][1] = 16384 + (vr + 8) * 256 + 16 * (c ^ f1) + 8 * (p_ & 1); }
    return a;
}
#define AT_SCHED() __builtin_amdgcn_sched_barrier(0)
template <int NDT>
__device__ __forceinline__ void load_k(LAS unsigned char* slot, const Addr<NDT>& a, int off, f16x8* kf) {
#pragma unroll
    for (int st = 0; st < 4; ++st) kf[st] = *(const LAS f16x8*)(slot + a.k[st] + off);
}
template <int NDT>
__device__ __forceinline__ void load_v(LAS unsigned char* slot, const Addr<NDT>& a, int off, f16x8* vf) {
#pragma unroll
    for (int s2 = 0; s2 < 2; ++s2)
#pragma unroll
        for (int dt = 0; dt < NDT; ++dt) {
            const v4h lo = __builtin_bit_cast(v4h, __builtin_amdgcn_ds_read_tr16_b64_v4i16((LAS s16x4*)(slot + a.v[dt][0] + off + s2 * 4096)));
            const v4h hi = __builtin_bit_cast(v4h, __builtin_amdgcn_ds_read_tr16_b64_v4i16((LAS s16x4*)(slot + a.v[dt][1] + off + s2 * 4096)));
            vf[s2 * NDT + dt] = (f16x8){lo[0], lo[1], lo[2], lo[3], hi[0], hi[1], hi[2], hi[3]};
        }
}
__device__ __forceinline__ f32x16 qk32(const f16x8* kf, const f16x8 (&qf)[4], const f32x16& negm) {
    f32x16 s = __builtin_amdgcn_mfma_f32_32x32x16_f16(kf[0], qf[0], negm, 0, 0, 0);
#pragma unroll
    for (int st = 1; st < 4; ++st) s = __builtin_amdgcn_mfma_f32_32x32x16_f16(kf[st], qf[st], s, 0, 0, 0);
    return s;
}
__device__ __forceinline__ float max3f(float a, float b, float c) { float r; asm("v_max3_f32 %0, %1, %2, %3" : "=v"(r) : "v"(a), "v"(b), "v"(c)); return r; }
template <int NDT>
__device__ __forceinline__ void pv32(const f16x8* vf, const f32x16& p, f32x16 (&o)[NDT]) {
#pragma unroll
    for (int s2 = 0; s2 < 2; ++s2) {
        f16x8 pb;
#pragma unroll
        for (int j = 0; j < 8; ++j) pb[j] = (f16)p[8 * s2 + j];
#pragma unroll
        for (int dt = 0; dt < NDT; ++dt) o[dt] = __builtin_amdgcn_mfma_f32_32x32x16_f16(vf[s2 * NDT + dt], pb, o[dt], 0, 0, 0);
    }
}
__device__ __forceinline__ float rowmax16(const f32x16& s) { float a = max3f(s[0], s[1], s[2]), b = max3f(s[3], s[4], s[5]);
    a = max3f(a, s[6], s[7]); b = max3f(b, s[8], s[9]); a = max3f(a, s[10], s[11]); b = max3f(b, s[12], s[13]); a = max3f(a, s[14], s[15]); return fmaxf(a, b); }
template <int NDT>
__device__ __forceinline__ float rescale(float mx, float& m, float& l, f32x16 (&o)[NDT], f32x16& negm, bool& started) {
    const bool quiet = started ? (mx <= THR) : (mx == -INFINITY);
    if (__all(quiet)) return 0.f;
    float d = 0.f, alpha = 1.f;
    if (started) { d = fmaxf(mx, 0.f); alpha = __builtin_amdgcn_exp2f(-d); }
    else if (mx > -INFINITY) { d = mx; started = true; }
    m += d; l *= alpha;
#pragma unroll
    for (int dt = 0; dt < NDT; ++dt)
#pragma unroll
        for (int r = 0; r < 16; ++r) o[dt][r] *= alpha;
#pragma unroll
    for (int r = 0; r < 16; ++r) negm[r] = -m;
    return d;
}
__device__ __forceinline__ float expsum(f32x16& s, float d) { float ps = 0.f;
    if (__any(d != 0.f)) {
#pragma unroll
        for (int r = 0; r < 16; ++r) s[r] -= d; }
#pragma unroll
    for (int r = 0; r < 16; ++r) { s[r] = __builtin_amdgcn_exp2f(s[r]); ps += s[r]; }
    return ps; }
template <int NDT>
__device__ __forceinline__ void step64(LAS unsigned char* slot, const Addr<NDT>& a, const f16x8 (&qf)[4], f32x16 (&o)[NDT], float& m, float& l, f32x16& negm, bool& started) {
    f16x8 kf[8], va[2 * NDT], vb[2 * NDT];
    load_k<NDT>(slot, a, 0, kf); load_k<NDT>(slot, a, 8192, kf + 4);
    load_v<NDT>(slot, a, 0, va);
    AT_SCHED();
    f32x16 s0 = qk32(kf, qf, negm), s1 = qk32(kf + 4, qf, negm);
    AT_SCHED();
    load_v<NDT>(slot, a, 8192, vb);
    float mx = fmaxf(rowmax16(s0), rowmax16(s1)); mx = fmaxf(mx, __shfl_xor(mx, 32));
    const float d = rescale<NDT>(mx, m, l, o, negm, started);
    l += expsum(s0, d) + expsum(s1, d);
    AT_SCHED();
    pv32<NDT>(va, s0, o); pv32<NDT>(vb, s1, o);
    AT_SCHED();
}

__device__ __forceinline__ void diff_unit(int u, const f16* Z, f16* Y, const float* subln, float lam, LAS unsigned char* lds) {
    const int tid = opaque_tid(), lane = tid & 63, wave = __builtin_amdgcn_readfirstlane(tid >> 6);
    const int qb = u & 15, h = (u >> 4) & 3, b = u >> 6;
    const int map = wave >> 2, r32 = lane & 31, hh = lane >> 5;
    const long tokbase = (long)b * SEQ;
    const long qrow = tokbase + qb * 128 + (wave & 3) * 32 + r32;
    const int kcol = 1536 + 128 * h, vcol = 2560 + 128 * h;
    constexpr int NT = 36;
#define DIFF_ROWBASE(t) ((t) < 32 ? tokbase + 64 * (t) : (long)NTOK + b * CTXL + 64 * ((t) - 32))
#pragma unroll
    for (int t = 0; t < 3; ++t) dma_tile(Z, DIFF_ROWBASE(t), kcol, vcol, lds + t * SLOT, wave, lane);
    f16x8 qf[4];
#pragma unroll
    for (int st = 0; st < 4; ++st) qf[st] = *(const f16x8*)(Z + (size_t)qrow * ZP0 + 512 + 128 * h + 64 * map + 16 * st + 8 * hh);
    asm volatile("" : "+v"(qf[0]), "+v"(qf[1]), "+v"(qf[2]), "+v"(qf[3]));
    const Addr<4> ad = make_addr<4>(0, 8 * map, 0, lane);
    f32x16 o[4];
#pragma unroll
    for (int dt = 0; dt < 4; ++dt)
#pragma unroll
        for (int r = 0; r < 16; ++r) o[dt][r] = 0.f;
    float m = 0.f, l = 0.f; bool started = false;
    f32x16 negm;
#pragma unroll
    for (int r = 0; r < 16; ++r) negm[r] = 0.f;
    for (int t = 0; t < NT; ++t) {
        wait_tile(NT - 1 - t);
        __builtin_amdgcn_s_barrier();
        if (t + 3 < NT) dma_tile(Z, DIFF_ROWBASE(t + 3), kcol, vcol, lds + ((t + 3) & 3) * SLOT, wave, lane);
        step64<4>(lds + (t & 3) * SLOT, ad, qf, o, m, l, negm, started);
    }
#undef DIFF_ROWBASE
    __syncthreads();
    const float linv = 1.f / (l + __shfl_xor(l, 32));
    LAS float* cb = (LAS float*)lds + (wave & 3) * 4096;
    if (map == 1) {
#pragma unroll
        for (int dt = 0; dt < 4; ++dt)
#pragma unroll
            for (int r = 0; r < 16; ++r) cb[(dt * 16 + r) * 64 + lane] = o[dt][r] * linv;
    }
    __syncthreads();
    if (map == 0) {
        float ss = 0.f;
#pragma unroll
        for (int dt = 0; dt < 4; ++dt)
#pragma unroll
            for (int r = 0; r < 16; ++r) { const float d = o[dt][r] * linv - lam * cb[(dt * 16 + r) * 64 + lane]; o[dt][r] = d; ss += d * d; }
        ss += __shfl_xor(ss, 32);
        const float rstd = 0.8f / sqrtf(ss * (1.f / 128.f) + EPS);
        f16* yr = Y + (size_t)qrow * DM + 512 + 128 * h;
#pragma unroll
        for (int dt = 0; dt < 4; ++dt)
#pragma unroll
            for (int rg = 0; rg < 4; ++rg) { const int d0 = 32 * dt + 8 * rg + 4 * hh; const f32x4 sg = *(const f32x4*)(subln + d0);
                u32x2 w; w.x = pkh(o[dt][4 * rg] * rstd * sg[0], o[dt][4 * rg + 1] * rstd * sg[1]); w.y = pkh(o[dt][4 * rg + 2] * rstd * sg[2], o[dt][4 * rg + 3] * rstd * sg[3]);
                *(u32x2*)(yr + d0) = w; }
    }
    __syncthreads();
}

__device__ __forceinline__ void na_unit(int u, const f16* Z, f16* Y, const float* rpb, LAS unsigned char* lds) {
    const int tid = opaque_tid(), lane = tid & 63, wave = __builtin_amdgcn_readfirstlane(tid >> 6);
    const int rp = u & 15, hp = (u >> 4) & 3, b = u >> 6;
    const int hs = wave >> 2, a = wave & 3, head = 2 * hp + hs, r32 = lane & 31, hh = lane >> 5;
    const int r0 = 2 * rp, qr = r0 + (r32 >> 4), qc = 16 * a + (r32 & 15);
    const int rsq = min(max(qr - 4, 0), 24), csq = min(max(qc - 8, 0), 48);
    const int lo = min(max(r0 - 4, 0), 24), hi = min(max(r0 + 1 - 4, 0), 24) + 8;
    const int seg = (a == 0) ? 0 : (a == 1) ? 8 : (a == 2) ? 24 : 32;
    const long tokbase = (long)b * SEQ;
    const long qrow = tokbase + qr * 64 + qc;
    const int kcol = 1024 + 128 * hp, vcol = 2048 + 128 * hp;
    const int nwin = hi - lo, NT = nwin + 4;
#define NA_ROWBASE(t) ((t) < nwin ? tokbase + (lo + (t)) * 64 : (long)NTOK + b * CTXL + 64 * ((t) - nwin))
    LAS float* tab = (LAS float*)(lds + RPB_OFF);
    for (int i = tid; i < 2 * 465; i += 512) tab[i] = rpb[(2 * hp) * 465 + i] * LOG2E;
#pragma unroll
    for (int t = 0; t < 3; ++t) dma_tile(Z, NA_ROWBASE(t), kcol, vcol, lds + t * SLOT, wave, lane);
    f16x8 qf[4];
#pragma unroll
    for (int st = 0; st < 4; ++st) qf[st] = *(const f16x8*)(Z + (size_t)qrow * ZP0 + 64 * head + 16 * st + 8 * hh);
    asm volatile("" : "+v"(qf[0]), "+v"(qf[1]), "+v"(qf[2]), "+v"(qf[3]));
    const Addr<2> aw = make_addr<2>(seg, 8 * hs, 8 * hs, lane), ac = make_addr<2>(0, 8 * hs, 8 * hs, lane);
    f32x16 o[2];
#pragma unroll
    for (int dt = 0; dt < 2; ++dt)
#pragma unroll
        for (int r = 0; r < 16; ++r) o[dt][r] = 0.f;
    float m = 0.f, l = 0.f; bool started = false;
    f32x16 negm;
#pragma unroll
    for (int r = 0; r < 16; ++r) negm[r] = 0.f;
    for (int t = 0; t < NT; ++t) {
        wait_tile(NT - 1 - t);
        __builtin_amdgcn_s_barrier();
        if (t + 3 < NT) dma_tile(Z, NA_ROWBASE(t + 3), kcol, vcol, lds + ((t + 3) & 3) * SLOT, wave, lane);
        LAS unsigned char* slot = lds + (t & 3) * SLOT;
        if (t < nwin) {
            const int krow = lo + t;
            f16x8 kf[4], va[4];
            load_k<2>(slot, aw, 0, kf); load_v<2>(slot, aw, 0, va);
            AT_SCHED();
            f32x16 s = qk32(kf, qf, negm);
            const bool rowok = (krow >= rsq) && (krow < rsq + 8);
            const int rbase = (krow - qr + 7) * 31 + 15 - qc;
            float bias[16];
#pragma unroll
            for (int r = 0; r < 16; ++r) { const int kc = seg + (r & 3) + 8 * (r >> 2) + 4 * hh; bias[r] = tab[hs * 465 + min(max(rbase + kc, 0), 464)]; asm volatile("" : "+v"(bias[r])); }
#pragma unroll
            for (int r = 0; r < 16; ++r) { const int kc = seg + (r & 3) + 8 * (r >> 2) + 4 * hh; const bool ok = rowok && (kc >= csq) && (kc < csq + 16);
                s[r] = ok ? s[r] + bias[r] : -INFINITY; }
            float mx = rowmax16(s); mx = fmaxf(mx, __shfl_xor(mx, 32));
            const float d = rescale<2>(mx, m, l, o, negm, started);
            l += expsum(s, d);
            pv32<2>(va, s, o);
        } else {
            step64<2>(slot, ac, qf, o, m, l, negm, started);
        }
    }
#undef NA_ROWBASE
    const float linv = 1.f / (l + __shfl_xor(l, 32));
    f16* yr = Y + (size_t)qrow * DM + 64 * head;
#pragma unroll
    for (int dt = 0; dt < 2; ++dt)
#pragma unroll
        for (int rg = 0; rg < 4; ++rg) { const int d0 = 32 * dt + 8 * rg + 4 * hh;
            u32x2 w; w.x = pkh(o[dt][4 * rg] * linv, o[dt][4 * rg + 1] * linv); w.y = pkh(o[dt][4 * rg + 2] * linv, o[dt][4 * rg + 3] * linv);
            *(u32x2*)(yr + d0) = w; }
    __syncthreads();
}

__device__ __forceinline__ void attn_phase(const f16* Z, f16* Y, const float* rpb, const float* subln, const float* lamp, LAS unsigned char* lds, int rep = 0) {
    const float lam = *lamp;
    const int ulo = (rep == 3) ? 1024 : 0, uhi = (rep == 2) ? 1024 : 2048;
    for (int u = ulo + blockIdx.x; u < uhi; u += gridDim.x) {
        if (u < 1024) diff_unit(u, Z, Y, subln, lam, lds);
        else na_unit(u - 1024, Z, Y, rpb, lds);
    }
}
}

__device__ __forceinline__ void conv_phase(const f16* Z1, f16* Y, const float* scw, const float* cfw, const float* cfb, const float* lng, const float* lnb, LAS unsigned char* lds) {
    const int tid = opaque_tid(), lane = tid & 63, wave = __builtin_amdgcn_readfirstlane(tid >> 6);
    LAS float* U = (LAS float*)lds;
    float cw[31];
#pragma unroll
    for (int k = 0; k < 31; ++k) cw[k] = cfw[k * 512 + tid];
    const float cb = cfb[tid];
    for (int u = blockIdx.x; u < NTOK / 32; u += gridDim.x) {
        const int b = u >> 6, t0 = (u & 63) * 32;
        const f16* zb = Z1 + (size_t)b * SEQ * ZP1;
        {
            f16x4 av[16], gv[16];
#pragma unroll
            for (int pass = 0; pass < 16; ++pass) { const int row = pass * 4 + (tid >> 7), c4 = (tid & 127) * 4, tt = t0 - 15 + row; const bool ok = row < 62 && tt >= 0 && tt < SEQ;
                const int tc = ok ? tt : (t0 < SEQ ? t0 : 0);
                av[pass] = *(const f16x4*)(zb + (size_t)tc * ZP1 + 1536 + c4); gv[pass] = *(const f16x4*)(zb + (size_t)tc * ZP1 + 2048 + c4); }
#pragma unroll
            for (int pass = 0; pass < 16; ++pass) { const int row = pass * 4 + (tid >> 7), c4 = (tid & 127) * 4, tt = t0 - 15 + row; const bool ok = tt >= 0 && tt < SEQ;
                if (row < 62) { f32x4 uv;
#pragma unroll
                    for (int j = 0; j < 4; ++j) uv[j] = ok ? (float)av[pass][j] * __builtin_amdgcn_rcpf(1.f + __builtin_amdgcn_exp2f(-LOG2E * (float)gv[pass][j])) : 0.f;
                    *(LAS f32x4*)(U + row * 512 + c4) = uv; } }
        }
        __syncthreads();
        float uu[62];
#pragma unroll
        for (int i = 0; i < 62; ++i) uu[i] = U[i * 512 + tid];
        __syncthreads();
#pragma unroll
        for (int tt = 0; tt < 32; ++tt) { float v = cb;
#pragma unroll
            for (int k = 0; k < 31; ++k) v += cw[k] * uu[tt + k];
            U[tt * 512 + tid] = v; }
        __syncthreads();
#pragma unroll
        for (int q = 0; q < 4; ++q) { const int tt = wave * 4 + q, t = t0 + tt, c8 = lane * 8;
            const f32x4 x0 = *(const LAS f32x4*)(U + tt * 512 + c8), x1 = *(const LAS f32x4*)(U + tt * 512 + c8 + 4);
            float x[8] = {x0[0], x0[1], x0[2], x0[3], x1[0], x1[1], x1[2], x1[3]};
            float s = 0.f;
#pragma unroll
            for (int j = 0; j < 8; ++j) s += x[j];
            const float mean = wave_sum(s) * (1.f / 512.f); float s2 = 0.f;
#pragma unroll
            for (int j = 0; j < 8; ++j) { x[j] -= mean; s2 += x[j] * x[j]; }
            const float rstd = 1.0f / sqrtf(wave_sum(s2) * (1.f / 512.f) + EPS);
            const f32x4 g0 = *(const f32x4*)(lng + c8), g1 = *(const f32x4*)(lng + c8 + 4), b0 = *(const f32x4*)(lnb + c8), b1 = *(const f32x4*)(lnb + c8 + 4);
            const float gg[8] = {g0[0], g0[1], g0[2], g0[3], g1[0], g1[1], g1[2], g1[3]}, bb[8] = {b0[0], b0[1], b0[2], b0[3], b1[0], b1[1], b1[2], b1[3]};
            float yd[8];
#pragma unroll
            for (int j = 0; j < 8; ++j) yd[j] = silu_f(x[j] * rstd * gg[j] + bb[j]);
            f16* yr = Y + ((size_t)b * SEQ + t) * DM;
            { u32x4 w; w.x = pkh(yd[0], yd[1]); w.y = pkh(yd[2], yd[3]); w.z = pkh(yd[4], yd[5]); w.w = pkh(yd[6], yd[7]); *(u32x4*)(yr + 512 + c8) = w; }
            float cacc[8];
#pragma unroll
            for (int j = 0; j < 8; ++j) cacc[j] = 0.f;
#pragma unroll
            for (int k = 0; k < 3; ++k) { const int ts = t + k - 1;
                if (ts >= 0 && ts < SEQ) { const f16x8 xc = *(const f16x8*)(zb + (size_t)ts * ZP1 + c8), gc = *(const f16x8*)(zb + (size_t)ts * ZP1 + 1024 + c8);
                    const f32x4 w0 = *(const f32x4*)(scw + k * 512 + c8), w1 = *(const f32x4*)(scw + k * 512 + c8 + 4);
                    const float ww[8] = {w0[0], w0[1], w0[2], w0[3], w1[0], w1[1], w1[2], w1[3]};
#pragma unroll
                    for (int j = 0; j < 8; ++j) cacc[j] += ww[j] * ((float)gc[j] * (float)xc[j]); } }
            const f16x8 gb = *(const f16x8*)(zb + (size_t)t * ZP1 + 512 + c8);
            { u32x4 w; w.x = pkh((float)gb[0] * cacc[0], (float)gb[1] * cacc[1]); w.y = pkh((float)gb[2] * cacc[2], (float)gb[3] * cacc[3]);
              w.z = pkh((float)gb[4] * cacc[4], (float)gb[5] * cacc[5]); w.w = pkh((float)gb[6] * cacc[6], (float)gb[7] * cacc[7]); *(u32x4*)(yr + c8) = w; }
        }
        __syncthreads();
    }
}

constexpr int NPHASE = 18;
__global__ void __launch_bounds__(512, 2) fwd(Params p) {
    extern __shared__ __attribute__((aligned(16))) unsigned char lds_raw[];
    LAS unsigned char* lds = (LAS unsigned char*)lds_raw;
    const int tid = threadIdx.x;
    unsigned char* ws = p.ws;
    for (int u = tid; u < (LDS_BYTES - LDSCTL_OFF) / 4; u += 512) ((LAS unsigned*)(lds + LDSCTL_OFF))[u] = 0u;
    __syncthreads();
    XcdBarrier bar; bar.bar = (unsigned*)(ws + WS_CTL) + 4096; bar.x = 0; bar.st = nullptr;
    if (N_LAUNCH_MODE == 1) bar = xcd_barrier_post((unsigned*)(ws + WS_CTL) + 4096, (volatile LAS unsigned*)(lds + MISC_OFF) + 8);
    const int lo = p.ph_lo, hi = p.ph_hi, rep = p.alt;
#ifndef ONLYP
#define ONLYP -1
#endif
#define IN(k) ((ONLYP < 0 || ONLYP == (k)) && lo <= (k) && (k) < hi)
#define SEAM(k) do { if (IN(k) && IN((k) + 1)) xcd_barrier(bar); } while (0)
    const int G = gridDim.x, c = blockIdx.x;
    float* mod0 = (float*)(ws + WS_MOD + MOD0_OFF); float* mod1 = (float*)(ws + WS_MOD + MOD1_OFF);
    f16* H = (f16*)(ws + WS_H); f16* Z = (f16*)(ws + WS_Z); f16* Y = (f16*)(ws + WS_Y); f16* XIN = (f16*)(ws + WS_XIN); f16* HID = (f16*)(ws + WS_HID); f16* Y2 = (f16*)(ws + WS_Y2);
    f16* W13 = (f16*)(ws + WS_W13); f16* W2T = (f16*)(ws + WS_W2);
    float* AFF = (float*)(ws + WS_AFF); int* IDX = (int*)(ws + WS_IDX); float* GV = (float*)(ws + WS_G); short* INV = (short*)(ws + WS_INV);

    if (IN(0)) { phase_prologue(p, lds); } SEAM(0);
    if (IN(1)) { NormArgs a{}; a.src = p.in[I_X]; a.gain = p.in[I_L0_NORM1]; a.shift = mod0; a.scale = mod0 + 1024; a.mstride = 6144; a.hout = H;
        norm_phase<4>(a, lds, true, p.in[I_CTX], mod0 + 16 * 6144, mod0 + 16 * 6144 + 1024); } SEAM(1);
    if (IN(2)) { gm::Gemm g{H, (const f16*)(ws + WS_WIN0), DM, 0, 0}; gm::Order S; S.init(NROWS, ZP0, 1, G, c);
        gm::EpiInProj0 E{Z, (const float*)(ws + WS_MOD + ROPE_OFF)}; gm::gemm_phase<false>(lds, g, S, E); } SEAM(2);
    if (IN(3)) { at::attn_phase(Z, Y, p.in[I_L0_RPB], p.in[I_L0_SUBLN], (const float*)(ws + WS_MOD + LAM_OFF), lds, rep); } SEAM(3);
    if (IN(4)) { gm::Gemm g{Y, (const f16*)(ws + WS_WOUT0), DM, 0, 0}; gm::Order S; S.init(NTOK, DM, 1, G, c);
        gm::EpiResGate E{p.in[I_X], p.out, mod0 + 2048, 6144}; gm::gemm_phase<false>(lds, g, S, E); } SEAM(4);
    if (IN(5)) { NormArgs a{}; a.src = p.out; a.gain = p.in[I_L0_NORM2]; a.shift = mod0 + 3072; a.scale = mod0 + 4096; a.mstride = 6144; a.hout = H; a.wr = p.in[I_L0_WR]; a.aff = AFF; a.hbf = MOE_BF16;
        norm_phase<4>(a, lds, false, nullptr, nullptr, nullptr); } SEAM(5);
    if (IN(6)) { topk_phase(AFF, IDX, GV, INV, H, XIN, lds); } SEAM(6);
    if (IN(7)) { gm::Gemm g{H, W13, DM, 0, (long)2 * DE * DM, IDX}; gm::Order S; S.init(EROWS, 2 * DE, NE, G, c);
        gm::EpiSwiGLU E{HID}; gm::gemm_phase<MOE_BF16, true>(lds, g, S, E); } SEAM(7);
    if (IN(8)) { gm::Gemm g{HID, W2T, DE, (long)EROWS * DE, (long)DM * DE}; gm::Order S; S.init(EROWS, DM, NE, G, c, 1);
        gm::EpiRowScale E{Y2, GV}; gm::gemm_phase<MOE_BF16>(lds, g, S, E); } SEAM(8);
    if (IN(9)) { NormArgs a{}; a.src = p.out; a.xout = rep ? (float*)(ws + WS_BIG) : p.out; a.y2 = Y2; a.inv = INV; a.gate2 = mod0 + 5120; a.gain = p.in[I_L1_NORM1]; a.shift = mod1; a.scale = mod1 + 1024; a.mstride = 6144; a.hout = rep ? (f16*)(ws + WS_BIG + 128 * MiB) : H;
        norm_phase<2>(a, lds, false, nullptr, nullptr, nullptr);
        cvt_moe(p.in[I_L1_W1], p.in[I_L1_W3], p.in[I_L1_W2], W13, W2T, c * 8 + (tid >> 6), G * 8, tid & 63, lds + (tid >> 6) * CVT_SCR); } SEAM(9);
    if (IN(10)) { gm::Gemm g{H, (const f16*)(ws + WS_WIN1), DM, 0, 0}; gm::Order S; S.init(NTOK, ZP1, 1, G, c);
        gm::EpiF16 E{Z, ZP1}; gm::gemm_phase<false>(lds, g, S, E); } SEAM(10);
    if (IN(11)) { conv_phase(Z, Y, p.in[I_L1_SCW], p.in[I_L1_CFW], p.in[I_L1_CFB], p.in[I_L1_LNG], p.in[I_L1_LNB], lds); } SEAM(11);
    if (IN(12)) { gm::Gemm g{Y, (const f16*)(ws + WS_WOUT1), DM, 0, 0}; gm::Order S; S.init(NTOK, DM, 1, G, c);
        gm::EpiResGate E{p.out, rep ? (float*)(ws + WS_XIN) : p.out, mod1 + 2048, 6144}; gm::gemm_phase<false>(lds, g, S, E); } SEAM(12);
    if (IN(13)) { NormArgs a{}; a.src = p.out; a.gain = p.in[I_L1_NORM2]; a.shift = mod1 + 3072; a.scale = mod1 + 4096; a.mstride = 6144; a.hout = H; a.wr = p.in[I_L1_WR]; a.aff = AFF; a.hbf = MOE_BF16;
        norm_phase<4>(a, lds, false, nullptr, nullptr, nullptr); } SEAM(13);
    if (IN(14)) { topk_phase(AFF, IDX, GV, INV, H, XIN, lds); } SEAM(14);
    if (IN(15)) { gm::Gemm g{H, W13, DM, 0, (long)2 * DE * DM, IDX}; gm::Order S; S.init(EROWS, 2 * DE, NE, G, c);
        gm::EpiSwiGLU E{HID}; gm::gemm_phase<MOE_BF16, true>(lds, g, S, E); } SEAM(15);
    if (IN(16)) { gm::Gemm g{HID, W2T, DE, (long)EROWS * DE, (long)DM * DE}; gm::Order S; S.init(EROWS, DM, NE, G, c, 1);
        gm::EpiRowScale E{Y2, GV}; gm::gemm_phase<MOE_BF16>(lds, g, S, E); } SEAM(16);
    if (IN(17)) { NormArgs a{}; a.src = p.out; a.xout = p.out; a.y2 = Y2; a.inv = INV; a.gate2 = mod1 + 5120; a.gain = p.in[I_FNORM]; a.fout = rep ? (float*)(ws + WS_BIG) : p.out;
        norm_phase<2>(a, lds, false, nullptr, nullptr, nullptr); }
#undef IN
#undef SEAM
}

extern "C" void kernel_launch(void* const* d_in, const int* in_sizes, int n_in, void* d_out, int out_size, void* d_ws, size_t ws_size, hipStream_t stream) {
    static int grid = 0;
    if (grid == 0) {
        if (n_in != 36 || out_size != NTOK * DM || ws_size < WS_END) { fprintf(stderr, "kernel_launch: unexpected shapes (n_in %d out %d ws %zu need %zu)\n", n_in, out_size, ws_size, (size_t)WS_END); grid = -1; return; }
        int dev = 0, cus = 0;
        if (hipGetDevice(&dev) != hipSuccess || hipDeviceGetAttribute(&cus, hipDeviceAttributeMultiprocessorCount, dev) != hipSuccess) { grid = -1; return; }
        if (hipFuncSetAttribute((const void*)fwd, hipFuncAttributeMaxDynamicSharedMemorySize, LDS_BYTES) != hipSuccess) { fprintf(stderr, "kernel_launch: hipFuncSetAttribute failed\n"); grid = -1; return; }
        int per_cu = 0;
        if (hipOccupancyMaxActiveBlocksPerMultiprocessor(&per_cu, (const void*)fwd, 512, LDS_BYTES) != hipSuccess || per_cu < 1) fprintf(stderr, "kernel_launch: occupancy query says %d\n", per_cu);
        (void)hipGetLastError();
        grid = cus;
    }
    if (grid < 0) return;
    (void)hipMemsetAsync((char*)d_ws + WS_CTL, 0, CTL_ZERO_BYTES, stream);
    Params p{};
    for (int i = 0; i < 36; ++i) p.in[i] = (const float*)d_in[i];
    p.out = (float*)d_out; p.ws = (unsigned char*)d_ws;
#if N_LAUNCH_MODE == 1
    p.ph_lo = 0; p.ph_hi = NPHASE;
    hipLaunchKernelGGL(fwd, dim3(grid), dim3(512), LDS_BYTES, stream, p);
#else
    for (int k = 0; k < NPHASE; ++k) { p.ph_lo = k; p.ph_hi = k + 1; p.alt = 0; hipLaunchKernelGGL(fwd, dim3(grid), dim3(512), LDS_BYTES, stream, p);
        for (int r = 0; r < HOSTDUP_N; ++r) if ((HOSTDUP >> k) & 1) { p.alt = HOSTDUP_ALT; hipLaunchKernelGGL(fwd, dim3(grid), dim3(512), LDS_BYTES, stream, p); } }
#endif
}
```

```cpp
#include <hip/hip_runtime.h>
#include <cstdio>
#include <cstdint>

#define LAS __attribute__((address_space(3)))
#define GAS __attribute__((address_space(1)))
typedef _Float16 f16;
typedef _Float16 f16x8 __attribute__((ext_vector_type(8)));
typedef _Float16 f16x4 __attribute__((ext_vector_type(4)));
typedef _Float16 f16x2 __attribute__((ext_vector_type(2)));
typedef float f32x2 __attribute__((ext_vector_type(2)));
typedef float f32x4 __attribute__((ext_vector_type(4)));
typedef float f32x16 __attribute__((ext_vector_type(16)));
typedef unsigned u32x2 __attribute__((ext_vector_type(2)));
typedef unsigned u32x4 __attribute__((ext_vector_type(4)));
typedef short s16x4 __attribute__((ext_vector_type(4)));

#ifndef MOE_BF16
#define MOE_BF16 true
#endif
#ifndef HOSTDUP
#define HOSTDUP 0
#endif
#ifndef HOSTDUP_ALT
#define HOSTDUP_ALT 1
#endif
#ifndef HOSTDUP_N
#define HOSTDUP_N 1
#endif
#ifndef N_LAUNCH_MODE
#define N_LAUNCH_MODE 1
#endif

constexpr int NB = 16, SEQ = 2048, DM = 1024, NTOK = NB * SEQ, CTXL = 256, NCTX = NB * CTXL, NROWS = NTOK + NCTX;
constexpr int ZP0 = 3072, ZP1 = 2560;
constexpr int NE = 16, DE = 2816, CAP = 256, EROWS = NB * CAP;
constexpr float EPS = 1e-6f;
constexpr float LOG2E = 1.4426950408889634f;
constexpr float QSCALE = 0.125f * LOG2E;

constexpr size_t MiB = 1u << 20;
constexpr size_t WS_CTL = 0, CTL_ZERO_BYTES = 256 * 1024;
constexpr size_t WS_MOD = 1 * MiB;
constexpr size_t MOD0_OFF = 0, MOD1_OFF = 17 * 6144 * 4, ROPE_OFF = MOD1_OFF + 16 * 6144 * 4, LAM_OFF = ROPE_OFF + 64 * 16 * 2 * 4;
constexpr size_t WS_WIN0 = 2 * MiB, WS_WOUT0 = 8 * MiB, WS_WIN1 = 10 * MiB, WS_WOUT1 = 15 * MiB;
constexpr size_t WS_AFF = 17 * MiB;
constexpr size_t WS_IDX = 19 * MiB;
constexpr size_t WS_G = 19 * MiB + 512 * 1024;
constexpr size_t WS_INV = 20 * MiB;
constexpr size_t WS_W13 = 22 * MiB;
constexpr size_t WS_W2 = WS_W13 + 176 * MiB;
constexpr size_t WS_H = WS_W2 + 88 * MiB;
constexpr size_t WS_XIN = WS_H + 72 * MiB;
constexpr size_t WS_Y2 = WS_XIN + 128 * MiB;
constexpr size_t WS_BIG = WS_Y2 + 128 * MiB;
constexpr size_t WS_Z = WS_BIG, WS_Y = WS_BIG + 216 * MiB, WS_HID = WS_BIG;
constexpr size_t WS_END = WS_BIG + 352 * MiB;

constexpr int RING_BYTES = 131072;
constexpr int LDSCTL_OFF = RING_BYTES, MISC_OFF = LDSCTL_OFF + 320;
constexpr int LDS_BYTES = 147456;

#define RLX_AGENT __ATOMIC_RELAXED, __HIP_MEMORY_SCOPE_AGENT
#define LDS_WAIT() asm volatile("s_waitcnt lgkmcnt(0)" ::: "memory")
#define VM_WAIT() asm volatile("s_waitcnt vmcnt(0)" ::: "memory")

__device__ __forceinline__ unsigned pkh(float lo, float hi) { f16x2 v; v.x = (f16)lo; v.y = (f16)hi; return __builtin_bit_cast(unsigned, v); }
typedef __bf16 bf16x2_t __attribute__((ext_vector_type(2)));
typedef short s16x8 __attribute__((ext_vector_type(8)));
__device__ __forceinline__ unsigned pkb(float lo, float hi) { f32x2 v = {lo, hi}; bf16x2_t b = __builtin_convertvector(v, bf16x2_t); return __builtin_bit_cast(unsigned, b); }
template <bool BF> __device__ __forceinline__ unsigned pk16(float lo, float hi) { return BF ? pkb(lo, hi) : pkh(lo, hi); }
__device__ __forceinline__ float silu_f(float v) { return v / (1.f + __expf(-v)); }

#define XB_TMO      128
#define XB_XCNT(j)  (256  + 64 * (j))
#define XB_XSUB(j)  (1280 + 64 * (j))
#define XB_XGEN(j)  (2304 + 64 * (j))
#define XB_TOP      3328
#define XB_TOPGEN   3392
#define XCD_BAR_WORDS 3456
#define XB_SPIN_CAP (1u << 18)
__device__ __forceinline__ unsigned xb_ld(unsigned* p)              { return __hip_atomic_load(p, __ATOMIC_RELAXED, __HIP_MEMORY_SCOPE_AGENT); }
__device__ __forceinline__ unsigned xb_add(unsigned* p, unsigned v) { return __hip_atomic_fetch_add(p, v, __ATOMIC_RELAXED, __HIP_MEMORY_SCOPE_AGENT); }
__device__ __forceinline__ unsigned xb_xcc_id() { return (unsigned)__builtin_amdgcn_s_getreg((3 << 11) | 20) & 0xFu; }
#define XB_SPIN(cond, bar) do { unsigned _sp = 0; while (cond) { __builtin_amdgcn_s_sleep(1); \
    if ((++_sp & 255u) == 0u) { if (xb_ld(&(bar)[XB_TMO])) break; if (_sp > XB_SPIN_CAP) { atomicAdd(&(bar)[XB_TMO], 1u); break; } } } } while (0)
struct XcdBarrier { unsigned* bar; unsigned x; volatile LAS unsigned* st; };
__device__ __forceinline__ XcdBarrier xcd_barrier_post(unsigned* bar, volatile LAS unsigned* st) {
    XcdBarrier b; b.bar = bar; b.x = xb_xcc_id(); b.st = st;
    if (threadIdx.x == 0) (void)xb_add(&bar[XB_XCNT(b.x)], 1u);
    return b;
}
__device__ __forceinline__ void xcd_barrier_complete(unsigned* bar, unsigned x, unsigned& nloc, unsigned& nx) {
    const unsigned G = gridDim.x * gridDim.y * gridDim.z;
    unsigned sum, cnt, mine, sp = 0u;
    for (;;) {
        sum = 0u; cnt = 0u; mine = 0u;
#pragma unroll
        for (unsigned j = 0; j < 16; ++j) { const unsigned c = xb_ld(&bar[XB_XCNT(j)]); sum += c; cnt += (c > 0u) ? 1u : 0u; mine = (j == x) ? c : mine; }
        if (sum == G) break;
        __builtin_amdgcn_s_sleep(1);
        if ((++sp & 255u) == 0u) { if (xb_ld(&bar[XB_TMO])) break; if (sp > XB_SPIN_CAP) { atomicAdd(&bar[XB_TMO], 1u); break; } }
    }
    nloc = mine > 0u ? mine : 1u; nx = cnt > 0u ? cnt : 1u;
}
__device__ __forceinline__ void xcd_barrier(const XcdBarrier& b) {
    asm volatile("s_waitcnt vmcnt(0)" ::: "memory");
    __syncthreads();
    if (threadIdx.x == 0) {
        unsigned* bar = b.bar;
        __builtin_amdgcn_s_waitcnt(0);
        unsigned nloc = b.st[0], nx = b.st[1];
        if (nloc == 0u) { xcd_barrier_complete(bar, b.x, nloc, nx); b.st[0] = nloc; b.st[1] = nx; }
        const unsigned old = xb_add(&bar[XB_XSUB(b.x)], 1u);
        const unsigned gen = old / nloc;
        if (old + 1u == (gen + 1u) * nloc) {
            __builtin_amdgcn_fence(__ATOMIC_RELEASE, "agent");
            asm volatile("s_waitcnt vmcnt(0)" ::: "memory");
            const unsigned og = xb_add(&bar[XB_TOP], 1u);
            const unsigned tg = og / nx;
            if (og + 1u == (tg + 1u) * nx) xb_add(&bar[XB_TOPGEN], 1u);
            else XB_SPIN(xb_ld(&bar[XB_TOPGEN]) == tg, bar);
            __builtin_amdgcn_fence(__ATOMIC_ACQUIRE, "agent");
            xb_add(&bar[XB_XGEN(b.x)], 1u);
            asm volatile("s_waitcnt vmcnt(0)" ::: "memory");
        } else {
            XB_SPIN(xb_ld(&bar[XB_XGEN(b.x)]) == gen, bar);
            __builtin_amdgcn_fence(__ATOMIC_ACQUIRE, "agent");
            asm volatile("s_waitcnt vmcnt(0)" ::: "memory");
        }
    }
    __syncthreads();
}

__device__ __forceinline__ int opaque_tid0() { int t = threadIdx.x; asm volatile("" : "+v"(t)); return t; }
namespace gm {
constexpr int BM = 256, BK = 64, HALF = 128, HTB = HALF * BK * 2, STAGE_BYTES = 8 * HTB, NXCD = 8, WGM = 8;
__host__ __device__ __forceinline__ int lds_byte(int r, int c) { const int st = (r >> 4) * 2 + (c >> 5), rr = r & 15, cc = c & 31, ob = rr * 64 + cc * 2; return st * 1024 + (ob ^ (((ob >> 9) & 1) << 5)); }
__host__ __device__ __forceinline__ void stage_rc(int b, int& R, int& C) { const int st = b / 1024, sb = b % 1024, swz = sb ^ (((sb >> 9) & 1) << 5); R = (st >> 1) * 16 + swz / 64; C = (st & 1) * 32 + (swz % 64) / 2; }
__host__ __device__ __forceinline__ int perm32(int rho) { const int n = rho >> 4, i = rho & 15; return 8 * (i >> 2) + 4 * n + (i & 3); }

struct Unit { int g, pm, pn; };
struct Gemm { const f16* A; const f16* Bt; int K; long sA, sB; const int* gidx; };
struct Order {
    int nM, nN, tpg, total, G, c, mode;
    __device__ void init(int M, int N, int groups, int G_, int c_, int mode_ = 0) { nM = M / BM; nN = N / BM; tpg = nM * nN; total = tpg * groups; G = G_; c = c_; mode = (mode_ == 1 && G_ == 256 && nM == 16 && nN == 4) ? 1 : 0; }
    __device__ bool next(int i, Unit& u) const {
        const long L = (long)i * G + c; if (L >= total) return false;
        if (mode == 1) { const int x = c & 7, j = c >> 3; u.g = 4 * i + (x >> 1); u.pm = 8 * (x & 1) + (j >> 2); u.pn = j & 3; return true; }
        const int g = (int)(L / tpg); int wgid = (int)(L % tpg);
        { const int q = tpg / NXCD, r = tpg % NXCD, xcd = wgid % NXCD, off = wgid / NXCD; wgid = (xcd < r ? xcd * (q + 1) : r * (q + 1) + (xcd - r) * q) + off; }
        const int nig = WGM * nN, gid = wgid / nig, fm = gid * WGM, gsz = (nM - fm) < WGM ? (nM - fm) : WGM;
        u.g = g; u.pm = fm + ((wgid % nig) % gsz); u.pn = (wgid % nig) / gsz; return true;
    }
};

typedef f32x4 Acc[2][2][4][2];
typedef __bf16 bf16x8_t __attribute__((ext_vector_type(8)));
template <bool BF> __device__ __forceinline__ f32x4 mma16(const s16x8& a, const s16x8& b, const f32x4& c) {
    if constexpr (BF) return __builtin_amdgcn_mfma_f32_16x16x32_bf16(__builtin_bit_cast(bf16x8_t, a), __builtin_bit_cast(bf16x8_t, b), c, 0, 0, 0);
    else return __builtin_amdgcn_mfma_f32_16x16x32_f16(__builtin_bit_cast(f16x8, a), __builtin_bit_cast(f16x8, b), c, 0, 0, 0);
}

struct EpiF16 {
    static constexpr bool PERM = true;
    f16* O; int ldc;
    __device__ __forceinline__ void operator()(const Acc& acc, const Unit& u, int wr, int wc, int fr, int fq) const {
        const int row0 = u.pm * BM + wr * 64 + fr, col0 = u.pn * BM + wc * 32 + 8 * fq;
#pragma unroll
        for (int ai = 0; ai < 2; ++ai)
#pragma unroll
            for (int m = 0; m < 4; ++m) { f16* rowp = O + (size_t)(row0 + ai * HALF + m * 16) * ldc + col0;
#pragma unroll
                for (int bj = 0; bj < 2; ++bj) { const f32x4 v0 = acc[ai][bj][m][0], v1 = acc[ai][bj][m][1];
                    u32x4 w; w.x = pkh(v0[0], v0[1]); w.y = pkh(v0[2], v0[3]); w.z = pkh(v1[0], v1[1]); w.w = pkh(v1[2], v1[3]);
                    *(u32x4*)(rowp + bj * HALF) = w; } }
    }
};
struct EpiInProj0 {
    static constexpr bool PERM = true;
    f16* O; const float* rope;
    __device__ __forceinline__ void operator()(const Acc& acc, const Unit& u, int wr, int wc, int fr, int fq) const {
        const int row0 = u.pm * BM + wr * 64 + fr, col0 = u.pn * BM + wc * 32 + 8 * fq;
        const float sc = (u.pn < 4) ? QSCALE : 1.f;
        const bool dorope = (u.pn == 2 || u.pn == 3 || u.pn == 6 || u.pn == 7) && (u.pm * BM < NTOK);
#pragma unroll
        for (int ai = 0; ai < 2; ++ai)
#pragma unroll
            for (int m = 0; m < 4; ++m) { const int row = row0 + ai * HALF + m * 16; f16* rowp = O + (size_t)row * ZP0 + col0;
                const int t = row & (SEQ - 1), prow = t >> 6, pcol = t & 63;
#pragma unroll
                for (int bj = 0; bj < 2; ++bj) { f32x4 v0 = acc[ai][bj][m][0] * sc, v1 = acc[ai][bj][m][1] * sc;
                    if (dorope) { const int c = col0 + bj * HALF, half = (c >> 5) & 1, i0 = (c & 31) >> 1; const int pos = half ? pcol : prow;
                        const f32x4* tp = (const f32x4*)(rope + (pos * 16 + i0) * 2); const f32x4 t0 = tp[0], t1 = tp[1];
                        f32x4 r0, r1;
                        r0[0] = v0[0] * t0[0] - v0[1] * t0[1]; r0[1] = v0[0] * t0[1] + v0[1] * t0[0];
                        r0[2] = v0[2] * t0[2] - v0[3] * t0[3]; r0[3] = v0[2] * t0[3] + v0[3] * t0[2];
                        r1[0] = v1[0] * t1[0] - v1[1] * t1[1]; r1[1] = v1[0] * t1[1] + v1[1] * t1[0];
                        r1[2] = v1[2] * t1[2] - v1[3] * t1[3]; r1[3] = v1[2] * t1[3] + v1[3] * t1[2];
                        v0 = r0; v1 = r1; }
                    u32x4 w; w.x = pkh(v0[0], v0[1]); w.y = pkh(v0[2], v0[3]); w.z = pkh(v1[0], v1[1]); w.w = pkh(v1[2], v1[3]);
                    *(u32x4*)(rowp + bj * HALF) = w; } }
    }
};
template <bool BASE16>
struct EpiResGate {
    static constexpr bool PERM = true;
    const void* base; f16* out; const float* gate; int gstride;
    __device__ __forceinline__ void operator()(const Acc& acc, const Unit& u, int wr, int wc, int fr, int fq) const {
        const int col0 = u.pn * BM + wc * 32 + 8 * fq; const int b = (u.pm * BM) / SEQ;
        f32x4 gv[2][2];
#pragma unroll
        for (int bj = 0; bj < 2; ++bj)
#pragma unroll
            for (int n = 0; n < 2; ++n) gv[bj][n] = *(const f32x4*)(gate + (size_t)b * gstride + col0 + bj * HALF + 4 * n);
#pragma unroll
        for (int ai = 0; ai < 2; ++ai)
#pragma unroll
            for (int m = 0; m < 4; ++m) { const size_t off = (size_t)(u.pm * BM + ai * HALF + wr * 64 + m * 16 + fr) * DM + col0;
#pragma unroll
                for (int bj = 0; bj < 2; ++bj) { f32x4 b0, b1;
                    if constexpr (BASE16) { const f16x8 bv = *(const f16x8*)((const f16*)base + off + bj * HALF);
                        b0 = (f32x4){(float)bv[0], (float)bv[1], (float)bv[2], (float)bv[3]}; b1 = (f32x4){(float)bv[4], (float)bv[5], (float)bv[6], (float)bv[7]}; }
                    else { b0 = *(const f32x4*)((const float*)base + off + bj * HALF); b1 = *(const f32x4*)((const float*)base + off + bj * HALF + 4); }
                    const f32x4 v0 = b0 + gv[bj][0] * acc[ai][bj][m][0], v1 = b1 + gv[bj][1] * acc[ai][bj][m][1];
                    u32x4 w; w.x = pkh(v0[0], v0[1]); w.y = pkh(v0[2], v0[3]); w.z = pkh(v1[0], v1[1]); w.w = pkh(v1[2], v1[3]);
                    *(u32x4*)(out + off + bj * HALF) = w; }
                if (m & 1) asm volatile("" ::: "memory"); }
    }
};
struct EpiSwiGLU {
    static constexpr bool PERM = true;
    f16* O;
    __device__ __forceinline__ void operator()(const Acc& acc, const Unit& u, int wr, int wc, int fr, int fq) const {
        const int row0 = u.pm * BM + wr * 64 + fr, col0 = u.pn * HALF + wc * 32 + 8 * fq;
        f16* Og = O + (size_t)u.g * EROWS * DE;
#pragma unroll
        for (int ai = 0; ai < 2; ++ai)
#pragma unroll
            for (int m = 0; m < 4; ++m) { f16* rowp = Og + (size_t)(row0 + ai * HALF + m * 16) * DE + col0;
                float h[8];
#pragma unroll
                for (int n = 0; n < 2; ++n)
#pragma unroll
                    for (int j = 0; j < 4; ++j) { const float g = acc[ai][0][m][n][j], up = acc[ai][1][m][n][j]; h[n * 4 + j] = g * up * __builtin_amdgcn_rcpf(1.f + __builtin_amdgcn_exp2f(-LOG2E * g)); }
                u32x4 w; w.x = pk16<MOE_BF16>(h[0], h[1]); w.y = pk16<MOE_BF16>(h[2], h[3]); w.z = pk16<MOE_BF16>(h[4], h[5]); w.w = pk16<MOE_BF16>(h[6], h[7]);
                *(u32x4*)rowp = w; }
    }
};
struct EpiRowScale {
    static constexpr bool PERM = true;
    f16* O; const float* gv;
    __device__ __forceinline__ void operator()(const Acc& acc, const Unit& u, int wr, int wc, int fr, int fq) const {
        const int row0 = u.pm * BM + wr * 64 + fr, col0 = u.pn * BM + wc * 32 + 8 * fq;
        f16* Og = O + (size_t)u.g * EROWS * DM;
#pragma unroll
        for (int ai = 0; ai < 2; ++ai)
#pragma unroll
            for (int m = 0; m < 4; ++m) { const int row = row0 + ai * HALF + m * 16; const float s = gv[((row >> 8) * NE + u.g) * CAP + (row & 255)];
                f16* rowp = Og + (size_t)row * DM + col0;
#pragma unroll
                for (int bj = 0; bj < 2; ++bj) { const f32x4 v0 = acc[ai][bj][m][0] * s, v1 = acc[ai][bj][m][1] * s;
                    u32x4 w; w.x = pkh(v0[0], v0[1]); w.y = pkh(v0[2], v0[3]); w.z = pkh(v1[0], v1[1]); w.w = pkh(v1[2], v1[3]);
                    *(u32x4*)(rowp + bj * HALF) = w; } }
    }
};

template <bool BF, bool GATHER = false, class Epi>
__device__ __forceinline__ void gemm_phase(LAS unsigned char* lds, const Gemm g, const Order& S, const Epi& E) {
    const int tid = opaque_tid0(), wid = __builtin_amdgcn_readfirstlane(tid >> 6), lane = tid & 63, wr = wid >> 2, wc = wid & 3, fr = lane & 15, fq = lane >> 4;
    const int K = g.K, nt = K / BK;
    unsigned voffA[2], voffB[2];
#pragma unroll
    for (int i = 0; i < 2; ++i) { int R, C; stage_rc(tid * 16 + i * 8192, R, C); const int Rb = Epi::PERM ? ((R & ~31) + perm32(R & 31)) : R;
        voffA[i] = (unsigned)(R * K + C) * 2u; voffB[i] = (unsigned)(Rb * K + C) * 2u; }
    int gR[2], gC[2];
#pragma unroll
    for (int i = 0; i < 2; ++i) { int R, C; stage_rc(tid * 16 + i * 8192, R, C); gR[i] = R; gC[i] = C; }
    unsigned gA0[2] = {0u, 0u}, gA1[2] = {0u, 0u}, nA0[2] = {0u, 0u}, nA1[2] = {0u, 0u};
    LAS unsigned short* gtab = (LAS unsigned short*)(lds + 132096);
    constexpr int GT_MAXU = 22;
#define GM_GCVT(dst0, dst1, uu, ui_) do { const LAS unsigned short* _tp = gtab + (ui_) * 256; _Pragma("unroll") for (int _i = 0; _i < 2; ++_i) { const int _t0 = _tp[gR[_i]], _t1 = _tp[128 + gR[_i]]; \
        dst0[_i] = (unsigned)((((uu).pm * SEQ + _t0) * K + gC[_i]) * 2); dst1[_i] = (unsigned)((((uu).pm * SEQ + _t1) * K + gC[_i]) * 2); } } while (0)
    const size_t kstep = (size_t)(BK * 2);
    const size_t hstep = GATHER ? (size_t)0 : (size_t)HALF * K * 2;
    const size_t hstepB = (size_t)HALF * K * 2;
    const size_t tstep = 2 * hstepB;
    const unsigned ldsw = (unsigned)wid * 1024u;
    const int aoff = lds_byte(wr * 64 + fr, fq * 8), boff = lds_byte(wc * 32 + fr, fq * 8);
#define GM_SA(b, h) (((b) * 2 + (h)) * HTB)
#define GM_SB(b, h) ((4 + (b) * 2 + (h)) * HTB)
#define GM_STAGE(bufoff, gbase, voff) do { _Pragma("unroll") for (int _i = 0; _i < 2; ++_i) \
        __builtin_amdgcn_global_load_lds((const unsigned*)((const char*)(gbase) + (voff)[_i]), (LAS unsigned*)(lds + (bufoff) + ldsw + _i * 8192), 16, 0, 0); } while (0)
#define GM_LDA(dst, b, h) do { _Pragma("unroll") for (int m = 0; m < 4; ++m) _Pragma("unroll") for (int k = 0; k < 2; ++k) dst[m][k] = *(const LAS s16x8*)(lds + GM_SA(b, h) + aoff + m * 2048 + k * 1024); } while (0)
#define GM_LDB(dst, b, h) do { _Pragma("unroll") for (int n = 0; n < 2; ++n) _Pragma("unroll") for (int k = 0; k < 2; ++k) dst[n][k] = *(const LAS s16x8*)(lds + GM_SB(b, h) + boff + n * 2048 + k * 1024); } while (0)
#define GM_MMA(ai, bj, At, Bt) do { __builtin_amdgcn_s_setprio(1); _Pragma("unroll") for (int m = 0; m < 4; ++m) _Pragma("unroll") for (int n = 0; n < 2; ++n) _Pragma("unroll") for (int k = 0; k < 2; ++k) \
        acc[ai][bj][m][n] = mma16<BF>(Bt[n][k], At[m][k], acc[ai][bj][m][n]); __builtin_amdgcn_s_setprio(0); } while (0)
#define GM_WAIT_V(n) asm volatile("s_waitcnt vmcnt(" #n ")" ::: "memory")
#define GM_WAIT_L(n) asm volatile("s_waitcnt lgkmcnt(" #n ")" ::: "memory")
#define GM_BAR __builtin_amdgcn_s_barrier()
#define GM_SCHED __builtin_amdgcn_sched_barrier(0)
    Unit cur, nxt; int ui = 0;
    if (!S.next(0, cur)) return;
    Acc acc;
#pragma unroll
    for (int a = 0; a < 2; ++a)
#pragma unroll
        for (int b = 0; b < 2; ++b)
#pragma unroll
            for (int m = 0; m < 4; ++m)
#pragma unroll
                for (int n = 0; n < 2; ++n) acc[a][b][m][n] = (f32x4){0.f, 0.f, 0.f, 0.f};
    s16x8 At[4][2], B0[2][2], B1[2][2];
    const char* cA = GATHER ? (const char*)g.A : (const char*)(g.A + (size_t)cur.g * g.sA) + (size_t)cur.pm * tstep; const char* cB = (const char*)(g.Bt + (size_t)cur.g * g.sB) + (size_t)cur.pn * tstep;
    if constexpr (GATHER) {
        int tv[GT_MAXU / 2];
#pragma unroll
        for (int j = 0; j < GT_MAXU / 2; ++j) { const int ui_ = 2 * j + (tid >> 8); Unit uu; const bool okk = S.next(ui_, uu); tv[j] = g.gidx[(okk ? (uu.pm * NE + uu.g) * CAP : 0) + (tid & 255)]; }
#pragma unroll
        for (int j = 0; j < GT_MAXU / 2; ++j) gtab[(2 * j + (tid >> 8)) * 256 + (tid & 255)] = (unsigned short)tv[j];
        __syncthreads();
        GM_GCVT(gA0, gA1, cur, 0);
    }
#define GM_STA_H0(buf, p, o0) do { if constexpr (GATHER) GM_STAGE(buf, p, o0); else GM_STAGE(buf, p, voffA); } while (0)
#define GM_STA_H1(buf, p, o1) do { if constexpr (GATHER) GM_STAGE(buf, p, o1); else GM_STAGE(buf, (p) + hstepB, voffA); } while (0)
    GM_STAGE(GM_SB(0, 0), cB, voffB); GM_STAGE(GM_SB(0, 1), cB + hstepB, voffB); GM_STA_H0(GM_SA(0, 0), cA, gA0); GM_STA_H1(GM_SA(0, 1), cA, gA1);
    if (wr == 1) GM_BAR;
    GM_WAIT_V(2); GM_BAR;
    GM_STAGE(GM_SB(1, 0), cB + kstep, voffB); GM_STA_H0(GM_SA(1, 0), cA + kstep, gA0); GM_STAGE(GM_SB(1, 1), cB + hstepB + kstep, voffB);
    GM_WAIT_V(6); GM_BAR;
    for (;;) {
        const bool has_next = S.next(ui + 1, nxt);
        const char* nA = GATHER ? cA : (has_next ? (const char*)(g.A + (size_t)nxt.g * g.sA) + (size_t)nxt.pm * tstep : cA); const char* nB = has_next ? (const char*)(g.Bt + (size_t)nxt.g * g.sB) + (size_t)nxt.pn * tstep : cB;
        if constexpr (GATHER) { if (has_next) GM_GCVT(nA0, nA1, nxt, ui + 1); else { nA0[0] = gA0[0]; nA0[1] = gA0[1]; nA1[0] = gA1[0]; nA1[1] = gA1[1]; } }
        for (int t = 0; t < nt; t += 2) {
            const bool last = (t == nt - 2);
            const char* a1 = cA + (size_t)(t + 1) * kstep;
            const char* a2 = last ? nA : cA + (size_t)(t + 2) * kstep; const char* b2 = last ? nB : cB + (size_t)(t + 2) * kstep;
            const char* a3 = a2 + kstep; const char* b3 = b2 + kstep;
            unsigned s0[2], s1[2];
            if constexpr (GATHER) { s0[0] = last ? nA0[0] : gA0[0]; s0[1] = last ? nA0[1] : gA0[1]; s1[0] = last ? nA1[0] : gA1[0]; s1[1] = last ? nA1[1] : gA1[1]; }
            GM_LDB(B0, 0, 0); GM_LDB(B1, 0, 1); GM_SCHED; GM_LDA(At, 0, 0); GM_STA_H1(GM_SA(1, 1), a1, gA1);
            GM_WAIT_V(8); GM_WAIT_L(0); GM_BAR; GM_MMA(0, 0, At, B0); GM_MMA(0, 1, At, B1); GM_BAR; GM_SCHED;
            GM_LDA(At, 0, 1); GM_STAGE(GM_SB(0, 0), b2, voffB); GM_STAGE(GM_SB(0, 1), b2 + hstepB, voffB); GM_STA_H0(GM_SA(0, 0), a2, s0);
            GM_WAIT_V(8); GM_WAIT_L(0); GM_BAR; GM_MMA(1, 0, At, B0); GM_MMA(1, 1, At, B1); GM_BAR; GM_SCHED;
            GM_LDB(B0, 1, 0); GM_LDB(B1, 1, 1); GM_SCHED; GM_LDA(At, 1, 0); GM_STA_H1(GM_SA(0, 1), a2, s1);
            GM_WAIT_V(8); GM_WAIT_L(0); GM_BAR; GM_MMA(0, 0, At, B0); GM_MMA(0, 1, At, B1); GM_BAR; GM_SCHED;
            GM_LDA(At, 1, 1); GM_STAGE(GM_SB(1, 0), b3, voffB); GM_STAGE(GM_SB(1, 1), b3 + hstepB, voffB); GM_STA_H0(GM_SA(1, 0), a3, s0);
            GM_WAIT_V(8); GM_WAIT_L(0); GM_BAR; GM_MMA(1, 0, At, B0); GM_MMA(1, 1, At, B1); GM_BAR; GM_SCHED;
        }
        if (wr == 0) GM_BAR;
        E(acc, cur, wr, wc, fr, fq);
        if (!has_next) break;
#pragma unroll
        for (int a = 0; a < 2; ++a)
#pragma unroll
            for (int b = 0; b < 2; ++b)
#pragma unroll
                for (int m = 0; m < 4; ++m)
#pragma unroll
                    for (int n = 0; n < 2; ++n) acc[a][b][m][n] = (f32x4){0.f, 0.f, 0.f, 0.f};
        cur = nxt; cA = nA; cB = nB; ++ui;
        if constexpr (GATHER) { gA0[0] = nA0[0]; gA0[1] = nA0[1]; gA1[0] = nA1[0]; gA1[1] = nA1[1]; }
        if (wr == 1) GM_BAR;
    }
    GM_WAIT_V(0);
    GM_BAR;
#undef GM_SA
#undef GM_STA_H0
#undef GM_STA_H1
#undef GM_GCVT
#undef GM_SB
#undef GM_STAGE
#undef GM_LDA
#undef GM_LDB
#undef GM_MMA
#undef GM_WAIT_V
#undef GM_WAIT_L
#undef GM_BAR
#undef GM_SCHED
}
}

struct Params { const float* in[36]; float* out; unsigned char* ws; int ph_lo, ph_hi, alt, pad; };
enum { I_X = 0, I_C, I_CTX, I_CCTX, I_L0_NORM1, I_L0_WMOD, I_L0_BMOD, I_L0_WIN, I_L0_WOUT, I_L0_RPB, I_L0_LQ1, I_L0_LK1, I_L0_LQ2, I_L0_LK2, I_L0_SUBLN,
       I_L0_NORM2, I_L0_WR, I_L0_W1, I_L0_W3, I_L0_W2, I_L1_NORM1, I_L1_WMOD, I_L1_BMOD, I_L1_WIN, I_L1_WOUT, I_L1_SCW, I_L1_CFW, I_L1_CFB, I_L1_LNG, I_L1_LNB,
       I_L1_NORM2, I_L1_WR, I_L1_W1, I_L1_W3, I_L1_W2, I_FNORM };

__device__ __forceinline__ int opaque_tid() { int t = threadIdx.x; asm volatile("" : "+v"(t)); return t; }
__device__ __forceinline__ float wave_sum(float v) {
#pragma unroll
    for (int o = 1; o < 64; o <<= 1) v += __shfl_xor(v, o);
    return v;
}

constexpr int CVT_RS = 136, CVT_SCR = 64 * CVT_RS;
template <bool BF, class RowMap>
__device__ __forceinline__ void cvt_item(const float* W, int K, int N, f16* WT, const RowMap& rm, int item, int lane, LAS unsigned char* scr) {
    const int nblk = N / 64, kb = item / nblk, nb = item % nblk, k0 = 64 * kb, n0 = 64 * nb;
    const float* src = W + (size_t)(k0 + (lane >> 4)) * N + n0 + 4 * (lane & 15);
    f32x4 v[16];
#pragma unroll
    for (int i = 0; i < 16; ++i) v[i] = *(const f32x4*)(src + (size_t)(4 * i) * N);
#pragma unroll
    for (int i = 0; i < 16; ++i) { u32x2 w; w.x = pk16<BF>(v[i][0], v[i][1]); w.y = pk16<BF>(v[i][2], v[i][3]);
        *(LAS u32x2*)(scr + (4 * i + (lane >> 4)) * CVT_RS + 8 * (lane & 15)) = w; }
    const int g = lane >> 4, i16 = lane & 15, q_ = i16 >> 2, p_ = i16 & 3;
#pragma unroll
    for (int st = 0; st < 8; ++st) {
        const int nl = 16 * (st >> 1), ch = 4 * (st & 1) + g;
        const LAS unsigned char* ap = scr + (8 * ch + q_) * CVT_RS + (nl + 4 * p_) * 2;
        const s16x4 lo = __builtin_amdgcn_ds_read_tr16_b64_v4i16((LAS s16x4*)ap);
        const s16x4 hi = __builtin_amdgcn_ds_read_tr16_b64_v4i16((LAS s16x4*)(ap + 4 * CVT_RS));
        u32x4 w; const u32x2 l2 = __builtin_bit_cast(u32x2, lo), h2 = __builtin_bit_cast(u32x2, hi); w.x = l2.x; w.y = l2.y; w.z = h2.x; w.w = h2.y;
        *(u32x4*)(WT + (size_t)rm(n0 + nl + i16) * K + k0 + 8 * ch) = w;
    }
}
struct MapPlain { __device__ __forceinline__ int operator()(int n) const { return n; } };
struct MapRope { __device__ __forceinline__ int operator()(int n) const {
    const bool rp = (n >= 512 && n < 1024) || (n >= 1536 && n < 2048); if (!rp) return n; const int i = n & 31; return (n & ~31) + (i < 16 ? 2 * i : 2 * (i - 16) + 1); } };
struct MapGLU { int add; __device__ __forceinline__ int operator()(int n) const { return (n >> 7) * 256 + (n & 127) + add; } };

__device__ __forceinline__ void cvt_moe(const float* w1, const float* w3, const float* w2, f16* W13, f16* W2T, int gw, int NGW, int lane, LAS unsigned char* scr) {
    constexpr int I13 = (DM / 64) * (DE / 64), I2 = (DE / 64) * (DM / 64);
    constexpr int NIT = NE * (2 * I13 + I2);
    for (int it = gw; it < NIT; it += NGW) {
        const int e = it / (2 * I13 + I2); int r = it % (2 * I13 + I2);
        if (r < I13) { cvt_item<MOE_BF16>(w1 + (size_t)e * DM * DE, DM, DE, W13 + (size_t)e * 2 * DE * DM, MapGLU{0}, r, lane, scr); continue; } r -= I13;
        if (r < I13) { cvt_item<MOE_BF16>(w3 + (size_t)e * DM * DE, DM, DE, W13 + (size_t)e * 2 * DE * DM, MapGLU{128}, r, lane, scr); continue; } r -= I13;
        cvt_item<MOE_BF16>(w2 + (size_t)e * DE * DM, DE, DM, W2T + (size_t)e * DM * DE, MapPlain{}, r, lane, scr);
    }
}

__device__ __forceinline__ void phase_prologue(const Params& p, LAS unsigned char* lds) {
    const int tid = opaque_tid(), lane = tid & 63, wave = __builtin_amdgcn_readfirstlane(tid >> 6);
    const int G = gridDim.x;
    unsigned char* ws = p.ws;
    LAS float* S = (LAS float*)lds;
    LAS float* red = (LAS float*)(lds + 17 * 1024 * 4);
    for (int u = blockIdx.x; u < 193; u += G) {
        if (u == 192) {
            float* rope = (float*)(ws + WS_MOD + ROPE_OFF);
            for (int idx = tid; idx < 1024; idx += 512) { const int pos = idx >> 4, i = idx & 15; const float fr = powf(10000.f, -(float)i / 16.f), ang = (float)pos * fr;
                rope[idx * 2] = cosf(ang); rope[idx * 2 + 1] = sinf(ang); }
            if (wave == 0) { const float s1 = wave_sum(p.in[I_L0_LQ1][lane] * p.in[I_L0_LK1][lane]), s2 = wave_sum(p.in[I_L0_LQ2][lane] * p.in[I_L0_LK2][lane]);
                if (lane == 0) *(float*)(ws + WS_MOD + LAM_OFF) = expf(s1) - expf(s2) + 0.2f; }
            continue;
        }
        const int l = u / 96, col0 = (u % 96) * 64;
        const float* wmod = p.in[l ? I_L1_WMOD : I_L0_WMOD]; const float* bmod = p.in[l ? I_L1_BMOD : I_L0_BMOD];
        float* mod = (float*)(ws + WS_MOD + (l ? MOD1_OFF : MOD0_OFF));
        for (int idx = tid; idx < 17 * 1024; idx += 512) { const float v = idx < 16 * 1024 ? p.in[I_C][idx] : p.in[I_CCTX][idx - 16 * 1024]; S[idx] = silu_f(v); }
        __syncthreads();
        float acc[17];
#pragma unroll
        for (int r = 0; r < 17; ++r) acc[r] = 0.f;
        const int kb = wave * 128;
        for (int kk = 0; kk < 128; kk += 4) {
            float wv[4];
#pragma unroll
            for (int i = 0; i < 4; ++i) wv[i] = wmod[(size_t)(kb + kk + i) * 6144 + col0 + lane];
#pragma unroll
            for (int r = 0; r < 17; ++r) { const f32x4 sv = *(const LAS f32x4*)(S + r * 1024 + kb + kk); acc[r] += sv[0] * wv[0] + sv[1] * wv[1] + sv[2] * wv[2] + sv[3] * wv[3]; }
        }
#pragma unroll
        for (int r = 0; r < 17; ++r) red[(wave * 17 + r) * 64 + lane] = acc[r];
        __syncthreads();
        for (int idx = tid; idx < 17 * 64; idx += 512) { const int r = idx >> 6, ln = idx & 63; float s = bmod[col0 + ln];
#pragma unroll
            for (int w = 0; w < 8; ++w) s += red[(w * 17 + r) * 64 + ln];
            if (r < 16 || l == 0) mod[(size_t)r * 6144 + col0 + ln] = s; }
        __syncthreads();
    }
    const int gw = blockIdx.x * 8 + wave, NGW = G * 8;
    LAS unsigned char* scr = lds + wave * CVT_SCR;
    constexpr int IT_IN0 = (DM / 64) * (ZP0 / 64), IT_OUT = (DM / 64) * (DM / 64), IT_IN1 = (DM / 64) * (ZP1 / 64);
    for (int it = gw; it < IT_IN0 + 2 * IT_OUT + IT_IN1; it += NGW) {
        int r = it;
        if (r < IT_IN0) { cvt_item<false>(p.in[I_L0_WIN], DM, ZP0, (f16*)(ws + WS_WIN0), MapRope{}, r, lane, scr); continue; } r -= IT_IN0;
        if (r < IT_OUT) { cvt_item<false>(p.in[I_L0_WOUT], DM, DM, (f16*)(ws + WS_WOUT0), MapPlain{}, r, lane, scr); continue; } r -= IT_OUT;
        if (r < IT_IN1) { cvt_item<false>(p.in[I_L1_WIN], DM, ZP1, (f16*)(ws + WS_WIN1), MapPlain{}, r, lane, scr); continue; } r -= IT_IN1;
        cvt_item<false>(p.in[I_L1_WOUT], DM, DM, (f16*)(ws + WS_WOUT1), MapPlain{}, r, lane, scr);
    }
    cvt_moe(p.in[I_L0_W1], p.in[I_L0_W3], p.in[I_L0_W2], (f16*)(ws + WS_W13), (f16*)(ws + WS_W2), gw, NGW, lane, scr);
}

struct NormArgs {
    const float* src;
    const f16* src16;
    f16* xout;
    const f16* y2; const short* inv; const float* gate2;
    const float* gain;
    const float* shift; const float* scale; int mstride;
    f16* hout;
    float* fout;
    const float* wr; float* aff;
    bool hbf;
};

template <int R>
__device__ __forceinline__ void norm_phase(const NormArgs& a, LAS unsigned char* lds, bool ctx_rows, const float* ctx_src, const float* ctx_shift, const float* ctx_scale) {
    const int tid = opaque_tid(), lane = tid & 63, wave = __builtin_amdgcn_readfirstlane(tid >> 6);
    const int G = gridDim.x;
    LAS float* wl = (LAS float*)lds;
    if (a.wr) {
        for (int idx = tid; idx < 16384; idx += 512) { const int k = idx >> 4, e = idx & 15; wl[e * 1028 + k] = a.wr[idx]; }
        __syncthreads();
    }
    const int gw = blockIdx.x * 8 + wave, NGW = G * 8;
    for (int chunk = gw; chunk < NTOK / 16; chunk += NGW) {
        const int row0 = chunk * 16, b = row0 / SEQ;
        f32x4 A[4], Sh[4], G2[4];
#pragma unroll
        for (int j = 0; j < 4; ++j) { const int c = 4 * lane + 256 * j; const f32x4 g = *(const f32x4*)(a.gain + c);
            if (a.shift) { const f32x4 sc = *(const f32x4*)(a.scale + (size_t)b * a.mstride + c); A[j] = g * (sc + 1.f); Sh[j] = *(const f32x4*)(a.shift + (size_t)b * a.mstride + c); }
            else { A[j] = g; Sh[j] = (f32x4){0.f, 0.f, 0.f, 0.f}; }
            if (a.y2) G2[j] = *(const f32x4*)(a.gate2 + (size_t)b * 6144 + c); else G2[j] = (f32x4){0.f, 0.f, 0.f, 0.f}; }
        for (int rr = 0; rr < 16; rr += R) {
            f32x4 v[R][4];
            int sl[R];
#pragma unroll
            for (int q = 0; q < R; ++q) { sl[q] = -1; if (a.y2 && lane < 16) sl[q] = a.inv[((size_t)b * NE + lane) * SEQ + ((row0 + rr + q) & (SEQ - 1))]; }
#pragma unroll
            for (int q = 0; q < R; ++q) { const int row = row0 + rr + q;
                if (a.src16) { const f16* xr = a.src16 + (size_t)row * DM;
#pragma unroll
                    for (int j = 0; j < 4; ++j) { const f16x4 t = *(const f16x4*)(xr + 4 * lane + 256 * j); v[q][j] = (f32x4){(float)t[0], (float)t[1], (float)t[2], (float)t[3]}; } }
                else { const float* xr = a.src + (size_t)row * DM;
#pragma unroll
                    for (int j = 0; j < 4; ++j) v[q][j] = *(const f32x4*)(xr + 4 * lane + 256 * j); } }
            if (a.y2) {
                unsigned long long mask[R]; int ee[R][4]; float wgt[R][4]; f16x4 ld[R][4][4];
#pragma unroll
                for (int q = 0; q < R; ++q) { mask[q] = __ballot(sl[q] >= 0);
#pragma unroll
                    for (int i = 0; i < 4; ++i) { if (mask[q]) { ee[q][i] = __builtin_ctzll(mask[q]); mask[q] &= mask[q] - 1; wgt[q][i] = 1.f; } else { ee[q][i] = i ? ee[q][0] : 0; wgt[q][i] = 0.f; } }
#pragma unroll
                    for (int i = 0; i < 4; ++i) { int slot = __shfl(sl[q], ee[q][i]); slot = slot < 0 ? 0 : slot; const f16* yr = a.y2 + ((size_t)ee[q][i] * EROWS + b * CAP + slot) * DM + 4 * lane;
#pragma unroll
                        for (int j = 0; j < 4; ++j) ld[q][i][j] = *(const f16x4*)(yr + 256 * j); } }
#pragma unroll
                for (int q = 0; q < R; ++q) { const int row = row0 + rr + q;
                    f32x4 cs[4];
#pragma unroll
                    for (int j = 0; j < 4; ++j) cs[j] = (f32x4){0.f, 0.f, 0.f, 0.f};
#pragma unroll
                    for (int i = 0; i < 4; ++i)
#pragma unroll
                        for (int j = 0; j < 4; ++j) { cs[j][0] += wgt[q][i] * (float)ld[q][i][j][0]; cs[j][1] += wgt[q][i] * (float)ld[q][i][j][1]; cs[j][2] += wgt[q][i] * (float)ld[q][i][j][2]; cs[j][3] += wgt[q][i] * (float)ld[q][i][j][3]; }
                    while (mask[q]) {
                        const int e2 = __builtin_ctzll(mask[q]); mask[q] &= mask[q] - 1; const int slot = __shfl(sl[q], e2); const f16* yr = a.y2 + ((size_t)e2 * EROWS + b * CAP + slot) * DM + 4 * lane;
#pragma unroll
                        for (int j = 0; j < 4; ++j) { const f16x4 t = *(const f16x4*)(yr + 256 * j); cs[j][0] += (float)t[0]; cs[j][1] += (float)t[1]; cs[j][2] += (float)t[2]; cs[j][3] += (float)t[3]; }
                    }
                    f16* xo = a.xout + (size_t)row * DM;
#pragma unroll
                    for (int j = 0; j < 4; ++j) { v[q][j] = v[q][j] + G2[j] * cs[j]; if (!a.fout) { u32x2 w; w.x = pkh(v[q][j][0], v[q][j][1]); w.y = pkh(v[q][j][2], v[q][j][3]); *(u32x2*)(xo + 4 * lane + 256 * j) = w; } }
                }
            }
            float rstd[R];
#pragma unroll
            for (int q = 0; q < R; ++q) { float ss = 0.f;
#pragma unroll
                for (int j = 0; j < 4; ++j) ss += (v[q][j][0] * v[q][j][0] + v[q][j][1] * v[q][j][1]) + (v[q][j][2] * v[q][j][2] + v[q][j][3] * v[q][j][3]);
                rstd[q] = 1.0f / sqrtf(wave_sum(ss) * (1.f / DM) + EPS); }
#pragma unroll
            for (int q = 0; q < R; ++q) { const int row = row0 + rr + q;
#pragma unroll
                for (int j = 0; j < 4; ++j) v[q][j] = (v[q][j] * rstd[q]) * A[j] + Sh[j];
                if (a.fout) {
#pragma unroll
                    for (int j = 0; j < 4; ++j) *(f32x4*)(a.fout + (size_t)row * DM + 4 * lane + 256 * j) = v[q][j];
                }
                if (a.hout) {
#pragma unroll
                    for (int j = 0; j < 4; ++j) { u32x2 w; if (a.hbf) { w.x = pkb(v[q][j][0], v[q][j][1]); w.y = pkb(v[q][j][2], v[q][j][3]); } else { w.x = pkh(v[q][j][0], v[q][j][1]); w.y = pkh(v[q][j][2], v[q][j][3]); } *(u32x2*)(a.hout + (size_t)row * DM + 4 * lane + 256 * j) = w; }
                }
            }
            if (a.wr) {
#pragma unroll 1
                for (int q = 0; q < R; ++q) {
                    float lg[16];
                    f32x4 h0 = v[0][0], h1 = v[0][1], h2 = v[0][2], h3 = v[0][3];
#pragma unroll
                    for (int qq = 1; qq < R; ++qq) if (q == qq) { h0 = v[qq][0]; h1 = v[qq][1]; h2 = v[qq][2]; h3 = v[qq][3]; }
#pragma unroll
                    for (int e = 0; e < 16; ++e) { const LAS float* wp = wl + e * 1028 + 4 * lane;
                        const f32x4 w0 = *(const LAS f32x4*)(wp), w1 = *(const LAS f32x4*)(wp + 256), w2 = *(const LAS f32x4*)(wp + 512), w3 = *(const LAS f32x4*)(wp + 768);
                        lg[e] = ((h0[0] * w0[0] + h0[1] * w0[1]) + (h0[2] * w0[2] + h0[3] * w0[3])) + ((h1[0] * w1[0] + h1[1] * w1[1]) + (h1[2] * w1[2] + h1[3] * w1[3]))
                              + ((h2[0] * w2[0] + h2[1] * w2[1]) + (h2[2] * w2[2] + h2[3] * w2[3])) + ((h3[0] * w3[0] + h3[1] * w3[1]) + (h3[2] * w3[2] + h3[3] * w3[3]));
                        asm volatile("" ::: "memory"); }
#pragma unroll
                    for (int i = 0; i < 8; ++i) { const bool hi = lane & 32; const float send = hi ? lg[i] : lg[i + 8], keep = hi ? lg[i + 8] : lg[i]; lg[i] = keep + __shfl_xor(send, 32); }
#pragma unroll
                    for (int i = 0; i < 4; ++i) { const bool hi = lane & 16; const float send = hi ? lg[i] : lg[i + 4], keep = hi ? lg[i + 4] : lg[i]; lg[i] = keep + __shfl_xor(send, 16); }
#pragma unroll
                    for (int i = 0; i < 2; ++i) { const bool hi = lane & 8; const float send = hi ? lg[i] : lg[i + 2], keep = hi ? lg[i + 2] : lg[i]; lg[i] = keep + __shfl_xor(send, 8); }
                    { const bool hi = lane & 4; const float send = hi ? lg[0] : lg[1], keep = hi ? lg[1] : lg[0]; lg[0] = keep + __shfl_xor(send, 4); }
                    float lv = lg[0]; lv += __shfl_xor(lv, 2); lv += __shfl_xor(lv, 1);
                    float mx = lv;
#pragma unroll
                    for (int o = 4; o < 64; o <<= 1) mx = fmaxf(mx, __shfl_xor(mx, o));
                    const float ex = expf(lv - mx); float sm = ex;
#pragma unroll
                    for (int o = 4; o < 64; o <<= 1) sm += __shfl_xor(sm, o);
                    const int row = row0 + rr + q, t = row & (SEQ - 1), e = (lane >> 2) & 15;
                    if ((lane & 3) == 0) a.aff[((size_t)b * NE + e) * SEQ + t] = ex / sm;
                }
            }
        }
    }
    if (ctx_rows) {
        f32x4 A[4], Sh[4];
#pragma unroll
        for (int j = 0; j < 4; ++j) { const int c = 4 * lane + 256 * j; A[j] = *(const f32x4*)(a.gain + c) * (*(const f32x4*)(ctx_scale + c) + 1.f); Sh[j] = *(const f32x4*)(ctx_shift + c); }
        for (int row = gw; row < NCTX; row += NGW) {
            f32x4 v[4]; float ss = 0.f;
#pragma unroll
            for (int j = 0; j < 4; ++j) { v[j] = *(const f32x4*)(ctx_src + (size_t)row * DM + 4 * lane + 256 * j); ss += (v[j][0] * v[j][0] + v[j][1] * v[j][1]) + (v[j][2] * v[j][2] + v[j][3] * v[j][3]); }
            const float rstd = 1.0f / sqrtf(wave_sum(ss) * (1.f / DM) + EPS);
#pragma unroll
            for (int j = 0; j < 4; ++j) { const f32x4 h = (v[j] * rstd) * A[j] + Sh[j]; u32x2 w; w.x = pkh(h[0], h[1]); w.y = pkh(h[2], h[3]); *(u32x2*)(a.hout + (size_t)(NTOK + row) * DM + 4 * lane + 256 * j) = w; }
        }
    }
    __syncthreads();
}

__device__ __forceinline__ void topk_phase(const float* aff, int* idx, float* gv, short* inv, const f16* H, f16* XIN, LAS unsigned char* lds) {
    const int tid = opaque_tid(), lane = tid & 63, wave = __builtin_amdgcn_readfirstlane(tid >> 6);
    LAS unsigned long long* key = (LAS unsigned long long*)lds;
    for (int u = blockIdx.x; u < NB * NE; u += gridDim.x) {
        const int b = u / NE, e = u % NE;
        const float* av = aff + (size_t)u * SEQ;
        for (int t = tid; t < SEQ; t += 512) key[t] = ((unsigned long long)(~__float_as_uint(av[t])) << 32) | (unsigned)t;
        __syncthreads();
        for (int k = 2; k <= SEQ; k <<= 1)
            for (int j = k >> 1; j > 0; j >>= 1) {
#pragma unroll
                for (int pp = 0; pp < 2; ++pp) { const int pr = tid + pp * 512; const int i = ((pr & ~(j - 1)) << 1) | (pr & (j - 1)), i2 = i | j;
                    const unsigned long long x = key[i], y = key[i2]; const bool up = (i & k) == 0;
                    if ((x > y) == up) { key[i] = y; key[i2] = x; } }
                __syncthreads();
            }
        for (int r = tid; r < SEQ; r += 512) { const unsigned long long kk = key[r]; const int t = (int)(unsigned)kk;
            inv[(size_t)u * SEQ + t] = (short)(r < CAP ? r : -1);
            if (r < CAP) { idx[u * CAP + r] = t; gv[u * CAP + r] = __uint_as_float(~(unsigned)(kk >> 32)); } }
        __syncthreads();
    }
}

namespace at {
constexpr int SLOT = 32768, NSLOT = 4;
constexpr int RPB_OFF = 132096;
constexpr float THR = 8.f;
typedef _Float16 v4h __attribute__((ext_vector_type(4)));
__device__ __forceinline__ int fsw(int row) { return ((row & 3) << 2) | ((row >> 2) & 3); }

__device__ __forceinline__ void glds16(const void* gsrc, unsigned lds_dst) { unsigned keep;
    asm volatile("s_mov_b32 %0, m0\n\ts_mov_b32 m0, %2\n\ts_nop 0\n\tglobal_load_lds_dwordx4 %1, off\n\ts_mov_b32 m0, %0" : "=&s"(keep) : "v"(gsrc), "s"(lds_dst) : "memory"); }
__device__ __forceinline__ void dma_tile(const f16* Z, long rowbase, int kcol, int vcol, LAS unsigned char* slot, int wave, int lane) {
    const unsigned sbase = (unsigned)__builtin_amdgcn_readfirstlane((int)(unsigned)(uintptr_t)slot);
#pragma unroll
    for (int i = 0; i < 2; ++i) { const int piece = wave + 8 * i, row = 4 * piece + (lane >> 4), c = (lane & 15) ^ fsw(row);
        const f16* gp = Z + (size_t)(rowbase + row) * ZP0 + 8 * c;
        glds16(gp + kcol, sbase + piece * 1024);
        glds16(gp + vcol, sbase + 16384 + piece * 1024); }
}
#define AT_WAIT(n) asm volatile("s_waitcnt vmcnt(" #n ") lgkmcnt(0)" ::: "memory")
__device__ __forceinline__ void wait_tile(int younger) { if (younger >= 2) AT_WAIT(8); else if (younger == 1) AT_WAIT(4); else AT_WAIT(0); }

template <int NDT> struct Addr { int k[4]; int v[NDT][2]; };
template <int NDT>
__device__ __forceinline__ Addr<NDT> make_addr(int kb0, int kchunk0, int vchunk0, int lane) {
    Addr<NDT> a; const int r32 = lane & 31, hh = lane >> 5, i = lane & 15, q_ = i >> 2, p_ = i & 3, g1 = (lane >> 4) & 1;
    const int kr = kb0 + r32, fk = fsw(kr);
#pragma unroll
    for (int st = 0; st < 4; ++st) a.k[st] = kr * 256 + 16 * ((kchunk0 + 2 * st + hh) ^ fk);
    const int vr = kb0 + 4 * hh + q_, f0 = fsw(vr), f1 = fsw(vr + 8);
#pragma unroll
    for (int dt = 0; dt < NDT; ++dt) { const int c = vchunk0 + 4 * dt + 2 * g1 + (p_ >> 1);
        a.v[dt][0] = 16384 + vr * 256 + 16 * (c ^ f0) + 8 * (p_ & 1); a.v[dt][1] = 16384 + (vr + 8) * 256 + 16 * (c ^ f1) + 8 * (p_ & 1); }
    return a;
}
#define AT_SCHED() __builtin_amdgcn_sched_barrier(0)
template <int NDT>
__device__ __forceinline__ void load_k(LAS unsigned char* slot, const Addr<NDT>& a, int off, f16x8* kf) {
#pragma unroll
    for (int st = 0; st < 4; ++st) kf[st] = *(const LAS f16x8*)(slot + a.k[st] + off);
}
template <int NDT>
__device__ __forceinline__ void load_v(LAS unsigned char* slot, const Addr<NDT>& a, int off, f16x8* vf) {
#pragma unroll
    for (int s2 = 0; s2 < 2; ++s2)
#pragma unroll
        for (int dt = 0; dt < NDT; ++dt) {
            const v4h lo = __builtin_bit_cast(v4h, __builtin_amdgcn_ds_read_tr16_b64_v4i16((LAS s16x4*)(slot + a.v[dt][0] + off + s2 * 4096)));
            const v4h hi = __builtin_bit_cast(v4h, __builtin_amdgcn_ds_read_tr16_b64_v4i16((LAS s16x4*)(slot + a.v[dt][1] + off + s2 * 4096)));
            vf[s2 * NDT + dt] = (f16x8){lo[0], lo[1], lo[2], lo[3], hi[0], hi[1], hi[2], hi[3]};
        }
}
__device__ __forceinline__ f32x16 qk32(const f16x8* kf, const f16x8 (&qf)[4], const f32x16& negm) {
    f32x16 s = __builtin_amdgcn_mfma_f32_32x32x16_f16(kf[0], qf[0], negm, 0, 0, 0);
#pragma unroll
    for (int st = 1; st < 4; ++st) s = __builtin_amdgcn_mfma_f32_32x32x16_f16(kf[st], qf[st], s, 0, 0, 0);
    return s;
}
__device__ __forceinline__ float max3f(float a, float b, float c) { float r; asm("v_max3_f32 %0, %1, %2, %3" : "=v"(r) : "v"(a), "v"(b), "v"(c)); return r; }
template <int NDT>
__device__ __forceinline__ void pv32(const f16x8* vf, const f32x16& p, f32x16 (&o)[NDT]) {
#pragma unroll
    for (int s2 = 0; s2 < 2; ++s2) {
        f16x8 pb;
#pragma unroll
        for (int j = 0; j < 8; ++j) pb[j] = (f16)p[8 * s2 + j];
#pragma unroll
        for (int dt = 0; dt < NDT; ++dt) o[dt] = __builtin_amdgcn_mfma_f32_32x32x16_f16(vf[s2 * NDT + dt], pb, o[dt], 0, 0, 0);
    }
}
__device__ __forceinline__ float rowmax16(const f32x16& s) { float a = max3f(s[0], s[1], s[2]), b = max3f(s[3], s[4], s[5]);
    a = max3f(a, s[6], s[7]); b = max3f(b, s[8], s[9]); a = max3f(a, s[10], s[11]); b = max3f(b, s[12], s[13]); a = max3f(a, s[14], s[15]); return fmaxf(a, b); }
template <int NDT>
__device__ __forceinline__ float rescale(float mx, float& m, float& l, f32x16 (&o)[NDT], f32x16& negm, bool& started) {
    const bool quiet = started ? (mx <= THR) : (mx == -INFINITY);
    if (__all(quiet)) return 0.f;
    float d = 0.f, alpha = 1.f;
    if (started) { d = fmaxf(mx, 0.f); alpha = __builtin_amdgcn_exp2f(-d); }
    else if (mx > -INFINITY) { d = mx; started = true; }
    m += d; l *= alpha;
#pragma unroll
    for (int dt = 0; dt < NDT; ++dt)
#pragma unroll
        for (int r = 0; r < 16; ++r) o[dt][r] *= alpha;
#pragma unroll
    for (int r = 0; r < 16; ++r) negm[r] = -m;
    return d;
}
__device__ __forceinline__ float expsum(f32x16& s, float d) { float ps = 0.f;
    if (__any(d != 0.f)) {
#pragma unroll
        for (int r = 0; r < 16; ++r) s[r] -= d; }
#pragma unroll
    for (int r = 0; r < 16; ++r) { s[r] = __builtin_amdgcn_exp2f(s[r]); ps += s[r]; }
    return ps; }
template <int NDT>
__device__ __forceinline__ void step64(LAS unsigned char* slot, const Addr<NDT>& a, const f16x8 (&qf)[4], f32x16 (&o)[NDT], float& m, float& l, f32x16& negm, bool& started) {
    f16x8 kf[8], va[2 * NDT], vb[2 * NDT];
    load_k<NDT>(slot, a, 0, kf); load_k<NDT>(slot, a, 8192, kf + 4);
    load_v<NDT>(slot, a, 0, va);
    AT_SCHED();
    f32x16 s0 = qk32(kf, qf, negm), s1 = qk32(kf + 4, qf, negm);
    AT_SCHED();
    load_v<NDT>(slot, a, 8192, vb);
    float mx = fmaxf(rowmax16(s0), rowmax16(s1)); mx = fmaxf(mx, __shfl_xor(mx, 32));
    const float d = rescale<NDT>(mx, m, l, o, negm, started);
    l += expsum(s0, d) + expsum(s1, d);
    AT_SCHED();
    pv32<NDT>(va, s0, o); pv32<NDT>(vb, s1, o);
    AT_SCHED();
}

__device__ __forceinline__ void diff_unit(int u, const f16* Z, f16* Y, const float* subln, float lam, LAS unsigned char* lds) {
    const int tid = opaque_tid(), lane = tid & 63, wave = __builtin_amdgcn_readfirstlane(tid >> 6);
    const int qb = u & 15, h = (u >> 4) & 3, b = u >> 6;
    const int map = wave >> 2, r32 = lane & 31, hh = lane >> 5;
    const long tokbase = (long)b * SEQ;
    const long qrow = tokbase + qb * 128 + (wave & 3) * 32 + r32;
    const int kcol = 1536 + 128 * h, vcol = 2560 + 128 * h;
    constexpr int NT = 36;
#define DIFF_ROWBASE(t) ((t) < 32 ? tokbase + 64 * (t) : (long)NTOK + b * CTXL + 64 * ((t) - 32))
#pragma unroll
    for (int t = 0; t < 3; ++t) dma_tile(Z, DIFF_ROWBASE(t), kcol, vcol, lds + t * SLOT, wave, lane);
    f16x8 qf[4];
#pragma unroll
    for (int st = 0; st < 4; ++st) qf[st] = *(const f16x8*)(Z + (size_t)qrow * ZP0 + 512 + 128 * h + 64 * map + 16 * st + 8 * hh);
    asm volatile("" : "+v"(qf[0]), "+v"(qf[1]), "+v"(qf[2]), "+v"(qf[3]));
    const Addr<4> ad = make_addr<4>(0, 8 * map, 0, lane);
    f32x16 o[4];
#pragma unroll
    for (int dt = 0; dt < 4; ++dt)
#pragma unroll
        for (int r = 0; r < 16; ++r) o[dt][r] = 0.f;
    float m = 0.f, l = 0.f; bool started = false;
    f32x16 negm;
#pragma unroll
    for (int r = 0; r < 16; ++r) negm[r] = 0.f;
    for (int t = 0; t < NT; ++t) {
        wait_tile(NT - 1 - t);
        __builtin_amdgcn_s_barrier();
        if (t + 3 < NT) dma_tile(Z, DIFF_ROWBASE(t + 3), kcol, vcol, lds + ((t + 3) & 3) * SLOT, wave, lane);
        step64<4>(lds + (t & 3) * SLOT, ad, qf, o, m, l, negm, started);
    }
#undef DIFF_ROWBASE
    __syncthreads();
    const float linv = 1.f / (l + __shfl_xor(l, 32));
    LAS float* cb = (LAS float*)lds + (wave & 3) * 4096;
    if (map == 1) {
#pragma unroll
        for (int dt = 0; dt < 4; ++dt)
#pragma unroll
            for (int r = 0; r < 16; ++r) cb[(dt * 16 + r) * 64 + lane] = o[dt][r] * linv;
    }
    __syncthreads();
    if (map == 0) {
        float ss = 0.f;
#pragma unroll
        for (int dt = 0; dt < 4; ++dt)
#pragma unroll
            for (int r = 0; r < 16; ++r) { const float d = o[dt][r] * linv - lam * cb[(dt * 16 + r) * 64 + lane]; o[dt][r] = d; ss += d * d; }
        ss += __shfl_xor(ss, 32);
        const float rstd = 0.8f / sqrtf(ss * (1.f / 128.f) + EPS);
        f16* yr = Y + (size_t)qrow * DM + 512 + 128 * h;
#pragma unroll
        for (int dt = 0; dt < 4; ++dt)
#pragma unroll
            for (int rg = 0; rg < 4; ++rg) { const int d0 = 32 * dt + 8 * rg + 4 * hh; const f32x4 sg = *(const f32x4*)(subln + d0);
                u32x2 w; w.x = pkh(o[dt][4 * rg] * rstd * sg[0], o[dt][4 * rg + 1] * rstd * sg[1]); w.y = pkh(o[dt][4 * rg + 2] * rstd * sg[2], o[dt][4 * rg + 3] * rstd * sg[3]);
                *(u32x2*)(yr + d0) = w; }
    }
    __syncthreads();
}

__device__ __forceinline__ void na_unit(int u, const f16* Z, f16* Y, const float* rpb, LAS unsigned char* lds) {
    const int tid = opaque_tid(), lane = tid & 63, wave = __builtin_amdgcn_readfirstlane(tid >> 6);
    const int rp = u & 15, hp = (u >> 4) & 3, b = u >> 6;
    const int hs = wave >> 2, a = wave & 3, head = 2 * hp + hs, r32 = lane & 31, hh = lane >> 5;
    const int r0 = 2 * rp, qr = r0 + (r32 >> 4), qc = 16 * a + (r32 & 15);
    const int rsq = min(max(qr - 4, 0), 24), csq = min(max(qc - 8, 0), 48);
    const int lo = min(max(r0 - 4, 0), 24), hi = min(max(r0 + 1 - 4, 0), 24) + 8;
    const int seg = (a == 0) ? 0 : (a == 1) ? 8 : (a == 2) ? 24 : 32;
    const long tokbase = (long)b * SEQ;
    const long qrow = tokbase + qr * 64 + qc;
    const int kcol = 1024 + 128 * hp, vcol = 2048 + 128 * hp;
    const int nwin = hi - lo, NT = nwin + 4;
#define NA_ROWBASE(t) ((t) < nwin ? tokbase + (lo + (t)) * 64 : (long)NTOK + b * CTXL + 64 * ((t) - nwin))
    LAS float* tab = (LAS float*)(lds + RPB_OFF);
    for (int i = tid; i < 2 * 465; i += 512) tab[i] = rpb[(2 * hp) * 465 + i] * LOG2E;
#pragma unroll
    for (int t = 0; t < 3; ++t) dma_tile(Z, NA_ROWBASE(t), kcol, vcol, lds + t * SLOT, wave, lane);
    f16x8 qf[4];
#pragma unroll
    for (int st = 0; st < 4; ++st) qf[st] = *(const f16x8*)(Z + (size_t)qrow * ZP0 + 64 * head + 16 * st + 8 * hh);
    asm volatile("" : "+v"(qf[0]), "+v"(qf[1]), "+v"(qf[2]), "+v"(qf[3]));
    const Addr<2> aw = make_addr<2>(seg, 8 * hs, 8 * hs, lane), ac = make_addr<2>(0, 8 * hs, 8 * hs, lane);
    f32x16 o[2];
#pragma unroll
    for (int dt = 0; dt < 2; ++dt)
#pragma unroll
        for (int r = 0; r < 16; ++r) o[dt][r] = 0.f;
    float m = 0.f, l = 0.f; bool started = false;
    f32x16 negm;
#pragma unroll
    for (int r = 0; r < 16; ++r) negm[r] = 0.f;
    for (int t = 0; t < NT; ++t) {
        wait_tile(NT - 1 - t);
        __builtin_amdgcn_s_barrier();
        if (t + 3 < NT) dma_tile(Z, NA_ROWBASE(t + 3), kcol, vcol, lds + ((t + 3) & 3) * SLOT, wave, lane);
        LAS unsigned char* slot = lds + (t & 3) * SLOT;
        if (t < nwin) {
            const int krow = lo + t;
            f16x8 kf[4], va[4];
            load_k<2>(slot, aw, 0, kf); load_v<2>(slot, aw, 0, va);
            AT_SCHED();
            f32x16 s = qk32(kf, qf, negm);
            const bool rowok = (krow >= rsq) && (krow < rsq + 8);
            const int rbase = (krow - qr + 7) * 31 + 15 - qc;
            float bias[16];
#pragma unroll
            for (int r = 0; r < 16; ++r) { const int kc = seg + (r & 3) + 8 * (r >> 2) + 4 * hh; bias[r] = tab[hs * 465 + min(max(rbase + kc, 0), 464)]; asm volatile("" : "+v"(bias[r])); }
#pragma unroll
            for (int r = 0; r < 16; ++r) { const int kc = seg + (r & 3) + 8 * (r >> 2) + 4 * hh; const bool ok = rowok && (kc >= csq) && (kc < csq + 16);
                s[r] = ok ? s[r] + bias[r] : -INFINITY; }
            float mx = rowmax16(s); mx = fmaxf(mx, __shfl_xor(mx, 32));
            const float d = rescale<2>(mx, m, l, o, negm, started);
            l += expsum(s, d);
            pv32<2>(va, s, o);
        } else {
            step64<2>(slot, ac, qf, o, m, l, negm, started);
        }
    }
#undef NA_ROWBASE
    const float linv = 1.f / (l + __shfl_xor(l, 32));
    f16* yr = Y + (size_t)qrow * DM + 64 * head;
#pragma unroll
    for (int dt = 0; dt < 2; ++dt)
#pragma unroll
        for (int rg = 0; rg < 4; ++rg) { const int d0 = 32 * dt + 8 * rg + 4 * hh;
            u32x2 w; w.x = pkh(o[dt][4 * rg] * linv, o[dt][4 * rg + 1] * linv); w.y = pkh(o[dt][4 * rg + 2] * linv, o[dt][4 * rg + 3] * linv);
            *(u32x2*)(yr + d0) = w; }
    __syncthreads();
}

__device__ __forceinline__ void attn_phase(const f16* Z, f16* Y, const float* rpb, const float* subln, const float* lamp, LAS unsigned char* lds, int rep = 0) {
    const float lam = *lamp;
    const int ulo = (rep == 3) ? 1024 : 0, uhi = (rep == 2) ? 1024 : 2048;
    for (int u = ulo + blockIdx.x; u < uhi; u += gridDim.x) {
        if (u < 1024) diff_unit(u, Z, Y, subln, lam, lds);
        else na_unit(u - 1024, Z, Y, rpb, lds);
    }
}
}

__device__ __forceinline__ void conv_phase(const f16* Z1, f16* Y, const float* scw, const float* cfw, const float* cfb, const float* lng, const float* lnb, LAS unsigned char* lds) {
    const int tid = opaque_tid(), lane = tid & 63, wave = __builtin_amdgcn_readfirstlane(tid >> 6);
    LAS float* U = (LAS float*)lds;
    float cw[31];
#pragma unroll
    for (int k = 0; k < 31; ++k) cw[k] = cfw[k * 512 + tid];
    const float cb = cfb[tid];
    for (int u = blockIdx.x; u < NTOK / 32; u += gridDim.x) {
        const int b = u >> 6, t0 = (u & 63) * 32;
        const f16* zb = Z1 + (size_t)b * SEQ * ZP1;
        {
            f16x4 av[16], gv[16];
#pragma unroll
            for (int pass = 0; pass < 16; ++pass) { const int row = pass * 4 + (tid >> 7), c4 = (tid & 127) * 4, tt = t0 - 15 + row; const bool ok = row < 62 && tt >= 0 && tt < SEQ;
                const int tc = ok ? tt : (t0 < SEQ ? t0 : 0);
                av[pass] = *(const f16x4*)(zb + (size_t)tc * ZP1 + 1536 + c4); gv[pass] = *(const f16x4*)(zb + (size_t)tc * ZP1 + 2048 + c4); }
#pragma unroll
            for (int pass = 0; pass < 16; ++pass) { const int row = pass * 4 + (tid >> 7), c4 = (tid & 127) * 4, tt = t0 - 15 + row; const bool ok = tt >= 0 && tt < SEQ;
                if (row < 62) { f32x4 uv;
#pragma unroll
                    for (int j = 0; j < 4; ++j) uv[j] = ok ? (float)av[pass][j] * __builtin_amdgcn_rcpf(1.f + __builtin_amdgcn_exp2f(-LOG2E * (float)gv[pass][j])) : 0.f;
                    *(LAS f32x4*)(U + row * 512 + c4) = uv; } }
        }
        __syncthreads();
        float uu[62];
#pragma unroll
        for (int i = 0; i < 62; ++i) uu[i] = U[i * 512 + tid];
        __syncthreads();
#pragma unroll
        for (int tt = 0; tt < 32; ++tt) { float v = cb;
#pragma unroll
            for (int k = 0; k < 31; ++k) v += cw[k] * uu[tt + k];
            U[tt * 512 + tid] = v; }
        __syncthreads();
#pragma unroll
        for (int q = 0; q < 4; ++q) { const int tt = wave * 4 + q, t = t0 + tt, c8 = lane * 8;
            const f32x4 x0 = *(const LAS f32x4*)(U + tt * 512 + c8), x1 = *(const LAS f32x4*)(U + tt * 512 + c8 + 4);
            float x[8] = {x0[0], x0[1], x0[2], x0[3], x1[0], x1[1], x1[2], x1[3]};
            float s = 0.f;
#pragma unroll
            for (int j = 0; j < 8; ++j) s += x[j];
            const float mean = wave_sum(s) * (1.f / 512.f); float s2 = 0.f;
#pragma unroll
            for (int j = 0; j < 8; ++j) { x[j] -= mean; s2 += x[j] * x[j]; }
            const float rstd = 1.0f / sqrtf(wave_sum(s2) * (1.f / 512.f) + EPS);
            const f32x4 g0 = *(const f32x4*)(lng + c8), g1 = *(const f32x4*)(lng + c8 + 4), b0 = *(const f32x4*)(lnb + c8), b1 = *(const f32x4*)(lnb + c8 + 4);
            const float gg[8] = {g0[0], g0[1], g0[2], g0[3], g1[0], g1[1], g1[2], g1[3]}, bb[8] = {b0[0], b0[1], b0[2], b0[3], b1[0], b1[1], b1[2], b1[3]};
            float yd[8];
#pragma unroll
            for (int j = 0; j < 8; ++j) yd[j] = silu_f(x[j] * rstd * gg[j] + bb[j]);
            f16* yr = Y + ((size_t)b * SEQ + t) * DM;
            { u32x4 w; w.x = pkh(yd[0], yd[1]); w.y = pkh(yd[2], yd[3]); w.z = pkh(yd[4], yd[5]); w.w = pkh(yd[6], yd[7]); *(u32x4*)(yr + 512 + c8) = w; }
            float cacc[8];
#pragma unroll
            for (int j = 0; j < 8; ++j) cacc[j] = 0.f;
#pragma unroll
            for (int k = 0; k < 3; ++k) { const int ts = t + k - 1;
                if (ts >= 0 && ts < SEQ) { const f16x8 xc = *(const f16x8*)(zb + (size_t)ts * ZP1 + c8), gc = *(const f16x8*)(zb + (size_t)ts * ZP1 + 1024 + c8);
                    const f32x4 w0 = *(const f32x4*)(scw + k * 512 + c8), w1 = *(const f32x4*)(scw + k * 512 + c8 + 4);
                    const float ww[8] = {w0[0], w0[1], w0[2], w0[3], w1[0], w1[1], w1[2], w1[3]};
#pragma unroll
                    for (int j = 0; j < 8; ++j) cacc[j] += ww[j] * ((float)gc[j] * (float)xc[j]); } }
            const f16x8 gb = *(const f16x8*)(zb + (size_t)t * ZP1 + 512 + c8);
            { u32x4 w; w.x = pkh((float)gb[0] * cacc[0], (float)gb[1] * cacc[1]); w.y = pkh((float)gb[2] * cacc[2], (float)gb[3] * cacc[3]);
              w.z = pkh((float)gb[4] * cacc[4], (float)gb[5] * cacc[5]); w.w = pkh((float)gb[6] * cacc[6], (float)gb[7] * cacc[7]); *(u32x4*)(yr + c8) = w; }
        }
        __syncthreads();
    }
}

constexpr int NPHASE = 18;
__global__ void __launch_bounds__(512, 2) fwd(Params p) {
    extern __shared__ __attribute__((aligned(16))) unsigned char lds_raw[];
    LAS unsigned char* lds = (LAS unsigned char*)lds_raw;
    const int tid = threadIdx.x;
    unsigned char* ws = p.ws;
    for (int u = tid; u < (LDS_BYTES - LDSCTL_OFF) / 4; u += 512) ((LAS unsigned*)(lds + LDSCTL_OFF))[u] = 0u;
    __syncthreads();
    XcdBarrier bar; bar.bar = (unsigned*)(ws + WS_CTL) + 4096; bar.x = 0; bar.st = nullptr;
    if (N_LAUNCH_MODE == 1) bar = xcd_barrier_post((unsigned*)(ws + WS_CTL) + 4096, (volatile LAS unsigned*)(lds + MISC_OFF) + 8);
    const int lo = p.ph_lo, hi = p.ph_hi, rep = p.alt;
#ifndef ONLYP
#define ONLYP -1
#endif
#define IN(k) ((ONLYP < 0 || ONLYP == (k)) && lo <= (k) && (k) < hi)
#define SEAM(k) do { if (IN(k) && IN((k) + 1)) xcd_barrier(bar); } while (0)
    const int G = gridDim.x, c = blockIdx.x;
    float* mod0 = (float*)(ws + WS_MOD + MOD0_OFF); float* mod1 = (float*)(ws + WS_MOD + MOD1_OFF);
    f16* H = (f16*)(ws + WS_H); f16* Z = (f16*)(ws + WS_Z); f16* Y = (f16*)(ws + WS_Y); f16* XIN = (f16*)(ws + WS_XIN); f16* HID = (f16*)(ws + WS_HID); f16* Y2 = (f16*)(ws + WS_Y2);
    f16* XR = (f16*)(ws + WS_XIN);
    f16* W13 = (f16*)(ws + WS_W13); f16* W2T = (f16*)(ws + WS_W2);
    float* AFF = (float*)(ws + WS_AFF); int* IDX = (int*)(ws + WS_IDX); float* GV = (float*)(ws + WS_G); short* INV = (short*)(ws + WS_INV);

    if (IN(0)) { phase_prologue(p, lds); } SEAM(0);
    if (IN(1)) { NormArgs a{}; a.src = p.in[I_X]; a.gain = p.in[I_L0_NORM1]; a.shift = mod0; a.scale = mod0 + 1024; a.mstride = 6144; a.hout = H;
        norm_phase<4>(a, lds, true, p.in[I_CTX], mod0 + 16 * 6144, mod0 + 16 * 6144 + 1024); } SEAM(1);
    if (IN(2)) { gm::Gemm g{H, (const f16*)(ws + WS_WIN0), DM, 0, 0}; gm::Order S; S.init(NROWS, ZP0, 1, G, c);
        gm::EpiInProj0 E{Z, (const float*)(ws + WS_MOD + ROPE_OFF)}; gm::gemm_phase<false>(lds, g, S, E); } SEAM(2);
    if (IN(3)) { at::attn_phase(Z, Y, p.in[I_L0_RPB], p.in[I_L0_SUBLN], (const float*)(ws + WS_MOD + LAM_OFF), lds, rep); } SEAM(3);
    if (IN(4)) { gm::Gemm g{Y, (const f16*)(ws + WS_WOUT0), DM, 0, 0}; gm::Order S; S.init(NTOK, DM, 1, G, c);
        gm::EpiResGate<false> E{p.in[I_X], XR, mod0 + 2048, 6144}; gm::gemm_phase<false>(lds, g, S, E); } SEAM(4);
    if (IN(5)) { NormArgs a{}; a.src16 = XR; a.gain = p.in[I_L0_NORM2]; a.shift = mod0 + 3072; a.scale = mod0 + 4096; a.mstride = 6144; a.hout = H; a.wr = p.in[I_L0_WR]; a.aff = AFF; a.hbf = MOE_BF16;
        norm_phase<4>(a, lds, false, nullptr, nullptr, nullptr); } SEAM(5);
    if (IN(6)) { topk_phase(AFF, IDX, GV, INV, H, XIN, lds); } SEAM(6);
    if (IN(7)) { gm::Gemm g{H, W13, DM, 0, (long)2 * DE * DM, IDX}; gm::Order S; S.init(EROWS, 2 * DE, NE, G, c);
        gm::EpiSwiGLU E{HID}; gm::gemm_phase<MOE_BF16, true>(lds, g, S, E); } SEAM(7);
    if (IN(8)) { gm::Gemm g{HID, W2T, DE, (long)EROWS * DE, (long)DM * DE}; gm::Order S; S.init(EROWS, DM, NE, G, c, 1);
        gm::EpiRowScale E{Y2, GV}; gm::gemm_phase<MOE_BF16>(lds, g, S, E); } SEAM(8);
    if (IN(9)) { NormArgs a{}; a.src16 = XR; a.xout = rep ? (f16*)(ws + WS_BIG) : XR; a.y2 = Y2; a.inv = INV; a.gate2 = mod0 + 5120; a.gain = p.in[I_L1_NORM1]; a.shift = mod1; a.scale = mod1 + 1024; a.mstride = 6144; a.hout = rep ? (f16*)(ws + WS_BIG + 128 * MiB) : H;
        norm_phase<2>(a, lds, false, nullptr, nullptr, nullptr);
        cvt_moe(p.in[I_L1_W1], p.in[I_L1_W3], p.in[I_L1_W2], W13, W2T, c * 8 + (tid >> 6), G * 8, tid & 63, lds + (tid >> 6) * CVT_SCR); } SEAM(9);
    if (IN(10)) { gm::Gemm g{H, (const f16*)(ws + WS_WIN1), DM, 0, 0}; gm::Order S; S.init(NTOK, ZP1, 1, G, c);
        gm::EpiF16 E{Z, ZP1}; gm::gemm_phase<false>(lds, g, S, E); } SEAM(10);
    if (IN(11)) { conv_phase(Z, Y, p.in[I_L1_SCW], p.in[I_L1_CFW], p.in[I_L1_CFB], p.in[I_L1_LNG], p.in[I_L1_LNB], lds); } SEAM(11);
    if (IN(12)) { gm::Gemm g{Y, (const f16*)(ws + WS_WOUT1), DM, 0, 0}; gm::Order S; S.init(NTOK, DM, 1, G, c);
        gm::EpiResGate<true> E{XR, rep ? (f16*)(ws + WS_BIG) : XR, mod1 + 2048, 6144}; gm::gemm_phase<false>(lds, g, S, E); } SEAM(12);
    if (IN(13)) { NormArgs a{}; a.src16 = XR; a.gain = p.in[I_L1_NORM2]; a.shift = mod1 + 3072; a.scale = mod1 + 4096; a.mstride = 6144; a.hout = H; a.wr = p.in[I_L1_WR]; a.aff = AFF; a.hbf = MOE_BF16;
        norm_phase<4>(a, lds, false, nullptr, nullptr, nullptr); } SEAM(13);
    if (IN(14)) { topk_phase(AFF, IDX, GV, INV, H, XIN, lds); } SEAM(14);
    if (IN(15)) { gm::Gemm g{H, W13, DM, 0, (long)2 * DE * DM, IDX}; gm::Order S; S.init(EROWS, 2 * DE, NE, G, c);
        gm::EpiSwiGLU E{HID}; gm::gemm_phase<MOE_BF16, true>(lds, g, S, E); } SEAM(15);
    if (IN(16)) { gm::Gemm g{HID, W2T, DE, (long)EROWS * DE, (long)DM * DE}; gm::Order S; S.init(EROWS, DM, NE, G, c, 1);
        gm::EpiRowScale E{Y2, GV}; gm::gemm_phase<MOE_BF16>(lds, g, S, E); } SEAM(16);
    if (IN(17)) { NormArgs a{}; a.src16 = XR; a.xout = XR; a.y2 = Y2; a.inv = INV; a.gate2 = mod1 + 5120; a.gain = p.in[I_FNORM]; a.fout = rep ? (float*)(ws + WS_BIG) : p.out;
        norm_phase<2>(a, lds, false, nullptr, nullptr, nullptr); }
#undef IN
#undef SEAM
}

extern "C" void kernel_launch(void* const* d_in, const int* in_sizes, int n_in, void* d_out, int out_size, void* d_ws, size_t ws_size, hipStream_t stream) {
    static int grid = 0;
    if (grid == 0) {
        if (n_in != 36 || out_size != NTOK * DM || ws_size < WS_END) { fprintf(stderr, "kernel_launch: unexpected shapes (n_in %d out %d ws %zu need %zu)\n", n_in, out_size, ws_size, (size_t)WS_END); grid = -1; return; }
        int dev = 0, cus = 0;
        if (hipGetDevice(&dev) != hipSuccess || hipDeviceGetAttribute(&cus, hipDeviceAttributeMultiprocessorCount, dev) != hipSuccess) { grid = -1; return; }
        if (hipFuncSetAttribute((const void*)fwd, hipFuncAttributeMaxDynamicSharedMemorySize, LDS_BYTES) != hipSuccess) { fprintf(stderr, "kernel_launch: hipFuncSetAttribute failed\n"); grid = -1; return; }
        int per_cu = 0;
        if (hipOccupancyMaxActiveBlocksPerMultiprocessor(&per_cu, (const void*)fwd, 512, LDS_BYTES) != hipSuccess || per_cu < 1) fprintf(stderr, "kernel_launch: occupancy query says %d\n", per_cu);
        (void)hipGetLastError();
        grid = cus;
    }
    if (grid < 0) return;
    (void)hipMemsetAsync((char*)d_ws + WS_CTL, 0, CTL_ZERO_BYTES, stream);
    Params p{};
    for (int i = 0; i < 36; ++i) p.in[i] = (const float*)d_in[i];
    p.out = (float*)d_out; p.ws = (unsigned char*)d_ws;
#if N_LAUNCH_MODE == 1
    p.ph_lo = 0; p.ph_hi = NPHASE;
    hipLaunchKernelGGL(fwd, dim3(grid), dim3(512), LDS_BYTES, stream, p);
#else
    for (int k = 0; k < NPHASE; ++k) { p.ph_lo = k; p.ph_hi = k + 1; p.alt = 0; hipLaunchKernelGGL(fwd, dim3(grid), dim3(512), LDS_BYTES, stream, p);
        for (int r = 0; r < HOSTDUP_N; ++r) if ((HOSTDUP >> k) & 1) { p.alt = HOSTDUP_ALT; hipLaunchKernelGGL(fwd, dim3(grid), dim3(512), LDS_BYTES, stream, p); } }
#endif
}
```

```cpp
#include <hip/hip_runtime.h>
#include <cstdio>
#include <cstdint>

#define LAS __attribute__((address_space(3)))
#define GAS __attribute__((address_space(1)))
typedef _Float16 f16;
typedef _Float16 f16x8 __attribute__((ext_vector_type(8)));
typedef _Float16 f16x4 __attribute__((ext_vector_type(4)));
typedef _Float16 f16x2 __attribute__((ext_vector_type(2)));
typedef float f32x2 __attribute__((ext_vector_type(2)));
typedef float f32x4 __attribute__((ext_vector_type(4)));
typedef float f32x16 __attribute__((ext_vector_type(16)));
typedef unsigned u32x2 __attribute__((ext_vector_type(2)));
typedef unsigned u32x4 __attribute__((ext_vector_type(4)));
typedef short s16x4 __attribute__((ext_vector_type(4)));

#ifndef MOE_BF16
#define MOE_BF16 true
#endif
#ifndef HOSTDUP
#define HOSTDUP 0
#endif
#ifndef HOSTDUP_ALT
#define HOSTDUP_ALT 1
#endif
#ifndef HOSTDUP_N
#define HOSTDUP_N 1
#endif
#ifndef N_LAUNCH_MODE
#define N_LAUNCH_MODE 1
#endif

constexpr int NB = 16, SEQ = 2048, DM = 1024, NTOK = NB * SEQ, CTXL = 256, NCTX = NB * CTXL, NROWS = NTOK + NCTX;
constexpr int ZP0 = 3072, ZP1 = 2560;
constexpr int NE = 16, DE = 2816, CAP = 256, EROWS = NB * CAP;
constexpr float EPS = 1e-6f;
constexpr float LOG2E = 1.4426950408889634f;
constexpr float QSCALE = 0.125f * LOG2E;

constexpr size_t MiB = 1u << 20;
constexpr size_t WS_CTL = 0, CTL_ZERO_BYTES = 256 * 1024;
constexpr size_t WS_MOD = 1 * MiB;
constexpr size_t MOD0_OFF = 0, MOD1_OFF = 17 * 6144 * 4, ROPE_OFF = MOD1_OFF + 16 * 6144 * 4, LAM_OFF = ROPE_OFF + 64 * 16 * 2 * 4;
constexpr size_t WS_WIN0 = 2 * MiB, WS_WOUT0 = 8 * MiB, WS_WIN1 = 10 * MiB, WS_WOUT1 = 15 * MiB;
constexpr size_t WS_AFF = 17 * MiB;
constexpr size_t WS_IDX = 19 * MiB;
constexpr size_t WS_G = 19 * MiB + 512 * 1024;
constexpr size_t WS_INV = 20 * MiB;
constexpr size_t WS_W13 = 22 * MiB;
constexpr size_t WS_W2 = WS_W13 + 176 * MiB;
constexpr size_t WS_H = WS_W2 + 88 * MiB;
constexpr size_t WS_XIN = WS_H + 72 * MiB;
constexpr size_t WS_Y2 = WS_XIN + 128 * MiB;
constexpr size_t WS_BIG = WS_Y2 + 128 * MiB;
constexpr size_t WS_Z = WS_BIG, WS_Y = WS_BIG + 216 * MiB, WS_HID = WS_BIG;
constexpr size_t WS_END = WS_BIG + 352 * MiB;

constexpr int RING_BYTES = 131072;
constexpr int LDSCTL_OFF = RING_BYTES, MISC_OFF = LDSCTL_OFF + 320;
constexpr int LDS_BYTES = 147456;

#define RLX_AGENT __ATOMIC_RELAXED, __HIP_MEMORY_SCOPE_AGENT
#define LDS_WAIT() asm volatile("s_waitcnt lgkmcnt(0)" ::: "memory")
#define VM_WAIT() asm volatile("s_waitcnt vmcnt(0)" ::: "memory")

__device__ __forceinline__ unsigned pkh(float lo, float hi) { f16x2 v; v.x = (f16)lo; v.y = (f16)hi; return __builtin_bit_cast(unsigned, v); }
typedef __bf16 bf16x2_t __attribute__((ext_vector_type(2)));
typedef short s16x8 __attribute__((ext_vector_type(8)));
__device__ __forceinline__ unsigned pkb(float lo, float hi) { f32x2 v = {lo, hi}; bf16x2_t b = __builtin_convertvector(v, bf16x2_t); return __builtin_bit_cast(unsigned, b); }
template <bool BF> __device__ __forceinline__ unsigned pk16(float lo, float hi) { return BF ? pkb(lo, hi) : pkh(lo, hi); }
__device__ __forceinline__ float silu_f(float v) { return v / (1.f + __expf(-v)); }

#define XB_TMO      128
#define XB_XCNT(j)  (256  + 64 * (j))
#define XB_XSUB(j)  (1280 + 64 * (j))
#define XB_XGEN(j)  (2304 + 64 * (j))
#define XB_TOP      3328
#define XB_TOPGEN   3392
#define XCD_BAR_WORDS 3456
#define XB_SPIN_CAP (1u << 18)
__device__ __forceinline__ unsigned xb_ld(unsigned* p)              { return __hip_atomic_load(p, __ATOMIC_RELAXED, __HIP_MEMORY_SCOPE_AGENT); }
__device__ __forceinline__ unsigned xb_add(unsigned* p, unsigned v) { return __hip_atomic_fetch_add(p, v, __ATOMIC_RELAXED, __HIP_MEMORY_SCOPE_AGENT); }
__device__ __forceinline__ unsigned xb_xcc_id() { return (unsigned)__builtin_amdgcn_s_getreg((3 << 11) | 20) & 0xFu; }
#define XB_SPIN(cond, bar) do { unsigned _sp = 0; while (cond) { __builtin_amdgcn_s_sleep(1); \
    if ((++_sp & 255u) == 0u) { if (xb_ld(&(bar)[XB_TMO])) break; if (_sp > XB_SPIN_CAP) { atomicAdd(&(bar)[XB_TMO], 1u); break; } } } } while (0)
struct XcdBarrier { unsigned* bar; unsigned x; volatile LAS unsigned* st; };
__device__ __forceinline__ XcdBarrier xcd_barrier_post(unsigned* bar, volatile LAS unsigned* st) {
    XcdBarrier b; b.bar = bar; b.x = xb_xcc_id(); b.st = st;
    if (threadIdx.x == 0) (void)xb_add(&bar[XB_XCNT(b.x)], 1u);
    return b;
}
__device__ __forceinline__ void xcd_barrier_complete(unsigned* bar, unsigned x, unsigned& nloc, unsigned& nx) {
    const unsigned G = gridDim.x * gridDim.y * gridDim.z;
    unsigned sum, cnt, mine, sp = 0u;
    for (;;) {
        sum = 0u; cnt = 0u; mine = 0u;
#pragma unroll
        for (unsigned j = 0; j < 16; ++j) { const unsigned c = xb_ld(&bar[XB_XCNT(j)]); sum += c; cnt += (c > 0u) ? 1u : 0u; mine = (j == x) ? c : mine; }
        if (sum == G) break;
        __builtin_amdgcn_s_sleep(1);
        if ((++sp & 255u) == 0u) { if (xb_ld(&bar[XB_TMO])) break; if (sp > XB_SPIN_CAP) { atomicAdd(&bar[XB_TMO], 1u); break; } }
    }
    nloc = mine > 0u ? mine : 1u; nx = cnt > 0u ? cnt : 1u;
}
__device__ __forceinline__ void xcd_barrier(const XcdBarrier& b) {
    asm volatile("s_waitcnt vmcnt(0)" ::: "memory");
    __syncthreads();
    if (threadIdx.x == 0) {
        unsigned* bar = b.bar;
        __builtin_amdgcn_s_waitcnt(0);
        unsigned nloc = b.st[0], nx = b.st[1];
        if (nloc == 0u) { xcd_barrier_complete(bar, b.x, nloc, nx); b.st[0] = nloc; b.st[1] = nx; }
        const unsigned old = xb_add(&bar[XB_XSUB(b.x)], 1u);
        const unsigned gen = old / nloc;
        if (old + 1u == (gen + 1u) * nloc) {
            __builtin_amdgcn_fence(__ATOMIC_RELEASE, "agent");
            asm volatile("s_waitcnt vmcnt(0)" ::: "memory");
            const unsigned og = xb_add(&bar[XB_TOP], 1u);
            const unsigned tg = og / nx;
            if (og + 1u == (tg + 1u) * nx) xb_add(&bar[XB_TOPGEN], 1u);
            else XB_SPIN(xb_ld(&bar[XB_TOPGEN]) == tg, bar);
            __builtin_amdgcn_fence(__ATOMIC_ACQUIRE, "agent");
            xb_add(&bar[XB_XGEN(b.x)], 1u);
            asm volatile("s_waitcnt vmcnt(0)" ::: "memory");
        } else {
            XB_SPIN(xb_ld(&bar[XB_XGEN(b.x)]) == gen, bar);
            __builtin_amdgcn_fence(__ATOMIC_ACQUIRE, "agent");
            asm volatile("s_waitcnt vmcnt(0)" ::: "memory");
        }
    }
    __syncthreads();
}

__device__ __forceinline__ int opaque_tid0() { int t = threadIdx.x; asm volatile("" : "+v"(t)); return t; }
namespace gm {
constexpr int BM = 256, BK = 64, HALF = 128, HTB = HALF * BK * 2, STAGE_BYTES = 8 * HTB, NXCD = 8, WGM = 8;
__host__ __device__ __forceinline__ int lds_byte(int r, int c) { const int st = (r >> 4) * 2 + (c >> 5), rr = r & 15, cc = c & 31, ob = rr * 64 + cc * 2; return st * 1024 + (ob ^ (((ob >> 9) & 1) << 5)); }
__host__ __device__ __forceinline__ void stage_rc(int b, int& R, int& C) { const int st = b / 1024, sb = b % 1024, swz = sb ^ (((sb >> 9) & 1) << 5); R = (st >> 1) * 16 + swz / 64; C = (st & 1) * 32 + (swz % 64) / 2; }
__host__ __device__ __forceinline__ int perm32(int rho) { const int n = rho >> 4, i = rho & 15; return 8 * (i >> 2) + 4 * n + (i & 3); }

struct Unit { int g, pm, pn; };
struct Gemm { const f16* A; const f16* Bt; int K; long sA, sB; const int* gidx; };
struct Order {
    int nM, nN, tpg, total, G, c, mode;
    __device__ void init(int M, int N, int groups, int G_, int c_, int mode_ = 0) { nM = M / BM; nN = N / BM; tpg = nM * nN; total = tpg * groups; G = G_; c = c_; mode = (mode_ == 1 && G_ == 256 && nM == 16 && nN == 4) ? 1 : 0; }
    __device__ bool next(int i, Unit& u) const {
        const long L = (long)i * G + c; if (L >= total) return false;
        if (mode == 1) { const int x = c & 7, j = c >> 3; u.g = 4 * i + (x >> 1); u.pm = 8 * (x & 1) + (j >> 2); u.pn = j & 3; return true; }
        const int g = (int)(L / tpg); int wgid = (int)(L % tpg);
        { const int q = tpg / NXCD, r = tpg % NXCD, xcd = wgid % NXCD, off = wgid / NXCD; wgid = (xcd < r ? xcd * (q + 1) : r * (q + 1) + (xcd - r) * q) + off; }
        const int nig = WGM * nN, gid = wgid / nig, fm = gid * WGM, gsz = (nM - fm) < WGM ? (nM - fm) : WGM;
        u.g = g; u.pm = fm + ((wgid % nig) % gsz); u.pn = (wgid % nig) / gsz; return true;
    }
};

typedef f32x4 Acc[2][2][4][2];
typedef __bf16 bf16x8_t __attribute__((ext_vector_type(8)));
template <bool BF> __device__ __forceinline__ f32x4 mma16(const s16x8& a, const s16x8& b, const f32x4& c) {
    if constexpr (BF) return __builtin_amdgcn_mfma_f32_16x16x32_bf16(__builtin_bit_cast(bf16x8_t, a), __builtin_bit_cast(bf16x8_t, b), c, 0, 0, 0);
    else return __builtin_amdgcn_mfma_f32_16x16x32_f16(__builtin_bit_cast(f16x8, a), __builtin_bit_cast(f16x8, b), c, 0, 0, 0);
}

struct EpiF16 {
    static constexpr bool PERM = true;
    f16* O; int ldc;
    __device__ __forceinline__ void operator()(const Acc& acc, const Unit& u, int wr, int wc, int fr, int fq) const {
        const int row0 = u.pm * BM + wr * 64 + fr, col0 = u.pn * BM + wc * 32 + 8 * fq;
#pragma unroll
        for (int ai = 0; ai < 2; ++ai)
#pragma unroll
            for (int m = 0; m < 4; ++m) { f16* rowp = O + (size_t)(row0 + ai * HALF + m * 16) * ldc + col0;
#pragma unroll
                for (int bj = 0; bj < 2; ++bj) { const f32x4 v0 = acc[ai][bj][m][0], v1 = acc[ai][bj][m][1];
                    u32x4 w; w.x = pkh(v0[0], v0[1]); w.y = pkh(v0[2], v0[3]); w.z = pkh(v1[0], v1[1]); w.w = pkh(v1[2], v1[3]);
                    *(u32x4*)(rowp + bj * HALF) = w; } }
    }
};
struct EpiInProj0 {
    static constexpr bool PERM = true;
    f16* O; const float* rope;
    __device__ __forceinline__ void operator()(const Acc& acc, const Unit& u, int wr, int wc, int fr, int fq) const {
        const int row0 = u.pm * BM + wr * 64 + fr, col0 = u.pn * BM + wc * 32 + 8 * fq;
        const float sc = (u.pn < 4) ? QSCALE : 1.f;
        const bool dorope = (u.pn == 2 || u.pn == 3 || u.pn == 6 || u.pn == 7) && (u.pm * BM < NTOK);
#pragma unroll
        for (int ai = 0; ai < 2; ++ai)
#pragma unroll
            for (int m = 0; m < 4; ++m) { const int row = row0 + ai * HALF + m * 16; f16* rowp = O + (size_t)row * ZP0 + col0;
                const int t = row & (SEQ - 1), prow = t >> 6, pcol = t & 63;
#pragma unroll
                for (int bj = 0; bj < 2; ++bj) { f32x4 v0 = acc[ai][bj][m][0] * sc, v1 = acc[ai][bj][m][1] * sc;
                    if (dorope) { const int c = col0 + bj * HALF, half = (c >> 5) & 1, i0 = (c & 31) >> 1; const int pos = half ? pcol : prow;
                        const f32x4* tp = (const f32x4*)(rope + (pos * 16 + i0) * 2); const f32x4 t0 = tp[0], t1 = tp[1];
                        f32x4 r0, r1;
                        r0[0] = v0[0] * t0[0] - v0[1] * t0[1]; r0[1] = v0[0] * t0[1] + v0[1] * t0[0];
                        r0[2] = v0[2] * t0[2] - v0[3] * t0[3]; r0[3] = v0[2] * t0[3] + v0[3] * t0[2];
                        r1[0] = v1[0] * t1[0] - v1[1] * t1[1]; r1[1] = v1[0] * t1[1] + v1[1] * t1[0];
                        r1[2] = v1[2] * t1[2] - v1[3] * t1[3]; r1[3] = v1[2] * t1[3] + v1[3] * t1[2];
                        v0 = r0; v1 = r1; }
                    u32x4 w; w.x = pkh(v0[0], v0[1]); w.y = pkh(v0[2], v0[3]); w.z = pkh(v1[0], v1[1]); w.w = pkh(v1[2], v1[3]);
                    *(u32x4*)(rowp + bj * HALF) = w; } }
    }
};
template <bool BASE16>
struct EpiResGate {
    static constexpr bool PERM = true;
    const void* base; f16* out; const float* gate; int gstride;
    __device__ __forceinline__ void operator()(const Acc& acc, const Unit& u, int wr, int wc, int fr, int fq) const {
        const int col0 = u.pn * BM + wc * 32 + 8 * fq; const int b = (u.pm * BM) / SEQ;
        f32x4 gv[2][2];
#pragma unroll
        for (int bj = 0; bj < 2; ++bj)
#pragma unroll
            for (int n = 0; n < 2; ++n) gv[bj][n] = *(const f32x4*)(gate + (size_t)b * gstride + col0 + bj * HALF + 4 * n);
#pragma unroll
        for (int ai = 0; ai < 2; ++ai)
#pragma unroll
            for (int m = 0; m < 4; ++m) { const size_t off = (size_t)(u.pm * BM + ai * HALF + wr * 64 + m * 16 + fr) * DM + col0;
#pragma unroll
                for (int bj = 0; bj < 2; ++bj) { f32x4 b0, b1;
                    if constexpr (BASE16) { const f16x8 bv = *(const f16x8*)((const f16*)base + off + bj * HALF);
                        b0 = (f32x4){(float)bv[0], (float)bv[1], (float)bv[2], (float)bv[3]}; b1 = (f32x4){(float)bv[4], (float)bv[5], (float)bv[6], (float)bv[7]}; }
                    else { b0 = *(const f32x4*)((const float*)base + off + bj * HALF); b1 = *(const f32x4*)((const float*)base + off + bj * HALF + 4); }
                    const f32x4 v0 = b0 + gv[bj][0] * acc[ai][bj][m][0], v1 = b1 + gv[bj][1] * acc[ai][bj][m][1];
                    u32x4 w; w.x = pkh(v0[0], v0[1]); w.y = pkh(v0[2], v0[3]); w.z = pkh(v1[0], v1[1]); w.w = pkh(v1[2], v1[3]);
                    *(u32x4*)(out + off + bj * HALF) = w; }
                if (m & 1) asm volatile("" ::: "memory"); }
    }
};
struct EpiSwiGLU {
    static constexpr bool PERM = true;
    f16* O;
    __device__ __forceinline__ void operator()(const Acc& acc, const Unit& u, int wr, int wc, int fr, int fq) const {
        const int row0 = u.pm * BM + wr * 64 + fr, col0 = u.pn * HALF + wc * 32 + 8 * fq;
        f16* Og = O + (size_t)u.g * EROWS * DE;
#pragma unroll
        for (int ai = 0; ai < 2; ++ai)
#pragma unroll
            for (int m = 0; m < 4; ++m) { f16* rowp = Og + (size_t)(row0 + ai * HALF + m * 16) * DE + col0;
                float h[8];
#pragma unroll
                for (int n = 0; n < 2; ++n)
#pragma unroll
                    for (int j = 0; j < 4; ++j) { const float g = acc[ai][0][m][n][j], up = acc[ai][1][m][n][j]; h[n * 4 + j] = g * up * __builtin_amdgcn_rcpf(1.f + __builtin_amdgcn_exp2f(-LOG2E * g)); }
                u32x4 w; w.x = pk16<MOE_BF16>(h[0], h[1]); w.y = pk16<MOE_BF16>(h[2], h[3]); w.z = pk16<MOE_BF16>(h[4], h[5]); w.w = pk16<MOE_BF16>(h[6], h[7]);
                *(u32x4*)rowp = w; }
    }
};
struct EpiRowScale {
    static constexpr bool PERM = true;
    f16* O; const float* gv;
    __device__ __forceinline__ void operator()(const Acc& acc, const Unit& u, int wr, int wc, int fr, int fq) const {
        const int row0 = u.pm * BM + wr * 64 + fr, col0 = u.pn * BM + wc * 32 + 8 * fq;
        f16* Og = O + (size_t)u.g * EROWS * DM;
#pragma unroll
        for (int ai = 0; ai < 2; ++ai)
#pragma unroll
            for (int m = 0; m < 4; ++m) { const int row = row0 + ai * HALF + m * 16; const float s = gv[((row >> 8) * NE + u.g) * CAP + (row & 255)];
                f16* rowp = Og + (size_t)row * DM + col0;
#pragma unroll
                for (int bj = 0; bj < 2; ++bj) { const f32x4 v0 = acc[ai][bj][m][0] * s, v1 = acc[ai][bj][m][1] * s;
                    u32x4 w; w.x = pkh(v0[0], v0[1]); w.y = pkh(v0[2], v0[3]); w.z = pkh(v1[0], v1[1]); w.w = pkh(v1[2], v1[3]);
                    *(u32x4*)(rowp + bj * HALF) = w; } }
    }
};

template <bool BF, bool GATHER = false, class Epi>
__device__ __forceinline__ void gemm_phase(LAS unsigned char* lds, const Gemm g, const Order& S, const Epi& E) {
    const int tid = opaque_tid0(), wid = __builtin_amdgcn_readfirstlane(tid >> 6), lane = tid & 63, wr = wid >> 2, wc = wid & 3, fr = lane & 15, fq = lane >> 4;
    const int K = g.K, nt = K / BK;
    unsigned voffA[2], voffB[2];
#pragma unroll
    for (int i = 0; i < 2; ++i) { int R, C; stage_rc(tid * 16 + i * 8192, R, C); const int Rb = Epi::PERM ? ((R & ~31) + perm32(R & 31)) : R;
        voffA[i] = (unsigned)(R * K + C) * 2u; voffB[i] = (unsigned)(Rb * K + C) * 2u; }
    int gR[2], gC[2];
#pragma unroll
    for (int i = 0; i < 2; ++i) { int R, C; stage_rc(tid * 16 + i * 8192, R, C); gR[i] = R; gC[i] = C; }
    unsigned gA0[2] = {0u, 0u}, gA1[2] = {0u, 0u}, nA0[2] = {0u, 0u}, nA1[2] = {0u, 0u};
    LAS unsigned short* gtab = (LAS unsigned short*)(lds + 132096);
    constexpr int GT_MAXU = 22;
#define GM_GCVT(dst0, dst1, uu, ui_) do { const LAS unsigned short* _tp = gtab + (ui_) * 256; _Pragma("unroll") for (int _i = 0; _i < 2; ++_i) { const int _t0 = _tp[gR[_i]], _t1 = _tp[128 + gR[_i]]; \
        dst0[_i] = (unsigned)((((uu).pm * SEQ + _t0) * K + gC[_i]) * 2); dst1[_i] = (unsigned)((((uu).pm * SEQ + _t1) * K + gC[_i]) * 2); } } while (0)
    const size_t kstep = (size_t)(BK * 2);
    const size_t hstep = GATHER ? (size_t)0 : (size_t)HALF * K * 2;
    const size_t hstepB = (size_t)HALF * K * 2;
    const size_t tstep = 2 * hstepB;
    const unsigned ldsw = (unsigned)wid * 1024u;
    const int aoff = lds_byte(wr * 64 + fr, fq * 8), boff = lds_byte(wc * 32 + fr, fq * 8);
#define GM_SA(b, h) (((b) * 2 + (h)) * HTB)
#define GM_SB(b, h) ((4 + (b) * 2 + (h)) * HTB)
#define GM_STAGE(bufoff, gbase, voff) do { _Pragma("unroll") for (int _i = 0; _i < 2; ++_i) \
        __builtin_amdgcn_global_load_lds((const unsigned*)((const char*)(gbase) + (voff)[_i]), (LAS unsigned*)(lds + (bufoff) + ldsw + _i * 8192), 16, 0, 0); } while (0)
#define GM_LDA(dst, b, h) do { _Pragma("unroll") for (int m = 0; m < 4; ++m) _Pragma("unroll") for (int k = 0; k < 2; ++k) dst[m][k] = *(const LAS s16x8*)(lds + GM_SA(b, h) + aoff + m * 2048 + k * 1024); } while (0)
#define GM_LDB(dst, b, h) do { _Pragma("unroll") for (int n = 0; n < 2; ++n) _Pragma("unroll") for (int k = 0; k < 2; ++k) dst[n][k] = *(const LAS s16x8*)(lds + GM_SB(b, h) + boff + n * 2048 + k * 1024); } while (0)
#define GM_MMA(ai, bj, At, Bt) do { __builtin_amdgcn_s_setprio(1); _Pragma("unroll") for (int m = 0; m < 4; ++m) _Pragma("unroll") for (int n = 0; n < 2; ++n) _Pragma("unroll") for (int k = 0; k < 2; ++k) \
        acc[ai][bj][m][n] = mma16<BF>(Bt[n][k], At[m][k], acc[ai][bj][m][n]); __builtin_amdgcn_s_setprio(0); } while (0)
#define GM_WAIT_V(n) asm volatile("s_waitcnt vmcnt(" #n ")" ::: "memory")
#define GM_WAIT_L(n) asm volatile("s_waitcnt lgkmcnt(" #n ")" ::: "memory")
#define GM_BAR __builtin_amdgcn_s_barrier()
#define GM_SCHED __builtin_amdgcn_sched_barrier(0)
    Unit cur, nxt; int ui = 0;
    if (!S.next(0, cur)) return;
    Acc acc;
#pragma unroll
    for (int a = 0; a < 2; ++a)
#pragma unroll
        for (int b = 0; b < 2; ++b)
#pragma unroll
            for (int m = 0; m < 4; ++m)
#pragma unroll
                for (int n = 0; n < 2; ++n) acc[a][b][m][n] = (f32x4){0.f, 0.f, 0.f, 0.f};
    s16x8 At[4][2], B0[2][2], B1[2][2];
    const char* cA = GATHER ? (const char*)g.A : (const char*)(g.A + (size_t)cur.g * g.sA) + (size_t)cur.pm * tstep; const char* cB = (const char*)(g.Bt + (size_t)cur.g * g.sB) + (size_t)cur.pn * tstep;
    if constexpr (GATHER) {
        int tv[GT_MAXU / 2];
#pragma unroll
        for (int j = 0; j < GT_MAXU / 2; ++j) { const int ui_ = 2 * j + (tid >> 8); Unit uu; const bool okk = S.next(ui_, uu); tv[j] = g.gidx[(okk ? (uu.pm * NE + uu.g) * CAP : 0) + (tid & 255)]; }
#pragma unroll
        for (int j = 0; j < GT_MAXU / 2; ++j) gtab[(2 * j + (tid >> 8)) * 256 + (tid & 255)] = (unsigned short)tv[j];
        __syncthreads();
        GM_GCVT(gA0, gA1, cur, 0);
    }
#define GM_STA_H0(buf, p, o0) do { if constexpr (GATHER) GM_STAGE(buf, p, o0); else GM_STAGE(buf, p, voffA); } while (0)
#define GM_STA_H1(buf, p, o1) do { if constexpr (GATHER) GM_STAGE(buf, p, o1); else GM_STAGE(buf, (p) + hstepB, voffA); } while (0)
    GM_STAGE(GM_SB(0, 0), cB, voffB); GM_STAGE(GM_SB(0, 1), cB + hstepB, voffB); GM_STA_H0(GM_SA(0, 0), cA, gA0); GM_STA_H1(GM_SA(0, 1), cA, gA1);
    if (wr == 1) GM_BAR;
    GM_WAIT_V(2); GM_BAR;
    GM_STAGE(GM_SB(1, 0), cB + kstep, voffB); GM_STA_H0(GM_SA(1, 0), cA + kstep, gA0); GM_STAGE(GM_SB(1, 1), cB + hstepB + kstep, voffB);
    GM_WAIT_V(6); GM_BAR;
    for (;;) {
        const bool has_next = S.next(ui + 1, nxt);
        const char* nA = GATHER ? cA : (has_next ? (const char*)(g.A + (size_t)nxt.g * g.sA) + (size_t)nxt.pm * tstep : cA); const char* nB = has_next ? (const char*)(g.Bt + (size_t)nxt.g * g.sB) + (size_t)nxt.pn * tstep : cB;
        if constexpr (GATHER) { if (has_next) GM_GCVT(nA0, nA1, nxt, ui + 1); else { nA0[0] = gA0[0]; nA0[1] = gA0[1]; nA1[0] = gA1[0]; nA1[1] = gA1[1]; } }
        for (int t = 0; t < nt; t += 2) {
            const bool last = (t == nt - 2);
            const char* a1 = cA + (size_t)(t + 1) * kstep;
            const char* a2 = last ? nA : cA + (size_t)(t + 2) * kstep; const char* b2 = last ? nB : cB + (size_t)(t + 2) * kstep;
            const char* a3 = a2 + kstep; const char* b3 = b2 + kstep;
            unsigned s0[2], s1[2];
            if constexpr (GATHER) { s0[0] = last ? nA0[0] : gA0[0]; s0[1] = last ? nA0[1] : gA0[1]; s1[0] = last ? nA1[0] : gA1[0]; s1[1] = last ? nA1[1] : gA1[1]; }
            GM_LDB(B0, 0, 0); GM_LDB(B1, 0, 1); GM_SCHED; GM_LDA(At, 0, 0); GM_STA_H1(GM_SA(1, 1), a1, gA1);
            GM_WAIT_V(8); GM_WAIT_L(0); GM_BAR; GM_MMA(0, 0, At, B0); GM_MMA(0, 1, At, B1); GM_BAR; GM_SCHED;
            GM_LDA(At, 0, 1); GM_STAGE(GM_SB(0, 0), b2, voffB); GM_STAGE(GM_SB(0, 1), b2 + hstepB, voffB); GM_STA_H0(GM_SA(0, 0), a2, s0);
            GM_WAIT_V(8); GM_WAIT_L(0); GM_BAR; GM_MMA(1, 0, At, B0); GM_MMA(1, 1, At, B1); GM_BAR; GM_SCHED;
            GM_LDB(B0, 1, 0); GM_LDB(B1, 1, 1); GM_SCHED; GM_LDA(At, 1, 0); GM_STA_H1(GM_SA(0, 1), a2, s1);
            GM_WAIT_V(8); GM_WAIT_L(0); GM_BAR; GM_MMA(0, 0, At, B0); GM_MMA(0, 1, At, B1); GM_BAR; GM_SCHED;
            GM_LDA(At, 1, 1); GM_STAGE(GM_SB(1, 0), b3, voffB); GM_STAGE(GM_SB(1, 1), b3 + hstepB, voffB); GM_STA_H0(GM_SA(1, 0), a3, s0);
            GM_WAIT_V(8); GM_WAIT_L(0); GM_BAR; GM_MMA(1, 0, At, B0); GM_MMA(1, 1, At, B1); GM_BAR; GM_SCHED;
        }
        if (wr == 0) GM_BAR;
        E(acc, cur, wr, wc, fr, fq);
        if (!has_next) break;
#pragma unroll
        for (int a = 0; a < 2; ++a)
#pragma unroll
            for (int b = 0; b < 2; ++b)
#pragma unroll
                for (int m = 0; m < 4; ++m)
#pragma unroll
                    for (int n = 0; n < 2; ++n) acc[a][b][m][n] = (f32x4){0.f, 0.f, 0.f, 0.f};
        cur = nxt; cA = nA; cB = nB; ++ui;
        if constexpr (GATHER) { gA0[0] = nA0[0]; gA0[1] = nA0[1]; gA1[0] = nA1[0]; gA1[1] = nA1[1]; }
        if (wr == 1) GM_BAR;
    }
    GM_WAIT_V(0);
    GM_BAR;
#undef GM_SA
#undef GM_STA_H0
#undef GM_STA_H1
#undef GM_GCVT
#undef GM_SB
#undef GM_STAGE
#undef GM_LDA
#undef GM_LDB
#undef GM_MMA
#undef GM_WAIT_V
#undef GM_WAIT_L
#undef GM_BAR
#undef GM_SCHED
}
}

struct Params { const float* in[36]; float* out; unsigned char* ws; int ph_lo, ph_hi, alt, pad; };
enum { I_X = 0, I_C, I_CTX, I_CCTX, I_L0_NORM1, I_L0_WMOD, I_L0_BMOD, I_L0_WIN, I_L0_WOUT, I_L0_RPB, I_L0_LQ1, I_L0_LK1, I_L0_LQ2, I_L0_LK2, I_L0_SUBLN,
       I_L0_NORM2, I_L0_WR, I_L0_W1, I_L0_W3, I_L0_W2, I_L1_NORM1, I_L1_WMOD, I_L1_BMOD, I_L1_WIN, I_L1_WOUT, I_L1_SCW, I_L1_CFW, I_L1_CFB, I_L1_LNG, I_L1_LNB,
       I_L1_NORM2, I_L1_WR, I_L1_W1, I_L1_W3, I_L1_W2, I_FNORM };

__device__ __forceinline__ int opaque_tid() { int t = threadIdx.x; asm volatile("" : "+v"(t)); return t; }
__device__ __forceinline__ float wave_sum(float v) {
#pragma unroll
    for (int o = 1; o < 64; o <<= 1) v += __shfl_xor(v, o);
    return v;
}

constexpr int CVT_RS = 136, CVT_SCR = 64 * CVT_RS;
template <bool BF, class RowMap>
__device__ __forceinline__ void cvt_item(const float* W, int K, int N, f16* WT, const RowMap& rm, int item, int lane, LAS unsigned char* scr) {
    const int nblk = N / 64, kb = item / nblk, nb = item % nblk, k0 = 64 * kb, n0 = 64 * nb;
    const float* src = W + (size_t)(k0 + (lane >> 4)) * N + n0 + 4 * (lane & 15);
    f32x4 v[16];
#pragma unroll
    for (int i = 0; i < 16; ++i) v[i] = *(const f32x4*)(src + (size_t)(4 * i) * N);
#pragma unroll
    for (int i = 0; i < 16; ++i) { u32x2 w; w.x = pk16<BF>(v[i][0], v[i][1]); w.y = pk16<BF>(v[i][2], v[i][3]);
        *(LAS u32x2*)(scr + (4 * i + (lane >> 4)) * CVT_RS + 8 * (lane & 15)) = w; }
    const int g = lane >> 4, i16 = lane & 15, q_ = i16 >> 2, p_ = i16 & 3;
#pragma unroll
    for (int st = 0; st < 8; ++st) {
        const int nl = 16 * (st >> 1), ch = 4 * (st & 1) + g;
        const LAS unsigned char* ap = scr + (8 * ch + q_) * CVT_RS + (nl + 4 * p_) * 2;
        const s16x4 lo = __builtin_amdgcn_ds_read_tr16_b64_v4i16((LAS s16x4*)ap);
        const s16x4 hi = __builtin_amdgcn_ds_read_tr16_b64_v4i16((LAS s16x4*)(ap + 4 * CVT_RS));
        u32x4 w; const u32x2 l2 = __builtin_bit_cast(u32x2, lo), h2 = __builtin_bit_cast(u32x2, hi); w.x = l2.x; w.y = l2.y; w.z = h2.x; w.w = h2.y;
        *(u32x4*)(WT + (size_t)rm(n0 + nl + i16) * K + k0 + 8 * ch) = w;
    }
}
struct MapPlain { __device__ __forceinline__ int operator()(int n) const { return n; } };
struct MapRope { __device__ __forceinline__ int operator()(int n) const {
    const bool rp = (n >= 512 && n < 1024) || (n >= 1536 && n < 2048); if (!rp) return n; const int i = n & 31; return (n & ~31) + (i < 16 ? 2 * i : 2 * (i - 16) + 1); } };
struct MapGLU { int add; __device__ __forceinline__ int operator()(int n) const { return (n >> 7) * 256 + (n & 127) + add; } };

constexpr int CVB_RS = 264;
template <bool BF, class RowMap>
__device__ __forceinline__ void cvt_block(const float* W, int K, int N, f16* WT, const RowMap& rm, int item, int tid, LAS unsigned char* S) {
    const int lane = tid & 63, wave = tid >> 6;
    const int nblk = N / 128, kb = item / nblk, nb = item % nblk, k0 = 256 * kb, n0 = 128 * nb;
    const float* src = W + (size_t)(k0 + 32 * wave + (lane >> 5)) * N + n0 + 4 * (lane & 31);
    f32x4 v[16];
#pragma unroll
    for (int i = 0; i < 16; ++i) v[i] = *(const f32x4*)(src + (size_t)(2 * i) * N);
#pragma unroll
    for (int i = 0; i < 16; ++i) { u32x2 w; w.x = pk16<BF>(v[i][0], v[i][1]); w.y = pk16<BF>(v[i][2], v[i][3]);
        *(LAS u32x2*)(S + (32 * wave + 2 * i + (lane >> 5)) * CVB_RS + 8 * (lane & 31)) = w; }
    __syncthreads();
    const int g = lane >> 4, i16 = lane & 15, q_ = i16 >> 2, p_ = i16 & 3;
    f16* drow = WT + (size_t)rm(n0 + 16 * wave + i16) * K + k0;
#pragma unroll
    for (int st = 0; st < 8; ++st) {
        const int ch = 4 * st + g;
        const LAS unsigned char* ap = S + (8 * ch + q_) * CVB_RS + (16 * wave + 4 * p_) * 2;
        const s16x4 lo = __builtin_amdgcn_ds_read_tr16_b64_v4i16((LAS s16x4*)ap);
        const s16x4 hi = __builtin_amdgcn_ds_read_tr16_b64_v4i16((LAS s16x4*)(ap + 4 * CVB_RS));
        u32x4 w; const u32x2 l2 = __builtin_bit_cast(u32x2, lo), h2 = __builtin_bit_cast(u32x2, hi); w.x = l2.x; w.y = l2.y; w.z = h2.x; w.w = h2.y;
        *(u32x4*)(drow + 8 * ch) = w;
    }
    __syncthreads();
}
__device__ __forceinline__ void cvt_moe(const float* w1, const float* w3, const float* w2, f16* W13, f16* W2T, int tid, LAS unsigned char* S) {
    constexpr int I13 = (DM / 256) * (DE / 128), I2 = (DE / 256) * (DM / 128);
    constexpr int NIT = NE * (2 * I13 + I2);
    for (int it = blockIdx.x; it < NIT; it += gridDim.x) {
        const int e = it / (2 * I13 + I2); int r = it % (2 * I13 + I2);
        if (r < I13) { cvt_block<MOE_BF16>(w1 + (size_t)e * DM * DE, DM, DE, W13 + (size_t)e * 2 * DE * DM, MapGLU{0}, r, tid, S); continue; } r -= I13;
        if (r < I13) { cvt_block<MOE_BF16>(w3 + (size_t)e * DM * DE, DM, DE, W13 + (size_t)e * 2 * DE * DM, MapGLU{128}, r, tid, S); continue; } r -= I13;
        cvt_block<MOE_BF16>(w2 + (size_t)e * DE * DM, DE, DM, W2T + (size_t)e * DM * DE, MapPlain{}, r, tid, S);
    }
}

__device__ __forceinline__ void phase_prologue(const Params& p, LAS unsigned char* lds) {
    const int tid = opaque_tid(), lane = tid & 63, wave = __builtin_amdgcn_readfirstlane(tid >> 6);
    const int G = gridDim.x;
    unsigned char* ws = p.ws;
    LAS float* S = (LAS float*)lds;
    LAS float* red = (LAS float*)(lds + 17 * 1024 * 4);
    for (int u = blockIdx.x; u < 193; u += G) {
        if (u == 192) {
            float* rope = (float*)(ws + WS_MOD + ROPE_OFF);
            for (int idx = tid; idx < 1024; idx += 512) { const int pos = idx >> 4, i = idx & 15; const float fr = powf(10000.f, -(float)i / 16.f), ang = (float)pos * fr;
                rope[idx * 2] = cosf(ang); rope[idx * 2 + 1] = sinf(ang); }
            if (wave == 0) { const float s1 = wave_sum(p.in[I_L0_LQ1][lane] * p.in[I_L0_LK1][lane]), s2 = wave_sum(p.in[I_L0_LQ2][lane] * p.in[I_L0_LK2][lane]);
                if (lane == 0) *(float*)(ws + WS_MOD + LAM_OFF) = expf(s1) - expf(s2) + 0.2f; }
            continue;
        }
        const int l = u / 96, col0 = (u % 96) * 64;
        const float* wmod = p.in[l ? I_L1_WMOD : I_L0_WMOD]; const float* bmod = p.in[l ? I_L1_BMOD : I_L0_BMOD];
        float* mod = (float*)(ws + WS_MOD + (l ? MOD1_OFF : MOD0_OFF));
        for (int idx = tid; idx < 17 * 1024; idx += 512) { const float v = idx < 16 * 1024 ? p.in[I_C][idx] : p.in[I_CCTX][idx - 16 * 1024]; S[idx] = silu_f(v); }
        __syncthreads();
        float acc[17];
#pragma unroll
        for (int r = 0; r < 17; ++r) acc[r] = 0.f;
        const int kb = wave * 128;
        for (int kk = 0; kk < 128; kk += 4) {
            float wv[4];
#pragma unroll
            for (int i = 0; i < 4; ++i) wv[i] = wmod[(size_t)(kb + kk + i) * 6144 + col0 + lane];
#pragma unroll
            for (int r = 0; r < 17; ++r) { const f32x4 sv = *(const LAS f32x4*)(S + r * 1024 + kb + kk); acc[r] += sv[0] * wv[0] + sv[1] * wv[1] + sv[2] * wv[2] + sv[3] * wv[3]; }
        }
#pragma unroll
        for (int r = 0; r < 17; ++r) red[(wave * 17 + r) * 64 + lane] = acc[r];
        __syncthreads();
        for (int idx = tid; idx < 17 * 64; idx += 512) { const int r = idx >> 6, ln = idx & 63; float s = bmod[col0 + ln];
#pragma unroll
            for (int w = 0; w < 8; ++w) s += red[(w * 17 + r) * 64 + ln];
            if (r < 16 || l == 0) mod[(size_t)r * 6144 + col0 + ln] = s; }
        __syncthreads();
    }
    constexpr int IT_IN0 = (DM / 256) * (ZP0 / 128), IT_OUT = (DM / 256) * (DM / 128), IT_IN1 = (DM / 256) * (ZP1 / 128);
    for (int it = blockIdx.x; it < IT_IN0 + 2 * IT_OUT + IT_IN1; it += G) {
        int r = it;
        if (r < IT_IN0) { cvt_block<false>(p.in[I_L0_WIN], DM, ZP0, (f16*)(ws + WS_WIN0), MapRope{}, r, tid, lds); continue; } r -= IT_IN0;
        if (r < IT_OUT) { cvt_block<false>(p.in[I_L0_WOUT], DM, DM, (f16*)(ws + WS_WOUT0), MapPlain{}, r, tid, lds); continue; } r -= IT_OUT;
        if (r < IT_IN1) { cvt_block<false>(p.in[I_L1_WIN], DM, ZP1, (f16*)(ws + WS_WIN1), MapPlain{}, r, tid, lds); continue; } r -= IT_IN1;
        cvt_block<false>(p.in[I_L1_WOUT], DM, DM, (f16*)(ws + WS_WOUT1), MapPlain{}, r, tid, lds);
    }
    cvt_moe(p.in[I_L0_W1], p.in[I_L0_W3], p.in[I_L0_W2], (f16*)(ws + WS_W13), (f16*)(ws + WS_W2), tid, lds);
}

struct NormArgs {
    const float* src;
    const f16* src16;
    f16* xout;
    const f16* y2; const short* inv; const float* gate2;
    const float* gain;
    const float* shift; const float* scale; int mstride;
    f16* hout;
    float* fout;
    const float* wr; float* aff;
    bool hbf;
};

template <int R>
__device__ __forceinline__ void norm_phase(const NormArgs& a, LAS unsigned char* lds, bool ctx_rows, const float* ctx_src, const float* ctx_shift, const float* ctx_scale) {
    const int tid = opaque_tid(), lane = tid & 63, wave = __builtin_amdgcn_readfirstlane(tid >> 6);
    const int G = gridDim.x;
    LAS float* wl = (LAS float*)lds;
    if (a.wr) {
        for (int idx = tid; idx < 16384; idx += 512) { const int k = idx >> 4, e = idx & 15; wl[e * 1028 + k] = a.wr[idx]; }
        __syncthreads();
    }
    const int gw = blockIdx.x * 8 + wave, NGW = G * 8;
    for (int chunk = gw; chunk < NTOK / 16; chunk += NGW) {
        const int row0 = chunk * 16, b = row0 / SEQ;
        f32x4 A[4], Sh[4], G2[4];
#pragma unroll
        for (int j = 0; j < 4; ++j) { const int c = 4 * lane + 256 * j; const f32x4 g = *(const f32x4*)(a.gain + c);
            if (a.shift) { const f32x4 sc = *(const f32x4*)(a.scale + (size_t)b * a.mstride + c); A[j] = g * (sc + 1.f); Sh[j] = *(const f32x4*)(a.shift + (size_t)b * a.mstride + c); }
            else { A[j] = g; Sh[j] = (f32x4){0.f, 0.f, 0.f, 0.f}; }
            if (a.y2) G2[j] = *(const f32x4*)(a.gate2 + (size_t)b * 6144 + c); else G2[j] = (f32x4){0.f, 0.f, 0.f, 0.f}; }
        for (int rr = 0; rr < 16; rr += R) {
            f32x4 v[R][4];
            int sl[R];
#pragma unroll
            for (int q = 0; q < R; ++q) { sl[q] = -1; if (a.y2 && lane < 16) sl[q] = a.inv[((size_t)b * NE + lane) * SEQ + ((row0 + rr + q) & (SEQ - 1))]; }
#pragma unroll
            for (int q = 0; q < R; ++q) { const int row = row0 + rr + q;
                if (a.src16) { const f16* xr = a.src16 + (size_t)row * DM;
#pragma unroll
                    for (int j = 0; j < 4; ++j) { const f16x4 t = *(const f16x4*)(xr + 4 * lane + 256 * j); v[q][j] = (f32x4){(float)t[0], (float)t[1], (float)t[2], (float)t[3]}; } }
                else { const float* xr = a.src + (size_t)row * DM;
#pragma unroll
                    for (int j = 0; j < 4; ++j) v[q][j] = *(const f32x4*)(xr + 4 * lane + 256 * j); } }
            if (a.y2) {
                unsigned long long mask[R]; int ee[R][4]; float wgt[R][4]; f16x4 ld[R][4][4];
#pragma unroll
                for (int q = 0; q < R; ++q) { mask[q] = __ballot(sl[q] >= 0);
#pragma unroll
                    for (int i = 0; i < 4; ++i) { if (mask[q]) { ee[q][i] = __builtin_ctzll(mask[q]); mask[q] &= mask[q] - 1; wgt[q][i] = 1.f; } else { ee[q][i] = i ? ee[q][0] : 0; wgt[q][i] = 0.f; } }
#pragma unroll
                    for (int i = 0; i < 4; ++i) { int slot = __shfl(sl[q], ee[q][i]); slot = slot < 0 ? 0 : slot; const f16* yr = a.y2 + ((size_t)ee[q][i] * EROWS + b * CAP + slot) * DM + 4 * lane;
#pragma unroll
                        for (int j = 0; j < 4; ++j) ld[q][i][j] = *(const f16x4*)(yr + 256 * j); } }
#pragma unroll
                for (int q = 0; q < R; ++q) { const int row = row0 + rr + q;
                    f32x4 cs[4];
#pragma unroll
                    for (int j = 0; j < 4; ++j) cs[j] = (f32x4){0.f, 0.f, 0.f, 0.f};
#pragma unroll
                    for (int i = 0; i < 4; ++i)
#pragma unroll
                        for (int j = 0; j < 4; ++j) { cs[j][0] += wgt[q][i] * (float)ld[q][i][j][0]; cs[j][1] += wgt[q][i] * (float)ld[q][i][j][1]; cs[j][2] += wgt[q][i] * (float)ld[q][i][j][2]; cs[j][3] += wgt[q][i] * (float)ld[q][i][j][3]; }
                    while (mask[q]) {
                        const int e2 = __builtin_ctzll(mask[q]); mask[q] &= mask[q] - 1; const int slot = __shfl(sl[q], e2); const f16* yr = a.y2 + ((size_t)e2 * EROWS + b * CAP + slot) * DM + 4 * lane;
#pragma unroll
                        for (int j = 0; j < 4; ++j) { const f16x4 t = *(const f16x4*)(yr + 256 * j); cs[j][0] += (float)t[0]; cs[j][1] += (float)t[1]; cs[j][2] += (float)t[2]; cs[j][3] += (float)t[3]; }
                    }
                    f16* xo = a.xout + (size_t)row * DM;
#pragma unroll
                    for (int j = 0; j < 4; ++j) { v[q][j] = v[q][j] + G2[j] * cs[j]; if (!a.fout) { u32x2 w; w.x = pkh(v[q][j][0], v[q][j][1]); w.y = pkh(v[q][j][2], v[q][j][3]); *(u32x2*)(xo + 4 * lane + 256 * j) = w; } }
                }
            }
            float rstd[R];
#pragma unroll
            for (int q = 0; q < R; ++q) { float ss = 0.f;
#pragma unroll
                for (int j = 0; j < 4; ++j) ss += (v[q][j][0] * v[q][j][0] + v[q][j][1] * v[q][j][1]) + (v[q][j][2] * v[q][j][2] + v[q][j][3] * v[q][j][3]);
                rstd[q] = 1.0f / sqrtf(wave_sum(ss) * (1.f / DM) + EPS); }
#pragma unroll
            for (int q = 0; q < R; ++q) { const int row = row0 + rr + q;
#pragma unroll
                for (int j = 0; j < 4; ++j) v[q][j] = (v[q][j] * rstd[q]) * A[j] + Sh[j];
                if (a.fout) {
#pragma unroll
                    for (int j = 0; j < 4; ++j) *(f32x4*)(a.fout + (size_t)row * DM + 4 * lane + 256 * j) = v[q][j];
                }
                if (a.hout) {
#pragma unroll
                    for (int j = 0; j < 4; ++j) { u32x2 w; if (a.hbf) { w.x = pkb(v[q][j][0], v[q][j][1]); w.y = pkb(v[q][j][2], v[q][j][3]); } else { w.x = pkh(v[q][j][0], v[q][j][1]); w.y = pkh(v[q][j][2], v[q][j][3]); } *(u32x2*)(a.hout + (size_t)row * DM + 4 * lane + 256 * j) = w; }
                }
            }
            if (a.wr) {
#pragma unroll 1
                for (int q = 0; q < R; ++q) {
                    float lg[16];
                    f32x4 h0 = v[0][0], h1 = v[0][1], h2 = v[0][2], h3 = v[0][3];
#pragma unroll
                    for (int qq = 1; qq < R; ++qq) if (q == qq) { h0 = v[qq][0]; h1 = v[qq][1]; h2 = v[qq][2]; h3 = v[qq][3]; }
#pragma unroll
                    for (int e = 0; e < 16; ++e) { const LAS float* wp = wl + e * 1028 + 4 * lane;
                        const f32x4 w0 = *(const LAS f32x4*)(wp), w1 = *(const LAS f32x4*)(wp + 256), w2 = *(const LAS f32x4*)(wp + 512), w3 = *(const LAS f32x4*)(wp + 768);
                        lg[e] = ((h0[0] * w0[0] + h0[1] * w0[1]) + (h0[2] * w0[2] + h0[3] * w0[3])) + ((h1[0] * w1[0] + h1[1] * w1[1]) + (h1[2] * w1[2] + h1[3] * w1[3]))
                              + ((h2[0] * w2[0] + h2[1] * w2[1]) + (h2[2] * w2[2] + h2[3] * w2[3])) + ((h3[0] * w3[0] + h3[1] * w3[1]) + (h3[2] * w3[2] + h3[3] * w3[3]));
                        asm volatile("" ::: "memory"); }
#pragma unroll
                    for (int i = 0; i < 8; ++i) { const bool hi = lane & 32; const float send = hi ? lg[i] : lg[i + 8], keep = hi ? lg[i + 8] : lg[i]; lg[i] = keep + __shfl_xor(send, 32); }
#pragma unroll
                    for (int i = 0; i < 4; ++i) { const bool hi = lane & 16; const float send = hi ? lg[i] : lg[i + 4], keep = hi ? lg[i + 4] : lg[i]; lg[i] = keep + __shfl_xor(send, 16); }
#pragma unroll
                    for (int i = 0; i < 2; ++i) { const bool hi = lane & 8; const float send = hi ? lg[i] : lg[i + 2], keep = hi ? lg[i + 2] : lg[i]; lg[i] = keep + __shfl_xor(send, 8); }
                    { const bool hi = lane & 4; const float send = hi ? lg[0] : lg[1], keep = hi ? lg[1] : lg[0]; lg[0] = keep + __shfl_xor(send, 4); }
                    float lv = lg[0]; lv += __shfl_xor(lv, 2); lv += __shfl_xor(lv, 1);
                    float mx = lv;
#pragma unroll
                    for (int o = 4; o < 64; o <<= 1) mx = fmaxf(mx, __shfl_xor(mx, o));
                    const float ex = expf(lv - mx); float sm = ex;
#pragma unroll
                    for (int o = 4; o < 64; o <<= 1) sm += __shfl_xor(sm, o);
                    const int row = row0 + rr + q, t = row & (SEQ - 1), e = (lane >> 2) & 15;
                    if ((lane & 3) == 0) a.aff[((size_t)b * NE + e) * SEQ + t] = ex / sm;
                }
            }
        }
    }
    if (ctx_rows) {
        f32x4 A[4], Sh[4];
#pragma unroll
        for (int j = 0; j < 4; ++j) { const int c = 4 * lane + 256 * j; A[j] = *(const f32x4*)(a.gain + c) * (*(const f32x4*)(ctx_scale + c) + 1.f); Sh[j] = *(const f32x4*)(ctx_shift + c); }
        for (int row = gw; row < NCTX; row += NGW) {
            f32x4 v[4]; float ss = 0.f;
#pragma unroll
            for (int j = 0; j < 4; ++j) { v[j] = *(const f32x4*)(ctx_src + (size_t)row * DM + 4 * lane + 256 * j); ss += (v[j][0] * v[j][0] + v[j][1] * v[j][1]) + (v[j][2] * v[j][2] + v[j][3] * v[j][3]); }
            const float rstd = 1.0f / sqrtf(wave_sum(ss) * (1.f / DM) + EPS);
#pragma unroll
            for (int j = 0; j < 4; ++j) { const f32x4 h = (v[j] * rstd) * A[j] + Sh[j]; u32x2 w; w.x = pkh(h[0], h[1]); w.y = pkh(h[2], h[3]); *(u32x2*)(a.hout + (size_t)(NTOK + row) * DM + 4 * lane + 256 * j) = w; }
        }
    }
    __syncthreads();
}

__device__ __forceinline__ void topk_phase(const float* aff, int* idx, float* gv, short* inv, const f16* H, f16* XIN, LAS unsigned char* lds) {
    const int tid = opaque_tid(), lane = tid & 63, wave = __builtin_amdgcn_readfirstlane(tid >> 6);
    LAS unsigned long long* key = (LAS unsigned long long*)lds;
    for (int u = blockIdx.x; u < NB * NE; u += gridDim.x) {
        const int b = u / NE, e = u % NE;
        const float* av = aff + (size_t)u * SEQ;
        for (int t = tid; t < SEQ; t += 512) key[t] = ((unsigned long long)(~__float_as_uint(av[t])) << 32) | (unsigned)t;
        __syncthreads();
        for (int k = 2; k <= SEQ; k <<= 1)
            for (int j = k >> 1; j > 0; j >>= 1) {
#pragma unroll
                for (int pp = 0; pp < 2; ++pp) { const int pr = tid + pp * 512; const int i = ((pr & ~(j - 1)) << 1) | (pr & (j - 1)), i2 = i | j;
                    const unsigned long long x = key[i], y = key[i2]; const bool up = (i & k) == 0;
                    if ((x > y) == up) { key[i] = y; key[i2] = x; } }
                __syncthreads();
            }
        for (int r = tid; r < SEQ; r += 512) { const unsigned long long kk = key[r]; const int t = (int)(unsigned)kk;
            inv[(size_t)u * SEQ + t] = (short)(r < CAP ? r : -1);
            if (r < CAP) { idx[u * CAP + r] = t; gv[u * CAP + r] = __uint_as_float(~(unsigned)(kk >> 32)); } }
        __syncthreads();
    }
}

namespace at {
constexpr int SLOT = 32768, NSLOT = 4;
constexpr int RPB_OFF = 132096;
constexpr float THR = 8.f;
typedef _Float16 v4h __attribute__((ext_vector_type(4)));
__device__ __forceinline__ int fsw(int row) { return ((row & 3) << 2) | ((row >> 2) & 3); }

__device__ __forceinline__ void glds16(const void* gsrc, unsigned lds_dst) { unsigned keep;
    asm volatile("s_mov_b32 %0, m0\n\ts_mov_b32 m0, %2\n\ts_nop 0\n\tglobal_load_lds_dwordx4 %1, off\n\ts_mov_b32 m0, %0" : "=&s"(keep) : "v"(gsrc), "s"(lds_dst) : "memory"); }
__device__ __forceinline__ void dma_tile(const f16* Z, long rowbase, int kcol, int vcol, LAS unsigned char* slot, int wave, int lane) {
    const unsigned sbase = (unsigned)__builtin_amdgcn_readfirstlane((int)(unsigned)(uintptr_t)slot);
#pragma unroll
    for (int i = 0; i < 2; ++i) { const int piece = wave + 8 * i, row = 4 * piece + (lane >> 4), c = (lane & 15) ^ fsw(row);
        const f16* gp = Z + (size_t)(rowbase + row) * ZP0 + 8 * c;
        glds16(gp + kcol, sbase + piece * 1024);
        glds16(gp + vcol, sbase + 16384 + piece * 1024); }
}
#define AT_WAIT(n) asm volatile("s_waitcnt vmcnt(" #n ") lgkmcnt(0)" ::: "memory")
__device__ __forceinline__ void wait_tile(int younger) { if (younger >= 2) AT_WAIT(8); else if (younger == 1) AT_WAIT(4); else AT_WAIT(0); }

template <int NDT> struct Addr { int k[4]; int v[NDT][2]; };
template <int NDT>
__device__ __forceinline__ Addr<NDT> make_addr(int kb0, int kchunk0, int vchunk0, int lane) {
    Addr<NDT> a; const int r32 = lane & 31, hh = lane >> 5, i = lane & 15, q_ = i >> 2, p_ = i & 3, g1 = (lane >> 4) & 1;
    const int kr = kb0 + r32, fk = fsw(kr);
#pragma unroll
    for (int st = 0; st < 4; ++st) a.k[st] = kr * 256 + 16 * ((kchunk0 + 2 * st + hh) ^ fk);
    const int vr = kb0 + 4 * hh + q_, f0 = fsw(vr), f1 = fsw(vr + 8);
#pragma unroll
    for (int dt = 0; dt < NDT; ++dt) { const int c = vchunk0 + 4 * dt + 2 * g1 + (p_ >> 1);
        a.v[dt][0] = 16384 + vr * 256 + 16 * (c ^ f0) + 8 * (p_ & 1); a.v[dt][1] = 16384 + (vr + 8) * 256 + 16 * (c ^ f1) + 8 * (p_ & 1); }
    return a;
}
#define AT_SCHED() __builtin_amdgcn_sched_barrier(0)
template <int NDT>
__device__ __forceinline__ void load_k(LAS unsigned char* slot, const Addr<NDT>& a, int off, f16x8* kf) {
#pragma unroll
    for (int st = 0; st < 4; ++st) kf[st] = *(const LAS f16x8*)(slot + a.k[st] + off);
}
template <int NDT>
__device__ __forceinline__ void load_v(LAS unsigned char* slot, const Addr<NDT>& a, int off, f16x8* vf) {
#pragma unroll
    for (int s2 = 0; s2 < 2; ++s2)
#pragma unroll
        for (int dt = 0; dt < NDT; ++dt) {
            const v4h lo = __builtin_bit_cast(v4h, __builtin_amdgcn_ds_read_tr16_b64_v4i16((LAS s16x4*)(slot + a.v[dt][0] + off + s2 * 4096)));
            const v4h hi = __builtin_bit_cast(v4h, __builtin_amdgcn_ds_read_tr16_b64_v4i16((LAS s16x4*)(slot + a.v[dt][1] + off + s2 * 4096)));
            vf[s2 * NDT + dt] = (f16x8){lo[0], lo[1], lo[2], lo[3], hi[0], hi[1], hi[2], hi[3]};
        }
}
__device__ __forceinline__ f32x16 qk32(const f16x8* kf, const f16x8 (&qf)[4], const f32x16& negm) {
    f32x16 s = __builtin_amdgcn_mfma_f32_32x32x16_f16(kf[0], qf[0], negm, 0, 0, 0);
#pragma unroll
    for (int st = 1; st < 4; ++st) s = __builtin_amdgcn_mfma_f32_32x32x16_f16(kf[st], qf[st], s, 0, 0, 0);
    return s;
}
__device__ __forceinline__ float max3f(float a, float b, float c) { float r; asm("v_max3_f32 %0, %1, %2, %3" : "=v"(r) : "v"(a), "v"(b), "v"(c)); return r; }
template <int NDT>
__device__ __forceinline__ void pv32(const f16x8* vf, const f32x16& p, f32x16 (&o)[NDT]) {
#pragma unroll
    for (int s2 = 0; s2 < 2; ++s2) {
        f16x8 pb;
#pragma unroll
        for (int j = 0; j < 8; ++j) pb[j] = (f16)p[8 * s2 + j];
#pragma unroll
        for (int dt = 0; dt < NDT; ++dt) o[dt] = __builtin_amdgcn_mfma_f32_32x32x16_f16(vf[s2 * NDT + dt], pb, o[dt], 0, 0, 0);
    }
}
__device__ __forceinline__ float rowmax16(const f32x16& s) { float a = max3f(s[0], s[1], s[2]), b = max3f(s[3], s[4], s[5]);
    a = max3f(a, s[6], s[7]); b = max3f(b, s[8], s[9]); a = max3f(a, s[10], s[11]); b = max3f(b, s[12], s[13]); a = max3f(a, s[14], s[15]); return fmaxf(a, b); }
template <int NDT>
__device__ __forceinline__ float rescale(float mx, float& m, float& l, f32x16 (&o)[NDT], f32x16& negm, bool& started) {
    const bool quiet = started ? (mx <= THR) : (mx == -INFINITY);
    if (__all(quiet)) return 0.f;
    float d = 0.f, alpha = 1.f;
    if (started) { d = fmaxf(mx, 0.f); alpha = __builtin_amdgcn_exp2f(-d); }
    else if (mx > -INFINITY) { d = mx; started = true; }
    m += d; l *= alpha;
#pragma unroll
    for (int dt = 0; dt < NDT; ++dt)
#pragma unroll
        for (int r = 0; r < 16; ++r) o[dt][r] *= alpha;
#pragma unroll
    for (int r = 0; r < 16; ++r) negm[r] = -m;
    return d;
}
__device__ __forceinline__ float expsum(f32x16& s, float d) { float ps = 0.f;
    if (__any(d != 0.f)) {
#pragma unroll
        for (int r = 0; r < 16; ++r) s[r] -= d; }
#pragma unroll
    for (int r = 0; r < 16; ++r) { s[r] = __builtin_amdgcn_exp2f(s[r]); ps += s[r]; }
    return ps; }
template <int NDT>
__device__ __forceinline__ void step64(LAS unsigned char* slot, const Addr<NDT>& a, const f16x8 (&qf)[4], f32x16 (&o)[NDT], float& m, float& l, f32x16& negm, bool& started) {
    f16x8 kf[8], va[2 * NDT], vb[2 * NDT];
    load_k<NDT>(slot, a, 0, kf); load_k<NDT>(slot, a, 8192, kf + 4);
    load_v<NDT>(slot, a, 0, va);
    AT_SCHED();
    f32x16 s0 = qk32(kf, qf, negm), s1 = qk32(kf + 4, qf, negm);
    AT_SCHED();
    load_v<NDT>(slot, a, 8192, vb);
    float mx = fmaxf(rowmax16(s0), rowmax16(s1)); mx = fmaxf(mx, __shfl_xor(mx, 32));
    const float d = rescale<NDT>(mx, m, l, o, negm, started);
    l += expsum(s0, d) + expsum(s1, d);
    AT_SCHED();
    pv32<NDT>(va, s0, o); pv32<NDT>(vb, s1, o);
    AT_SCHED();
}

__device__ __forceinline__ void diff_unit(int u, const f16* Z, f16* Y, const float* subln, float lam, LAS unsigned char* lds) {
    const int tid = opaque_tid(), lane = tid & 63, wave = __builtin_amdgcn_readfirstlane(tid >> 6);
    const int qb = u & 15, h = (u >> 4) & 3, b = u >> 6;
    const int map = wave >> 2, r32 = lane & 31, hh = lane >> 5;
    const long tokbase = (long)b * SEQ;
    const long qrow = tokbase + qb * 128 + (wave & 3) * 32 + r32;
    const int kcol = 1536 + 128 * h, vcol = 2560 + 128 * h;
    constexpr int NT = 36;
#define DIFF_ROWBASE(t) ((t) < 32 ? tokbase + 64 * (t) : (long)NTOK + b * CTXL + 64 * ((t) - 32))
#pragma unroll
    for (int t = 0; t < 3; ++t) dma_tile(Z, DIFF_ROWBASE(t), kcol, vcol, lds + t * SLOT, wave, lane);
    f16x8 qf[4];
#pragma unroll
    for (int st = 0; st < 4; ++st) qf[st] = *(const f16x8*)(Z + (size_t)qrow * ZP0 + 512 + 128 * h + 64 * map + 16 * st + 8 * hh);
    asm volatile("" : "+v"(qf[0]), "+v"(qf[1]), "+v"(qf[2]), "+v"(qf[3]));
    const Addr<4> ad = make_addr<4>(0, 8 * map, 0, lane);
    f32x16 o[4];
#pragma unroll
    for (int dt = 0; dt < 4; ++dt)
#pragma unroll
        for (int r = 0; r < 16; ++r) o[dt][r] = 0.f;
    float m = 0.f, l = 0.f; bool started = false;
    f32x16 negm;
#pragma unroll
    for (int r = 0; r < 16; ++r) negm[r] = 0.f;
    for (int t = 0; t < NT; ++t) {
        wait_tile(NT - 1 - t);
        __builtin_amdgcn_s_barrier();
        if (t + 3 < NT) dma_tile(Z, DIFF_ROWBASE(t + 3), kcol, vcol, lds + ((t + 3) & 3) * SLOT, wave, lane);
        step64<4>(lds + (t & 3) * SLOT, ad, qf, o, m, l, negm, started);
    }
#undef DIFF_ROWBASE
    __syncthreads();
    const float linv = 1.f / (l + __shfl_xor(l, 32));
    LAS float* cb = (LAS float*)lds + (wave & 3) * 4096;
    if (map == 1) {
#pragma unroll
        for (int dt = 0; dt < 4; ++dt)
#pragma unroll
            for (int r = 0; r < 16; ++r) cb[(dt * 16 + r) * 64 + lane] = o[dt][r] * linv;
    }
    __syncthreads();
    if (map == 0) {
        float ss = 0.f;
#pragma unroll
        for (int dt = 0; dt < 4; ++dt)
#pragma unroll
            for (int r = 0; r < 16; ++r) { const float d = o[dt][r] * linv - lam * cb[(dt * 16 + r) * 64 + lane]; o[dt][r] = d; ss += d * d; }
        ss += __shfl_xor(ss, 32);
        const float rstd = 0.8f / sqrtf(ss * (1.f / 128.f) + EPS);
        f16* yr = Y + (size_t)qrow * DM + 512 + 128 * h;
#pragma unroll
        for (int dt = 0; dt < 4; ++dt)
#pragma unroll
            for (int rg = 0; rg < 4; ++rg) { const int d0 = 32 * dt + 8 * rg + 4 * hh; const f32x4 sg = *(const f32x4*)(subln + d0);
                u32x2 w; w.x = pkh(o[dt][4 * rg] * rstd * sg[0], o[dt][4 * rg + 1] * rstd * sg[1]); w.y = pkh(o[dt][4 * rg + 2] * rstd * sg[2], o[dt][4 * rg + 3] * rstd * sg[3]);
                *(u32x2*)(yr + d0) = w; }
    }
    __syncthreads();
}

__device__ __forceinline__ void na_unit(int u, const f16* Z, f16* Y, const float* rpb, LAS unsigned char* lds) {
    const int tid = opaque_tid(), lane = tid & 63, wave = __builtin_amdgcn_readfirstlane(tid >> 6);
    const int rp = u & 15, hp = (u >> 4) & 3, b = u >> 6;
    const int hs = wave >> 2, a = wave & 3, head = 2 * hp + hs, r32 = lane & 31, hh = lane >> 5;
    const int r0 = 2 * rp, qr = r0 + (r32 >> 4), qc = 16 * a + (r32 & 15);
    const int rsq = min(max(qr - 4, 0), 24), csq = min(max(qc - 8, 0), 48);
    const int lo = min(max(r0 - 4, 0), 24), hi = min(max(r0 + 1 - 4, 0), 24) + 8;
    const int seg = (a == 0) ? 0 : (a == 1) ? 8 : (a == 2) ? 24 : 32;
    const long tokbase = (long)b * SEQ;
    const long qrow = tokbase + qr * 64 + qc;
    const int kcol = 1024 + 128 * hp, vcol = 2048 + 128 * hp;
    const int nwin = hi - lo, NT = nwin + 4;
#define NA_ROWBASE(t) ((t) < nwin ? tokbase + (lo + (t)) * 64 : (long)NTOK + b * CTXL + 64 * ((t) - nwin))
    LAS float* tab = (LAS float*)(lds + RPB_OFF);
    for (int i = tid; i < 2 * 465; i += 512) tab[i] = rpb[(2 * hp) * 465 + i] * LOG2E;
#pragma unroll
    for (int t = 0; t < 3; ++t) dma_tile(Z, NA_ROWBASE(t), kcol, vcol, lds + t * SLOT, wave, lane);
    f16x8 qf[4];
#pragma unroll
    for (int st = 0; st < 4; ++st) qf[st] = *(const f16x8*)(Z + (size_t)qrow * ZP0 + 64 * head + 16 * st + 8 * hh);
    asm volatile("" : "+v"(qf[0]), "+v"(qf[1]), "+v"(qf[2]), "+v"(qf[3]));
    const Addr<2> aw = make_addr<2>(seg, 8 * hs, 8 * hs, lane), ac = make_addr<2>(0, 8 * hs, 8 * hs, lane);
    f32x16 o[2];
#pragma unroll
    for (int dt = 0; dt < 2; ++dt)
#pragma unroll
        for (int r = 0; r < 16; ++r) o[dt][r] = 0.f;
    float m = 0.f, l = 0.f; bool started = false;
    f32x16 negm;
#pragma unroll
    for (int r = 0; r < 16; ++r) negm[r] = 0.f;
    for (int t = 0; t < NT; ++t) {
        wait_tile(NT - 1 - t);
        __builtin_amdgcn_s_barrier();
        if (t + 3 < NT) dma_tile(Z, NA_ROWBASE(t + 3), kcol, vcol, lds + ((t + 3) & 3) * SLOT, wave, lane);
        LAS unsigned char* slot = lds + (t & 3) * SLOT;
        if (t < nwin) {
            const int krow = lo + t;
            f16x8 kf[4], va[4];
            load_k<2>(slot, aw, 0, kf); load_v<2>(slot, aw, 0, va);
            AT_SCHED();
            f32x16 s = qk32(kf, qf, negm);
            const bool rowok = (krow >= rsq) && (krow < rsq + 8);
            const int rbase = (krow - qr + 7) * 31 + 15 - qc;
            float bias[16];
#pragma unroll
            for (int r = 0; r < 16; ++r) { const int kc = seg + (r & 3) + 8 * (r >> 2) + 4 * hh; bias[r] = tab[hs * 465 + min(max(rbase + kc, 0), 464)]; asm volatile("" : "+v"(bias[r])); }
#pragma unroll
            for (int r = 0; r < 16; ++r) { const int kc = seg + (r & 3) + 8 * (r >> 2) + 4 * hh; const bool ok = rowok && (kc >= csq) && (kc < csq + 16);
                s[r] = ok ? s[r] + bias[r] : -INFINITY; }
            float mx = rowmax16(s); mx = fmaxf(mx, __shfl_xor(mx, 32));
            const float d = rescale<2>(mx, m, l, o, negm, started);
            l += expsum(s, d);
            pv32<2>(va, s, o);
        } else {
            step64<2>(slot, ac, qf, o, m, l, negm, started);
        }
    }
#undef NA_ROWBASE
    const float linv = 1.f / (l + __shfl_xor(l, 32));
    f16* yr = Y + (size_t)qrow * DM + 64 * head;
#pragma unroll
    for (int dt = 0; dt < 2; ++dt)
#pragma unroll
        for (int rg = 0; rg < 4; ++rg) { const int d0 = 32 * dt + 8 * rg + 4 * hh;
            u32x2 w; w.x = pkh(o[dt][4 * rg] * linv, o[dt][4 * rg + 1] * linv); w.y = pkh(o[dt][4 * rg + 2] * linv, o[dt][4 * rg + 3] * linv);
            *(u32x2*)(yr + d0) = w; }
    __syncthreads();
}

__device__ __forceinline__ void attn_phase(const f16* Z, f16* Y, const float* rpb, const float* subln, const float* lamp, LAS unsigned char* lds, int rep = 0) {
    const float lam = *lamp;
    const int ulo = (rep == 3) ? 1024 : 0, uhi = (rep == 2) ? 1024 : 2048;
    for (int u = ulo + blockIdx.x; u < uhi; u += gridDim.x) {
        if (u < 1024) diff_unit(u, Z, Y, subln, lam, lds);
        else na_unit(u - 1024, Z, Y, rpb, lds);
    }
}
}

__device__ __forceinline__ void conv_phase(const f16* Z1, f16* Y, const float* scw, const float* cfw, const float* cfb, const float* lng, const float* lnb, LAS unsigned char* lds) {
    const int tid = opaque_tid(), lane = tid & 63, wave = __builtin_amdgcn_readfirstlane(tid >> 6);
    LAS float* U = (LAS float*)lds;
    float cw[31];
#pragma unroll
    for (int k = 0; k < 31; ++k) cw[k] = cfw[k * 512 + tid];
    const float cb = cfb[tid];
    for (int u = blockIdx.x; u < NTOK / 32; u += gridDim.x) {
        const int b = u >> 6, t0 = (u & 63) * 32;
        const f16* zb = Z1 + (size_t)b * SEQ * ZP1;
        {
            f16x4 av[16], gv[16];
#pragma unroll
            for (int pass = 0; pass < 16; ++pass) { const int row = pass * 4 + (tid >> 7), c4 = (tid & 127) * 4, tt = t0 - 15 + row; const bool ok = row < 62 && tt >= 0 && tt < SEQ;
                const int tc = ok ? tt : (t0 < SEQ ? t0 : 0);
                av[pass] = *(const f16x4*)(zb + (size_t)tc * ZP1 + 1536 + c4); gv[pass] = *(const f16x4*)(zb + (size_t)tc * ZP1 + 2048 + c4); }
#pragma unroll
            for (int pass = 0; pass < 16; ++pass) { const int row = pass * 4 + (tid >> 7), c4 = (tid & 127) * 4, tt = t0 - 15 + row; const bool ok = tt >= 0 && tt < SEQ;
                if (row < 62) { f32x4 uv;
#pragma unroll
                    for (int j = 0; j < 4; ++j) uv[j] = ok ? (float)av[pass][j] * __builtin_amdgcn_rcpf(1.f + __builtin_amdgcn_exp2f(-LOG2E * (float)gv[pass][j])) : 0.f;
                    *(LAS f32x4*)(U + row * 512 + c4) = uv; } }
        }
        __syncthreads();
        float uu[62];
#pragma unroll
        for (int i = 0; i < 62; ++i) uu[i] = U[i * 512 + tid];
        __syncthreads();
#pragma unroll
        for (int tt = 0; tt < 32; ++tt) { float v = cb;
#pragma unroll
            for (int k = 0; k < 31; ++k) v += cw[k] * uu[tt + k];
            U[tt * 512 + tid] = v; }
        __syncthreads();
#pragma unroll
        for (int q = 0; q < 4; ++q) { const int tt = wave * 4 + q, t = t0 + tt, c8 = lane * 8;
            const f32x4 x0 = *(const LAS f32x4*)(U + tt * 512 + c8), x1 = *(const LAS f32x4*)(U + tt * 512 + c8 + 4);
            float x[8] = {x0[0], x0[1], x0[2], x0[3], x1[0], x1[1], x1[2], x1[3]};
            float s = 0.f;
#pragma unroll
            for (int j = 0; j < 8; ++j) s += x[j];
            const float mean = wave_sum(s) * (1.f / 512.f); float s2 = 0.f;
#pragma unroll
            for (int j = 0; j < 8; ++j) { x[j] -= mean; s2 += x[j] * x[j]; }
            const float rstd = 1.0f / sqrtf(wave_sum(s2) * (1.f / 512.f) + EPS);
            const f32x4 g0 = *(const f32x4*)(lng + c8), g1 = *(const f32x4*)(lng + c8 + 4), b0 = *(const f32x4*)(lnb + c8), b1 = *(const f32x4*)(lnb + c8 + 4);
            const float gg[8] = {g0[0], g0[1], g0[2], g0[3], g1[0], g1[1], g1[2], g1[3]}, bb[8] = {b0[0], b0[1], b0[2], b0[3], b1[0], b1[1], b1[2], b1[3]};
            float yd[8];
#pragma unroll
            for (int j = 0; j < 8; ++j) yd[j] = silu_f(x[j] * rstd * gg[j] + bb[j]);
            f16* yr = Y + ((size_t)b * SEQ + t) * DM;
            { u32x4 w; w.x = pkh(yd[0], yd[1]); w.y = pkh(yd[2], yd[3]); w.z = pkh(yd[4], yd[5]); w.w = pkh(yd[6], yd[7]); *(u32x4*)(yr + 512 + c8) = w; }
            float cacc[8];
#pragma unroll
            for (int j = 0; j < 8; ++j) cacc[j] = 0.f;
#pragma unroll
            for (int k = 0; k < 3; ++k) { const int ts = t + k - 1;
                if (ts >= 0 && ts < SEQ) { const f16x8 xc = *(const f16x8*)(zb + (size_t)ts * ZP1 + c8), gc = *(const f16x8*)(zb + (size_t)ts * ZP1 + 1024 + c8);
                    const f32x4 w0 = *(const f32x4*)(scw + k * 512 + c8), w1 = *(const f32x4*)(scw + k * 512 + c8 + 4);
                    const float ww[8] = {w0[0], w0[1], w0[2], w0[3], w1[0], w1[1], w1[2], w1[3]};
#pragma unroll
                    for (int j = 0; j < 8; ++j) cacc[j] += ww[j] * ((float)gc[j] * (float)xc[j]); } }
            const f16x8 gb = *(const f16x8*)(zb + (size_t)t * ZP1 + 512 + c8);
            { u32x4 w; w.x = pkh((float)gb[0] * cacc[0], (float)gb[1] * cacc[1]); w.y = pkh((float)gb[2] * cacc[2], (float)gb[3] * cacc[3]);
              w.z = pkh((float)gb[4] * cacc[4], (float)gb[5] * cacc[5]); w.w = pkh((float)gb[6] * cacc[6], (float)gb[7] * cacc[7]); *(u32x4*)(yr + c8) = w; }
        }
        __syncthreads();
    }
}

constexpr int NPHASE = 18;
__global__ void __launch_bounds__(512, 2) fwd(Params p) {
    extern __shared__ __attribute__((aligned(16))) unsigned char lds_raw[];
    LAS unsigned char* lds = (LAS unsigned char*)lds_raw;
    const int tid = threadIdx.x;
    unsigned char* ws = p.ws;
    for (int u = tid; u < (LDS_BYTES - LDSCTL_OFF) / 4; u += 512) ((LAS unsigned*)(lds + LDSCTL_OFF))[u] = 0u;
    __syncthreads();
    XcdBarrier bar; bar.bar = (unsigned*)(ws + WS_CTL) + 4096; bar.x = 0; bar.st = nullptr;
    if (N_LAUNCH_MODE == 1) bar = xcd_barrier_post((unsigned*)(ws + WS_CTL) + 4096, (volatile LAS unsigned*)(lds + MISC_OFF) + 8);
    const int lo = p.ph_lo, hi = p.ph_hi, rep = p.alt;
#ifndef ONLYP
#define ONLYP -1
#endif
#define IN(k) ((ONLYP < 0 || ONLYP == (k)) && lo <= (k) && (k) < hi)
#define SEAM(k) do { if (IN(k) && IN((k) + 1)) xcd_barrier(bar); } while (0)
    const int G = gridDim.x, c = blockIdx.x;
    float* mod0 = (float*)(ws + WS_MOD + MOD0_OFF); float* mod1 = (float*)(ws + WS_MOD + MOD1_OFF);
    f16* H = (f16*)(ws + WS_H); f16* Z = (f16*)(ws + WS_Z); f16* Y = (f16*)(ws + WS_Y); f16* XIN = (f16*)(ws + WS_XIN); f16* HID = (f16*)(ws + WS_HID); f16* Y2 = (f16*)(ws + WS_Y2);
    f16* XR = (f16*)(ws + WS_XIN);
    f16* W13 = (f16*)(ws + WS_W13); f16* W2T = (f16*)(ws + WS_W2);
    float* AFF = (float*)(ws + WS_AFF); int* IDX = (int*)(ws + WS_IDX); float* GV = (float*)(ws + WS_G); short* INV = (short*)(ws + WS_INV);

    if (IN(0)) { phase_prologue(p, lds); } SEAM(0);
    if (IN(1)) { NormArgs a{}; a.src = p.in[I_X]; a.gain = p.in[I_L0_NORM1]; a.shift = mod0; a.scale = mod0 + 1024; a.mstride = 6144; a.hout = H;
        norm_phase<4>(a, lds, true, p.in[I_CTX], mod0 + 16 * 6144, mod0 + 16 * 6144 + 1024); } SEAM(1);
    if (IN(2)) { gm::Gemm g{H, (const f16*)(ws + WS_WIN0), DM, 0, 0}; gm::Order S; S.init(NROWS, ZP0, 1, G, c);
        gm::EpiInProj0 E{Z, (const float*)(ws + WS_MOD + ROPE_OFF)}; gm::gemm_phase<false>(lds, g, S, E); } SEAM(2);
    if (IN(3)) { at::attn_phase(Z, Y, p.in[I_L0_RPB], p.in[I_L0_SUBLN], (const float*)(ws + WS_MOD + LAM_OFF), lds, rep); } SEAM(3);
    if (IN(4)) { gm::Gemm g{Y, (const f16*)(ws + WS_WOUT0), DM, 0, 0}; gm::Order S; S.init(NTOK, DM, 1, G, c);
        gm::EpiResGate<false> E{p.in[I_X], XR, mod0 + 2048, 6144}; gm::gemm_phase<false>(lds, g, S, E); } SEAM(4);
    if (IN(5)) { NormArgs a{}; a.src16 = XR; a.gain = p.in[I_L0_NORM2]; a.shift = mod0 + 3072; a.scale = mod0 + 4096; a.mstride = 6144; a.hout = H; a.wr = p.in[I_L0_WR]; a.aff = AFF; a.hbf = MOE_BF16;
        norm_phase<4>(a, lds, false, nullptr, nullptr, nullptr); } SEAM(5);
    if (IN(6)) { topk_phase(AFF, IDX, GV, INV, H, XIN, lds); } SEAM(6);
    if (IN(7)) { gm::Gemm g{H, W13, DM, 0, (long)2 * DE * DM, IDX}; gm::Order S; S.init(EROWS, 2 * DE, NE, G, c);
        gm::EpiSwiGLU E{HID}; gm::gemm_phase<MOE_BF16, true>(lds, g, S, E); } SEAM(7);
    if (IN(8)) { gm::Gemm g{HID, W2T, DE, (long)EROWS * DE, (long)DM * DE}; gm::Order S; S.init(EROWS, DM, NE, G, c, 1);
        gm::EpiRowScale E{Y2, GV}; gm::gemm_phase<MOE_BF16>(lds, g, S, E); } SEAM(8);
    if (IN(9)) { NormArgs a{}; a.src16 = XR; a.xout = rep ? (f16*)(ws + WS_BIG) : XR; a.y2 = Y2; a.inv = INV; a.gate2 = mod0 + 5120; a.gain = p.in[I_L1_NORM1]; a.shift = mod1; a.scale = mod1 + 1024; a.mstride = 6144; a.hout = rep ? (f16*)(ws + WS_BIG + 128 * MiB) : H;
        norm_phase<2>(a, lds, false, nullptr, nullptr, nullptr);
        cvt_moe(p.in[I_L1_W1], p.in[I_L1_W3], p.in[I_L1_W2], W13, W2T, tid, lds); } SEAM(9);
    if (IN(10)) { gm::Gemm g{H, (const f16*)(ws + WS_WIN1), DM, 0, 0}; gm::Order S; S.init(NTOK, ZP1, 1, G, c);
        gm::EpiF16 E{Z, ZP1}; gm::gemm_phase<false>(lds, g, S, E); } SEAM(10);
    if (IN(11)) { conv_phase(Z, Y, p.in[I_L1_SCW], p.in[I_L1_CFW], p.in[I_L1_CFB], p.in[I_L1_LNG], p.in[I_L1_LNB], lds); } SEAM(11);
    if (IN(12)) { gm::Gemm g{Y, (const f16*)(ws + WS_WOUT1), DM, 0, 0}; gm::Order S; S.init(NTOK, DM, 1, G, c);
        gm::EpiResGate<true> E{XR, rep ? (f16*)(ws + WS_BIG) : XR, mod1 + 2048, 6144}; gm::gemm_phase<false>(lds, g, S, E); } SEAM(12);
    if (IN(13)) { NormArgs a{}; a.src16 = XR; a.gain = p.in[I_L1_NORM2]; a.shift = mod1 + 3072; a.scale = mod1 + 4096; a.mstride = 6144; a.hout = H; a.wr = p.in[I_L1_WR]; a.aff = AFF; a.hbf = MOE_BF16;
        norm_phase<4>(a, lds, false, nullptr, nullptr, nullptr); } SEAM(13);
    if (IN(14)) { topk_phase(AFF, IDX, GV, INV, H, XIN, lds); } SEAM(14);
    if (IN(15)) { gm::Gemm g{H, W13, DM, 0, (long)2 * DE * DM, IDX}; gm::Order S; S.init(EROWS, 2 * DE, NE, G, c);
        gm::EpiSwiGLU E{HID}; gm::gemm_phase<MOE_BF16, true>(lds, g, S, E); } SEAM(15);
    if (IN(16)) { gm::Gemm g{HID, W2T, DE, (long)EROWS * DE, (long)DM * DE}; gm::Order S; S.init(EROWS, DM, NE, G, c, 1);
        gm::EpiRowScale E{Y2, GV}; gm::gemm_phase<MOE_BF16>(lds, g, S, E); } SEAM(16);
    if (IN(17)) { NormArgs a{}; a.src16 = XR; a.xout = XR; a.y2 = Y2; a.inv = INV; a.gate2 = mod1 + 5120; a.gain = p.in[I_FNORM]; a.fout = rep ? (float*)(ws + WS_BIG) : p.out;
        norm_phase<2>(a, lds, false, nullptr, nullptr, nullptr); }
#undef IN
#undef SEAM
}

extern "C" void kernel_launch(void* const* d_in, const int* in_sizes, int n_in, void* d_out, int out_size, void* d_ws, size_t ws_size, hipStream_t stream) {
    static int grid = 0;
    if (grid == 0) {
        if (n_in != 36 || out_size != NTOK * DM || ws_size < WS_END) { fprintf(stderr, "kernel_launch: unexpected shapes (n_in %d out %d ws %zu need %zu)\n", n_in, out_size, ws_size, (size_t)WS_END); grid = -1; return; }
        int dev = 0, cus = 0;
        if (hipGetDevice(&dev) != hipSuccess || hipDeviceGetAttribute(&cus, hipDeviceAttributeMultiprocessorCount, dev) != hipSuccess) { grid = -1; return; }
        if (hipFuncSetAttribute((const void*)fwd, hipFuncAttributeMaxDynamicSharedMemorySize, LDS_BYTES) != hipSuccess) { fprintf(stderr, "kernel_launch: hipFuncSetAttribute failed\n"); grid = -1; return; }
        int per_cu = 0;
        if (hipOccupancyMaxActiveBlocksPerMultiprocessor(&per_cu, (const void*)fwd, 512, LDS_BYTES) != hipSuccess || per_cu < 1) fprintf(stderr, "kernel_launch: occupancy query says %d\n", per_cu);
        (void)hipGetLastError();
        grid = cus;
    }
    if (grid < 0) return;
    (void)hipMemsetAsync((char*)d_ws + WS_CTL, 0, CTL_ZERO_BYTES, stream);
    Params p{};
    for (int i = 0; i < 36; ++i) p.in[i] = (const float*)d_in[i];
    p.out = (float*)d_out; p.ws = (unsigned char*)d_ws;
#if N_LAUNCH_MODE == 1
    p.ph_lo = 0; p.ph_hi = NPHASE;
    hipLaunchKernelGGL(fwd, dim3(grid), dim3(512), LDS_BYTES, stream, p);
#else
    for (int k = 0; k < NPHASE; ++k) { p.ph_lo = k; p.ph_hi = k + 1; p.alt = 0; hipLaunchKernelGGL(fwd, dim3(grid), dim3(512), LDS_BYTES, stream, p);
        for (int r = 0; r < HOSTDUP_N; ++r) if ((HOSTDUP >> k) & 1) { p.alt = HOSTDUP_ALT; hipLaunchKernelGGL(fwd, dim3(grid), dim3(512), LDS_BYTES, stream, p); } }
#endif
}
```

```cpp
#include <hip/hip_runtime.h>
#include <cstdio>
#include <cstdint>

#define LAS __attribute__((address_space(3)))
#define GAS __attribute__((address_space(1)))
typedef _Float16 f16;
typedef _Float16 f16x8 __attribute__((ext_vector_type(8)));
typedef _Float16 f16x4 __attribute__((ext_vector_type(4)));
typedef _Float16 f16x2 __attribute__((ext_vector_type(2)));
typedef float f32x2 __attribute__((ext_vector_type(2)));
typedef float f32x4 __attribute__((ext_vector_type(4)));
typedef float f32x16 __attribute__((ext_vector_type(16)));
typedef unsigned u32x2 __attribute__((ext_vector_type(2)));
typedef unsigned u32x4 __attribute__((ext_vector_type(4)));
typedef short s16x4 __attribute__((ext_vector_type(4)));

#ifndef MOE_BF16
#define MOE_BF16 true
#endif
#ifndef HOSTDUP
#define HOSTDUP 0
#endif
#ifndef HOSTDUP_ALT
#define HOSTDUP_ALT 1
#endif
#ifndef HOSTDUP_N
#define HOSTDUP_N 1
#endif
#ifndef N_LAUNCH_MODE
#define N_LAUNCH_MODE 1
#endif

constexpr int NB = 16, SEQ = 2048, DM = 1024, NTOK = NB * SEQ, CTXL = 256, NCTX = NB * CTXL, NROWS = NTOK + NCTX;
constexpr int ZP0 = 3072, ZP1 = 2560;
constexpr int NE = 16, DE = 2816, CAP = 256, EROWS = NB * CAP;
constexpr float EPS = 1e-6f;
constexpr float LOG2E = 1.4426950408889634f;
constexpr float QSCALE = 0.125f * LOG2E;

constexpr size_t MiB = 1u << 20;
constexpr size_t WS_CTL = 0, CTL_ZERO_BYTES = 256 * 1024;
constexpr size_t WS_MOD = 1 * MiB;
constexpr size_t MOD0_OFF = 0, MOD1_OFF = 17 * 6144 * 4, ROPE_OFF = MOD1_OFF + 16 * 6144 * 4, LAM_OFF = ROPE_OFF + 64 * 16 * 2 * 4;
constexpr size_t WS_WIN0 = 2 * MiB, WS_WOUT0 = 8 * MiB, WS_WIN1 = 10 * MiB, WS_WOUT1 = 15 * MiB;
constexpr size_t WS_AFF = 17 * MiB;
constexpr size_t WS_IDX = 19 * MiB;
constexpr size_t WS_G = 19 * MiB + 512 * 1024;
constexpr size_t WS_INV = 20 * MiB;
constexpr size_t WS_W13 = 22 * MiB;
constexpr size_t WS_W2 = WS_W13 + 176 * MiB;
constexpr size_t WS_H = WS_W2 + 88 * MiB;
constexpr size_t WS_XIN = WS_H + 72 * MiB;
constexpr size_t WS_Y2 = WS_XIN + 128 * MiB;
constexpr size_t WS_BIG = WS_Y2 + 128 * MiB;
constexpr size_t WS_Z = WS_BIG, WS_Y = WS_BIG + 216 * MiB, WS_HID = WS_BIG;
constexpr size_t WS_END = WS_BIG + 352 * MiB;

constexpr int RING_BYTES = 131072;
constexpr int LDSCTL_OFF = RING_BYTES, MISC_OFF = LDSCTL_OFF + 320;
constexpr int LDS_BYTES = 147456;

#define RLX_AGENT __ATOMIC_RELAXED, __HIP_MEMORY_SCOPE_AGENT
#define LDS_WAIT() asm volatile("s_waitcnt lgkmcnt(0)" ::: "memory")
#define VM_WAIT() asm volatile("s_waitcnt vmcnt(0)" ::: "memory")

__device__ __forceinline__ unsigned pkh(float lo, float hi) { f16x2 v; v.x = (f16)lo; v.y = (f16)hi; return __builtin_bit_cast(unsigned, v); }
typedef __bf16 bf16x2_t __attribute__((ext_vector_type(2)));
typedef short s16x8 __attribute__((ext_vector_type(8)));
__device__ __forceinline__ unsigned pkb(float lo, float hi) { f32x2 v = {lo, hi}; bf16x2_t b = __builtin_convertvector(v, bf16x2_t); return __builtin_bit_cast(unsigned, b); }
template <bool BF> __device__ __forceinline__ unsigned pk16(float lo, float hi) { return BF ? pkb(lo, hi) : pkh(lo, hi); }
__device__ __forceinline__ float silu_f(float v) { return v / (1.f + __expf(-v)); }

#define XB_TMO      128
#define XB_XCNT(j)  (256  + 64 * (j))
#define XB_XSUB(j)  (1280 + 64 * (j))
#define XB_XGEN(j)  (2304 + 64 * (j))
#define XB_TOP      3328
#define XB_TOPGEN   3392
#define XCD_BAR_WORDS 3456
#define XB_SPIN_CAP (1u << 18)
__device__ __forceinline__ unsigned xb_ld(unsigned* p)              { return __hip_atomic_load(p, __ATOMIC_RELAXED, __HIP_MEMORY_SCOPE_AGENT); }
__device__ __forceinline__ unsigned xb_add(unsigned* p, unsigned v) { return __hip_atomic_fetch_add(p, v, __ATOMIC_RELAXED, __HIP_MEMORY_SCOPE_AGENT); }
__device__ __forceinline__ unsigned xb_xcc_id() { return (unsigned)__builtin_amdgcn_s_getreg((3 << 11) | 20) & 0xFu; }
#define XB_SPIN(cond, bar) do { unsigned _sp = 0; while (cond) { __builtin_amdgcn_s_sleep(1); \
    if ((++_sp & 255u) == 0u) { if (xb_ld(&(bar)[XB_TMO])) break; if (_sp > XB_SPIN_CAP) { atomicAdd(&(bar)[XB_TMO], 1u); break; } } } } while (0)
struct XcdBarrier { unsigned* bar; unsigned x; volatile LAS unsigned* st; };
__device__ __forceinline__ XcdBarrier xcd_barrier_post(unsigned* bar, volatile LAS unsigned* st) {
    XcdBarrier b; b.bar = bar; b.x = xb_xcc_id(); b.st = st;
    if (threadIdx.x == 0) (void)xb_add(&bar[XB_XCNT(b.x)], 1u);
    return b;
}
__device__ __forceinline__ void xcd_barrier_complete(unsigned* bar, unsigned x, unsigned& nloc, unsigned& nx) {
    const unsigned G = gridDim.x * gridDim.y * gridDim.z;
    unsigned sum, cnt, mine, sp = 0u;
    for (;;) {
        sum = 0u; cnt = 0u; mine = 0u;
#pragma unroll
        for (unsigned j = 0; j < 16; ++j) { const unsigned c = xb_ld(&bar[XB_XCNT(j)]); sum += c; cnt += (c > 0u) ? 1u : 0u; mine = (j == x) ? c : mine; }
        if (sum == G) break;
        __builtin_amdgcn_s_sleep(1);
        if ((++sp & 255u) == 0u) { if (xb_ld(&bar[XB_TMO])) break; if (sp > XB_SPIN_CAP) { atomicAdd(&bar[XB_TMO], 1u); break; } }
    }
    nloc = mine > 0u ? mine : 1u; nx = cnt > 0u ? cnt : 1u;
}
__device__ __forceinline__ void xcd_barrier(const XcdBarrier& b) {
    asm volatile("s_waitcnt vmcnt(0)" ::: "memory");
    __syncthreads();
    if (threadIdx.x == 0) {
        unsigned* bar = b.bar;
        __builtin_amdgcn_s_waitcnt(0);
        unsigned nloc = b.st[0], nx = b.st[1];
        if (nloc == 0u) { xcd_barrier_complete(bar, b.x, nloc, nx); b.st[0] = nloc; b.st[1] = nx; }
        const unsigned old = xb_add(&bar[XB_XSUB(b.x)], 1u);
        const unsigned gen = old / nloc;
        if (old + 1u == (gen + 1u) * nloc) {
            __builtin_amdgcn_fence(__ATOMIC_RELEASE, "agent");
            asm volatile("s_waitcnt vmcnt(0)" ::: "memory");
            const unsigned og = xb_add(&bar[XB_TOP], 1u);
            const unsigned tg = og / nx;
            if (og + 1u == (tg + 1u) * nx) xb_add(&bar[XB_TOPGEN], 1u);
            else XB_SPIN(xb_ld(&bar[XB_TOPGEN]) == tg, bar);
            __builtin_amdgcn_fence(__ATOMIC_ACQUIRE, "agent");
            xb_add(&bar[XB_XGEN(b.x)], 1u);
            asm volatile("s_waitcnt vmcnt(0)" ::: "memory");
        } else {
            XB_SPIN(xb_ld(&bar[XB_XGEN(b.x)]) == gen, bar);
            __builtin_amdgcn_fence(__ATOMIC_ACQUIRE, "agent");
            asm volatile("s_waitcnt vmcnt(0)" ::: "memory");
        }
    }
    __syncthreads();
}

__device__ __forceinline__ int opaque_tid0() { int t = threadIdx.x; asm volatile("" : "+v"(t)); return t; }
namespace gm {
constexpr int BM = 256, BK = 64, HALF = 128, HTB = HALF * BK * 2, STAGE_BYTES = 8 * HTB, NXCD = 8, WGM = 8;
__host__ __device__ __forceinline__ int lds_byte(int r, int c) { const int st = (r >> 4) * 2 + (c >> 5), rr = r & 15, cc = c & 31, ob = rr * 64 + cc * 2; return st * 1024 + (ob ^ (((ob >> 9) & 1) << 5)); }
__host__ __device__ __forceinline__ void stage_rc(int b, int& R, int& C) { const int st = b / 1024, sb = b % 1024, swz = sb ^ (((sb >> 9) & 1) << 5); R = (st >> 1) * 16 + swz / 64; C = (st & 1) * 32 + (swz % 64) / 2; }
__host__ __device__ __forceinline__ int perm32(int rho) { const int n = rho >> 4, i = rho & 15; return 8 * (i >> 2) + 4 * n + (i & 3); }

struct Unit { int g, pm, pn; };
struct Gemm { const f16* A; const f16* Bt; int K; long sA, sB; const int* gidx; };
struct Order {
    int nM, nN, tpg, total, G, c, mode;
    __device__ void init(int M, int N, int groups, int G_, int c_, int mode_ = 0) { nM = M / BM; nN = N / BM; tpg = nM * nN; total = tpg * groups; G = G_; c = c_; mode = (mode_ == 1 && G_ == 256 && nM == 16 && nN == 4) ? 1 : 0; }
    __device__ bool next(int i, Unit& u) const {
        const long L = (long)i * G + c; if (L >= total) return false;
        if (mode == 1) { const int x = c & 7, j = c >> 3; u.g = 4 * i + (x >> 1); u.pm = 8 * (x & 1) + (j >> 2); u.pn = j & 3; return true; }
        const int g = (int)(L / tpg); int wgid = (int)(L % tpg);
        { const int q = tpg / NXCD, r = tpg % NXCD, xcd = wgid % NXCD, off = wgid / NXCD; wgid = (xcd < r ? xcd * (q + 1) : r * (q + 1) + (xcd - r) * q) + off; }
        const int nig = WGM * nN, gid = wgid / nig, fm = gid * WGM, gsz = (nM - fm) < WGM ? (nM - fm) : WGM;
        u.g = g; u.pm = fm + ((wgid % nig) % gsz); u.pn = (wgid % nig) / gsz; return true;
    }
};

typedef f32x4 Acc[2][2][4][2];
typedef __bf16 bf16x8_t __attribute__((ext_vector_type(8)));
template <bool BF> __device__ __forceinline__ f32x4 mma16(const s16x8& a, const s16x8& b, const f32x4& c) {
    if constexpr (BF) return __builtin_amdgcn_mfma_f32_16x16x32_bf16(__builtin_bit_cast(bf16x8_t, a), __builtin_bit_cast(bf16x8_t, b), c, 0, 0, 0);
    else return __builtin_amdgcn_mfma_f32_16x16x32_f16(__builtin_bit_cast(f16x8, a), __builtin_bit_cast(f16x8, b), c, 0, 0, 0);
}

struct EpiF16 {
    static constexpr bool PERM = true;
    f16* O; int ldc;
    __device__ __forceinline__ void operator()(const Acc& acc, const Unit& u, int wr, int wc, int fr, int fq) const {
        const int row0 = u.pm * BM + wr * 64 + fr, col0 = u.pn * BM + wc * 32 + 8 * fq;
#pragma unroll
        for (int ai = 0; ai < 2; ++ai)
#pragma unroll
            for (int m = 0; m < 4; ++m) { f16* rowp = O + (size_t)(row0 + ai * HALF + m * 16) * ldc + col0;
#pragma unroll
                for (int bj = 0; bj < 2; ++bj) { const f32x4 v0 = acc[ai][bj][m][0], v1 = acc[ai][bj][m][1];
                    u32x4 w; w.x = pkh(v0[0], v0[1]); w.y = pkh(v0[2], v0[3]); w.z = pkh(v1[0], v1[1]); w.w = pkh(v1[2], v1[3]);
                    *(u32x4*)(rowp + bj * HALF) = w; } }
    }
};
struct EpiInProj0 {
    static constexpr bool PERM = true;
    f16* O; const float* rope;
    __device__ __forceinline__ void operator()(const Acc& acc, const Unit& u, int wr, int wc, int fr, int fq) const {
        const int row0 = u.pm * BM + wr * 64 + fr, col0 = u.pn * BM + wc * 32 + 8 * fq;
        const float sc = (u.pn < 4) ? QSCALE : 1.f;
        const bool dorope = (u.pn == 2 || u.pn == 3 || u.pn == 6 || u.pn == 7) && (u.pm * BM < NTOK);
#pragma unroll
        for (int ai = 0; ai < 2; ++ai)
#pragma unroll
            for (int m = 0; m < 4; ++m) { const int row = row0 + ai * HALF + m * 16; f16* rowp = O + (size_t)row * ZP0 + col0;
                const int t = row & (SEQ - 1), prow = t >> 6, pcol = t & 63;
#pragma unroll
                for (int bj = 0; bj < 2; ++bj) { f32x4 v0 = acc[ai][bj][m][0] * sc, v1 = acc[ai][bj][m][1] * sc;
                    if (dorope) { const int c = col0 + bj * HALF, half = (c >> 5) & 1, i0 = (c & 31) >> 1; const int pos = half ? pcol : prow;
                        const f32x4* tp = (const f32x4*)(rope + (pos * 16 + i0) * 2); const f32x4 t0 = tp[0], t1 = tp[1];
                        f32x4 r0, r1;
                        r0[0] = v0[0] * t0[0] - v0[1] * t0[1]; r0[1] = v0[0] * t0[1] + v0[1] * t0[0];
                        r0[2] = v0[2] * t0[2] - v0[3] * t0[3]; r0[3] = v0[2] * t0[3] + v0[3] * t0[2];
                        r1[0] = v1[0] * t1[0] - v1[1] * t1[1]; r1[1] = v1[0] * t1[1] + v1[1] * t1[0];
                        r1[2] = v1[2] * t1[2] - v1[3] * t1[3]; r1[3] = v1[2] * t1[3] + v1[3] * t1[2];
                        v0 = r0; v1 = r1; }
                    u32x4 w; w.x = pkh(v0[0], v0[1]); w.y = pkh(v0[2], v0[3]); w.z = pkh(v1[0], v1[1]); w.w = pkh(v1[2], v1[3]);
                    *(u32x4*)(rowp + bj * HALF) = w; } }
    }
};
template <bool BASE16>
struct EpiResGate {
    static constexpr bool PERM = true;
    const void* base; f16* out; const float* gate; int gstride;
    __device__ __forceinline__ void operator()(const Acc& acc, const Unit& u, int wr, int wc, int fr, int fq) const {
        const int col0 = u.pn * BM + wc * 32 + 8 * fq; const int b = (u.pm * BM) / SEQ;
        f32x4 gv[2][2];
#pragma unroll
        for (int bj = 0; bj < 2; ++bj)
#pragma unroll
            for (int n = 0; n < 2; ++n) gv[bj][n] = *(const f32x4*)(gate + (size_t)b * gstride + col0 + bj * HALF + 4 * n);
#pragma unroll
        for (int ai = 0; ai < 2; ++ai)
#pragma unroll
            for (int m = 0; m < 4; ++m) { const size_t off = (size_t)(u.pm * BM + ai * HALF + wr * 64 + m * 16 + fr) * DM + col0;
#pragma unroll
                for (int bj = 0; bj < 2; ++bj) { f32x4 b0, b1;
                    if constexpr (BASE16) { const f16x8 bv = *(const f16x8*)((const f16*)base + off + bj * HALF);
                        b0 = (f32x4){(float)bv[0], (float)bv[1], (float)bv[2], (float)bv[3]}; b1 = (f32x4){(float)bv[4], (float)bv[5], (float)bv[6], (float)bv[7]}; }
                    else { b0 = *(const f32x4*)((const float*)base + off + bj * HALF); b1 = *(const f32x4*)((const float*)base + off + bj * HALF + 4); }
                    const f32x4 v0 = b0 + gv[bj][0] * acc[ai][bj][m][0], v1 = b1 + gv[bj][1] * acc[ai][bj][m][1];
                    u32x4 w; w.x = pkh(v0[0], v0[1]); w.y = pkh(v0[2], v0[3]); w.z = pkh(v1[0], v1[1]); w.w = pkh(v1[2], v1[3]);
                    *(u32x4*)(out + off + bj * HALF) = w; }
                if (m & 1) asm volatile("" ::: "memory"); }
    }
};
struct EpiSwiGLU {
    static constexpr bool PERM = true;
    f16* O;
    __device__ __forceinline__ void operator()(const Acc& acc, const Unit& u, int wr, int wc, int fr, int fq) const {
        const int row0 = u.pm * BM + wr * 64 + fr, col0 = u.pn * HALF + wc * 32 + 8 * fq;
        f16* Og = O + (size_t)u.g * EROWS * DE;
#pragma unroll
        for (int ai = 0; ai < 2; ++ai)
#pragma unroll
            for (int m = 0; m < 4; ++m) { f16* rowp = Og + (size_t)(row0 + ai * HALF + m * 16) * DE + col0;
                float h[8];
#pragma unroll
                for (int n = 0; n < 2; ++n)
#pragma unroll
                    for (int j = 0; j < 4; ++j) { const float g = acc[ai][0][m][n][j], up = acc[ai][1][m][n][j]; h[n * 4 + j] = g * up * __builtin_amdgcn_rcpf(1.f + __builtin_amdgcn_exp2f(-LOG2E * g)); }
                u32x4 w; w.x = pk16<MOE_BF16>(h[0], h[1]); w.y = pk16<MOE_BF16>(h[2], h[3]); w.z = pk16<MOE_BF16>(h[4], h[5]); w.w = pk16<MOE_BF16>(h[6], h[7]);
                *(u32x4*)rowp = w; }
    }
};
struct EpiRowScale {
    static constexpr bool PERM = true;
    f16* O; const float* gv;
    __device__ __forceinline__ void operator()(const Acc& acc, const Unit& u, int wr, int wc, int fr, int fq) const {
        const int row0 = u.pm * BM + wr * 64 + fr, col0 = u.pn * BM + wc * 32 + 8 * fq;
        f16* Og = O + (size_t)u.g * EROWS * DM;
#pragma unroll
        for (int ai = 0; ai < 2; ++ai)
#pragma unroll
            for (int m = 0; m < 4; ++m) { const int row = row0 + ai * HALF + m * 16; const float s = gv[((row >> 8) * NE + u.g) * CAP + (row & 255)];
                f16* rowp = Og + (size_t)row * DM + col0;
#pragma unroll
                for (int bj = 0; bj < 2; ++bj) { const f32x4 v0 = acc[ai][bj][m][0] * s, v1 = acc[ai][bj][m][1] * s;
                    u32x4 w; w.x = pkh(v0[0], v0[1]); w.y = pkh(v0[2], v0[3]); w.z = pkh(v1[0], v1[1]); w.w = pkh(v1[2], v1[3]);
                    *(u32x4*)(rowp + bj * HALF) = w; } }
    }
};

template <bool BF, bool GATHER = false, class Epi>
__device__ __forceinline__ void gemm_phase(LAS unsigned char* lds, const Gemm g, const Order& S, const Epi& E) {
    const int tid = opaque_tid0(), wid = __builtin_amdgcn_readfirstlane(tid >> 6), lane = tid & 63, wr = wid >> 2, wc = wid & 3, fr = lane & 15, fq = lane >> 4;
    const int K = g.K, nt = K / BK;
    unsigned voffA[2], voffB[2];
#pragma unroll
    for (int i = 0; i < 2; ++i) { int R, C; stage_rc(tid * 16 + i * 8192, R, C); const int Rb = Epi::PERM ? ((R & ~31) + perm32(R & 31)) : R;
        voffA[i] = (unsigned)(R * K + C) * 2u; voffB[i] = (unsigned)(Rb * K + C) * 2u; }
    int gR[2], gC[2];
#pragma unroll
    for (int i = 0; i < 2; ++i) { int R, C; stage_rc(tid * 16 + i * 8192, R, C); gR[i] = R; gC[i] = C; }
    unsigned gA0[2] = {0u, 0u}, gA1[2] = {0u, 0u}, nA0[2] = {0u, 0u}, nA1[2] = {0u, 0u};
    LAS unsigned short* gtab = (LAS unsigned short*)(lds + 132096);
    constexpr int GT_MAXU = 22;
#define GM_GCVT(dst0, dst1, uu, ui_) do { const LAS unsigned short* _tp = gtab + (ui_) * 256; _Pragma("unroll") for (int _i = 0; _i < 2; ++_i) { const int _t0 = _tp[gR[_i]], _t1 = _tp[128 + gR[_i]]; \
        dst0[_i] = (unsigned)((((uu).pm * SEQ + _t0) * K + gC[_i]) * 2); dst1[_i] = (unsigned)((((uu).pm * SEQ + _t1) * K + gC[_i]) * 2); } } while (0)
    const size_t kstep = (size_t)(BK * 2);
    const size_t hstep = GATHER ? (size_t)0 : (size_t)HALF * K * 2;
    const size_t hstepB = (size_t)HALF * K * 2;
    const size_t tstep = 2 * hstepB;
    const unsigned ldsw = (unsigned)wid * 1024u;
    const int aoff = lds_byte(wr * 64 + fr, fq * 8), boff = lds_byte(wc * 32 + fr, fq * 8);
#define GM_SA(b, h) (((b) * 2 + (h)) * HTB)
#define GM_SB(b, h) ((4 + (b) * 2 + (h)) * HTB)
#define GM_STAGE(bufoff, gbase, voff) do { _Pragma("unroll") for (int _i = 0; _i < 2; ++_i) \
        __builtin_amdgcn_global_load_lds((const unsigned*)((const char*)(gbase) + (voff)[_i]), (LAS unsigned*)(lds + (bufoff) + ldsw + _i * 8192), 16, 0, 0); } while (0)
#define GM_LDA(dst, b, h) do { _Pragma("unroll") for (int m = 0; m < 4; ++m) _Pragma("unroll") for (int k = 0; k < 2; ++k) dst[m][k] = *(const LAS s16x8*)(lds + GM_SA(b, h) + aoff + m * 2048 + k * 1024); } while (0)
#define GM_LDB(dst, b, h) do { _Pragma("unroll") for (int n = 0; n < 2; ++n) _Pragma("unroll") for (int k = 0; k < 2; ++k) dst[n][k] = *(const LAS s16x8*)(lds + GM_SB(b, h) + boff + n * 2048 + k * 1024); } while (0)
#define GM_MMA(ai, bj, At, Bt) do { __builtin_amdgcn_s_setprio(1); _Pragma("unroll") for (int m = 0; m < 4; ++m) _Pragma("unroll") for (int n = 0; n < 2; ++n) _Pragma("unroll") for (int k = 0; k < 2; ++k) \
        acc[ai][bj][m][n] = mma16<BF>(Bt[n][k], At[m][k], acc[ai][bj][m][n]); __builtin_amdgcn_s_setprio(0); } while (0)
#define GM_WAIT_V(n) asm volatile("s_waitcnt vmcnt(" #n ")" ::: "memory")
#define GM_WAIT_L(n) asm volatile("s_waitcnt lgkmcnt(" #n ")" ::: "memory")
#define GM_BAR __builtin_amdgcn_s_barrier()
#define GM_SCHED __builtin_amdgcn_sched_barrier(0)
    Unit cur, nxt; int ui = 0;
    if (!S.next(0, cur)) return;
    Acc acc;
#pragma unroll
    for (int a = 0; a < 2; ++a)
#pragma unroll
        for (int b = 0; b < 2; ++b)
#pragma unroll
            for (int m = 0; m < 4; ++m)
#pragma unroll
                for (int n = 0; n < 2; ++n) acc[a][b][m][n] = (f32x4){0.f, 0.f, 0.f, 0.f};
    s16x8 At[4][2], B0[2][2], B1[2][2];
    const char* cA = GATHER ? (const char*)g.A : (const char*)(g.A + (size_t)cur.g * g.sA) + (size_t)cur.pm * tstep; const char* cB = (const char*)(g.Bt + (size_t)cur.g * g.sB) + (size_t)cur.pn * tstep;
    if constexpr (GATHER) {
        int tv[GT_MAXU / 2];
#pragma unroll
        for (int j = 0; j < GT_MAXU / 2; ++j) { const int ui_ = 2 * j + (tid >> 8); Unit uu; const bool okk = S.next(ui_, uu); tv[j] = g.gidx[(okk ? (uu.pm * NE + uu.g) * CAP : 0) + (tid & 255)]; }
#pragma unroll
        for (int j = 0; j < GT_MAXU / 2; ++j) gtab[(2 * j + (tid >> 8)) * 256 + (tid & 255)] = (unsigned short)tv[j];
        __syncthreads();
        GM_GCVT(gA0, gA1, cur, 0);
    }
#define GM_STA_H0(buf, p, o0) do { if constexpr (GATHER) GM_STAGE(buf, p, o0); else GM_STAGE(buf, p, voffA); } while (0)
#define GM_STA_H1(buf, p, o1) do { if constexpr (GATHER) GM_STAGE(buf, p, o1); else GM_STAGE(buf, (p) + hstepB, voffA); } while (0)
    GM_STAGE(GM_SB(0, 0), cB, voffB); GM_STAGE(GM_SB(0, 1), cB + hstepB, voffB); GM_STA_H0(GM_SA(0, 0), cA, gA0); GM_STA_H1(GM_SA(0, 1), cA, gA1);
    if (wr == 1) GM_BAR;
    GM_WAIT_V(2); GM_BAR;
    GM_STAGE(GM_SB(1, 0), cB + kstep, voffB); GM_STA_H0(GM_SA(1, 0), cA + kstep, gA0); GM_STAGE(GM_SB(1, 1), cB + hstepB + kstep, voffB);
    GM_WAIT_V(6); GM_BAR;
    for (;;) {
        const bool has_next = S.next(ui + 1, nxt);
        const char* nA = GATHER ? cA : (has_next ? (const char*)(g.A + (size_t)nxt.g * g.sA) + (size_t)nxt.pm * tstep : cA); const char* nB = has_next ? (const char*)(g.Bt + (size_t)nxt.g * g.sB) + (size_t)nxt.pn * tstep : cB;
        if constexpr (GATHER) { if (has_next) GM_GCVT(nA0, nA1, nxt, ui + 1); else { nA0[0] = gA0[0]; nA0[1] = gA0[1]; nA1[0] = gA1[0]; nA1[1] = gA1[1]; } }
        for (int t = 0; t < nt; t += 2) {
            const bool last = (t == nt - 2);
            const char* a1 = cA + (size_t)(t + 1) * kstep;
            const char* a2 = last ? nA : cA + (size_t)(t + 2) * kstep; const char* b2 = last ? nB : cB + (size_t)(t + 2) * kstep;
            const char* a3 = a2 + kstep; const char* b3 = b2 + kstep;
            unsigned s0[2], s1[2];
            if constexpr (GATHER) { s0[0] = last ? nA0[0] : gA0[0]; s0[1] = last ? nA0[1] : gA0[1]; s1[0] = last ? nA1[0] : gA1[0]; s1[1] = last ? nA1[1] : gA1[1]; }
            GM_LDB(B0, 0, 0); GM_LDB(B1, 0, 1); GM_SCHED; GM_LDA(At, 0, 0); GM_STA_H1(GM_SA(1, 1), a1, gA1);
            GM_WAIT_V(8); GM_WAIT_L(0); GM_BAR; GM_MMA(0, 0, At, B0); GM_MMA(0, 1, At, B1); GM_BAR; GM_SCHED;
            GM_LDA(At, 0, 1); GM_STAGE(GM_SB(0, 0), b2, voffB); GM_STAGE(GM_SB(0, 1), b2 + hstepB, voffB); GM_STA_H0(GM_SA(0, 0), a2, s0);
            GM_WAIT_V(8); GM_WAIT_L(0); GM_BAR; GM_MMA(1, 0, At, B0); GM_MMA(1, 1, At, B1); GM_BAR; GM_SCHED;
            GM_LDB(B0, 1, 0); GM_LDB(B1, 1, 1); GM_SCHED; GM_LDA(At, 1, 0); GM_STA_H1(GM_SA(0, 1), a2, s1);
            GM_WAIT_V(8); GM_WAIT_L(0); GM_BAR; GM_MMA(0, 0, At, B0); GM_MMA(0, 1, At, B1); GM_BAR; GM_SCHED;
            GM_LDA(At, 1, 1); GM_STAGE(GM_SB(1, 0), b3, voffB); GM_STAGE(GM_SB(1, 1), b3 + hstepB, voffB); GM_STA_H0(GM_SA(1, 0), a3, s0);
            GM_WAIT_V(8); GM_WAIT_L(0); GM_BAR; GM_MMA(1, 0, At, B0); GM_MMA(1, 1, At, B1); GM_BAR; GM_SCHED;
        }
        if (wr == 0) GM_BAR;
        E(acc, cur, wr, wc, fr, fq);
        if (!has_next) break;
#pragma unroll
        for (int a = 0; a < 2; ++a)
#pragma unroll
            for (int b = 0; b < 2; ++b)
#pragma unroll
                for (int m = 0; m < 4; ++m)
#pragma unroll
                    for (int n = 0; n < 2; ++n) acc[a][b][m][n] = (f32x4){0.f, 0.f, 0.f, 0.f};
        cur = nxt; cA = nA; cB = nB; ++ui;
        if constexpr (GATHER) { gA0[0] = nA0[0]; gA0[1] = nA0[1]; gA1[0] = nA1[0]; gA1[1] = nA1[1]; }
        if (wr == 1) GM_BAR;
    }
    GM_WAIT_V(0);
    GM_BAR;
#undef GM_SA
#undef GM_STA_H0
#undef GM_STA_H1
#undef GM_GCVT
#undef GM_SB
#undef GM_STAGE
#undef GM_LDA
#undef GM_LDB
#undef GM_MMA
#undef GM_WAIT_V
#undef GM_WAIT_L
#undef GM_BAR
#undef GM_SCHED
}
}

struct Params { const float* in[36]; float* out; unsigned char* ws; int ph_lo, ph_hi, alt, pad; };
enum { I_X = 0, I_C, I_CTX, I_CCTX, I_L0_NORM1, I_L0_WMOD, I_L0_BMOD, I_L0_WIN, I_L0_WOUT, I_L0_RPB, I_L0_LQ1, I_L0_LK1, I_L0_LQ2, I_L0_LK2, I_L0_SUBLN,
       I_L0_NORM2, I_L0_WR, I_L0_W1, I_L0_W3, I_L0_W2, I_L1_NORM1, I_L1_WMOD, I_L1_BMOD, I_L1_WIN, I_L1_WOUT, I_L1_SCW, I_L1_CFW, I_L1_CFB, I_L1_LNG, I_L1_LNB,
       I_L1_NORM2, I_L1_WR, I_L1_W1, I_L1_W3, I_L1_W2, I_FNORM };

__device__ __forceinline__ int opaque_tid() { int t = threadIdx.x; asm volatile("" : "+v"(t)); return t; }
__device__ __forceinline__ float wave_sum(float v) {
#pragma unroll
    for (int o = 1; o < 64; o <<= 1) v += __shfl_xor(v, o);
    return v;
}

constexpr int CVT_RS = 136, CVT_SCR = 64 * CVT_RS;
template <bool BF, class RowMap>
__device__ __forceinline__ void cvt_item(const float* W, int K, int N, f16* WT, const RowMap& rm, int item, int lane, LAS unsigned char* scr) {
    const int nblk = N / 64, kb = item / nblk, nb = item % nblk, k0 = 64 * kb, n0 = 64 * nb;
    const float* src = W + (size_t)(k0 + (lane >> 4)) * N + n0 + 4 * (lane & 15);
    f32x4 v[16];
#pragma unroll
    for (int i = 0; i < 16; ++i) v[i] = *(const f32x4*)(src + (size_t)(4 * i) * N);
#pragma unroll
    for (int i = 0; i < 16; ++i) { u32x2 w; w.x = pk16<BF>(v[i][0], v[i][1]); w.y = pk16<BF>(v[i][2], v[i][3]);
        *(LAS u32x2*)(scr + (4 * i + (lane >> 4)) * CVT_RS + 8 * (lane & 15)) = w; }
    const int g = lane >> 4, i16 = lane & 15, q_ = i16 >> 2, p_ = i16 & 3;
#pragma unroll
    for (int st = 0; st < 8; ++st) {
        const int nl = 16 * (st >> 1), ch = 4 * (st & 1) + g;
        const LAS unsigned char* ap = scr + (8 * ch + q_) * CVT_RS + (nl + 4 * p_) * 2;
        const s16x4 lo = __builtin_amdgcn_ds_read_tr16_b64_v4i16((LAS s16x4*)ap);
        const s16x4 hi = __builtin_amdgcn_ds_read_tr16_b64_v4i16((LAS s16x4*)(ap + 4 * CVT_RS));
        u32x4 w; const u32x2 l2 = __builtin_bit_cast(u32x2, lo), h2 = __builtin_bit_cast(u32x2, hi); w.x = l2.x; w.y = l2.y; w.z = h2.x; w.w = h2.y;
        *(u32x4*)(WT + (size_t)rm(n0 + nl + i16) * K + k0 + 8 * ch) = w;
    }
}
struct MapPlain { __device__ __forceinline__ int operator()(int n) const { return n; } };
struct MapRope { __device__ __forceinline__ int operator()(int n) const {
    const bool rp = (n >= 512 && n < 1024) || (n >= 1536 && n < 2048); if (!rp) return n; const int i = n & 31; return (n & ~31) + (i < 16 ? 2 * i : 2 * (i - 16) + 1); } };
struct MapGLU { int add; __device__ __forceinline__ int operator()(int n) const { return (n >> 7) * 256 + (n & 127) + add; } };

constexpr int CVB_RS = 264, CVT_TS = 528;
template <bool BF, class RowMap>
__device__ __forceinline__ void cvt_block(const float* W, int K, int N, f16* WT, const RowMap& rm, int item, int tid, LAS unsigned char* S) {
    const int lane = tid & 63, wave = tid >> 6;
    const int nblk = N / 128, kb = item / nblk, nb = item % nblk, k0 = 256 * kb, n0 = 128 * nb;
    const float* src = W + (size_t)(k0 + 32 * wave + (lane >> 5)) * N + n0 + 4 * (lane & 31);
    f32x4 v[16];
#pragma unroll
    for (int i = 0; i < 16; ++i) v[i] = *(const f32x4*)(src + (size_t)(2 * i) * N);
#pragma unroll
    for (int i = 0; i < 16; ++i) { u32x2 w; w.x = pk16<BF>(v[i][0], v[i][1]); w.y = pk16<BF>(v[i][2], v[i][3]);
        *(LAS u32x2*)(S + (32 * wave + 2 * i + (lane >> 5)) * CVB_RS + 8 * (lane & 31)) = w; }
    __syncthreads();
    const int g = lane >> 4, i16 = lane & 15, q_ = i16 >> 2, p_ = i16 & 3;
    LAS unsigned char* T = S;
    u32x4 wv[8];
#pragma unroll
    for (int st = 0; st < 8; ++st) {
        const int ch = 4 * st + g;
        const LAS unsigned char* ap = S + (8 * ch + q_) * CVB_RS + (16 * wave + 4 * p_) * 2;
        const s16x4 lo = __builtin_amdgcn_ds_read_tr16_b64_v4i16((LAS s16x4*)ap);
        const s16x4 hi = __builtin_amdgcn_ds_read_tr16_b64_v4i16((LAS s16x4*)(ap + 4 * CVB_RS));
        const u32x2 l2 = __builtin_bit_cast(u32x2, lo), h2 = __builtin_bit_cast(u32x2, hi); wv[st].x = l2.x; wv[st].y = l2.y; wv[st].z = h2.x; wv[st].w = h2.y;
    }
    __syncthreads();
#pragma unroll
    for (int st = 0; st < 8; ++st) *(LAS u32x4*)(T + (16 * wave + i16) * CVT_TS + 16 * (4 * st + g)) = wv[st];
    LDS_WAIT();
#pragma unroll
    for (int j = 0; j < 8; ++j) { const int nr = 16 * wave + 2 * j + (lane >> 5), ch = lane & 31;
        const u32x4 w = *(const LAS u32x4*)(T + nr * CVT_TS + 16 * ch);
        *(u32x4*)(WT + (size_t)rm(n0 + nr) * K + k0 + 8 * ch) = w; }
    __syncthreads();
}
__device__ __forceinline__ void cvt_moe(const float* w1, const float* w3, const float* w2, f16* W13, f16* W2T, int tid, LAS unsigned char* S) {
    constexpr int I13 = (DM / 256) * (DE / 128), I2 = (DE / 256) * (DM / 128);
    constexpr int NIT = NE * (2 * I13 + I2);
    for (int it = blockIdx.x; it < NIT; it += gridDim.x) {
        const int e = it / (2 * I13 + I2); int r = it % (2 * I13 + I2);
        if (r < I13) { cvt_block<MOE_BF16>(w1 + (size_t)e * DM * DE, DM, DE, W13 + (size_t)e * 2 * DE * DM, MapGLU{0}, r, tid, S); continue; } r -= I13;
        if (r < I13) { cvt_block<MOE_BF16>(w3 + (size_t)e * DM * DE, DM, DE, W13 + (size_t)e * 2 * DE * DM, MapGLU{128}, r, tid, S); continue; } r -= I13;
        cvt_block<MOE_BF16>(w2 + (size_t)e * DE * DM, DE, DM, W2T + (size_t)e * DM * DE, MapPlain{}, r, tid, S);
    }
}

__device__ __forceinline__ void phase_prologue(const Params& p, LAS unsigned char* lds) {
    const int tid = opaque_tid(), lane = tid & 63, wave = __builtin_amdgcn_readfirstlane(tid >> 6);
    const int G = gridDim.x;
    unsigned char* ws = p.ws;
    LAS float* S = (LAS float*)lds;
    LAS float* red = (LAS float*)(lds + 17 * 1024 * 4);
    for (int u = blockIdx.x; u < 193; u += G) {
        if (u == 192) {
            float* rope = (float*)(ws + WS_MOD + ROPE_OFF);
            for (int idx = tid; idx < 1024; idx += 512) { const int pos = idx >> 4, i = idx & 15; const float fr = powf(10000.f, -(float)i / 16.f), ang = (float)pos * fr;
                rope[idx * 2] = cosf(ang); rope[idx * 2 + 1] = sinf(ang); }
            if (wave == 0) { const float s1 = wave_sum(p.in[I_L0_LQ1][lane] * p.in[I_L0_LK1][lane]), s2 = wave_sum(p.in[I_L0_LQ2][lane] * p.in[I_L0_LK2][lane]);
                if (lane == 0) *(float*)(ws + WS_MOD + LAM_OFF) = expf(s1) - expf(s2) + 0.2f; }
            continue;
        }
        const int l = u / 96, col0 = (u % 96) * 64;
        const float* wmod = p.in[l ? I_L1_WMOD : I_L0_WMOD]; const float* bmod = p.in[l ? I_L1_BMOD : I_L0_BMOD];
        float* mod = (float*)(ws + WS_MOD + (l ? MOD1_OFF : MOD0_OFF));
        for (int idx = tid; idx < 17 * 1024; idx += 512) { const float v = idx < 16 * 1024 ? p.in[I_C][idx] : p.in[I_CCTX][idx - 16 * 1024]; S[idx] = silu_f(v); }
        __syncthreads();
        float acc[17];
#pragma unroll
        for (int r = 0; r < 17; ++r) acc[r] = 0.f;
        const int kb = wave * 128;
        for (int kk = 0; kk < 128; kk += 4) {
            float wv[4];
#pragma unroll
            for (int i = 0; i < 4; ++i) wv[i] = wmod[(size_t)(kb + kk + i) * 6144 + col0 + lane];
#pragma unroll
            for (int r = 0; r < 17; ++r) { const f32x4 sv = *(const LAS f32x4*)(S + r * 1024 + kb + kk); acc[r] += sv[0] * wv[0] + sv[1] * wv[1] + sv[2] * wv[2] + sv[3] * wv[3]; }
        }
#pragma unroll
        for (int r = 0; r < 17; ++r) red[(wave * 17 + r) * 64 + lane] = acc[r];
        __syncthreads();
        for (int idx = tid; idx < 17 * 64; idx += 512) { const int r = idx >> 6, ln = idx & 63; float s = bmod[col0 + ln];
#pragma unroll
            for (int w = 0; w < 8; ++w) s += red[(w * 17 + r) * 64 + ln];
            if (r < 16 || l == 0) mod[(size_t)r * 6144 + col0 + ln] = s; }
        __syncthreads();
    }
    constexpr int IT_IN0 = (DM / 256) * (ZP0 / 128), IT_OUT = (DM / 256) * (DM / 128), IT_IN1 = (DM / 256) * (ZP1 / 128);
    for (int it = blockIdx.x; it < IT_IN0 + 2 * IT_OUT + IT_IN1; it += G) {
        int r = it;
        if (r < IT_IN0) { cvt_block<false>(p.in[I_L0_WIN], DM, ZP0, (f16*)(ws + WS_WIN0), MapRope{}, r, tid, lds); continue; } r -= IT_IN0;
        if (r < IT_OUT) { cvt_block<false>(p.in[I_L0_WOUT], DM, DM, (f16*)(ws + WS_WOUT0), MapPlain{}, r, tid, lds); continue; } r -= IT_OUT;
        if (r < IT_IN1) { cvt_block<false>(p.in[I_L1_WIN], DM, ZP1, (f16*)(ws + WS_WIN1), MapPlain{}, r, tid, lds); continue; } r -= IT_IN1;
        cvt_block<false>(p.in[I_L1_WOUT], DM, DM, (f16*)(ws + WS_WOUT1), MapPlain{}, r, tid, lds);
    }
    cvt_moe(p.in[I_L0_W1], p.in[I_L0_W3], p.in[I_L0_W2], (f16*)(ws + WS_W13), (f16*)(ws + WS_W2), tid, lds);
}

struct NormArgs {
    const float* src;
    const f16* src16;
    f16* xout;
    const f16* y2; const short* inv; const float* gate2;
    const float* gain;
    const float* shift; const float* scale; int mstride;
    f16* hout;
    float* fout;
    const float* wr; float* aff;
    bool hbf;
};

template <int R>
__device__ __forceinline__ void norm_phase(const NormArgs& a, LAS unsigned char* lds, bool ctx_rows, const float* ctx_src, const float* ctx_shift, const float* ctx_scale) {
    const int tid = opaque_tid(), lane = tid & 63, wave = __builtin_amdgcn_readfirstlane(tid >> 6);
    const int G = gridDim.x;
    LAS float* wl = (LAS float*)lds;
    if (a.wr) {
        for (int idx = tid; idx < 16384; idx += 512) { const int k = idx >> 4, e = idx & 15; wl[e * 1028 + k] = a.wr[idx]; }
        __syncthreads();
    }
    const int gw = blockIdx.x * 8 + wave, NGW = G * 8;
    for (int chunk = gw; chunk < NTOK / 16; chunk += NGW) {
        const int row0 = chunk * 16, b = row0 / SEQ;
        f32x4 A[4], Sh[4], G2[4];
#pragma unroll
        for (int j = 0; j < 4; ++j) { const int c = 4 * lane + 256 * j; const f32x4 g = *(const f32x4*)(a.gain + c);
            if (a.shift) { const f32x4 sc = *(const f32x4*)(a.scale + (size_t)b * a.mstride + c); A[j] = g * (sc + 1.f); Sh[j] = *(const f32x4*)(a.shift + (size_t)b * a.mstride + c); }
            else { A[j] = g; Sh[j] = (f32x4){0.f, 0.f, 0.f, 0.f}; }
            if (a.y2) G2[j] = *(const f32x4*)(a.gate2 + (size_t)b * 6144 + c); else G2[j] = (f32x4){0.f, 0.f, 0.f, 0.f}; }
        for (int rr = 0; rr < 16; rr += R) {
            f32x4 v[R][4];
            int sl[R];
#pragma unroll
            for (int q = 0; q < R; ++q) { sl[q] = -1; if (a.y2 && lane < 16) sl[q] = a.inv[((size_t)b * NE + lane) * SEQ + ((row0 + rr + q) & (SEQ - 1))]; }
#pragma unroll
            for (int q = 0; q < R; ++q) { const int row = row0 + rr + q;
                if (a.src16) { const f16* xr = a.src16 + (size_t)row * DM;
#pragma unroll
                    for (int j = 0; j < 4; ++j) { const f16x4 t = *(const f16x4*)(xr + 4 * lane + 256 * j); v[q][j] = (f32x4){(float)t[0], (float)t[1], (float)t[2], (float)t[3]}; } }
                else { const float* xr = a.src + (size_t)row * DM;
#pragma unroll
                    for (int j = 0; j < 4; ++j) v[q][j] = *(const f32x4*)(xr + 4 * lane + 256 * j); } }
            if (a.y2) {
                unsigned long long mask[R]; int ee[R][4]; float wgt[R][4]; f16x4 ld[R][4][4];
#pragma unroll
                for (int q = 0; q < R; ++q) { mask[q] = __ballot(sl[q] >= 0);
#pragma unroll
                    for (int i = 0; i < 4; ++i) { if (mask[q]) { ee[q][i] = __builtin_ctzll(mask[q]); mask[q] &= mask[q] - 1; wgt[q][i] = 1.f; } else { ee[q][i] = i ? ee[q][0] : 0; wgt[q][i] = 0.f; } }
#pragma unroll
                    for (int i = 0; i < 4; ++i) { int slot = __shfl(sl[q], ee[q][i]); slot = slot < 0 ? 0 : slot; const f16* yr = a.y2 + ((size_t)ee[q][i] * EROWS + b * CAP + slot) * DM + 4 * lane;
#pragma unroll
                        for (int j = 0; j < 4; ++j) ld[q][i][j] = *(const f16x4*)(yr + 256 * j); } }
#pragma unroll
                for (int q = 0; q < R; ++q) { const int row = row0 + rr + q;
                    f32x4 cs[4];
#pragma unroll
                    for (int j = 0; j < 4; ++j) cs[j] = (f32x4){0.f, 0.f, 0.f, 0.f};
#pragma unroll
                    for (int i = 0; i < 4; ++i)
#pragma unroll
                        for (int j = 0; j < 4; ++j) { cs[j][0] += wgt[q][i] * (float)ld[q][i][j][0]; cs[j][1] += wgt[q][i] * (float)ld[q][i][j][1]; cs[j][2] += wgt[q][i] * (float)ld[q][i][j][2]; cs[j][3] += wgt[q][i] * (float)ld[q][i][j][3]; }
                    while (mask[q]) {
                        const int e2 = __builtin_ctzll(mask[q]); mask[q] &= mask[q] - 1; const int slot = __shfl(sl[q], e2); const f16* yr = a.y2 + ((size_t)e2 * EROWS + b * CAP + slot) * DM + 4 * lane;
#pragma unroll
                        for (int j = 0; j < 4; ++j) { const f16x4 t = *(const f16x4*)(yr + 256 * j); cs[j][0] += (float)t[0]; cs[j][1] += (float)t[1]; cs[j][2] += (float)t[2]; cs[j][3] += (float)t[3]; }
                    }
                    f16* xo = a.xout + (size_t)row * DM;
#pragma unroll
                    for (int j = 0; j < 4; ++j) { v[q][j] = v[q][j] + G2[j] * cs[j]; if (!a.fout) { u32x2 w; w.x = pkh(v[q][j][0], v[q][j][1]); w.y = pkh(v[q][j][2], v[q][j][3]); *(u32x2*)(xo + 4 * lane + 256 * j) = w; } }
                }
            }
            float rstd[R];
#pragma unroll
            for (int q = 0; q < R; ++q) { float ss = 0.f;
#pragma unroll
                for (int j = 0; j < 4; ++j) ss += (v[q][j][0] * v[q][j][0] + v[q][j][1] * v[q][j][1]) + (v[q][j][2] * v[q][j][2] + v[q][j][3] * v[q][j][3]);
                rstd[q] = 1.0f / sqrtf(wave_sum(ss) * (1.f / DM) + EPS); }
#pragma unroll
            for (int q = 0; q < R; ++q) { const int row = row0 + rr + q;
#pragma unroll
                for (int j = 0; j < 4; ++j) v[q][j] = (v[q][j] * rstd[q]) * A[j] + Sh[j];
                if (a.fout) {
#pragma unroll
                    for (int j = 0; j < 4; ++j) *(f32x4*)(a.fout + (size_t)row * DM + 4 * lane + 256 * j) = v[q][j];
                }
                if (a.hout) {
#pragma unroll
                    for (int j = 0; j < 4; ++j) { u32x2 w; if (a.hbf) { w.x = pkb(v[q][j][0], v[q][j][1]); w.y = pkb(v[q][j][2], v[q][j][3]); } else { w.x = pkh(v[q][j][0], v[q][j][1]); w.y = pkh(v[q][j][2], v[q][j][3]); } *(u32x2*)(a.hout + (size_t)row * DM + 4 * lane + 256 * j) = w; }
                }
            }
            if (a.wr) {
#pragma unroll 1
                for (int q = 0; q < R; ++q) {
                    float lg[16];
                    f32x4 h0 = v[0][0], h1 = v[0][1], h2 = v[0][2], h3 = v[0][3];
#pragma unroll
                    for (int qq = 1; qq < R; ++qq) if (q == qq) { h0 = v[qq][0]; h1 = v[qq][1]; h2 = v[qq][2]; h3 = v[qq][3]; }
#pragma unroll
                    for (int e = 0; e < 16; ++e) { const LAS float* wp = wl + e * 1028 + 4 * lane;
                        const f32x4 w0 = *(const LAS f32x4*)(wp), w1 = *(const LAS f32x4*)(wp + 256), w2 = *(const LAS f32x4*)(wp + 512), w3 = *(const LAS f32x4*)(wp + 768);
                        lg[e] = ((h0[0] * w0[0] + h0[1] * w0[1]) + (h0[2] * w0[2] + h0[3] * w0[3])) + ((h1[0] * w1[0] + h1[1] * w1[1]) + (h1[2] * w1[2] + h1[3] * w1[3]))
                              + ((h2[0] * w2[0] + h2[1] * w2[1]) + (h2[2] * w2[2] + h2[3] * w2[3])) + ((h3[0] * w3[0] + h3[1] * w3[1]) + (h3[2] * w3[2] + h3[3] * w3[3]));
                        asm volatile("" ::: "memory"); }
#pragma unroll
                    for (int i = 0; i < 8; ++i) { const bool hi = lane & 32; const float send = hi ? lg[i] : lg[i + 8], keep = hi ? lg[i + 8] : lg[i]; lg[i] = keep + __shfl_xor(send, 32); }
#pragma unroll
                    for (int i = 0; i < 4; ++i) { const bool hi = lane & 16; const float send = hi ? lg[i] : lg[i + 4], keep = hi ? lg[i + 4] : lg[i]; lg[i] = keep + __shfl_xor(send, 16); }
#pragma unroll
                    for (int i = 0; i < 2; ++i) { const bool hi = lane & 8; const float send = hi ? lg[i] : lg[i + 2], keep = hi ? lg[i + 2] : lg[i]; lg[i] = keep + __shfl_xor(send, 8); }
                    { const bool hi = lane & 4; const float send = hi ? lg[0] : lg[1], keep = hi ? lg[1] : lg[0]; lg[0] = keep + __shfl_xor(send, 4); }
                    float lv = lg[0]; lv += __shfl_xor(lv, 2); lv += __shfl_xor(lv, 1);
                    float mx = lv;
#pragma unroll
                    for (int o = 4; o < 64; o <<= 1) mx = fmaxf(mx, __shfl_xor(mx, o));
                    const float ex = expf(lv - mx); float sm = ex;
#pragma unroll
                    for (int o = 4; o < 64; o <<= 1) sm += __shfl_xor(sm, o);
                    const int row = row0 + rr + q, t = row & (SEQ - 1), e = (lane >> 2) & 15;
                    if ((lane & 3) == 0) a.aff[((size_t)b * NE + e) * SEQ + t] = ex / sm;
                }
            }
        }
    }
    if (ctx_rows) {
        f32x4 A[4], Sh[4];
#pragma unroll
        for (int j = 0; j < 4; ++j) { const int c = 4 * lane + 256 * j; A[j] = *(const f32x4*)(a.gain + c) * (*(const f32x4*)(ctx_scale + c) + 1.f); Sh[j] = *(const f32x4*)(ctx_shift + c); }
        for (int row = gw; row < NCTX; row += NGW) {
            f32x4 v[4]; float ss = 0.f;
#pragma unroll
            for (int j = 0; j < 4; ++j) { v[j] = *(const f32x4*)(ctx_src + (size_t)row * DM + 4 * lane + 256 * j); ss += (v[j][0] * v[j][0] + v[j][1] * v[j][1]) + (v[j][2] * v[j][2] + v[j][3] * v[j][3]); }
            const float rstd = 1.0f / sqrtf(wave_sum(ss) * (1.f / DM) + EPS);
#pragma unroll
            for (int j = 0; j < 4; ++j) { const f32x4 h = (v[j] * rstd) * A[j] + Sh[j]; u32x2 w; w.x = pkh(h[0], h[1]); w.y = pkh(h[2], h[3]); *(u32x2*)(a.hout + (size_t)(NTOK + row) * DM + 4 * lane + 256 * j) = w; }
        }
    }
    __syncthreads();
}

__device__ __forceinline__ void topk_phase(const float* aff, int* idx, float* gv, short* inv, const f16* H, f16* XIN, LAS unsigned char* lds) {
    const int tid = opaque_tid(), lane = tid & 63, wave = __builtin_amdgcn_readfirstlane(tid >> 6);
    LAS unsigned long long* key = (LAS unsigned long long*)lds;
    for (int u = blockIdx.x; u < NB * NE; u += gridDim.x) {
        const int b = u / NE, e = u % NE;
        const float* av = aff + (size_t)u * SEQ;
        for (int t = tid; t < SEQ; t += 512) key[t] = ((unsigned long long)(~__float_as_uint(av[t])) << 32) | (unsigned)t;
        __syncthreads();
        for (int k = 2; k <= SEQ; k <<= 1)
            for (int j = k >> 1; j > 0; j >>= 1) {
#pragma unroll
                for (int pp = 0; pp < 2; ++pp) { const int pr = tid + pp * 512; const int i = ((pr & ~(j - 1)) << 1) | (pr & (j - 1)), i2 = i | j;
                    const unsigned long long x = key[i], y = key[i2]; const bool up = (i & k) == 0;
                    if ((x > y) == up) { key[i] = y; key[i2] = x; } }
                __syncthreads();
            }
        for (int r = tid; r < SEQ; r += 512) { const unsigned long long kk = key[r]; const int t = (int)(unsigned)kk;
            inv[(size_t)u * SEQ + t] = (short)(r < CAP ? r : -1);
            if (r < CAP) { idx[u * CAP + r] = t; gv[u * CAP + r] = __uint_as_float(~(unsigned)(kk >> 32)); } }
        __syncthreads();
    }
}

namespace at {
constexpr int SLOT = 32768, NSLOT = 4;
constexpr int RPB_OFF = 132096;
constexpr float THR = 8.f;
typedef _Float16 v4h __attribute__((ext_vector_type(4)));
__device__ __forceinline__ int fsw(int row) { return ((row & 3) << 2) | ((row >> 2) & 3); }

__device__ __forceinline__ void glds16(const void* gsrc, unsigned lds_dst) { unsigned keep;
    asm volatile("s_mov_b32 %0, m0\n\ts_mov_b32 m0, %2\n\ts_nop 0\n\tglobal_load_lds_dwordx4 %1, off\n\ts_mov_b32 m0, %0" : "=&s"(keep) : "v"(gsrc), "s"(lds_dst) : "memory"); }
__device__ __forceinline__ void dma_tile(const f16* Z, long rowbase, int kcol, int vcol, LAS unsigned char* slot, int wave, int lane) {
    const unsigned sbase = (unsigned)__builtin_amdgcn_readfirstlane((int)(unsigned)(uintptr_t)slot);
#pragma unroll
    for (int i = 0; i < 2; ++i) { const int piece = wave + 8 * i, row = 4 * piece + (lane >> 4), c = (lane & 15) ^ fsw(row);
        const f16* gp = Z + (size_t)(rowbase + row) * ZP0 + 8 * c;
        glds16(gp + kcol, sbase + piece * 1024);
        glds16(gp + vcol, sbase + 16384 + piece * 1024); }
}
#define AT_WAIT(n) asm volatile("s_waitcnt vmcnt(" #n ") lgkmcnt(0)" ::: "memory")
__device__ __forceinline__ void wait_tile(int younger) { if (younger >= 2) AT_WAIT(8); else if (younger == 1) AT_WAIT(4); else AT_WAIT(0); }

template <int NDT> struct Addr { int k[4]; int v[NDT][2]; };
template <int NDT>
__device__ __forceinline__ Addr<NDT> make_addr(int kb0, int kchunk0, int vchunk0, int lane) {
    Addr<NDT> a; const int r32 = lane & 31, hh = lane >> 5, i = lane & 15, q_ = i >> 2, p_ = i & 3, g1 = (lane >> 4) & 1;
    const int kr = kb0 + r32, fk = fsw(kr);
#pragma unroll
    for (int st = 0; st < 4; ++st) a.k[st] = kr * 256 + 16 * ((kchunk0 + 2 * st + hh) ^ fk);
    const int vr = kb0 + 4 * hh + q_, f0 = fsw(vr), f1 = fsw(vr + 8);
#pragma unroll
    for (int dt = 0; dt < NDT; ++dt) { const int c = vchunk0 + 4 * dt + 2 * g1 + (p_ >> 1);
        a.v[dt][0] = 16384 + vr * 256 + 16 * (c ^ f0) + 8 * (p_ & 1); a.v[dt][1] = 16384 + (vr + 8) * 256 + 16 * (c ^ f1) + 8 * (p_ & 1); }
    return a;
}
#define AT_SCHED() __builtin_amdgcn_sched_barrier(0)
template <int NDT>
__device__ __forceinline__ void load_k(LAS unsigned char* slot, const Addr<NDT>& a, int off, f16x8* kf) {
#pragma unroll
    for (int st = 0; st < 4; ++st) kf[st] = *(const LAS f16x8*)(slot + a.k[st] + off);
}
template <int NDT>
__device__ __forceinline__ void load_v(LAS unsigned char* slot, const Addr<NDT>& a, int off, f16x8* vf) {
#pragma unroll
    for (int s2 = 0; s2 < 2; ++s2)
#pragma unroll
        for (int dt = 0; dt < NDT; ++dt) {
            const v4h lo = __builtin_bit_cast(v4h, __builtin_amdgcn_ds_read_tr16_b64_v4i16((LAS s16x4*)(slot + a.v[dt][0] + off + s2 * 4096)));
            const v4h hi = __builtin_bit_cast(v4h, __builtin_amdgcn_ds_read_tr16_b64_v4i16((LAS s16x4*)(slot + a.v[dt][1] + off + s2 * 4096)));
            vf[s2 * NDT + dt] = (f16x8){lo[0], lo[1], lo[2], lo[3], hi[0], hi[1], hi[2], hi[3]};
        }
}
__device__ __forceinline__ f32x16 qk32(const f16x8* kf, const f16x8 (&qf)[4], const f32x16& negm) {
    f32x16 s = __builtin_amdgcn_mfma_f32_32x32x16_f16(kf[0], qf[0], negm, 0, 0, 0);
#pragma unroll
    for (int st = 1; st < 4; ++st) s = __builtin_amdgcn_mfma_f32_32x32x16_f16(kf[st], qf[st], s, 0, 0, 0);
    return s;
}
__device__ __forceinline__ float max3f(float a, float b, float c) { float r; asm("v_max3_f32 %0, %1, %2, %3" : "=v"(r) : "v"(a), "v"(b), "v"(c)); return r; }
template <int NDT>
__device__ __forceinline__ void pv32(const f16x8* vf, const f32x16& p, f32x16 (&o)[NDT]) {
#pragma unroll
    for (int s2 = 0; s2 < 2; ++s2) {
        f16x8 pb;
#pragma unroll
        for (int j = 0; j < 8; ++j) pb[j] = (f16)p[8 * s2 + j];
#pragma unroll
        for (int dt = 0; dt < NDT; ++dt) o[dt] = __builtin_amdgcn_mfma_f32_32x32x16_f16(vf[s2 * NDT + dt], pb, o[dt], 0, 0, 0);
    }
}
__device__ __forceinline__ float rowmax16(const f32x16& s) { float a = max3f(s[0], s[1], s[2]), b = max3f(s[3], s[4], s[5]);
    a = max3f(a, s[6], s[7]); b = max3f(b, s[8], s[9]); a = max3f(a, s[10], s[11]); b = max3f(b, s[12], s[13]); a = max3f(a, s[14], s[15]); return fmaxf(a, b); }
template <int NDT>
__device__ __forceinline__ float rescale(float mx, float& m, float& l, f32x16 (&o)[NDT], f32x16& negm, bool& started) {
    const bool quiet = started ? (mx <= THR) : (mx == -INFINITY);
    if (__all(quiet)) return 0.f;
    float d = 0.f, alpha = 1.f;
    if (started) { d = fmaxf(mx, 0.f); alpha = __builtin_amdgcn_exp2f(-d); }
    else if (mx > -INFINITY) { d = mx; started = true; }
    m += d; l *= alpha;
#pragma unroll
    for (int dt = 0; dt < NDT; ++dt)
#pragma unroll
        for (int r = 0; r < 16; ++r) o[dt][r] *= alpha;
#pragma unroll
    for (int r = 0; r < 16; ++r) negm[r] = -m;
    return d;
}
__device__ __forceinline__ float expsum(f32x16& s, float d) { float ps = 0.f;
    if (__any(d != 0.f)) {
#pragma unroll
        for (int r = 0; r < 16; ++r) s[r] -= d; }
#pragma unroll
    for (int r = 0; r < 16; ++r) { s[r] = __builtin_amdgcn_exp2f(s[r]); ps += s[r]; }
    return ps; }
template <int NDT>
__device__ __forceinline__ void step64(LAS unsigned char* slot, const Addr<NDT>& a, const f16x8 (&qf)[4], f32x16 (&o)[NDT], float& m, float& l, f32x16& negm, bool& started) {
    f16x8 kf[8], va[2 * NDT], vb[2 * NDT];
    load_k<NDT>(slot, a, 0, kf); load_k<NDT>(slot, a, 8192, kf + 4);
    load_v<NDT>(slot, a, 0, va);
    AT_SCHED();
    f32x16 s0 = qk32(kf, qf, negm), s1 = qk32(kf + 4, qf, negm);
    AT_SCHED();
    load_v<NDT>(slot, a, 8192, vb);
    float mx = fmaxf(rowmax16(s0), rowmax16(s1)); mx = fmaxf(mx, __shfl_xor(mx, 32));
    const float d = rescale<NDT>(mx, m, l, o, negm, started);
    l += expsum(s0, d) + expsum(s1, d);
    AT_SCHED();
    pv32<NDT>(va, s0, o); pv32<NDT>(vb, s1, o);
    AT_SCHED();
}

__device__ __forceinline__ void diff_unit(int u, const f16* Z, f16* Y, const float* subln, float lam, LAS unsigned char* lds) {
    const int tid = opaque_tid(), lane = tid & 63, wave = __builtin_amdgcn_readfirstlane(tid >> 6);
    const int qb = u & 15, h = (u >> 4) & 3, b = u >> 6;
    const int map = wave >> 2, r32 = lane & 31, hh = lane >> 5;
    const long tokbase = (long)b * SEQ;
    const long qrow = tokbase + qb * 128 + (wave & 3) * 32 + r32;
    const int kcol = 1536 + 128 * h, vcol = 2560 + 128 * h;
    constexpr int NT = 36;
#define DIFF_ROWBASE(t) ((t) < 32 ? tokbase + 64 * (t) : (long)NTOK + b * CTXL + 64 * ((t) - 32))
#pragma unroll
    for (int t = 0; t < 3; ++t) dma_tile(Z, DIFF_ROWBASE(t), kcol, vcol, lds + t * SLOT, wave, lane);
    f16x8 qf[4];
#pragma unroll
    for (int st = 0; st < 4; ++st) qf[st] = *(const f16x8*)(Z + (size_t)qrow * ZP0 + 512 + 128 * h + 64 * map + 16 * st + 8 * hh);
    asm volatile("" : "+v"(qf[0]), "+v"(qf[1]), "+v"(qf[2]), "+v"(qf[3]));
    const Addr<4> ad = make_addr<4>(0, 8 * map, 0, lane);
    f32x16 o[4];
#pragma unroll
    for (int dt = 0; dt < 4; ++dt)
#pragma unroll
        for (int r = 0; r < 16; ++r) o[dt][r] = 0.f;
    float m = 0.f, l = 0.f; bool started = false;
    f32x16 negm;
#pragma unroll
    for (int r = 0; r < 16; ++r) negm[r] = 0.f;
    for (int t = 0; t < NT; ++t) {
        wait_tile(NT - 1 - t);
        __builtin_amdgcn_s_barrier();
        if (t + 3 < NT) dma_tile(Z, DIFF_ROWBASE(t + 3), kcol, vcol, lds + ((t + 3) & 3) * SLOT, wave, lane);
        step64<4>(lds + (t & 3) * SLOT, ad, qf, o, m, l, negm, started);
    }
#undef DIFF_ROWBASE
    __syncthreads();
    const float linv = 1.f / (l + __shfl_xor(l, 32));
    LAS float* cb = (LAS float*)lds + (wave & 3) * 4096;
    if (map == 1) {
#pragma unroll
        for (int dt = 0; dt < 4; ++dt)
#pragma unroll
            for (int r = 0; r < 16; ++r) cb[(dt * 16 + r) * 64 + lane] = o[dt][r] * linv;
    }
    __syncthreads();
    if (map == 0) {
        float ss = 0.f;
#pragma unroll
        for (int dt = 0; dt < 4; ++dt)
#pragma unroll
            for (int r = 0; r < 16; ++r) { const float d = o[dt][r] * linv - lam * cb[(dt * 16 + r) * 64 + lane]; o[dt][r] = d; ss += d * d; }
        ss += __shfl_xor(ss, 32);
        const float rstd = 0.8f / sqrtf(ss * (1.f / 128.f) + EPS);
        f16* yr = Y + (size_t)qrow * DM + 512 + 128 * h;
#pragma unroll
        for (int dt = 0; dt < 4; ++dt)
#pragma unroll
            for (int rg = 0; rg < 4; ++rg) { const int d0 = 32 * dt + 8 * rg + 4 * hh; const f32x4 sg = *(const f32x4*)(subln + d0);
                u32x2 w; w.x = pkh(o[dt][4 * rg] * rstd * sg[0], o[dt][4 * rg + 1] * rstd * sg[1]); w.y = pkh(o[dt][4 * rg + 2] * rstd * sg[2], o[dt][4 * rg + 3] * rstd * sg[3]);
                *(u32x2*)(yr + d0) = w; }
    }
    __syncthreads();
}

__device__ __forceinline__ void na_unit(int u, const f16* Z, f16* Y, const float* rpb, LAS unsigned char* lds) {
    const int tid = opaque_tid(), lane = tid & 63, wave = __builtin_amdgcn_readfirstlane(tid >> 6);
    const int rp = u & 15, hp = (u >> 4) & 3, b = u >> 6;
    const int hs = wave >> 2, a = wave & 3, head = 2 * hp + hs, r32 = lane & 31, hh = lane >> 5;
    const int r0 = 2 * rp, qr = r0 + (r32 >> 4), qc = 16 * a + (r32 & 15);
    const int rsq = min(max(qr - 4, 0), 24), csq = min(max(qc - 8, 0), 48);
    const int lo = min(max(r0 - 4, 0), 24), hi = min(max(r0 + 1 - 4, 0), 24) + 8;
    const int seg = (a == 0) ? 0 : (a == 1) ? 8 : (a == 2) ? 24 : 32;
    const long tokbase = (long)b * SEQ;
    const long qrow = tokbase + qr * 64 + qc;
    const int kcol = 1024 + 128 * hp, vcol = 2048 + 128 * hp;
    const int nwin = hi - lo, NT = nwin + 4;
#define NA_ROWBASE(t) ((t) < nwin ? tokbase + (lo + (t)) * 64 : (long)NTOK + b * CTXL + 64 * ((t) - nwin))
    LAS float* tab = (LAS float*)(lds + RPB_OFF);
    for (int i = tid; i < 2 * 465; i += 512) tab[i] = rpb[(2 * hp) * 465 + i] * LOG2E;
#pragma unroll
    for (int t = 0; t < 3; ++t) dma_tile(Z, NA_ROWBASE(t), kcol, vcol, lds + t * SLOT, wave, lane);
    f16x8 qf[4];
#pragma unroll
    for (int st = 0; st < 4; ++st) qf[st] = *(const f16x8*)(Z + (size_t)qrow * ZP0 + 64 * head + 16 * st + 8 * hh);
    asm volatile("" : "+v"(qf[0]), "+v"(qf[1]), "+v"(qf[2]), "+v"(qf[3]));
    const Addr<2> aw = make_addr<2>(seg, 8 * hs, 8 * hs, lane), ac = make_addr<2>(0, 8 * hs, 8 * hs, lane);
    f32x16 o[2];
#pragma unroll
    for (int dt = 0; dt < 2; ++dt)
#pragma unroll
        for (int r = 0; r < 16; ++r) o[dt][r] = 0.f;
    float m = 0.f, l = 0.f; bool started = false;
    f32x16 negm;
#pragma unroll
    for (int r = 0; r < 16; ++r) negm[r] = 0.f;
    for (int t = 0; t < NT; ++t) {
        wait_tile(NT - 1 - t);
        __builtin_amdgcn_s_barrier();
        if (t + 3 < NT) dma_tile(Z, NA_ROWBASE(t + 3), kcol, vcol, lds + ((t + 3) & 3) * SLOT, wave, lane);
        LAS unsigned char* slot = lds + (t & 3) * SLOT;
        if (t < nwin) {
            const int krow = lo + t;
            f16x8 kf[4], va[4];
            load_k<2>(slot, aw, 0, kf); load_v<2>(slot, aw, 0, va);
            AT_SCHED();
            f32x16 s = qk32(kf, qf, negm);
            const bool rowok = (krow >= rsq) && (krow < rsq + 8);
            const int rbase = (krow - qr + 7) * 31 + 15 - qc;
            float bias[16];
#pragma unroll
            for (int r = 0; r < 16; ++r) { const int kc = seg + (r & 3) + 8 * (r >> 2) + 4 * hh; bias[r] = tab[hs * 465 + min(max(rbase + kc, 0), 464)]; asm volatile("" : "+v"(bias[r])); }
#pragma unroll
            for (int r = 0; r < 16; ++r) { const int kc = seg + (r & 3) + 8 * (r >> 2) + 4 * hh; const bool ok = rowok && (kc >= csq) && (kc < csq + 16);
                s[r] = ok ? s[r] + bias[r] : -INFINITY; }
            float mx = rowmax16(s); mx = fmaxf(mx, __shfl_xor(mx, 32));
            const float d = rescale<2>(mx, m, l, o, negm, started);
            l += expsum(s, d);
            pv32<2>(va, s, o);
        } else {
            step64<2>(slot, ac, qf, o, m, l, negm, started);
        }
    }
#undef NA_ROWBASE
    const float linv = 1.f / (l + __shfl_xor(l, 32));
    f16* yr = Y + (size_t)qrow * DM + 64 * head;
#pragma unroll
    for (int dt = 0; dt < 2; ++dt)
#pragma unroll
        for (int rg = 0; rg < 4; ++rg) { const int d0 = 32 * dt + 8 * rg + 4 * hh;
            u32x2 w; w.x = pkh(o[dt][4 * rg] * linv, o[dt][4 * rg + 1] * linv); w.y = pkh(o[dt][4 * rg + 2] * linv, o[dt][4 * rg + 3] * linv);
            *(u32x2*)(yr + d0) = w; }
    __syncthreads();
}

__device__ __forceinline__ void attn_phase(const f16* Z, f16* Y, const float* rpb, const float* subln, const float* lamp, LAS unsigned char* lds, int rep = 0) {
    const float lam = *lamp;
    const int ulo = (rep == 3) ? 1024 : 0, uhi = (rep == 2) ? 1024 : 2048;
    for (int u = ulo + blockIdx.x; u < uhi; u += gridDim.x) {
        if (u < 1024) diff_unit(u, Z, Y, subln, lam, lds);
        else na_unit(u - 1024, Z, Y, rpb, lds);
    }
}
}

__device__ __forceinline__ void conv_phase(const f16* Z1, f16* Y, const float* scw, const float* cfw, const float* cfb, const float* lng, const float* lnb, LAS unsigned char* lds) {
    const int tid = opaque_tid(), lane = tid & 63, wave = __builtin_amdgcn_readfirstlane(tid >> 6);
    LAS float* U = (LAS float*)lds;
    float cw[31];
#pragma unroll
    for (int k = 0; k < 31; ++k) cw[k] = cfw[k * 512 + tid];
    const float cb = cfb[tid];
    for (int u = blockIdx.x; u < NTOK / 32; u += gridDim.x) {
        const int b = u >> 6, t0 = (u & 63) * 32;
        const f16* zb = Z1 + (size_t)b * SEQ * ZP1;
        {
            f16x4 av[16], gv[16];
#pragma unroll
            for (int pass = 0; pass < 16; ++pass) { const int row = pass * 4 + (tid >> 7), c4 = (tid & 127) * 4, tt = t0 - 15 + row; const bool ok = row < 62 && tt >= 0 && tt < SEQ;
                const int tc = ok ? tt : (t0 < SEQ ? t0 : 0);
                av[pass] = *(const f16x4*)(zb + (size_t)tc * ZP1 + 1536 + c4); gv[pass] = *(const f16x4*)(zb + (size_t)tc * ZP1 + 2048 + c4); }
#pragma unroll
            for (int pass = 0; pass < 16; ++pass) { const int row = pass * 4 + (tid >> 7), c4 = (tid & 127) * 4, tt = t0 - 15 + row; const bool ok = tt >= 0 && tt < SEQ;
                if (row < 62) { f32x4 uv;
#pragma unroll
                    for (int j = 0; j < 4; ++j) uv[j] = ok ? (float)av[pass][j] * __builtin_amdgcn_rcpf(1.f + __builtin_amdgcn_exp2f(-LOG2E * (float)gv[pass][j])) : 0.f;
                    *(LAS f32x4*)(U + row * 512 + c4) = uv; } }
        }
        __syncthreads();
        float uu[62];
#pragma unroll
        for (int i = 0; i < 62; ++i) uu[i] = U[i * 512 + tid];
        __syncthreads();
#pragma unroll
        for (int tt = 0; tt < 32; ++tt) { float v = cb;
#pragma unroll
            for (int k = 0; k < 31; ++k) v += cw[k] * uu[tt + k];
            U[tt * 512 + tid] = v; }
        __syncthreads();
#pragma unroll
        for (int q = 0; q < 4; ++q) { const int tt = wave * 4 + q, t = t0 + tt, c8 = lane * 8;
            const f32x4 x0 = *(const LAS f32x4*)(U + tt * 512 + c8), x1 = *(const LAS f32x4*)(U + tt * 512 + c8 + 4);
            float x[8] = {x0[0], x0[1], x0[2], x0[3], x1[0], x1[1], x1[2], x1[3]};
            float s = 0.f;
#pragma unroll
            for (int j = 0; j < 8; ++j) s += x[j];
            const float mean = wave_sum(s) * (1.f / 512.f); float s2 = 0.f;
#pragma unroll
            for (int j = 0; j < 8; ++j) { x[j] -= mean; s2 += x[j] * x[j]; }
            const float rstd = 1.0f / sqrtf(wave_sum(s2) * (1.f / 512.f) + EPS);
            const f32x4 g0 = *(const f32x4*)(lng + c8), g1 = *(const f32x4*)(lng + c8 + 4), b0 = *(const f32x4*)(lnb + c8), b1 = *(const f32x4*)(lnb + c8 + 4);
            const float gg[8] = {g0[0], g0[1], g0[2], g0[3], g1[0], g1[1], g1[2], g1[3]}, bb[8] = {b0[0], b0[1], b0[2], b0[3], b1[0], b1[1], b1[2], b1[3]};
            float yd[8];
#pragma unroll
            for (int j = 0; j < 8; ++j) yd[j] = silu_f(x[j] * rstd * gg[j] + bb[j]);
            f16* yr = Y + ((size_t)b * SEQ + t) * DM;
            { u32x4 w; w.x = pkh(yd[0], yd[1]); w.y = pkh(yd[2], yd[3]); w.z = pkh(yd[4], yd[5]); w.w = pkh(yd[6], yd[7]); *(u32x4*)(yr + 512 + c8) = w; }
            float cacc[8];
#pragma unroll
            for (int j = 0; j < 8; ++j) cacc[j] = 0.f;
#pragma unroll
            for (int k = 0; k < 3; ++k) { const int ts = t + k - 1;
                if (ts >= 0 && ts < SEQ) { const f16x8 xc = *(const f16x8*)(zb + (size_t)ts * ZP1 + c8), gc = *(const f16x8*)(zb + (size_t)ts * ZP1 + 1024 + c8);
                    const f32x4 w0 = *(const f32x4*)(scw + k * 512 + c8), w1 = *(const f32x4*)(scw + k * 512 + c8 + 4);
                    const float ww[8] = {w0[0], w0[1], w0[2], w0[3], w1[0], w1[1], w1[2], w1[3]};
#pragma unroll
                    for (int j = 0; j < 8; ++j) cacc[j] += ww[j] * ((float)gc[j] * (float)xc[j]); } }
            const f16x8 gb = *(const f16x8*)(zb + (size_t)t * ZP1 + 512 + c8);
            { u32x4 w; w.x = pkh((float)gb[0] * cacc[0], (float)gb[1] * cacc[1]); w.y = pkh((float)gb[2] * cacc[2], (float)gb[3] * cacc[3]);
              w.z = pkh((float)gb[4] * cacc[4], (float)gb[5] * cacc[5]); w.w = pkh((float)gb[6] * cacc[6], (float)gb[7] * cacc[7]); *(u32x4*)(yr + c8) = w; }
        }
        __syncthreads();
    }
}

constexpr int NPHASE = 18;
__global__ void __launch_bounds__(512, 2) fwd(Params p) {
    extern __shared__ __attribute__((aligned(16))) unsigned char lds_raw[];
    LAS unsigned char* lds = (LAS unsigned char*)lds_raw;
    const int tid = threadIdx.x;
    unsigned char* ws = p.ws;
    for (int u = tid; u < (LDS_BYTES - LDSCTL_OFF) / 4; u += 512) ((LAS unsigned*)(lds + LDSCTL_OFF))[u] = 0u;
    __syncthreads();
    XcdBarrier bar; bar.bar = (unsigned*)(ws + WS_CTL) + 4096; bar.x = 0; bar.st = nullptr;
    if (N_LAUNCH_MODE == 1) bar = xcd_barrier_post((unsigned*)(ws + WS_CTL) + 4096, (volatile LAS unsigned*)(lds + MISC_OFF) + 8);
    const int lo = p.ph_lo, hi = p.ph_hi, rep = p.alt;
#ifndef ONLYP
#define ONLYP -1
#endif
#define IN(k) ((ONLYP < 0 || ONLYP == (k)) && lo <= (k) && (k) < hi)
#define SEAM(k) do { if (IN(k) && IN((k) + 1)) xcd_barrier(bar); } while (0)
    const int G = gridDim.x, c = blockIdx.x;
    float* mod0 = (float*)(ws + WS_MOD + MOD0_OFF); float* mod1 = (float*)(ws + WS_MOD + MOD1_OFF);
    f16* H = (f16*)(ws + WS_H); f16* Z = (f16*)(ws + WS_Z); f16* Y = (f16*)(ws + WS_Y); f16* XIN = (f16*)(ws + WS_XIN); f16* HID = (f16*)(ws + WS_HID); f16* Y2 = (f16*)(ws + WS_Y2);
    f16* XR = (f16*)(ws + WS_XIN);
    f16* W13 = (f16*)(ws + WS_W13); f16* W2T = (f16*)(ws + WS_W2);
    float* AFF = (float*)(ws + WS_AFF); int* IDX = (int*)(ws + WS_IDX); float* GV = (float*)(ws + WS_G); short* INV = (short*)(ws + WS_INV);

    if (IN(0)) { phase_prologue(p, lds); } SEAM(0);
    if (IN(1)) { NormArgs a{}; a.src = p.in[I_X]; a.gain = p.in[I_L0_NORM1]; a.shift = mod0; a.scale = mod0 + 1024; a.mstride = 6144; a.hout = H;
        norm_phase<4>(a, lds, true, p.in[I_CTX], mod0 + 16 * 6144, mod0 + 16 * 6144 + 1024); } SEAM(1);
    if (IN(2)) { gm::Gemm g{H, (const f16*)(ws + WS_WIN0), DM, 0, 0}; gm::Order S; S.init(NROWS, ZP0, 1, G, c);
        gm::EpiInProj0 E{Z, (const float*)(ws + WS_MOD + ROPE_OFF)}; gm::gemm_phase<false>(lds, g, S, E); } SEAM(2);
    if (IN(3)) { at::attn_phase(Z, Y, p.in[I_L0_RPB], p.in[I_L0_SUBLN], (const float*)(ws + WS_MOD + LAM_OFF), lds, rep); } SEAM(3);
    if (IN(4)) { gm::Gemm g{Y, (const f16*)(ws + WS_WOUT0), DM, 0, 0}; gm::Order S; S.init(NTOK, DM, 1, G, c);
        gm::EpiResGate<false> E{p.in[I_X], XR, mod0 + 2048, 6144}; gm::gemm_phase<false>(lds, g, S, E); } SEAM(4);
    if (IN(5)) { NormArgs a{}; a.src16 = XR; a.gain = p.in[I_L0_NORM2]; a.shift = mod0 + 3072; a.scale = mod0 + 4096; a.mstride = 6144; a.hout = H; a.wr = p.in[I_L0_WR]; a.aff = AFF; a.hbf = MOE_BF16;
        norm_phase<4>(a, lds, false, nullptr, nullptr, nullptr); } SEAM(5);
    if (IN(6)) { topk_phase(AFF, IDX, GV, INV, H, XIN, lds); } SEAM(6);
    if (IN(7)) { gm::Gemm g{H, W13, DM, 0, (long)2 * DE * DM, IDX}; gm::Order S; S.init(EROWS, 2 * DE, NE, G, c);
        gm::EpiSwiGLU E{HID}; gm::gemm_phase<MOE_BF16, true>(lds, g, S, E); } SEAM(7);
    if (IN(8)) { gm::Gemm g{HID, W2T, DE, (long)EROWS * DE, (long)DM * DE}; gm::Order S; S.init(EROWS, DM, NE, G, c, 1);
        gm::EpiRowScale E{Y2, GV}; gm::gemm_phase<MOE_BF16>(lds, g, S, E); } SEAM(8);
    if (IN(9)) { NormArgs a{}; a.src16 = XR; a.xout = rep ? (f16*)(ws + WS_BIG) : XR; a.y2 = Y2; a.inv = INV; a.gate2 = mod0 + 5120; a.gain = p.in[I_L1_NORM1]; a.shift = mod1; a.scale = mod1 + 1024; a.mstride = 6144; a.hout = rep ? (f16*)(ws + WS_BIG + 128 * MiB) : H;
        norm_phase<2>(a, lds, false, nullptr, nullptr, nullptr);
        cvt_moe(p.in[I_L1_W1], p.in[I_L1_W3], p.in[I_L1_W2], W13, W2T, tid, lds); } SEAM(9);
    if (IN(10)) { gm::Gemm g{H, (const f16*)(ws + WS_WIN1), DM, 0, 0}; gm::Order S; S.init(NTOK, ZP1, 1, G, c);
        gm::EpiF16 E{Z, ZP1}; gm::gemm_phase<false>(lds, g, S, E); } SEAM(10);
    if (IN(11)) { conv_phase(Z, Y, p.in[I_L1_SCW], p.in[I_L1_CFW], p.in[I_L1_CFB], p.in[I_L1_LNG], p.in[I_L1_LNB], lds); } SEAM(11);
    if (IN(12)) { gm::Gemm g{Y, (const f16*)(ws + WS_WOUT1), DM, 0, 0}; gm::Order S; S.init(NTOK, DM, 1, G, c);
        gm::EpiResGate<true> E{XR, rep ? (f16*)(ws + WS_BIG) : XR, mod1 + 2048, 6144}; gm::gemm_phase<false>(lds, g, S, E); } SEAM(12);
    if (IN(13)) { NormArgs a{}; a.src16 = XR; a.gain = p.in[I_L1_NORM2]; a.shift = mod1 + 3072; a.scale = mod1 + 4096; a.mstride = 6144; a.hout = H; a.wr = p.in[I_L1_WR]; a.aff = AFF; a.hbf = MOE_BF16;
        norm_phase<4>(a, lds, false, nullptr, nullptr, nullptr); } SEAM(13);
    if (IN(14)) { topk_phase(AFF, IDX, GV, INV, H, XIN, lds); } SEAM(14);
    if (IN(15)) { gm::Gemm g{H, W13, DM, 0, (long)2 * DE * DM, IDX}; gm::Order S; S.init(EROWS, 2 * DE, NE, G, c);
        gm::EpiSwiGLU E{HID}; gm::gemm_phase<MOE_BF16, true>(lds, g, S, E); } SEAM(15);
    if (IN(16)) { gm::Gemm g{HID, W2T, DE, (long)EROWS * DE, (long)DM * DE}; gm::Order S; S.init(EROWS, DM, NE, G, c, 1);
        gm::EpiRowScale E{Y2, GV}; gm::gemm_phase<MOE_BF16>(lds, g, S, E); } SEAM(16);
    if (IN(17)) { NormArgs a{}; a.src16 = XR; a.xout = XR; a.y2 = Y2; a.inv = INV; a.gate2 = mod1 + 5120; a.gain = p.in[I_FNORM]; a.fout = rep ? (float*)(ws + WS_BIG) : p.out;
        norm_phase<2>(a, lds, false, nullptr, nullptr, nullptr); }
#undef IN
#undef SEAM
}

extern "C" void kernel_launch(void* const* d_in, const int* in_sizes, int n_in, void* d_out, int out_size, void* d_ws, size_t ws_size, hipStream_t stream) {
    static int grid = 0;
    if (grid == 0) {
        if (n_in != 36 || out_size != NTOK * DM || ws_size < WS_END) { fprintf(stderr, "kernel_launch: unexpected shapes (n_in %d out %d ws %zu need %zu)\n", n_in, out_size, ws_size, (size_t)WS_END); grid = -1; return; }
        int dev = 0, cus = 0;
        if (hipGetDevice(&dev) != hipSuccess || hipDeviceGetAttribute(&cus, hipDeviceAttributeMultiprocessorCount, dev) != hipSuccess) { grid = -1; return; }
        if (hipFuncSetAttribute((const void*)fwd, hipFuncAttributeMaxDynamicSharedMemorySize, LDS_BYTES) != hipSuccess) { fprintf(stderr, "kernel_launch: hipFuncSetAttribute failed\n"); grid = -1; return; }
        int per_cu = 0;
        if (hipOccupancyMaxActiveBlocksPerMultiprocessor(&per_cu, (const void*)fwd, 512, LDS_BYTES) != hipSuccess || per_cu < 1) fprintf(stderr, "kernel_launch: occupancy query says %d\n", per_cu);
        (void)hipGetLastError();
        grid = cus;
    }
    if (grid < 0) return;
    (void)hipMemsetAsync((char*)d_ws + WS_CTL, 0, CTL_ZERO_BYTES, stream);
    Params p{};
    for (int i = 0; i < 36; ++i) p.in[i] = (const float*)d_in[i];
    p.out = (float*)d_out; p.ws = (unsigned char*)d_ws;
#if N_LAUNCH_MODE == 1
    p.ph_lo = 0; p.ph_hi = NPHASE;
    hipLaunchKernelGGL(fwd, dim3(grid), dim3(512), LDS_BYTES, stream, p);
#else
    for (int k = 0; k < NPHASE; ++k) { p.ph_lo = k; p.ph_hi = k + 1; p.alt = 0; hipLaunchKernelGGL(fwd, dim3(grid), dim3(512), LDS_BYTES, stream, p);
        for (int r = 0; r < HOSTDUP_N; ++r) if ((HOSTDUP >> k) & 1) { p.alt = HOSTDUP_ALT; hipLaunchKernelGGL(fwd, dim3(grid), dim3(512), LDS_BYTES, stream, p); } }
#endif
}
```

```cpp
#include <hip/hip_runtime.h>
#include <cstdio>
#include <cstdint>

#define LAS __attribute__((address_space(3)))
#define GAS __attribute__((address_space(1)))
typedef _Float16 f16;
typedef _Float16 f16x8 __attribute__((ext_vector_type(8)));
typedef _Float16 f16x4 __attribute__((ext_vector_type(4)));
typedef _Float16 f16x2 __attribute__((ext_vector_type(2)));
typedef float f32x2 __attribute__((ext_vector_type(2)));
typedef float f32x4 __attribute__((ext_vector_type(4)));
typedef float f32x16 __attribute__((ext_vector_type(16)));
typedef unsigned u32x2 __attribute__((ext_vector_type(2)));
typedef unsigned u32x4 __attribute__((ext_vector_type(4)));
typedef short s16x4 __attribute__((ext_vector_type(4)));

#ifndef MOE_BF16
#define MOE_BF16 true
#endif
#ifndef HOSTDUP
#define HOSTDUP 0
#endif
#ifndef HOSTDUP_ALT
#define HOSTDUP_ALT 1
#endif
#ifndef HOSTDUP_N
#define HOSTDUP_N 1
#endif
#ifndef N_LAUNCH_MODE
#define N_LAUNCH_MODE 1
#endif

constexpr int NB = 16, SEQ = 2048, DM = 1024, NTOK = NB * SEQ, CTXL = 256, NCTX = NB * CTXL, NROWS = NTOK + NCTX;
constexpr int ZP0 = 3072, ZP1 = 2560;
constexpr int NE = 16, DE = 2816, CAP = 256, EROWS = NB * CAP;
constexpr float EPS = 1e-6f;
constexpr float LOG2E = 1.4426950408889634f;
constexpr float QSCALE = 0.125f * LOG2E;

constexpr size_t MiB = 1u << 20;
constexpr size_t WS_CTL = 0, CTL_ZERO_BYTES = 256 * 1024;
constexpr size_t WS_MOD = 1 * MiB;
constexpr size_t MOD0_OFF = 0, MOD1_OFF = 17 * 6144 * 4, ROPE_OFF = MOD1_OFF + 16 * 6144 * 4, LAM_OFF = ROPE_OFF + 64 * 16 * 2 * 4;
constexpr size_t WS_WIN0 = 2 * MiB, WS_WOUT0 = 8 * MiB, WS_WIN1 = 10 * MiB, WS_WOUT1 = 15 * MiB;
constexpr size_t WS_AFF = 17 * MiB;
constexpr size_t WS_IDX = 19 * MiB;
constexpr size_t WS_G = 19 * MiB + 512 * 1024;
constexpr size_t WS_INV = 20 * MiB;
constexpr size_t WS_W13 = 22 * MiB;
constexpr size_t WS_W2 = WS_W13 + 176 * MiB;
constexpr size_t WS_H = WS_W2 + 88 * MiB;
constexpr size_t WS_XIN = WS_H + 72 * MiB;
constexpr size_t WS_Y2 = WS_XIN + 128 * MiB;
constexpr size_t WS_BIG = WS_Y2 + 128 * MiB;
constexpr size_t WS_Z = WS_BIG, WS_Y = WS_BIG + 216 * MiB, WS_HID = WS_BIG;
constexpr size_t WS_END = WS_BIG + 352 * MiB;

constexpr int RING_BYTES = 131072;
constexpr int LDSCTL_OFF = RING_BYTES, MISC_OFF = LDSCTL_OFF + 320;
constexpr int LDS_BYTES = 147456;

#define RLX_AGENT __ATOMIC_RELAXED, __HIP_MEMORY_SCOPE_AGENT
#define LDS_WAIT() asm volatile("s_waitcnt lgkmcnt(0)" ::: "memory")
#define VM_WAIT() asm volatile("s_waitcnt vmcnt(0)" ::: "memory")

__device__ __forceinline__ unsigned pkh(float lo, float hi) { f16x2 v; v.x = (f16)lo; v.y = (f16)hi; return __builtin_bit_cast(unsigned, v); }
typedef __bf16 bf16x2_t __attribute__((ext_vector_type(2)));
typedef short s16x8 __attribute__((ext_vector_type(8)));
__device__ __forceinline__ unsigned pkb(float lo, float hi) { f32x2 v = {lo, hi}; bf16x2_t b = __builtin_convertvector(v, bf16x2_t); return __builtin_bit_cast(unsigned, b); }
template <bool BF> __device__ __forceinline__ unsigned pk16(float lo, float hi) { return BF ? pkb(lo, hi) : pkh(lo, hi); }
__device__ __forceinline__ float silu_f(float v) { return v * __builtin_amdgcn_rcpf(1.f + __builtin_amdgcn_exp2f(-LOG2E * v)); }

#define XB_TMO      128
#define XB_XCNT(j)  (256  + 64 * (j))
#define XB_XSUB(j)  (1280 + 64 * (j))
#define XB_XGEN(j)  (2304 + 64 * (j))
#define XB_TOP      3328
#define XB_TOPGEN   3392
#define XCD_BAR_WORDS 3456
#define XB_SPIN_CAP (1u << 18)
__device__ __forceinline__ unsigned xb_ld(unsigned* p)              { return __hip_atomic_load(p, __ATOMIC_RELAXED, __HIP_MEMORY_SCOPE_AGENT); }
__device__ __forceinline__ unsigned xb_add(unsigned* p, unsigned v) { return __hip_atomic_fetch_add(p, v, __ATOMIC_RELAXED, __HIP_MEMORY_SCOPE_AGENT); }
__device__ __forceinline__ unsigned xb_xcc_id() { return (unsigned)__builtin_amdgcn_s_getreg((3 << 11) | 20) & 0xFu; }
#define XB_SPIN(cond, bar) do { unsigned _sp = 0; while (cond) { __builtin_amdgcn_s_sleep(1); \
    if ((++_sp & 255u) == 0u) { if (xb_ld(&(bar)[XB_TMO])) break; if (_sp > XB_SPIN_CAP) { atomicAdd(&(bar)[XB_TMO], 1u); break; } } } } while (0)
struct XcdBarrier { unsigned* bar; unsigned x; volatile LAS unsigned* st; };
__device__ __forceinline__ XcdBarrier xcd_barrier_post(unsigned* bar, volatile LAS unsigned* st) {
    XcdBarrier b; b.bar = bar; b.x = xb_xcc_id(); b.st = st;
    if (threadIdx.x == 0) (void)xb_add(&bar[XB_XCNT(b.x)], 1u);
    return b;
}
__device__ __forceinline__ void xcd_barrier_complete(unsigned* bar, unsigned x, unsigned& nloc, unsigned& nx) {
    const unsigned G = gridDim.x * gridDim.y * gridDim.z;
    unsigned sum, cnt, mine, sp = 0u;
    for (;;) {
        sum = 0u; cnt = 0u; mine = 0u;
#pragma unroll
        for (unsigned j = 0; j < 16; ++j) { const unsigned c = xb_ld(&bar[XB_XCNT(j)]); sum += c; cnt += (c > 0u) ? 1u : 0u; mine = (j == x) ? c : mine; }
        if (sum == G) break;
        __builtin_amdgcn_s_sleep(1);
        if ((++sp & 255u) == 0u) { if (xb_ld(&bar[XB_TMO])) break; if (sp > XB_SPIN_CAP) { atomicAdd(&bar[XB_TMO], 1u); break; } }
    }
    nloc = mine > 0u ? mine : 1u; nx = cnt > 0u ? cnt : 1u;
}
__device__ __forceinline__ void xcd_barrier(const XcdBarrier& b) {
    asm volatile("s_waitcnt vmcnt(0)" ::: "memory");
    __syncthreads();
    if (threadIdx.x == 0) {
        unsigned* bar = b.bar;
        __builtin_amdgcn_s_waitcnt(0);
        unsigned nloc = b.st[0], nx = b.st[1];
        if (nloc == 0u) { xcd_barrier_complete(bar, b.x, nloc, nx); b.st[0] = nloc; b.st[1] = nx; }
        const unsigned old = xb_add(&bar[XB_XSUB(b.x)], 1u);
        const unsigned gen = old / nloc;
        if (old + 1u == (gen + 1u) * nloc) {
            __builtin_amdgcn_fence(__ATOMIC_RELEASE, "agent");
            asm volatile("s_waitcnt vmcnt(0)" ::: "memory");
            const unsigned og = xb_add(&bar[XB_TOP], 1u);
            const unsigned tg = og / nx;
            if (og + 1u == (tg + 1u) * nx) xb_add(&bar[XB_TOPGEN], 1u);
            else XB_SPIN(xb_ld(&bar[XB_TOPGEN]) == tg, bar);
            __builtin_amdgcn_fence(__ATOMIC_ACQUIRE, "agent");
            xb_add(&bar[XB_XGEN(b.x)], 1u);
            asm volatile("s_waitcnt vmcnt(0)" ::: "memory");
        } else {
            XB_SPIN(xb_ld(&bar[XB_XGEN(b.x)]) == gen, bar);
            __builtin_amdgcn_fence(__ATOMIC_ACQUIRE, "agent");
            asm volatile("s_waitcnt vmcnt(0)" ::: "memory");
        }
    }
    __syncthreads();
}

struct NoHook { __device__ __forceinline__ void operator()() {} };
__device__ __forceinline__ int opaque_tid0() { int t = threadIdx.x; asm volatile("" : "+v"(t)); return t; }
namespace gm {
constexpr int BM = 256, BK = 64, HALF = 128, HTB = HALF * BK * 2, STAGE_BYTES = 8 * HTB, NXCD = 8, WGM = 8;
__host__ __device__ __forceinline__ int lds_byte(int r, int c) { const int st = (r >> 4) * 2 + (c >> 5), rr = r & 15, cc = c & 31, ob = rr * 64 + cc * 2; return st * 1024 + (ob ^ (((ob >> 9) & 1) << 5)); }
__host__ __device__ __forceinline__ void stage_rc(int b, int& R, int& C) { const int st = b / 1024, sb = b % 1024, swz = sb ^ (((sb >> 9) & 1) << 5); R = (st >> 1) * 16 + swz / 64; C = (st & 1) * 32 + (swz % 64) / 2; }
__host__ __device__ __forceinline__ int perm32(int rho) { const int n = rho >> 4, i = rho & 15; return 8 * (i >> 2) + 4 * n + (i & 3); }

struct Unit { int g, pm, pn; };
struct Gemm { const f16* A; const f16* Bt; int K; long sA, sB; const int* gidx; };
struct Order {
    int nM, nN, tpg, total, G, c, mode;
    __device__ void init(int M, int N, int groups, int G_, int c_, int mode_ = 0) { nM = M / BM; nN = N / BM; tpg = nM * nN; total = tpg * groups; G = G_; c = c_; mode = (mode_ == 1 && G_ == 256 && nM == 16 && nN == 4) ? 1 : 0; }
    __device__ bool next(int i, Unit& u) const {
        const long L = (long)i * G + c; if (L >= total) return false;
        if (mode == 1) { const int x = c & 7, j = c >> 3; u.g = 4 * i + (x >> 1); u.pm = 8 * (x & 1) + (j >> 2); u.pn = j & 3; return true; }
        const int g = (int)(L / tpg); int wgid = (int)(L % tpg);
        { const int q = tpg / NXCD, r = tpg % NXCD, xcd = wgid % NXCD, off = wgid / NXCD; wgid = (xcd < r ? xcd * (q + 1) : r * (q + 1) + (xcd - r) * q) + off; }
        const int nig = WGM * nN, gid = wgid / nig, fm = gid * WGM, gsz = (nM - fm) < WGM ? (nM - fm) : WGM;
        u.g = g; u.pm = fm + ((wgid % nig) % gsz); u.pn = (wgid % nig) / gsz; return true;
    }
};

typedef f32x4 Acc[2][2][4][2];
typedef __bf16 bf16x8_t __attribute__((ext_vector_type(8)));
template <bool BF> __device__ __forceinline__ f32x4 mma16(const s16x8& a, const s16x8& b, const f32x4& c) {
    if constexpr (BF) return __builtin_amdgcn_mfma_f32_16x16x32_bf16(__builtin_bit_cast(bf16x8_t, a), __builtin_bit_cast(bf16x8_t, b), c, 0, 0, 0);
    else return __builtin_amdgcn_mfma_f32_16x16x32_f16(__builtin_bit_cast(f16x8, a), __builtin_bit_cast(f16x8, b), c, 0, 0, 0);
}

struct EpiF16 {
    static constexpr bool PERM = true;
    f16* O; int ldc;
    __device__ __forceinline__ void operator()(const Acc& acc, const Unit& u, int wr, int wc, int fr, int fq) const {
        const int row0 = u.pm * BM + wr * 64 + fr, col0 = u.pn * BM + wc * 32 + 8 * fq;
#pragma unroll
        for (int ai = 0; ai < 2; ++ai)
#pragma unroll
            for (int m = 0; m < 4; ++m) { f16* rowp = O + (size_t)(row0 + ai * HALF + m * 16) * ldc + col0;
#pragma unroll
                for (int bj = 0; bj < 2; ++bj) { const f32x4 v0 = acc[ai][bj][m][0], v1 = acc[ai][bj][m][1];
                    u32x4 w; w.x = pkh(v0[0], v0[1]); w.y = pkh(v0[2], v0[3]); w.z = pkh(v1[0], v1[1]); w.w = pkh(v1[2], v1[3]);
                    *(u32x4*)(rowp + bj * HALF) = w; } }
    }
};
struct EpiInProj0 {
    static constexpr bool PERM = true;
    f16* O; const float* rope;
    __device__ __forceinline__ void operator()(const Acc& acc, const Unit& u, int wr, int wc, int fr, int fq) const {
        const int row0 = u.pm * BM + wr * 64 + fr, col0 = u.pn * BM + wc * 32 + 8 * fq;
        const float sc = (u.pn < 4) ? QSCALE : 1.f;
        const bool dorope = (u.pn == 2 || u.pn == 3 || u.pn == 6 || u.pn == 7) && (u.pm * BM < NTOK);
#pragma unroll
        for (int ai = 0; ai < 2; ++ai)
#pragma unroll
            for (int m = 0; m < 4; ++m) { const int row = row0 + ai * HALF + m * 16; f16* rowp = O + (size_t)row * ZP0 + col0;
                const int t = row & (SEQ - 1), prow = t >> 6, pcol = t & 63;
#pragma unroll
                for (int bj = 0; bj < 2; ++bj) { f32x4 v0 = acc[ai][bj][m][0] * sc, v1 = acc[ai][bj][m][1] * sc;
                    if (dorope) { const int c = col0 + bj * HALF, half = (c >> 5) & 1, i0 = (c & 31) >> 1; const int pos = half ? pcol : prow;
                        const f32x4* tp = (const f32x4*)(rope + (pos * 16 + i0) * 2); const f32x4 t0 = tp[0], t1 = tp[1];
                        f32x4 r0, r1;
                        r0[0] = v0[0] * t0[0] - v0[1] * t0[1]; r0[1] = v0[0] * t0[1] + v0[1] * t0[0];
                        r0[2] = v0[2] * t0[2] - v0[3] * t0[3]; r0[3] = v0[2] * t0[3] + v0[3] * t0[2];
                        r1[0] = v1[0] * t1[0] - v1[1] * t1[1]; r1[1] = v1[0] * t1[1] + v1[1] * t1[0];
                        r1[2] = v1[2] * t1[2] - v1[3] * t1[3]; r1[3] = v1[2] * t1[3] + v1[3] * t1[2];
                        v0 = r0; v1 = r1; }
                    u32x4 w; w.x = pkh(v0[0], v0[1]); w.y = pkh(v0[2], v0[3]); w.z = pkh(v1[0], v1[1]); w.w = pkh(v1[2], v1[3]);
                    *(u32x4*)(rowp + bj * HALF) = w; } }
    }
};
template <bool BASE16>
struct EpiResGate {
    static constexpr bool PERM = true;
    const void* base; f16* out; const float* gate; int gstride;
    __device__ __forceinline__ void operator()(const Acc& acc, const Unit& u, int wr, int wc, int fr, int fq) const {
        const int col0 = u.pn * BM + wc * 32 + 8 * fq; const int b = (u.pm * BM) / SEQ;
        f32x4 gv[2][2];
#pragma unroll
        for (int bj = 0; bj < 2; ++bj)
#pragma unroll
            for (int n = 0; n < 2; ++n) gv[bj][n] = *(const f32x4*)(gate + (size_t)b * gstride + col0 + bj * HALF + 4 * n);
#pragma unroll
        for (int ai = 0; ai < 2; ++ai)
#pragma unroll
            for (int m = 0; m < 4; ++m) { const size_t off = (size_t)(u.pm * BM + ai * HALF + wr * 64 + m * 16 + fr) * DM + col0;
#pragma unroll
                for (int bj = 0; bj < 2; ++bj) { f32x4 b0, b1;
                    if constexpr (BASE16) { const f16x8 bv = *(const f16x8*)((const f16*)base + off + bj * HALF);
                        b0 = (f32x4){(float)bv[0], (float)bv[1], (float)bv[2], (float)bv[3]}; b1 = (f32x4){(float)bv[4], (float)bv[5], (float)bv[6], (float)bv[7]}; }
                    else { b0 = *(const f32x4*)((const float*)base + off + bj * HALF); b1 = *(const f32x4*)((const float*)base + off + bj * HALF + 4); }
                    const f32x4 v0 = b0 + gv[bj][0] * acc[ai][bj][m][0], v1 = b1 + gv[bj][1] * acc[ai][bj][m][1];
                    u32x4 w; w.x = pkh(v0[0], v0[1]); w.y = pkh(v0[2], v0[3]); w.z = pkh(v1[0], v1[1]); w.w = pkh(v1[2], v1[3]);
                    *(u32x4*)(out + off + bj * HALF) = w; }
                if (m & 1) asm volatile("" ::: "memory"); }
    }
};
constexpr int ZP1N = 1536;
struct EpiL1In {
    static constexpr bool PERM = true;
    f16* O;
    __device__ __forceinline__ void operator()(const Acc& acc, const Unit& u, int wr, int wc, int fr, int fq) const {
        const int row0 = u.pm * BM + wr * 64 + fr;
        if (u.pn < 8) {
            const int col0 = (u.pn < 4 ? 0 : 512) + 128 * (u.pn & 3) + wc * 32 + 8 * fq; const bool glu = u.pn >= 4;
#pragma unroll
            for (int ai = 0; ai < 2; ++ai)
#pragma unroll
                for (int m = 0; m < 4; ++m) { float h[8];
#pragma unroll
                    for (int n = 0; n < 2; ++n)
#pragma unroll
                        for (int j = 0; j < 4; ++j) { const float a = acc[ai][0][m][n][j], b = acc[ai][1][m][n][j]; h[n * 4 + j] = glu ? a * __builtin_amdgcn_rcpf(1.f + __builtin_amdgcn_exp2f(-LOG2E * b)) : a * b; }
                    u32x4 w; w.x = pkh(h[0], h[1]); w.y = pkh(h[2], h[3]); w.z = pkh(h[4], h[5]); w.w = pkh(h[6], h[7]);
                    *(u32x4*)(O + (size_t)(row0 + ai * HALF + m * 16) * ZP1N + col0) = w; }
        } else {
            const int col0 = 1024 + (u.pn - 8) * BM + wc * 32 + 8 * fq;
#pragma unroll
            for (int ai = 0; ai < 2; ++ai)
#pragma unroll
                for (int m = 0; m < 4; ++m) { f16* rowp = O + (size_t)(row0 + ai * HALF + m * 16) * ZP1N + col0;
#pragma unroll
                    for (int bj = 0; bj < 2; ++bj) { const f32x4 v0 = acc[ai][bj][m][0], v1 = acc[ai][bj][m][1];
                        u32x4 w; w.x = pkh(v0[0], v0[1]); w.y = pkh(v0[2], v0[3]); w.z = pkh(v1[0], v1[1]); w.w = pkh(v1[2], v1[3]);
                        *(u32x4*)(rowp + bj * HALF) = w; } }
        }
    }
};
struct EpiSwiGLU {
    static constexpr bool PERM = true;
    f16* O;
    __device__ __forceinline__ void operator()(const Acc& acc, const Unit& u, int wr, int wc, int fr, int fq) const {
        const int row0 = u.pm * BM + wr * 64 + fr, col0 = u.pn * HALF + wc * 32 + 8 * fq;
        f16* Og = O + (size_t)u.g * EROWS * DE;
#pragma unroll
        for (int ai = 0; ai < 2; ++ai)
#pragma unroll
            for (int m = 0; m < 4; ++m) { f16* rowp = Og + (size_t)(row0 + ai * HALF + m * 16) * DE + col0;
                float h[8];
#pragma unroll
                for (int n = 0; n < 2; ++n)
#pragma unroll
                    for (int j = 0; j < 4; ++j) { const float g = acc[ai][0][m][n][j], up = acc[ai][1][m][n][j]; h[n * 4 + j] = g * up * __builtin_amdgcn_rcpf(1.f + __builtin_amdgcn_exp2f(-LOG2E * g)); }
                u32x4 w; w.x = pk16<MOE_BF16>(h[0], h[1]); w.y = pk16<MOE_BF16>(h[2], h[3]); w.z = pk16<MOE_BF16>(h[4], h[5]); w.w = pk16<MOE_BF16>(h[6], h[7]);
                *(u32x4*)rowp = w; }
    }
};
struct EpiRowScale {
    static constexpr bool PERM = true;
    f16* O; const float* gv;
    __device__ __forceinline__ void operator()(const Acc& acc, const Unit& u, int wr, int wc, int fr, int fq) const {
        const int row0 = u.pm * BM + wr * 64 + fr, col0 = u.pn * BM + wc * 32 + 8 * fq;
        f16* Og = O + (size_t)u.g * EROWS * DM;
#pragma unroll
        for (int ai = 0; ai < 2; ++ai)
#pragma unroll
            for (int m = 0; m < 4; ++m) { const int row = row0 + ai * HALF + m * 16; const float s = gv[((row >> 8) * NE + u.g) * CAP + (row & 255)];
                f16* rowp = Og + (size_t)row * DM + col0;
#pragma unroll
                for (int bj = 0; bj < 2; ++bj) { const f32x4 v0 = acc[ai][bj][m][0] * s, v1 = acc[ai][bj][m][1] * s;
                    u32x4 w; w.x = pkh(v0[0], v0[1]); w.y = pkh(v0[2], v0[3]); w.z = pkh(v1[0], v1[1]); w.w = pkh(v1[2], v1[3]);
                    *(u32x4*)(rowp + bj * HALF) = w; } }
    }
};

template <bool BF, bool GATHER = false, class Epi, class Hook>
__device__ __forceinline__ void gemm_phase(LAS unsigned char* lds, const Gemm g, const Order& S, const Epi& E, Hook& HK) {
    const int tid = opaque_tid0(), wid = __builtin_amdgcn_readfirstlane(tid >> 6), lane = tid & 63, wr = wid >> 2, wc = wid & 3, fr = lane & 15, fq = lane >> 4;
    const int K = g.K, nt = K / BK;
    unsigned voffA[2], voffB[2];
#pragma unroll
    for (int i = 0; i < 2; ++i) { int R, C; stage_rc(tid * 16 + i * 8192, R, C); const int Rb = Epi::PERM ? ((R & ~31) + perm32(R & 31)) : R;
        voffA[i] = (unsigned)(R * K + C) * 2u; voffB[i] = (unsigned)(Rb * K + C) * 2u; }
    int gR[2], gC[2];
#pragma unroll
    for (int i = 0; i < 2; ++i) { int R, C; stage_rc(tid * 16 + i * 8192, R, C); gR[i] = R; gC[i] = C; }
    unsigned gA0[2] = {0u, 0u}, gA1[2] = {0u, 0u}, nA0[2] = {0u, 0u}, nA1[2] = {0u, 0u};
    LAS unsigned short* gtab = (LAS unsigned short*)(lds + 132096);
    constexpr int GT_MAXU = 22;
#define GM_GCVT(dst0, dst1, uu, ui_) do { const LAS unsigned short* _tp = gtab + (ui_) * 256; _Pragma("unroll") for (int _i = 0; _i < 2; ++_i) { const int _t0 = _tp[gR[_i]], _t1 = _tp[128 + gR[_i]]; \
        dst0[_i] = (unsigned)((((uu).pm * SEQ + _t0) * K + gC[_i]) * 2); dst1[_i] = (unsigned)((((uu).pm * SEQ + _t1) * K + gC[_i]) * 2); } } while (0)
    const size_t kstep = (size_t)(BK * 2);
    const size_t hstep = GATHER ? (size_t)0 : (size_t)HALF * K * 2;
    const size_t hstepB = (size_t)HALF * K * 2;
    const size_t tstep = 2 * hstepB;
    const unsigned ldsw = (unsigned)wid * 1024u;
    const int aoff = lds_byte(wr * 64 + fr, fq * 8), boff = lds_byte(wc * 32 + fr, fq * 8);
#define GM_SA(b, h) (((b) * 2 + (h)) * HTB)
#define GM_SB(b, h) ((4 + (b) * 2 + (h)) * HTB)
#define GM_STAGE(bufoff, gbase, voff) do { _Pragma("unroll") for (int _i = 0; _i < 2; ++_i) \
        __builtin_amdgcn_global_load_lds((const unsigned*)((const char*)(gbase) + (voff)[_i]), (LAS unsigned*)(lds + (bufoff) + ldsw + _i * 8192), 16, 0, 0); } while (0)
#define GM_LDA(dst, b, h) do { _Pragma("unroll") for (int m = 0; m < 4; ++m) _Pragma("unroll") for (int k = 0; k < 2; ++k) dst[m][k] = *(const LAS s16x8*)(lds + GM_SA(b, h) + aoff + m * 2048 + k * 1024); } while (0)
#define GM_LDB(dst, b, h) do { _Pragma("unroll") for (int n = 0; n < 2; ++n) _Pragma("unroll") for (int k = 0; k < 2; ++k) dst[n][k] = *(const LAS s16x8*)(lds + GM_SB(b, h) + boff + n * 2048 + k * 1024); } while (0)
#define GM_MMA(ai, bj, At, Bt) do { __builtin_amdgcn_s_setprio(1); _Pragma("unroll") for (int m = 0; m < 4; ++m) _Pragma("unroll") for (int n = 0; n < 2; ++n) _Pragma("unroll") for (int k = 0; k < 2; ++k) \
        acc[ai][bj][m][n] = mma16<BF>(Bt[n][k], At[m][k], acc[ai][bj][m][n]); __builtin_amdgcn_s_setprio(0); } while (0)
#define GM_WAIT_V(n) asm volatile("s_waitcnt vmcnt(" #n ")" ::: "memory")
#define GM_WAIT_L(n) asm volatile("s_waitcnt lgkmcnt(" #n ")" ::: "memory")
#define GM_BAR __builtin_amdgcn_s_barrier()
#define GM_SCHED __builtin_amdgcn_sched_barrier(0)
    Unit cur, nxt; int ui = 0;
    if (!S.next(0, cur)) return;
    Acc acc;
#pragma unroll
    for (int a = 0; a < 2; ++a)
#pragma unroll
        for (int b = 0; b < 2; ++b)
#pragma unroll
            for (int m = 0; m < 4; ++m)
#pragma unroll
                for (int n = 0; n < 2; ++n) acc[a][b][m][n] = (f32x4){0.f, 0.f, 0.f, 0.f};
    s16x8 At[4][2], B0[2][2], B1[2][2];
    const char* cA = GATHER ? (const char*)g.A : (const char*)(g.A + (size_t)cur.g * g.sA) + (size_t)cur.pm * tstep; const char* cB = (const char*)(g.Bt + (size_t)cur.g * g.sB) + (size_t)cur.pn * tstep;
    if constexpr (GATHER) {
        int tv[GT_MAXU / 2];
#pragma unroll
        for (int j = 0; j < GT_MAXU / 2; ++j) { const int ui_ = 2 * j + (tid >> 8); Unit uu; const bool okk = S.next(ui_, uu); tv[j] = g.gidx[(okk ? (uu.pm * NE + uu.g) * CAP : 0) + (tid & 255)]; }
#pragma unroll
        for (int j = 0; j < GT_MAXU / 2; ++j) gtab[(2 * j + (tid >> 8)) * 256 + (tid & 255)] = (unsigned short)tv[j];
        __syncthreads();
        GM_GCVT(gA0, gA1, cur, 0);
    }
#define GM_STA_H0(buf, p, o0) do { if constexpr (GATHER) GM_STAGE(buf, p, o0); else GM_STAGE(buf, p, voffA); } while (0)
#define GM_STA_H1(buf, p, o1) do { if constexpr (GATHER) GM_STAGE(buf, p, o1); else GM_STAGE(buf, (p) + hstepB, voffA); } while (0)
    GM_STAGE(GM_SB(0, 0), cB, voffB); GM_STAGE(GM_SB(0, 1), cB + hstepB, voffB); GM_STA_H0(GM_SA(0, 0), cA, gA0); GM_STA_H1(GM_SA(0, 1), cA, gA1);
    if (wr == 1) GM_BAR;
    GM_WAIT_V(2); GM_BAR;
    GM_STAGE(GM_SB(1, 0), cB + kstep, voffB); GM_STA_H0(GM_SA(1, 0), cA + kstep, gA0); GM_STAGE(GM_SB(1, 1), cB + hstepB + kstep, voffB);
    GM_WAIT_V(6); GM_BAR;
    for (;;) {
        const bool has_next = S.next(ui + 1, nxt);
        const char* nA = GATHER ? cA : (has_next ? (const char*)(g.A + (size_t)nxt.g * g.sA) + (size_t)nxt.pm * tstep : cA); const char* nB = has_next ? (const char*)(g.Bt + (size_t)nxt.g * g.sB) + (size_t)nxt.pn * tstep : cB;
        if constexpr (GATHER) { if (has_next) GM_GCVT(nA0, nA1, nxt, ui + 1); else { nA0[0] = gA0[0]; nA0[1] = gA0[1]; nA1[0] = gA1[0]; nA1[1] = gA1[1]; } }
        for (int t = 0; t < nt; t += 2) {
            const bool last = (t == nt - 2);
            const char* a1 = cA + (size_t)(t + 1) * kstep;
            const char* a2 = last ? nA : cA + (size_t)(t + 2) * kstep; const char* b2 = last ? nB : cB + (size_t)(t + 2) * kstep;
            const char* a3 = a2 + kstep; const char* b3 = b2 + kstep;
            unsigned s0[2], s1[2];
            if constexpr (GATHER) { s0[0] = last ? nA0[0] : gA0[0]; s0[1] = last ? nA0[1] : gA0[1]; s1[0] = last ? nA1[0] : gA1[0]; s1[1] = last ? nA1[1] : gA1[1]; }
            GM_LDB(B0, 0, 0); GM_LDB(B1, 0, 1); GM_SCHED; GM_LDA(At, 0, 0); GM_STA_H1(GM_SA(1, 1), a1, gA1);
            GM_WAIT_V(8); GM_WAIT_L(0); GM_BAR; GM_MMA(0, 0, At, B0); GM_MMA(0, 1, At, B1); GM_BAR; GM_SCHED;
            GM_LDA(At, 0, 1); GM_STAGE(GM_SB(0, 0), b2, voffB); GM_STAGE(GM_SB(0, 1), b2 + hstepB, voffB); GM_STA_H0(GM_SA(0, 0), a2, s0);
            GM_WAIT_V(8); GM_WAIT_L(0); GM_BAR; GM_MMA(1, 0, At, B0); GM_MMA(1, 1, At, B1); GM_BAR; GM_SCHED;
            GM_LDB(B0, 1, 0); GM_LDB(B1, 1, 1); GM_SCHED; GM_LDA(At, 1, 0); GM_STA_H1(GM_SA(0, 1), a2, s1);
            GM_WAIT_V(8); GM_WAIT_L(0); GM_BAR; GM_MMA(0, 0, At, B0); GM_MMA(0, 1, At, B1); GM_BAR; GM_SCHED;
            GM_LDA(At, 1, 1); GM_STAGE(GM_SB(1, 0), b3, voffB); GM_STAGE(GM_SB(1, 1), b3 + hstepB, voffB); GM_STA_H0(GM_SA(1, 0), a3, s0);
            GM_WAIT_V(8); GM_WAIT_L(0); GM_BAR; GM_MMA(1, 0, At, B0); GM_MMA(1, 1, At, B1); GM_BAR; GM_SCHED;
        }
        if (wr == 0) GM_BAR;
        E(acc, cur, wr, wc, fr, fq);
        HK();
        if (!has_next) break;
#pragma unroll
        for (int a = 0; a < 2; ++a)
#pragma unroll
            for (int b = 0; b < 2; ++b)
#pragma unroll
                for (int m = 0; m < 4; ++m)
#pragma unroll
                    for (int n = 0; n < 2; ++n) acc[a][b][m][n] = (f32x4){0.f, 0.f, 0.f, 0.f};
        cur = nxt; cA = nA; cB = nB; ++ui;
        if constexpr (GATHER) { gA0[0] = nA0[0]; gA0[1] = nA0[1]; gA1[0] = nA1[0]; gA1[1] = nA1[1]; }
        if (wr == 1) GM_BAR;
    }
    GM_WAIT_V(0);
    GM_BAR;
#undef GM_SA
#undef GM_STA_H0
#undef GM_STA_H1
#undef GM_GCVT
#undef GM_SB
#undef GM_STAGE
#undef GM_LDA
#undef GM_LDB
#undef GM_MMA
#undef GM_WAIT_V
#undef GM_WAIT_L
#undef GM_BAR
#undef GM_SCHED
}
template <bool BF, bool GATHER = false, class Epi>
__device__ __forceinline__ void gemm_phase(LAS unsigned char* lds, const Gemm g, const Order& S, const Epi& E) { NoHook nh; gemm_phase<BF, GATHER>(lds, g, S, E, nh); }
}

struct Params { const float* in[36]; float* out; unsigned char* ws; int ph_lo, ph_hi, alt, pad; };
enum { I_X = 0, I_C, I_CTX, I_CCTX, I_L0_NORM1, I_L0_WMOD, I_L0_BMOD, I_L0_WIN, I_L0_WOUT, I_L0_RPB, I_L0_LQ1, I_L0_LK1, I_L0_LQ2, I_L0_LK2, I_L0_SUBLN,
       I_L0_NORM2, I_L0_WR, I_L0_W1, I_L0_W3, I_L0_W2, I_L1_NORM1, I_L1_WMOD, I_L1_BMOD, I_L1_WIN, I_L1_WOUT, I_L1_SCW, I_L1_CFW, I_L1_CFB, I_L1_LNG, I_L1_LNB,
       I_L1_NORM2, I_L1_WR, I_L1_W1, I_L1_W3, I_L1_W2, I_FNORM };

__device__ __forceinline__ int opaque_tid() { int t = threadIdx.x; asm volatile("" : "+v"(t)); return t; }
__device__ __forceinline__ float wave_sum(float v) {
#define WS_DPP(x, ctrl, rmask) __builtin_bit_cast(float, __builtin_amdgcn_update_dpp(0, __builtin_bit_cast(int, x), ctrl, rmask, 0xF, false))
    v += WS_DPP(v, 0xB1, 0xF);
    v += WS_DPP(v, 0x4E, 0xF);
    v += WS_DPP(v, 0x141, 0xF);
    v += WS_DPP(v, 0x140, 0xF);
    v += WS_DPP(v, 0x142, 0xA);
    v += WS_DPP(v, 0x143, 0xC);
#undef WS_DPP
    return __builtin_bit_cast(float, __builtin_amdgcn_readlane(__builtin_bit_cast(int, v), 63));
}

constexpr int CVT_RS = 136, CVT_SCR = 64 * CVT_RS;
template <bool BF, class RowMap>
__device__ __forceinline__ void cvt_item(const float* W, int K, int N, f16* WT, const RowMap& rm, int item, int lane, LAS unsigned char* scr) {
    const int nblk = N / 64, kb = item / nblk, nb = item % nblk, k0 = 64 * kb, n0 = 64 * nb;
    const float* src = W + (size_t)(k0 + (lane >> 4)) * N + n0 + 4 * (lane & 15);
    f32x4 v[16];
#pragma unroll
    for (int i = 0; i < 16; ++i) v[i] = *(const f32x4*)(src + (size_t)(4 * i) * N);
#pragma unroll
    for (int i = 0; i < 16; ++i) { u32x2 w; w.x = pk16<BF>(v[i][0], v[i][1]); w.y = pk16<BF>(v[i][2], v[i][3]);
        *(LAS u32x2*)(scr + (4 * i + (lane >> 4)) * CVT_RS + 8 * (lane & 15)) = w; }
    const int g = lane >> 4, i16 = lane & 15, q_ = i16 >> 2, p_ = i16 & 3;
#pragma unroll
    for (int st = 0; st < 8; ++st) {
        const int nl = 16 * (st >> 1), ch = 4 * (st & 1) + g;
        const LAS unsigned char* ap = scr + (8 * ch + q_) * CVT_RS + (nl + 4 * p_) * 2;
        const s16x4 lo = __builtin_amdgcn_ds_read_tr16_b64_v4i16((LAS s16x4*)ap);
        const s16x4 hi = __builtin_amdgcn_ds_read_tr16_b64_v4i16((LAS s16x4*)(ap + 4 * CVT_RS));
        u32x4 w; const u32x2 l2 = __builtin_bit_cast(u32x2, lo), h2 = __builtin_bit_cast(u32x2, hi); w.x = l2.x; w.y = l2.y; w.z = h2.x; w.w = h2.y;
        *(u32x4*)(WT + (size_t)rm(n0 + nl + i16) * K + k0 + 8 * ch) = w;
    }
}
struct MapPlain { __device__ __forceinline__ int operator()(int n) const { return n; } };
struct MapRope { __device__ __forceinline__ int operator()(int n) const {
    const bool rp = (n >= 512 && n < 1024) || (n >= 1536 && n < 2048); if (!rp) return n; const int i = n & 31; return (n & ~31) + (i < 16 ? 2 * i : 2 * (i - 16) + 1); } };
struct MapL1In { __device__ __forceinline__ int operator()(int n) const {
    if (n < 512) return 256 * (n >> 7) + (n & 127);
    if (n < 1024) return 2048 + (n - 512);
    if (n < 1536) { const int c = n - 1024; return 256 * (c >> 7) + 128 + (c & 127); }
    if (n < 2048) { const int c = n - 1536; return 1024 + 256 * (c >> 7) + (c & 127); }
    const int c = n - 2048; return 1024 + 256 * (c >> 7) + 128 + (c & 127); } };
struct MapGLU { int add; __device__ __forceinline__ int operator()(int n) const { return (n >> 7) * 256 + (n & 127) + add; } };

constexpr int CVB_RS = 264, CVT_TS = 528;
template <bool BF, class RowMap>
__device__ __forceinline__ void cvt_block(const float* W, int K, int N, f16* WT, const RowMap& rm, int item, int tid, LAS unsigned char* S) {
    const int lane = tid & 63, wave = tid >> 6;
    const int nblk = N / 128, kb = item / nblk, nb = item % nblk, k0 = 256 * kb, n0 = 128 * nb;
    const float* src = W + (size_t)(k0 + 32 * wave + (lane >> 5)) * N + n0 + 4 * (lane & 31);
    f32x4 v[16];
#pragma unroll
    for (int i = 0; i < 16; ++i) v[i] = *(const f32x4*)(src + (size_t)(2 * i) * N);
#pragma unroll
    for (int i = 0; i < 16; ++i) { u32x2 w; w.x = pk16<BF>(v[i][0], v[i][1]); w.y = pk16<BF>(v[i][2], v[i][3]);
        *(LAS u32x2*)(S + (32 * wave + 2 * i + (lane >> 5)) * CVB_RS + 8 * (lane & 31)) = w; }
    __syncthreads();
    const int g = lane >> 4, i16 = lane & 15, q_ = i16 >> 2, p_ = i16 & 3;
    LAS unsigned char* T = S;
    u32x4 wv[8];
#pragma unroll
    for (int st = 0; st < 8; ++st) {
        const int ch = 4 * st + g;
        const LAS unsigned char* ap = S + (8 * ch + q_) * CVB_RS + (16 * wave + 4 * p_) * 2;
        const s16x4 lo = __builtin_amdgcn_ds_read_tr16_b64_v4i16((LAS s16x4*)ap);
        const s16x4 hi = __builtin_amdgcn_ds_read_tr16_b64_v4i16((LAS s16x4*)(ap + 4 * CVB_RS));
        const u32x2 l2 = __builtin_bit_cast(u32x2, lo), h2 = __builtin_bit_cast(u32x2, hi); wv[st].x = l2.x; wv[st].y = l2.y; wv[st].z = h2.x; wv[st].w = h2.y;
    }
    __syncthreads();
#pragma unroll
    for (int st = 0; st < 8; ++st) *(LAS u32x4*)(T + (16 * wave + i16) * CVT_TS + 16 * (4 * st + g)) = wv[st];
    LDS_WAIT();
#pragma unroll
    for (int j = 0; j < 8; ++j) { const int nr = 16 * wave + 2 * j + (lane >> 5), ch = lane & 31;
        const u32x4 w = *(const LAS u32x4*)(T + nr * CVT_TS + 16 * ch);
        *(u32x4*)(WT + (size_t)rm(n0 + nr) * K + k0 + 8 * ch) = w; }
    __syncthreads();
}
__device__ __forceinline__ void cvt_moe(const float* w1, const float* w3, const float* w2, f16* W13, f16* W2T, int tid, LAS unsigned char* S) {
    constexpr int I13 = (DM / 256) * (DE / 128), I2 = (DE / 256) * (DM / 128);
    constexpr int NIT = NE * (2 * I13 + I2);
    for (int it = blockIdx.x; it < NIT; it += gridDim.x) {
        const int e = it / (2 * I13 + I2); int r = it % (2 * I13 + I2);
        if (r < I13) { cvt_block<MOE_BF16>(w1 + (size_t)e * DM * DE, DM, DE, W13 + (size_t)e * 2 * DE * DM, MapGLU{0}, r, tid, S); continue; } r -= I13;
        if (r < I13) { cvt_block<MOE_BF16>(w3 + (size_t)e * DM * DE, DM, DE, W13 + (size_t)e * 2 * DE * DM, MapGLU{128}, r, tid, S); continue; } r -= I13;
        cvt_block<MOE_BF16>(w2 + (size_t)e * DE * DM, DE, DM, W2T + (size_t)e * DM * DE, MapPlain{}, r, tid, S);
    }
}

template <bool BF, class RowMap>
__device__ __forceinline__ void cvt_block_reg(const float* W, int K, int N, f16* WT, const RowMap& rm, int item, int tid) {
    const int lane = tid & 63, wave = tid >> 6, kg = lane >> 3, ng = lane & 7;
    const int nblk = N / 128, kb = item / nblk, nb = item % nblk;
    f32x4 v[2][8];
#pragma unroll
    for (int t = 0; t < 2; ++t) { const int sb = 2 * wave + t, k0 = 256 * kb + 64 * (sb >> 2) + 8 * kg, n0 = 128 * nb + 32 * (sb & 3) + 4 * ng;
#pragma unroll
        for (int i = 0; i < 8; ++i) v[t][i] = *(const f32x4*)(W + (size_t)(k0 + i) * N + n0); }
#pragma unroll
    for (int t = 0; t < 2; ++t) { const int sb = 2 * wave + t, k0 = 256 * kb + 64 * (sb >> 2) + 8 * kg, n0 = 128 * nb + 32 * (sb & 3) + 4 * ng;
#pragma unroll
        for (int j = 0; j < 4; ++j) { u32x4 w; w.x = pk16<BF>(v[t][0][j], v[t][1][j]); w.y = pk16<BF>(v[t][2][j], v[t][3][j]); w.z = pk16<BF>(v[t][4][j], v[t][5][j]); w.w = pk16<BF>(v[t][6][j], v[t][7][j]);
            *(u32x4*)(WT + (size_t)rm(n0 + j) * K + k0) = w; } }
}
struct CvItem { const float* W; f16* WT; int K, N, add, r; };
struct MoeCvt {
    const float* w1; const float* w3; const float* w2; f16* W13; f16* W2T; int mode; int turn; int cnt; int tid_;
    __device__ __forceinline__ CvItem decode(int it) const {
        constexpr int I13 = (DM / 256) * (DE / 128), I2 = (DE / 256) * (DM / 128);
        const int per_e = mode == 0 ? 2 * I13 + I2 : (mode == 1 ? 2 * I13 : I2);
        const int e = it / per_e; int r = it % per_e; if (mode == 2) r += 2 * I13;
        CvItem d;
        if (r < I13) { d.W = w1 + (size_t)e * DM * DE; d.WT = W13 + (size_t)e * 2 * DE * DM; d.K = DM; d.N = DE; d.add = 0; d.r = r; }
        else if (r < 2 * I13) { d.W = w3 + (size_t)e * DM * DE; d.WT = W13 + (size_t)e * 2 * DE * DM; d.K = DM; d.N = DE; d.add = 128; d.r = r - I13; }
        else { d.W = w2 + (size_t)e * DE * DM; d.WT = W2T + (size_t)e * DM * DE; d.K = DE; d.N = DM; d.add = -1; d.r = r - 2 * I13; }
        return d; }
    static __device__ __forceinline__ void load(const CvItem& d, int tid, f32x4 (&v)[2][8]) {
        const int lane = tid & 63, wave = tid >> 6, kg = lane >> 3, ng = lane & 7; const int nblk = d.N / 128, kb = d.r / nblk, nb = d.r % nblk;
#pragma unroll
        for (int t = 0; t < 2; ++t) { const int sb = 2 * wave + t, k0 = 256 * kb + 64 * (sb >> 2) + 8 * kg, n0 = 128 * nb + 32 * (sb & 3) + 4 * ng;
#pragma unroll
            for (int i = 0; i < 8; ++i) v[t][i] = *(const f32x4*)(d.W + (size_t)(k0 + i) * d.N + n0); } }
    static __device__ __forceinline__ void store(const CvItem& d, int tid, const f32x4 (&v)[2][8]) {
        const int lane = tid & 63, wave = tid >> 6, kg = lane >> 3, ng = lane & 7; const int nblk = d.N / 128, kb = d.r / nblk, nb = d.r % nblk;
#pragma unroll
        for (int t = 0; t < 2; ++t) { const int sb = 2 * wave + t, k0 = 256 * kb + 64 * (sb >> 2) + 8 * kg, n0 = 128 * nb + 32 * (sb & 3) + 4 * ng;
#pragma unroll
            for (int j = 0; j < 4; ++j) { u32x4 w; w.x = pk16<MOE_BF16>(v[t][0][j], v[t][1][j]); w.y = pk16<MOE_BF16>(v[t][2][j], v[t][3][j]); w.z = pk16<MOE_BF16>(v[t][4][j], v[t][5][j]); w.w = pk16<MOE_BF16>(v[t][6][j], v[t][7][j]);
                const int n = n0 + j, row = d.add >= 0 ? (n >> 7) * 256 + (n & 127) + d.add : n;
                *(u32x4*)(d.WT + (size_t)row * d.K + k0) = w; } } }
    __device__ __forceinline__ void run_all(int tid) const {
        constexpr int I13 = (DM / 256) * (DE / 128), I2 = (DE / 256) * (DM / 128);
        const int nit = NE * (mode == 0 ? 2 * I13 + I2 : (mode == 1 ? 2 * I13 : I2)), G = gridDim.x;
        const int it_lo = (int)(((long)blockIdx.x * nit) / G), it_hi = (int)(((long)(blockIdx.x + 1) * nit) / G);
        for (int it = it_lo; it < it_hi; it += 2) {
            f32x4 va[2][8], vb[2][8];
            const CvItem d0 = decode(it); load(d0, tid, va);
            const bool two = it + 1 < it_hi; const CvItem d1 = decode(two ? it + 1 : it);
            if (two) load(d1, tid, vb);
            store(d0, tid, va);
            if (two) store(d1, tid, vb); }
    }
    __device__ __forceinline__ void operator()() { if (cnt == turn) run_all(tid_); ++cnt; }
    __device__ __forceinline__ void finish() { if (cnt <= turn) run_all(tid_); cnt = 1 << 20; }
};

__device__ __forceinline__ void phase_prologue(const Params& p, LAS unsigned char* lds) {
    const int tid = opaque_tid(), lane = tid & 63, wave = __builtin_amdgcn_readfirstlane(tid >> 6);
    const int G = gridDim.x;
    unsigned char* ws = p.ws;
    LAS float* S = (LAS float*)lds;
    LAS float* red = (LAS float*)(lds + 17 * 1024 * 4);
    for (int u = blockIdx.x; u < 193; u += G) {
        if (u == 192) {
            float* rope = (float*)(ws + WS_MOD + ROPE_OFF);
            for (int idx = tid; idx < 1024; idx += 512) { const int pos = idx >> 4, i = idx & 15; const float fr = powf(10000.f, -(float)i / 16.f), ang = (float)pos * fr;
                rope[idx * 2] = cosf(ang); rope[idx * 2 + 1] = sinf(ang); }
            if (wave == 0) { const float s1 = wave_sum(p.in[I_L0_LQ1][lane] * p.in[I_L0_LK1][lane]), s2 = wave_sum(p.in[I_L0_LQ2][lane] * p.in[I_L0_LK2][lane]);
                if (lane == 0) *(float*)(ws + WS_MOD + LAM_OFF) = expf(s1) - expf(s2) + 0.2f; }
            continue;
        }
        const int l = u / 96, col0 = (u % 96) * 64;
        const float* wmod = p.in[l ? I_L1_WMOD : I_L0_WMOD]; const float* bmod = p.in[l ? I_L1_BMOD : I_L0_BMOD];
        float* mod = (float*)(ws + WS_MOD + (l ? MOD1_OFF : MOD0_OFF));
        for (int idx = tid; idx < 17 * 1024; idx += 512) { const float v = idx < 16 * 1024 ? p.in[I_C][idx] : p.in[I_CCTX][idx - 16 * 1024]; S[idx] = silu_f(v); }
        __syncthreads();
        float acc[17];
#pragma unroll
        for (int r = 0; r < 17; ++r) acc[r] = 0.f;
        const int kb = wave * 128;
#pragma unroll 1
        for (int kk = 0; kk < 128; kk += 8) {
            float wv[8];
#pragma unroll
            for (int i = 0; i < 8; ++i) wv[i] = wmod[(size_t)(kb + kk + i) * 6144 + col0 + lane];
#pragma unroll
            for (int q = 0; q < 2; ++q)
#pragma unroll
                for (int r = 0; r < 17; ++r) { const f32x4 sv = *(const LAS f32x4*)(S + r * 1024 + kb + kk + 4 * q); acc[r] += sv[0] * wv[4 * q] + sv[1] * wv[4 * q + 1] + sv[2] * wv[4 * q + 2] + sv[3] * wv[4 * q + 3]; }
        }
#pragma unroll
        for (int r = 0; r < 17; ++r) red[(wave * 17 + r) * 64 + lane] = acc[r];
        __syncthreads();
        for (int idx = tid; idx < 17 * 64; idx += 512) { const int r = idx >> 6, ln = idx & 63; float s = bmod[col0 + ln];
#pragma unroll
            for (int w = 0; w < 8; ++w) s += red[(w * 17 + r) * 64 + ln];
            if (r < 16 || l == 0) mod[(size_t)r * 6144 + col0 + ln] = s; }
        __syncthreads();
    }
    constexpr int IT_IN0 = (DM / 256) * (ZP0 / 128), IT_OUT = (DM / 256) * (DM / 128), IT_IN1 = (DM / 256) * (ZP1 / 128);
    for (int it = (blockIdx.x + G - 193 % G) % G; it < IT_IN0 + 2 * IT_OUT + IT_IN1; it += G) {
        int r = it;
        if (r < IT_IN0) { cvt_block<false>(p.in[I_L0_WIN], DM, ZP0, (f16*)(ws + WS_WIN0), MapRope{}, r, tid, lds); continue; } r -= IT_IN0;
        if (r < IT_OUT) { cvt_block<false>(p.in[I_L0_WOUT], DM, DM, (f16*)(ws + WS_WOUT0), MapPlain{}, r, tid, lds); continue; } r -= IT_OUT;
        if (r < IT_IN1) { cvt_block<false>(p.in[I_L1_WIN], DM, ZP1, (f16*)(ws + WS_WIN1), MapL1In{}, r, tid, lds); continue; } r -= IT_IN1;
        cvt_block<false>(p.in[I_L1_WOUT], DM, DM, (f16*)(ws + WS_WOUT1), MapPlain{}, r, tid, lds);
    }
    if (N_LAUNCH_MODE != 1) cvt_moe(p.in[I_L0_W1], p.in[I_L0_W3], p.in[I_L0_W2], (f16*)(ws + WS_W13), (f16*)(ws + WS_W2), tid, lds);
}

struct NormArgs {
    const float* src;
    const f16* src16;
    f16* xout;
    const f16* y2; const short* inv; const float* gate2;
    const float* gain;
    const float* shift; const float* scale; int mstride;
    f16* hout;
    float* fout;
    const float* wr; float* aff;
    bool hbf;
};

template <int R, bool RT = false>
__device__ __forceinline__ void norm_phase(const NormArgs& a, LAS unsigned char* lds, bool ctx_rows, const float* ctx_src, const float* ctx_shift, const float* ctx_scale) {
    const int tid = opaque_tid(), lane = tid & 63, wave = __builtin_amdgcn_readfirstlane(tid >> 6);
    const int G = gridDim.x;
    LAS float* wl = (LAS float*)lds;
    float ce = 0.f;
    if (a.wr) {
        if constexpr (RT) {
            const int bq = (blockIdx.x * 128) / SEQ; float cp = 0.f;
            LAS float* am = (LAS float*)(lds + 65536); LAS float* sm_ = (LAS float*)(lds + 69632);
            for (int k = tid; k < DM; k += 512) { am[k] = a.gain[k] * (a.scale[(size_t)bq * a.mstride + k] + 1.f); sm_[k] = a.shift[(size_t)bq * a.mstride + k]; }
            __syncthreads();
#pragma unroll 16
            for (int idx = tid; idx < 16384; idx += 512) { const int k = idx >> 4, e = idx & 15; const float w = a.wr[idx];
                const float wp = am[k] * w; const f16 whi = (f16)wp, wlo = (f16)(wp - (float)whi);
                const int off = e * 2048 + (((k >> 3) ^ e) << 4) + (k & 7) * 2;
                *(LAS f16*)(lds + off) = whi; *(LAS f16*)(lds + 32768 + off) = wlo; cp += sm_[k] * w; }
            cp += __shfl_xor(cp, 16); cp += __shfl_xor(cp, 32);
            LAS float* cpart = (LAS float*)(lds + 132096);
            if (lane < 16) cpart[wave * 16 + lane] = cp;
            __syncthreads();
#pragma unroll
            for (int w8 = 0; w8 < 8; ++w8) ce += cpart[w8 * 16 + (lane & 15)];
        } else {
            for (int idx = tid; idx < 16384; idx += 512) { const int k = idx >> 4, e = idx & 15; wl[e * 1028 + k] = a.wr[idx]; }
            __syncthreads();
        }
    }
    const int gw = blockIdx.x * 8 + wave, NGW = G * 8;
    for (int chunk = gw; chunk < NTOK / 16; chunk += NGW) {
        const int row0 = chunk * 16, b = row0 / SEQ;
        f32x4 A[4], Sh[4], G2[4];
#pragma unroll
        for (int j = 0; j < 4; ++j) { const int c = 4 * lane + 256 * j; const f32x4 g = *(const f32x4*)(a.gain + c);
            if (a.shift) { const f32x4 sc = *(const f32x4*)(a.scale + (size_t)b * a.mstride + c); A[j] = g * (sc + 1.f); Sh[j] = *(const f32x4*)(a.shift + (size_t)b * a.mstride + c); }
            else { A[j] = g; Sh[j] = (f32x4){0.f, 0.f, 0.f, 0.f}; }
            if (a.y2) G2[j] = *(const f32x4*)(a.gate2 + (size_t)b * 6144 + c); else G2[j] = (f32x4){0.f, 0.f, 0.f, 0.f}; }
        int ipk[4] = {-1, -1, -1, -1};
        if (a.y2) {
#pragma unroll
            for (int i = 0; i < 4; ++i) ipk[i] = a.inv[((size_t)b * NE + (lane & 15)) * SEQ + ((row0 + 4 * i + (lane >> 4)) & (SEQ - 1))]; }
        u32x2 xp[RT ? 4 : 1][4][3]; float rsel[4] = {0.f, 0.f, 0.f, 0.f};
        LAS unsigned char* hs = wave < 7 ? lds + 65536 + wave * 8448 : lds + 132608;
#pragma unroll (RT ? 4 : 1)
        for (int rr = 0; rr < 16; rr += R) {
            if constexpr (RT) asm volatile("" ::: "memory");
            f32x4 v[R][4];
            int sl[R];
#pragma unroll
            for (int q = 0; q < R; ++q) { sl[q] = -1; if (a.y2) { const int r = rr + q; const int pk = r < 4 ? ipk[0] : (r < 8 ? ipk[1] : (r < 12 ? ipk[2] : ipk[3]));
                    const int got = __shfl(pk, (lane & 15) + 16 * (r & 3)); sl[q] = lane < 16 ? got : -1; } }
#pragma unroll
            for (int q = 0; q < R; ++q) { const int row = row0 + rr + q;
                if (a.src16) { const f16* xr = a.src16 + (size_t)row * DM;
#pragma unroll
                    for (int j = 0; j < 4; ++j) { const f16x4 t = *(const f16x4*)(xr + 4 * lane + 256 * j); v[q][j] = (f32x4){(float)t[0], (float)t[1], (float)t[2], (float)t[3]};
                        if constexpr (RT) { if (j == 0) *(LAS u32x2*)(hs + (rr + q) * 528 + 8 * lane) = __builtin_bit_cast(u32x2, t);
                            else xp[rr / 4][q][j - 1] = __builtin_bit_cast(u32x2, t); } } }
                else { const float* xr = a.src + (size_t)row * DM;
#pragma unroll
                    for (int j = 0; j < 4; ++j) v[q][j] = *(const f32x4*)(xr + 4 * lane + 256 * j); } }
            if (a.y2) {
                unsigned long long mask[R]; int ee[R][4]; float wgt[R][4]; f16x4 ld[R][4][4];
                int cnt[R];
#pragma unroll
                for (int q = 0; q < R; ++q) { mask[q] = __ballot(sl[q] >= 0); cnt[q] = __builtin_popcountll(mask[q]);
#pragma unroll
                    for (int i = 0; i < 4; ++i) { if (mask[q]) { ee[q][i] = __builtin_ctzll(mask[q]); mask[q] &= mask[q] - 1; wgt[q][i] = 1.f; } else { ee[q][i] = i ? ee[q][0] : 0; wgt[q][i] = 0.f; } }
#pragma unroll
                    for (int i = 0; i < 4; ++i) {
                        if (i < cnt[q]) { int slot = __shfl(sl[q], ee[q][i]); slot = slot < 0 ? 0 : slot; const f16* yr = a.y2 + ((size_t)ee[q][i] * EROWS + b * CAP + slot) * DM + 4 * lane;
#pragma unroll
                            for (int j = 0; j < 4; ++j) ld[q][i][j] = *(const f16x4*)(yr + 256 * j); } } }
#pragma unroll
                for (int q = 0; q < R; ++q) { const int row = row0 + rr + q;
                    f32x4 cs[4];
#pragma unroll
                    for (int j = 0; j < 4; ++j) cs[j] = (f32x4){0.f, 0.f, 0.f, 0.f};
#pragma unroll
                    for (int i = 0; i < 4; ++i) if (i < cnt[q]) {
#pragma unroll
                        for (int j = 0; j < 4; ++j) { cs[j][0] += (float)ld[q][i][j][0]; cs[j][1] += (float)ld[q][i][j][1]; cs[j][2] += (float)ld[q][i][j][2]; cs[j][3] += (float)ld[q][i][j][3]; } }
                    while (mask[q]) {
                        const int e2 = __builtin_ctzll(mask[q]); mask[q] &= mask[q] - 1; const int slot = __shfl(sl[q], e2); const f16* yr = a.y2 + ((size_t)e2 * EROWS + b * CAP + slot) * DM + 4 * lane;
#pragma unroll
                        for (int j = 0; j < 4; ++j) { const f16x4 t = *(const f16x4*)(yr + 256 * j); cs[j][0] += (float)t[0]; cs[j][1] += (float)t[1]; cs[j][2] += (float)t[2]; cs[j][3] += (float)t[3]; }
                    }
                    f16* xo = a.xout + (size_t)row * DM;
#pragma unroll
                    for (int j = 0; j < 4; ++j) { v[q][j] = v[q][j] + G2[j] * cs[j]; if (!a.fout) { u32x2 w; w.x = pkh(v[q][j][0], v[q][j][1]); w.y = pkh(v[q][j][2], v[q][j][3]); *(u32x2*)(xo + 4 * lane + 256 * j) = w; } }
                }
            }
            float rstd[R];
#pragma unroll
            for (int q = 0; q < R; ++q) { float ss = 0.f;
#pragma unroll
                for (int j = 0; j < 4; ++j) ss += (v[q][j][0] * v[q][j][0] + v[q][j][1] * v[q][j][1]) + (v[q][j][2] * v[q][j][2] + v[q][j][3] * v[q][j][3]);
                rstd[q] = __builtin_amdgcn_rsqf(wave_sum(ss) * (1.f / DM) + EPS);
                if constexpr (RT) rsel[q] = ((lane >> 4) == rr / 4) ? rstd[q] : rsel[q]; }
#pragma unroll
            for (int q = 0; q < R; ++q) { const int row = row0 + rr + q;
#pragma unroll
                for (int j = 0; j < 4; ++j) v[q][j] = (v[q][j] * rstd[q]) * A[j] + Sh[j];
                if (a.fout) {
#pragma unroll
                    for (int j = 0; j < 4; ++j) *(f32x4*)(a.fout + (size_t)row * DM + 4 * lane + 256 * j) = v[q][j];
                }
                if (a.hout) {
#pragma unroll
                    for (int j = 0; j < 4; ++j) { u32x2 w; if (a.hbf) { w.x = pkb(v[q][j][0], v[q][j][1]); w.y = pkb(v[q][j][2], v[q][j][3]); } else { w.x = pkh(v[q][j][0], v[q][j][1]); w.y = pkh(v[q][j][2], v[q][j][3]); } *(u32x2*)(a.hout + (size_t)row * DM + 4 * lane + 256 * j) = w; }
                }
            }
            if (!RT && a.wr) {
#pragma unroll 1
                for (int q = 0; q < R; ++q) {
                    float lg[16];
                    f32x4 h0 = v[0][0], h1 = v[0][1], h2 = v[0][2], h3 = v[0][3];
#pragma unroll
                    for (int qq = 1; qq < R; ++qq) if (q == qq) { h0 = v[qq][0]; h1 = v[qq][1]; h2 = v[qq][2]; h3 = v[qq][3]; }
#pragma unroll
                    for (int e = 0; e < 16; ++e) { const LAS float* wp = wl + e * 1028 + 4 * lane;
                        const f32x4 w0 = *(const LAS f32x4*)(wp), w1 = *(const LAS f32x4*)(wp + 256), w2 = *(const LAS f32x4*)(wp + 512), w3 = *(const LAS f32x4*)(wp + 768);
                        lg[e] = ((h0[0] * w0[0] + h0[1] * w0[1]) + (h0[2] * w0[2] + h0[3] * w0[3])) + ((h1[0] * w1[0] + h1[1] * w1[1]) + (h1[2] * w1[2] + h1[3] * w1[3]))
                              + ((h2[0] * w2[0] + h2[1] * w2[1]) + (h2[2] * w2[2] + h2[3] * w2[3])) + ((h3[0] * w3[0] + h3[1] * w3[1]) + (h3[2] * w3[2] + h3[3] * w3[3]));
                        asm volatile("" ::: "memory"); }
#pragma unroll
                    for (int i = 0; i < 8; ++i) { const bool hi = lane & 32; const float send = hi ? lg[i] : lg[i + 8], keep = hi ? lg[i + 8] : lg[i]; lg[i] = keep + __shfl_xor(send, 32); }
#pragma unroll
                    for (int i = 0; i < 4; ++i) { const bool hi = lane & 16; const float send = hi ? lg[i] : lg[i + 4], keep = hi ? lg[i + 4] : lg[i]; lg[i] = keep + __shfl_xor(send, 16); }
#pragma unroll
                    for (int i = 0; i < 2; ++i) { const bool hi = lane & 8; const float send = hi ? lg[i] : lg[i + 2], keep = hi ? lg[i + 2] : lg[i]; lg[i] = keep + __shfl_xor(send, 8); }
                    { const bool hi = lane & 4; const float send = hi ? lg[0] : lg[1], keep = hi ? lg[1] : lg[0]; lg[0] = keep + __shfl_xor(send, 4); }
                    float lv = lg[0]; lv += __shfl_xor(lv, 2); lv += __shfl_xor(lv, 1);
                    float mx = lv;
#pragma unroll
                    for (int o = 4; o < 64; o <<= 1) mx = fmaxf(mx, __shfl_xor(mx, o));
                    const float ex = expf(lv - mx); float sm = ex;
#pragma unroll
                    for (int o = 4; o < 64; o <<= 1) sm += __shfl_xor(sm, o);
                    const int row = row0 + rr + q, t = row & (SEQ - 1), e = (lane >> 2) & 15;
                    if ((lane & 3) == 0) a.aff[((size_t)b * NE + e) * SEQ + t] = ex / sm;
                }
            }
        }
        if constexpr (RT) {
            const int i16 = lane & 15, c4 = lane >> 4;
            const LAS unsigned char* ap = hs + i16 * 528 + 16 * c4; const LAS unsigned char* bp = lds + i16 * 2048;
            const int xa = (c4 ^ i16) << 4;
            f32x4 acc0 = {0.f, 0.f, 0.f, 0.f}, acc1 = acc0, acc2 = acc0, acc3 = acc0;
#pragma unroll
            for (int j = 0; j < 4; ++j) {
#pragma unroll
                for (int g = 0; g < 4; ++g)
#pragma unroll
                    for (int q = 0; q < 4; ++q) { const int row = 4 * g + q; if (j > 0) *(LAS u32x2*)(hs + row * 528 + 8 * lane) = xp[g][q][j > 0 ? j - 1 : 0]; }
#pragma unroll
                for (int s8 = 0; s8 < 8; ++s8) {
                    if ((s8 & 3) == 0) asm volatile("" ::: "memory");
                    const f16x8 Af = *(const LAS f16x8*)(ap + 64 * s8);
                    const f16x8 Bh = *(const LAS f16x8*)(bp + ((512 * j + 64 * s8) ^ xa)), Bl = *(const LAS f16x8*)(bp + 32768 + ((512 * j + 64 * s8) ^ xa));
                    if (s8 & 1) { acc1 = __builtin_amdgcn_mfma_f32_16x16x32_f16(Af, Bh, acc1, 0, 0, 0); acc3 = __builtin_amdgcn_mfma_f32_16x16x32_f16(Af, Bl, acc3, 0, 0, 0); }
                    else        { acc0 = __builtin_amdgcn_mfma_f32_16x16x32_f16(Af, Bh, acc0, 0, 0, 0); acc2 = __builtin_amdgcn_mfma_f32_16x16x32_f16(Af, Bl, acc2, 0, 0, 0); } }
            }
            const f32x4 d4 = (acc0 + acc1) + (acc2 + acc3);
            f32x4 o4;
#pragma unroll
            for (int r = 0; r < 4; ++r) { const float lgt = rsel[r] * d4[r] + ce; float mx = lgt;
#pragma unroll
                for (int o = 1; o < 16; o <<= 1) mx = fmaxf(mx, __shfl_xor(mx, o));
                const float ex = expf(lgt - mx); float sm = ex;
#pragma unroll
                for (int o = 1; o < 16; o <<= 1) sm += __shfl_xor(sm, o);
                o4[r] = ex / sm; }
            *(f32x4*)(a.aff + ((size_t)b * NE + i16) * SEQ + (row0 & (SEQ - 1)) + 4 * c4) = o4;
        }
    }
    if (ctx_rows) {
        f32x4 A[4], Sh[4];
#pragma unroll
        for (int j = 0; j < 4; ++j) { const int c = 4 * lane + 256 * j; A[j] = *(const f32x4*)(a.gain + c) * (*(const f32x4*)(ctx_scale + c) + 1.f); Sh[j] = *(const f32x4*)(ctx_shift + c); }
        for (int row = gw; row < NCTX; row += NGW) {
            f32x4 v[4]; float ss = 0.f;
#pragma unroll
            for (int j = 0; j < 4; ++j) { v[j] = *(const f32x4*)(ctx_src + (size_t)row * DM + 4 * lane + 256 * j); ss += (v[j][0] * v[j][0] + v[j][1] * v[j][1]) + (v[j][2] * v[j][2] + v[j][3] * v[j][3]); }
            const float rstd = __builtin_amdgcn_rsqf(wave_sum(ss) * (1.f / DM) + EPS);
#pragma unroll
            for (int j = 0; j < 4; ++j) { const f32x4 h = (v[j] * rstd) * A[j] + Sh[j]; u32x2 w; w.x = pkh(h[0], h[1]); w.y = pkh(h[2], h[3]); *(u32x2*)(a.hout + (size_t)(NTOK + row) * DM + 4 * lane + 256 * j) = w; }
        }
    }
    __syncthreads();
}

__device__ __forceinline__ void topk_phase(const float* aff, int* idx, float* gv, short* inv, const f16* H, f16* XIN, LAS unsigned char* lds) {
    const int tid = opaque_tid(), lane = tid & 63, wave = __builtin_amdgcn_readfirstlane(tid >> 6);
    LAS unsigned long long* key = (LAS unsigned long long*)lds;
    for (int u = blockIdx.x; u < NB * NE; u += gridDim.x) {
        const int b = u / NE, e = u % NE;
        const float* av = aff + (size_t)u * SEQ;
        for (int t = tid; t < SEQ; t += 512) key[t] = ((unsigned long long)(~__float_as_uint(av[t])) << 32) | (unsigned)t;
        __syncthreads();
        bool prev_big = false;
        for (int k = 2; k <= SEQ; k <<= 1)
            for (int j = k >> 1; j > 0; j >>= 1) {
                const bool big = j >= 64;
                if (big || prev_big) __syncthreads();
                prev_big = big;
#pragma unroll
                for (int pp = 0; pp < 2; ++pp) { const int pr = tid + pp * 512; const int i = ((pr & ~(j - 1)) << 1) | (pr & (j - 1)), i2 = i | j;
                    const unsigned long long x = key[i], y = key[i2]; const bool up = (i & k) == 0;
                    if ((x > y) == up) { key[i] = y; key[i2] = x; } }
                asm volatile("" ::: "memory");
            }
        __syncthreads();
        for (int r = tid; r < SEQ; r += 512) { const unsigned long long kk = key[r]; const int t = (int)(unsigned)kk;
            inv[(size_t)u * SEQ + t] = (short)(r < CAP ? r : -1);
            if (r < CAP) { idx[u * CAP + r] = t; gv[u * CAP + r] = __uint_as_float(~(unsigned)(kk >> 32)); } }
        __syncthreads();
    }
}

namespace at {
constexpr int SLOT = 32768, NSLOT = 4;
constexpr int RPB_OFF = 132096;
constexpr float THR = 8.f;
typedef _Float16 v4h __attribute__((ext_vector_type(4)));
__device__ __forceinline__ int fsw(int row) { return ((row & 3) << 2) | ((row >> 2) & 3); }

__device__ __forceinline__ void glds16(const void* gsrc, unsigned lds_dst) { unsigned keep;
    asm volatile("s_mov_b32 %0, m0\n\ts_mov_b32 m0, %2\n\ts_nop 0\n\tglobal_load_lds_dwordx4 %1, off\n\ts_mov_b32 m0, %0" : "=&s"(keep) : "v"(gsrc), "s"(lds_dst) : "memory"); }
__device__ __forceinline__ void dma_tile(const f16* Z, long rowbase, int kcol, int vcol, LAS unsigned char* slot, int wave, int lane) {
    const unsigned sbase = (unsigned)__builtin_amdgcn_readfirstlane((int)(unsigned)(uintptr_t)slot);
#pragma unroll
    for (int i = 0; i < 2; ++i) { const int piece = wave + 8 * i, row = 4 * piece + (lane >> 4), c = (lane & 15) ^ fsw(row);
        const f16* gp = Z + (size_t)(rowbase + row) * ZP0 + 8 * c;
        glds16(gp + kcol, sbase + piece * 1024);
        glds16(gp + vcol, sbase + 16384 + piece * 1024); }
}
#define AT_WAIT(n) asm volatile("s_waitcnt vmcnt(" #n ") lgkmcnt(0)" ::: "memory")
__device__ __forceinline__ void wait_tile(int younger) { if (younger >= 2) AT_WAIT(8); else if (younger == 1) AT_WAIT(4); else AT_WAIT(0); }

template <int NDT> struct Addr { int k[4]; int v[NDT][2]; };
template <int NDT>
__device__ __forceinline__ Addr<NDT> make_addr(int kb0, int kchunk0, int vchunk0, int lane) {
    Addr<NDT> a; const int r32 = lane & 31, hh = lane >> 5, i = lane & 15, q_ = i >> 2, p_ = i & 3, g1 = (lane >> 4) & 1;
    const int kr = kb0 + r32, fk = fsw(kr);
#pragma unroll
    for (int st = 0; st < 4; ++st) a.k[st] = kr * 256 + 16 * ((kchunk0 + 2 * st + hh) ^ fk);
    const int vr = kb0 + 4 * hh + q_, f0 = fsw(vr), f1 = fsw(vr + 8);
#pragma unroll
    for (int dt = 0; dt < NDT; ++dt) { const int c = vchunk0 + 4 * dt + 2 * g1 + (p_ >> 1);
        a.v[dt][0] = 16384 + vr * 256 + 16 * (c ^ f0) + 8 * (p_ & 1); a.v[dt][1] = 16384 + (vr + 8) * 256 + 16 * (c ^ f1) + 8 * (p_ & 1); }
    return a;
}
#define AT_SCHED() __builtin_amdgcn_sched_barrier(0)
__device__ __forceinline__ void store_pair16(f16* rowp, u32x2 a, u32x2 b, int hh) {
    auto r0 = __builtin_amdgcn_permlane32_swap(a.x, b.x, false, false); auto r1 = __builtin_amdgcn_permlane32_swap(a.y, b.y, false, false);
    u32x4 w; w.x = r0[0]; w.y = r1[0]; w.z = r0[1]; w.w = r1[1];
    *(u32x4*)(rowp + 8 * hh) = w;
}
template <int NDT>
__device__ __forceinline__ void load_k(LAS unsigned char* slot, const Addr<NDT>& a, int off, f16x8* kf) {
#pragma unroll
    for (int st = 0; st < 4; ++st) kf[st] = *(const LAS f16x8*)(slot + a.k[st] + off);
}
template <int NDT>
__device__ __forceinline__ void load_v(LAS unsigned char* slot, const Addr<NDT>& a, int off, f16x8* vf) {
#pragma unroll
    for (int s2 = 0; s2 < 2; ++s2)
#pragma unroll
        for (int dt = 0; dt < NDT; ++dt) {
            const v4h lo = __builtin_bit_cast(v4h, __builtin_amdgcn_ds_read_tr16_b64_v4i16((LAS s16x4*)(slot + a.v[dt][0] + off + s2 * 4096)));
            const v4h hi = __builtin_bit_cast(v4h, __builtin_amdgcn_ds_read_tr16_b64_v4i16((LAS s16x4*)(slot + a.v[dt][1] + off + s2 * 4096)));
            vf[s2 * NDT + dt] = (f16x8){lo[0], lo[1], lo[2], lo[3], hi[0], hi[1], hi[2], hi[3]};
        }
}
__device__ __forceinline__ f32x16 qk32(const f16x8* kf, const f16x8 (&qf)[4], const f32x16& negm) {
    f32x16 s = __builtin_amdgcn_mfma_f32_32x32x16_f16(kf[0], qf[0], negm, 0, 0, 0);
#pragma unroll
    for (int st = 1; st < 4; ++st) s = __builtin_amdgcn_mfma_f32_32x32x16_f16(kf[st], qf[st], s, 0, 0, 0);
    return s;
}
__device__ __forceinline__ float max3f(float a, float b, float c) { float r; asm("v_max3_f32 %0, %1, %2, %3" : "=v"(r) : "v"(a), "v"(b), "v"(c)); return r; }
template <int NDT>
__device__ __forceinline__ void pv32(const f16x8* vf, const f32x16& p, f32x16 (&o)[NDT]) {
#pragma unroll
    for (int s2 = 0; s2 < 2; ++s2) {
        f16x8 pb;
#pragma unroll
        for (int j = 0; j < 8; ++j) pb[j] = (f16)p[8 * s2 + j];
#pragma unroll
        for (int dt = 0; dt < NDT; ++dt) o[dt] = __builtin_amdgcn_mfma_f32_32x32x16_f16(vf[s2 * NDT + dt], pb, o[dt], 0, 0, 0);
    }
}
__device__ __forceinline__ float rowmax16(const f32x16& s) { float a = max3f(s[0], s[1], s[2]), b = max3f(s[3], s[4], s[5]);
    a = max3f(a, s[6], s[7]); b = max3f(b, s[8], s[9]); a = max3f(a, s[10], s[11]); b = max3f(b, s[12], s[13]); a = max3f(a, s[14], s[15]); return fmaxf(a, b); }
template <int NDT>
__device__ __forceinline__ float rescale(float mx, float& m, float& l, f32x16 (&o)[NDT], f32x16& negm, bool& started) {
    const bool quiet = started ? (mx <= THR) : (mx == -INFINITY);
    if (__all(quiet)) return 0.f;
    float d = 0.f, alpha = 1.f;
    if (started) { d = fmaxf(mx, 0.f); alpha = __builtin_amdgcn_exp2f(-d); }
    else if (mx > -INFINITY) { d = mx; started = true; }
    m += d; l *= alpha;
#pragma unroll
    for (int dt = 0; dt < NDT; ++dt)
#pragma unroll
        for (int r = 0; r < 16; ++r) o[dt][r] *= alpha;
#pragma unroll
    for (int r = 0; r < 16; ++r) negm[r] = -m;
    return d;
}
__device__ __forceinline__ float expsum(f32x16& s, float d) { float ps = 0.f;
    if (__any(d != 0.f)) {
#pragma unroll
        for (int r = 0; r < 16; ++r) s[r] -= d; }
#pragma unroll
    for (int r = 0; r < 16; ++r) { s[r] = __builtin_amdgcn_exp2f(s[r]); ps += s[r]; }
    return ps; }
template <int NDT>
__device__ __forceinline__ void step64(LAS unsigned char* slot, const Addr<NDT>& a, const f16x8 (&qf)[4], f32x16 (&o)[NDT], float& m, float& l, f32x16& negm, bool& started) {
    f16x8 kf[8], va[2 * NDT], vb[2 * NDT];
    load_k<NDT>(slot, a, 0, kf); load_k<NDT>(slot, a, 8192, kf + 4);
    load_v<NDT>(slot, a, 0, va);
    AT_SCHED();
    f32x16 s0 = qk32(kf, qf, negm), s1 = qk32(kf + 4, qf, negm);
    AT_SCHED();
    load_v<NDT>(slot, a, 8192, vb);
    float mx = fmaxf(rowmax16(s0), rowmax16(s1)); mx = fmaxf(mx, __shfl_xor(mx, 32));
    const float d = rescale<NDT>(mx, m, l, o, negm, started);
    l += expsum(s0, d) + expsum(s1, d);
    AT_SCHED();
    pv32<NDT>(va, s0, o); pv32<NDT>(vb, s1, o);
    AT_SCHED();
}

__device__ __forceinline__ void diff_unit(int u, const f16* Z, f16* Y, const float* subln, float lam, LAS unsigned char* lds) {
    const int tid = opaque_tid(), lane = tid & 63, wave = __builtin_amdgcn_readfirstlane(tid >> 6);
    const int qb = u & 15, h = (u >> 4) & 3, b = u >> 6;
    const int map = wave >> 2, r32 = lane & 31, hh = lane >> 5;
    const long tokbase = (long)b * SEQ;
    const long qrow = tokbase + qb * 128 + (wave & 3) * 32 + r32;
    const int kcol = 1536 + 128 * h, vcol = 2560 + 128 * h;
    constexpr int NT = 36;
#define DIFF_ROWBASE(t) ((t) < 32 ? tokbase + 64 * (t) : (long)NTOK + b * CTXL + 64 * ((t) - 32))
#pragma unroll
    for (int t = 0; t < 3; ++t) dma_tile(Z, DIFF_ROWBASE(t), kcol, vcol, lds + t * SLOT, wave, lane);
    f16x8 qf[4];
#pragma unroll
    for (int st = 0; st < 4; ++st) qf[st] = *(const f16x8*)(Z + (size_t)qrow * ZP0 + 512 + 128 * h + 64 * map + 16 * st + 8 * hh);
    asm volatile("" : "+v"(qf[0]), "+v"(qf[1]), "+v"(qf[2]), "+v"(qf[3]));
    const Addr<4> ad = make_addr<4>(0, 8 * map, 0, lane);
    f32x16 o[4];
#pragma unroll
    for (int dt = 0; dt < 4; ++dt)
#pragma unroll
        for (int r = 0; r < 16; ++r) o[dt][r] = 0.f;
    float m = 0.f, l = 0.f; bool started = false;
    f32x16 negm;
#pragma unroll
    for (int r = 0; r < 16; ++r) negm[r] = 0.f;
    for (int t = 0; t < NT; ++t) {
        wait_tile(NT - 1 - t);
        __builtin_amdgcn_s_barrier();
        if (t + 3 < NT) dma_tile(Z, DIFF_ROWBASE(t + 3), kcol, vcol, lds + ((t + 3) & 3) * SLOT, wave, lane);
        step64<4>(lds + (t & 3) * SLOT, ad, qf, o, m, l, negm, started);
    }
#undef DIFF_ROWBASE
    __syncthreads();
    const float linv = 1.f / (l + __shfl_xor(l, 32));
    LAS float* cb = (LAS float*)lds + (wave & 3) * 4096;
    if (map == 1) {
#pragma unroll
        for (int dt = 0; dt < 4; ++dt)
#pragma unroll
            for (int r = 0; r < 16; ++r) cb[(dt * 16 + r) * 64 + lane] = o[dt][r] * linv;
    }
    __syncthreads();
    if (map == 0) {
        float ss = 0.f;
#pragma unroll
        for (int dt = 0; dt < 4; ++dt)
#pragma unroll
            for (int r = 0; r < 16; ++r) { const float d = o[dt][r] * linv - lam * cb[(dt * 16 + r) * 64 + lane]; o[dt][r] = d; ss += d * d; }
        ss += __shfl_xor(ss, 32);
        const float rstd = 0.8f / sqrtf(ss * (1.f / 128.f) + EPS);
        f16* yr = Y + (size_t)qrow * DM + 512 + 128 * h;
#pragma unroll
        for (int dt = 0; dt < 4; ++dt)
#pragma unroll
            for (int rp = 0; rp < 2; ++rp) { u32x2 w[2];
#pragma unroll
                for (int z = 0; z < 2; ++z) { const int rg = 2 * rp + z, d0 = 32 * dt + 8 * rg + 4 * hh; const f32x4 sg = *(const f32x4*)(subln + d0);
                    w[z].x = pkh(o[dt][4 * rg] * rstd * sg[0], o[dt][4 * rg + 1] * rstd * sg[1]); w[z].y = pkh(o[dt][4 * rg + 2] * rstd * sg[2], o[dt][4 * rg + 3] * rstd * sg[3]); }
                store_pair16(yr + 32 * dt + 16 * rp, w[0], w[1], hh); }
    }
    __syncthreads();
}

__device__ __forceinline__ void na_unit(int u, const f16* Z, f16* Y, const float* rpb, LAS unsigned char* lds) {
    const int tid = opaque_tid(), lane = tid & 63, wave = __builtin_amdgcn_readfirstlane(tid >> 6);
    const int rp = u & 15, hp = (u >> 4) & 3, b = u >> 6;
    const int hs = wave >> 2, a = wave & 3, head = 2 * hp + hs, r32 = lane & 31, hh = lane >> 5;
    const int r0 = 2 * rp, qr = r0 + (r32 >> 4), qc = 16 * a + (r32 & 15);
    const int rsq = min(max(qr - 4, 0), 24), csq = min(max(qc - 8, 0), 48);
    const int lo = min(max(r0 - 4, 0), 24), hi = min(max(r0 + 1 - 4, 0), 24) + 8;
    const int seg = (a == 0) ? 0 : (a == 1) ? 8 : (a == 2) ? 24 : 32;
    const long tokbase = (long)b * SEQ;
    const long qrow = tokbase + qr * 64 + qc;
    const int kcol = 1024 + 128 * hp, vcol = 2048 + 128 * hp;
    const int nwin = hi - lo, NT = nwin + 4;
#define NA_ROWBASE(t) ((t) < nwin ? tokbase + (lo + (t)) * 64 : (long)NTOK + b * CTXL + 64 * ((t) - nwin))
    LAS float* tab = (LAS float*)(lds + RPB_OFF);
    for (int i = tid; i < 2 * 465; i += 512) tab[i] = rpb[(2 * hp) * 465 + i] * LOG2E;
#pragma unroll
    for (int t = 0; t < 3; ++t) dma_tile(Z, NA_ROWBASE(t), kcol, vcol, lds + t * SLOT, wave, lane);
    f16x8 qf[4];
#pragma unroll
    for (int st = 0; st < 4; ++st) qf[st] = *(const f16x8*)(Z + (size_t)qrow * ZP0 + 64 * head + 16 * st + 8 * hh);
    asm volatile("" : "+v"(qf[0]), "+v"(qf[1]), "+v"(qf[2]), "+v"(qf[3]));
    const Addr<2> aw = make_addr<2>(seg, 8 * hs, 8 * hs, lane), ac = make_addr<2>(0, 8 * hs, 8 * hs, lane);
    f32x16 o[2];
#pragma unroll
    for (int dt = 0; dt < 2; ++dt)
#pragma unroll
        for (int r = 0; r < 16; ++r) o[dt][r] = 0.f;
    float m = 0.f, l = 0.f; bool started = false;
    f32x16 negm;
#pragma unroll
    for (int r = 0; r < 16; ++r) negm[r] = 0.f;
    for (int t = 0; t < NT; ++t) {
        wait_tile(NT - 1 - t);
        __builtin_amdgcn_s_barrier();
        if (t + 3 < NT) dma_tile(Z, NA_ROWBASE(t + 3), kcol, vcol, lds + ((t + 3) & 3) * SLOT, wave, lane);
        LAS unsigned char* slot = lds + (t & 3) * SLOT;
        if (t < nwin) {
            const int krow = lo + t;
            f16x8 kf[4], va[4];
            load_k<2>(slot, aw, 0, kf); load_v<2>(slot, aw, 0, va);
            AT_SCHED();
            f32x16 s = qk32(kf, qf, negm);
            const bool rowok = (krow >= rsq) && (krow < rsq + 8);
            const int rbase = (krow - qr + 7) * 31 + 15 - qc;
            float bias[16];
#pragma unroll
            for (int r = 0; r < 16; ++r) { const int kc = seg + (r & 3) + 8 * (r >> 2) + 4 * hh; bias[r] = tab[hs * 465 + min(max(rbase + kc, 0), 464)]; asm volatile("" : "+v"(bias[r])); }
#pragma unroll
            for (int r = 0; r < 16; ++r) { const int kc = seg + (r & 3) + 8 * (r >> 2) + 4 * hh; const bool ok = rowok && (kc >= csq) && (kc < csq + 16);
                s[r] = ok ? s[r] + bias[r] : -INFINITY; }
            float mx = rowmax16(s); mx = fmaxf(mx, __shfl_xor(mx, 32));
            const float d = rescale<2>(mx, m, l, o, negm, started);
            l += expsum(s, d);
            pv32<2>(va, s, o);
        } else {
            step64<2>(slot, ac, qf, o, m, l, negm, started);
        }
    }
#undef NA_ROWBASE
    const float linv = 1.f / (l + __shfl_xor(l, 32));
    f16* yr = Y + (size_t)qrow * DM + 64 * head;
#pragma unroll
    for (int dt = 0; dt < 2; ++dt)
#pragma unroll
        for (int rp = 0; rp < 2; ++rp) { u32x2 w[2];
#pragma unroll
            for (int z = 0; z < 2; ++z) { const int rg = 2 * rp + z; w[z].x = pkh(o[dt][4 * rg] * linv, o[dt][4 * rg + 1] * linv); w[z].y = pkh(o[dt][4 * rg + 2] * linv, o[dt][4 * rg + 3] * linv); }
            store_pair16(yr + 32 * dt + 16 * rp, w[0], w[1], hh); }
    __syncthreads();
}

template <class Hook>
__device__ __forceinline__ void attn_phase(const f16* Z, f16* Y, const float* rpb, const float* subln, const float* lamp, LAS unsigned char* lds, int rep, Hook& HK) {
    const float lam = *lamp;
    const int ulo = (rep == 3) ? 1024 : 0, uhi = (rep == 2) ? 1024 : 2048;
    for (int u = ulo + blockIdx.x; u < uhi; u += gridDim.x) {
        if (u < 1024) diff_unit(u, Z, Y, subln, lam, lds);
        else na_unit(u - 1024, Z, Y, rpb, lds);
        HK();
    }
}
}

__device__ __forceinline__ void conv_phase(const f16* Z1, f16* Y, const float* scw, const float* cfw, const float* cfb, const float* lng, const float* lnb, LAS unsigned char* lds) {
    const int tid = opaque_tid(), lane = tid & 63, wave = __builtin_amdgcn_readfirstlane(tid >> 6);
    LAS float* U = (LAS float*)lds;
    float cw[31];
#pragma unroll
    for (int k = 0; k < 31; ++k) cw[k] = cfw[k * 512 + tid];
    const float cb = cfb[tid];
    for (int u = blockIdx.x; u < NTOK / 32; u += gridDim.x) {
        const int b = u >> 6, t0 = (u & 63) * 32;
        const f16* zb = Z1 + (size_t)b * SEQ * gm::ZP1N;
        {
            f16x4 av[16];
#pragma unroll
            for (int pass = 0; pass < 16; ++pass) { const int row = pass * 4 + (tid >> 7), c4 = (tid & 127) * 4, tt = t0 - 15 + row; const bool ok = row < 62 && tt >= 0 && tt < SEQ;
                const int tc = ok ? tt : (t0 < SEQ ? t0 : 0);
                av[pass] = *(const f16x4*)(zb + (size_t)tc * gm::ZP1N + 512 + c4); }
#pragma unroll
            for (int pass = 0; pass < 16; ++pass) { const int row = pass * 4 + (tid >> 7), c4 = (tid & 127) * 4, tt = t0 - 15 + row; const bool ok = tt >= 0 && tt < SEQ;
                if (row < 62) { f32x4 uv;
#pragma unroll
                    for (int j = 0; j < 4; ++j) uv[j] = ok ? (float)av[pass][j] : 0.f;
                    *(LAS f32x4*)(U + row * 512 + c4) = uv; } }
        }
        __syncthreads();
        float uu[62];
#pragma unroll
        for (int i = 0; i < 62; ++i) uu[i] = U[i * 512 + tid];
        __syncthreads();
#pragma unroll
        for (int tt = 0; tt < 32; ++tt) { float v = cb;
#pragma unroll
            for (int k = 0; k < 31; ++k) v += cw[k] * uu[tt + k];
            U[tt * 512 + tid] = v; }
        __syncthreads();
#pragma unroll
        for (int q = 0; q < 4; ++q) { const int tt = wave * 4 + q, t = t0 + tt, c8 = lane * 8;
            const f32x4 x0 = *(const LAS f32x4*)(U + tt * 512 + c8), x1 = *(const LAS f32x4*)(U + tt * 512 + c8 + 4);
            float x[8] = {x0[0], x0[1], x0[2], x0[3], x1[0], x1[1], x1[2], x1[3]};
            float s = 0.f;
#pragma unroll
            for (int j = 0; j < 8; ++j) s += x[j];
            const float mean = wave_sum(s) * (1.f / 512.f); float s2 = 0.f;
#pragma unroll
            for (int j = 0; j < 8; ++j) { x[j] -= mean; s2 += x[j] * x[j]; }
            const float rstd = __builtin_amdgcn_rsqf(wave_sum(s2) * (1.f / 512.f) + EPS);
            const f32x4 g0 = *(const f32x4*)(lng + c8), g1 = *(const f32x4*)(lng + c8 + 4), b0 = *(const f32x4*)(lnb + c8), b1 = *(const f32x4*)(lnb + c8 + 4);
            const float gg[8] = {g0[0], g0[1], g0[2], g0[3], g1[0], g1[1], g1[2], g1[3]}, bb[8] = {b0[0], b0[1], b0[2], b0[3], b1[0], b1[1], b1[2], b1[3]};
            float yd[8];
#pragma unroll
            for (int j = 0; j < 8; ++j) yd[j] = silu_f(x[j] * rstd * gg[j] + bb[j]);
            f16* yr = Y + ((size_t)b * SEQ + t) * DM;
            { u32x4 w; w.x = pkh(yd[0], yd[1]); w.y = pkh(yd[2], yd[3]); w.z = pkh(yd[4], yd[5]); w.w = pkh(yd[6], yd[7]); *(u32x4*)(yr + 512 + c8) = w; }
            float cacc[8];
#pragma unroll
            for (int j = 0; j < 8; ++j) cacc[j] = 0.f;
#pragma unroll
            for (int k = 0; k < 3; ++k) { const int ts = t + k - 1;
                if (ts >= 0 && ts < SEQ) { const f16x8 in8 = *(const f16x8*)(zb + (size_t)ts * gm::ZP1N + c8);
                    const f32x4 w0 = *(const f32x4*)(scw + k * 512 + c8), w1 = *(const f32x4*)(scw + k * 512 + c8 + 4);
                    const float ww[8] = {w0[0], w0[1], w0[2], w0[3], w1[0], w1[1], w1[2], w1[3]};
#pragma unroll
                    for (int j = 0; j < 8; ++j) cacc[j] += ww[j] * (float)in8[j]; } }
            const f16x8 gb = *(const f16x8*)(zb + (size_t)t * gm::ZP1N + 1024 + c8);
            { u32x4 w; w.x = pkh((float)gb[0] * cacc[0], (float)gb[1] * cacc[1]); w.y = pkh((float)gb[2] * cacc[2], (float)gb[3] * cacc[3]);
              w.z = pkh((float)gb[4] * cacc[4], (float)gb[5] * cacc[5]); w.w = pkh((float)gb[6] * cacc[6], (float)gb[7] * cacc[7]); *(u32x4*)(yr + c8) = w; }
        }
        __syncthreads();
    }
}

constexpr int NPHASE = 18;
__global__ void __launch_bounds__(512, 2) fwd(Params p) {
    extern __shared__ __attribute__((aligned(16))) unsigned char lds_raw[];
    LAS unsigned char* lds = (LAS unsigned char*)lds_raw;
    const int tid = threadIdx.x;
    unsigned char* ws = p.ws;
    for (int u = tid; u < (LDS_BYTES - LDSCTL_OFF) / 4; u += 512) ((LAS unsigned*)(lds + LDSCTL_OFF))[u] = 0u;
    __syncthreads();
    XcdBarrier bar; bar.bar = (unsigned*)(ws + WS_CTL) + 4096; bar.x = 0; bar.st = nullptr;
    if (N_LAUNCH_MODE == 1) bar = xcd_barrier_post((unsigned*)(ws + WS_CTL) + 4096, (volatile LAS unsigned*)(lds + MISC_OFF) + 8);
    const int lo = p.ph_lo, hi = p.ph_hi, rep = p.alt;
#ifndef ONLYP
#define ONLYP -1
#endif
#define IN(k) ((ONLYP < 0 || ONLYP == (k)) && lo <= (k) && (k) < hi)
#define SEAM(k) do { if (IN(k) && IN((k) + 1)) xcd_barrier(bar); } while (0)
    const int G = gridDim.x, c = blockIdx.x;
    float* mod0 = (float*)(ws + WS_MOD + MOD0_OFF); float* mod1 = (float*)(ws + WS_MOD + MOD1_OFF);
    f16* H = (f16*)(ws + WS_H); f16* Z = (f16*)(ws + WS_Z); f16* Y = (f16*)(ws + WS_Y); f16* XIN = (f16*)(ws + WS_XIN); f16* HID = (f16*)(ws + WS_HID); f16* Y2 = (f16*)(ws + WS_Y2);
    f16* XR = (f16*)(ws + WS_XIN);
    f16* W13 = (f16*)(ws + WS_W13); f16* W2T = (f16*)(ws + WS_W2);
    float* AFF = (float*)(ws + WS_AFF); int* IDX = (int*)(ws + WS_IDX); float* GV = (float*)(ws + WS_G); short* INV = (short*)(ws + WS_INV);

    constexpr bool ILV = (N_LAUNCH_MODE == 1);
    MoeCvt cv0{p.in[I_L0_W1], p.in[I_L0_W3], p.in[I_L0_W2], W13, W2T, 0, (c >> 3) & 7, 0, tid};
    if (IN(0)) { phase_prologue(p, lds); } SEAM(0);
    if (IN(1)) { NormArgs a{}; a.src = p.in[I_X]; a.gain = p.in[I_L0_NORM1]; a.shift = mod0; a.scale = mod0 + 1024; a.mstride = 6144; a.hout = H;
        norm_phase<4>(a, lds, true, p.in[I_CTX], mod0 + 16 * 6144, mod0 + 16 * 6144 + 1024); } SEAM(1);
    if (IN(2)) { gm::Gemm g{H, (const f16*)(ws + WS_WIN0), DM, 0, 0}; gm::Order S; S.init(NROWS, ZP0, 1, G, c);
        gm::EpiInProj0 E{Z, (const float*)(ws + WS_MOD + ROPE_OFF)};
        gm::gemm_phase<false>(lds, g, S, E); } SEAM(2);
    if (IN(3)) { NoHook nh3; if (ILV) at::attn_phase(Z, Y, p.in[I_L0_RPB], p.in[I_L0_SUBLN], (const float*)(ws + WS_MOD + LAM_OFF), lds, rep, cv0);
        else at::attn_phase(Z, Y, p.in[I_L0_RPB], p.in[I_L0_SUBLN], (const float*)(ws + WS_MOD + LAM_OFF), lds, rep, nh3);
        if (ILV) cv0.finish(); } SEAM(3);
    if (IN(4)) { gm::Gemm g{Y, (const f16*)(ws + WS_WOUT0), DM, 0, 0}; gm::Order S; S.init(NTOK, DM, 1, G, c);
        gm::EpiResGate<false> E{p.in[I_X], XR, mod0 + 2048, 6144};
        gm::gemm_phase<false>(lds, g, S, E); } SEAM(4);
    if (IN(5)) { NormArgs a{}; a.src16 = XR; a.gain = p.in[I_L0_NORM2]; a.shift = mod0 + 3072; a.scale = mod0 + 4096; a.mstride = 6144; a.hout = H; a.wr = p.in[I_L0_WR]; a.aff = AFF; a.hbf = MOE_BF16;
        if (G == 256 && !rep) norm_phase<4, true>(a, lds, false, nullptr, nullptr, nullptr); else norm_phase<4, false>(a, lds, false, nullptr, nullptr, nullptr); } SEAM(5);
    if (IN(6)) { topk_phase(AFF, IDX, GV, INV, H, XIN, lds); } SEAM(6);
    if (IN(7)) { gm::Gemm g{H, W13, DM, 0, (long)2 * DE * DM, IDX}; gm::Order S; S.init(EROWS, 2 * DE, NE, G, c);
        gm::EpiSwiGLU E{HID}; gm::gemm_phase<MOE_BF16, true>(lds, g, S, E); } SEAM(7);
    if (IN(8)) { gm::Gemm g{HID, W2T, DE, (long)EROWS * DE, (long)DM * DE}; gm::Order S; S.init(EROWS, DM, NE, G, c, 1);
        gm::EpiRowScale E{Y2, GV};
        gm::gemm_phase<MOE_BF16>(lds, g, S, E); } SEAM(8);
    if (IN(9)) { NormArgs a{}; a.src16 = XR; a.xout = rep ? (f16*)(ws + WS_BIG) : XR; a.y2 = Y2; a.inv = INV; a.gate2 = mod0 + 5120; a.gain = p.in[I_L1_NORM1]; a.shift = mod1; a.scale = mod1 + 1024; a.mstride = 6144; a.hout = rep ? (f16*)(ws + WS_BIG + 128 * MiB) : H;
        norm_phase<2>(a, lds, false, nullptr, nullptr, nullptr);
        cvt_moe(p.in[I_L1_W1], p.in[I_L1_W3], p.in[I_L1_W2], W13, W2T, tid, lds); } SEAM(9);
    if (IN(10)) { gm::Gemm g{H, (const f16*)(ws + WS_WIN1), DM, 0, 0}; gm::Order S; S.init(NTOK, ZP1, 1, G, c);
        gm::EpiL1In E{Z};
        gm::gemm_phase<false>(lds, g, S, E); } SEAM(10);
    if (IN(11)) { conv_phase(Z, Y, p.in[I_L1_SCW], p.in[I_L1_CFW], p.in[I_L1_CFB], p.in[I_L1_LNG], p.in[I_L1_LNB], lds); } SEAM(11);
    if (IN(12)) { gm::Gemm g{Y, (const f16*)(ws + WS_WOUT1), DM, 0, 0}; gm::Order S; S.init(NTOK, DM, 1, G, c);
        gm::EpiResGate<true> E{XR, rep ? (f16*)(ws + WS_BIG) : XR, mod1 + 2048, 6144}; gm::gemm_phase<false>(lds, g, S, E); } SEAM(12);
    if (IN(13)) { NormArgs a{}; a.src16 = XR; a.gain = p.in[I_L1_NORM2]; a.shift = mod1 + 3072; a.scale = mod1 + 4096; a.mstride = 6144; a.hout = H; a.wr = p.in[I_L1_WR]; a.aff = AFF; a.hbf = MOE_BF16;
        if (G == 256 && !rep) norm_phase<4, true>(a, lds, false, nullptr, nullptr, nullptr); else norm_phase<4, false>(a, lds, false, nullptr, nullptr, nullptr); } SEAM(13);
    if (IN(14)) { topk_phase(AFF, IDX, GV, INV, H, XIN, lds); } SEAM(14);
    if (IN(15)) { gm::Gemm g{H, W13, DM, 0, (long)2 * DE * DM, IDX}; gm::Order S; S.init(EROWS, 2 * DE, NE, G, c);
        gm::EpiSwiGLU E{HID}; gm::gemm_phase<MOE_BF16, true>(lds, g, S, E); } SEAM(15);
    if (IN(16)) { gm::Gemm g{HID, W2T, DE, (long)EROWS * DE, (long)DM * DE}; gm::Order S; S.init(EROWS, DM, NE, G, c, 1);
        gm::EpiRowScale E{Y2, GV}; gm::gemm_phase<MOE_BF16>(lds, g, S, E); } SEAM(16);
    if (IN(17)) { NormArgs a{}; a.src16 = XR; a.xout = XR; a.y2 = Y2; a.inv = INV; a.gate2 = mod1 + 5120; a.gain = p.in[I_FNORM]; a.fout = rep ? (float*)(ws + WS_BIG) : p.out;
        norm_phase<2>(a, lds, false, nullptr, nullptr, nullptr); }
#undef IN
#undef SEAM
}

extern "C" void kernel_launch(void* const* d_in, const int* in_sizes, int n_in, void* d_out, int out_size, void* d_ws, size_t ws_size, hipStream_t stream) {
    static int grid = 0;
    if (grid == 0) {
        if (n_in != 36 || out_size != NTOK * DM || ws_size < WS_END) { fprintf(stderr, "kernel_launch: unexpected shapes (n_in %d out %d ws %zu need %zu)\n", n_in, out_size, ws_size, (size_t)WS_END); grid = -1; return; }
        int dev = 0, cus = 0;
        if (hipGetDevice(&dev) != hipSuccess || hipDeviceGetAttribute(&cus, hipDeviceAttributeMultiprocessorCount, dev) != hipSuccess) { grid = -1; return; }
        if (hipFuncSetAttribute((const void*)fwd, hipFuncAttributeMaxDynamicSharedMemorySize, LDS_BYTES) != hipSuccess) { fprintf(stderr, "kernel_launch: hipFuncSetAttribute failed\n"); grid = -1; return; }
        int per_cu = 0;
        if (hipOccupancyMaxActiveBlocksPerMultiprocessor(&per_cu, (const void*)fwd, 512, LDS_BYTES) != hipSuccess || per_cu < 1) fprintf(stderr, "kernel_launch: occupancy query says %d\n", per_cu);
        (void)hipGetLastError();
        grid = cus;
    }
    if (grid < 0) return;
    (void)hipMemsetAsync((char*)d_ws + WS_CTL, 0, CTL_ZERO_BYTES, stream);
    Params p{};
    for (int i = 0; i < 36; ++i) p.in[i] = (const float*)d_in[i];
    p.out = (float*)d_out; p.ws = (unsigned char*)d_ws;
#if N_LAUNCH_MODE == 1
    p.ph_lo = 0; p.ph_hi = NPHASE;
    hipLaunchKernelGGL(fwd, dim3(grid), dim3(512), LDS_BYTES, stream, p);
#else
    for (int k = 0; k < NPHASE; ++k) { p.ph_lo = k; p.ph_hi = k + 1; p.alt = 0; hipLaunchKernelGGL(fwd, dim3(grid), dim3(512), LDS_BYTES, stream, p);
        for (int r = 0; r < HOSTDUP_N; ++r) if ((HOSTDUP >> k) & 1) { p.alt = HOSTDUP_ALT; hipLaunchKernelGGL(fwd, dim3(grid), dim3(512), LDS_BYTES, stream, p); } }
#endif
}
```
